# Optimizing an MI355X kernel written in HIP

```python
import jax, jax.numpy as jnp
from jax import lax
import numpy as np

D_MODEL = 1024
BATCH = 2
SEQ = 8192
DEPTH = 2

N_EVEN = (DEPTH + 1) // 2
N_ODD = DEPTH // 2
RMS_EPS = 1e-6
A_WIDTH = D_MODEL
CONV_WIDTH = 3
B_WIDTH = D_MODEL
B_GROUPS = 8
CHUNK = 128
SGU_LN_EPS = 1e-5
C_WIDTH = D_MODEL
C_HEAD_DIM = 64
C_HEADS = C_WIDTH // C_HEAD_DIM
DECAY_LORA = 64
AAA_LORA = 64
GN_EPS = 64e-5
RWKV_STREAM = 3 * C_WIDTH + DECAY_LORA + AAA_LORA
RWKV_SPLITS = (C_WIDTH, 2 * C_WIDTH, 3 * C_WIDTH, 3 * C_WIDTH + DECAY_LORA)
D_WIDTH = D_MODEL // 2
D_GROUPS = 4
D_GROUP_DIM = D_WIDTH // D_GROUPS
EVEN_PROJ = 4 * A_WIDTH + 3 * B_WIDTH
EVEN_SPLITS = (A_WIDTH, 2 * A_WIDTH, 3 * A_WIDTH, 4 * A_WIDTH,
               4 * A_WIDTH + B_WIDTH, 4 * A_WIDTH + 2 * B_WIDTH)
ODD_PROJ = RWKV_STREAM + C_WIDTH + 2 * D_WIDTH
ODD_SPLITS = (RWKV_STREAM, RWKV_STREAM + C_WIDTH, RWKV_STREAM + C_WIDTH + D_WIDTH)

kernel_name = "hybrid_conv_sgu_rwkv7_fnet_encoder"


def rms_norm(x, g):
    xf = x.astype(jnp.float32)
    y = xf * lax.rsqrt(jnp.mean(xf * xf, axis=-1, keepdims=True) + RMS_EPS)
    return (y * g.astype(jnp.float32)).astype(x.dtype)


def layer_norm(x, g, b, eps):
    xf = x.astype(jnp.float32)
    mu = jnp.mean(xf, axis=-1, keepdims=True)
    var = jnp.mean(jnp.square(xf - mu), axis=-1, keepdims=True)
    y = (xf - mu) * lax.rsqrt(var + eps)
    return (y * g + b).astype(x.dtype)


def shift_prev(p):
    pad = [(0, 0)] * (p.ndim - 2) + [(1, 0), (0, 0)]
    return jnp.pad(p, pad)[..., :-1, :]


def shift_next(p):
    pad = [(0, 0)] * (p.ndim - 2) + [(0, 1), (0, 0)]
    return jnp.pad(p, pad)[..., 1:, :]


def short_conv_branch(h, gate_b, gate_c, conv_w):
    xc = gate_c * h
    y = conv_w[0] * shift_prev(xc) + conv_w[1] * xc + conv_w[2] * shift_next(xc)
    return gate_b * y


def chunked_sgu_branch(u, v, ln_g, ln_b, w_s, b_s):
    bsz, s, c = v.shape
    vn = layer_norm(v, ln_g, ln_b, SGU_LN_EPS)
    vc = vn.reshape(bsz, s // CHUNK, CHUNK, B_GROUPS, c // B_GROUPS)
    mixed = jnp.einsum('gij,bnjgd->bnigd', w_s, vc) + b_s.T[:, :, None]
    return u * mixed.reshape(bsz, s, c)


def wkv7_step(state, inp):
    r, w, k, v, a, b = inp
    sa = jnp.einsum('...ij,...j->...i', state, a)
    state = (state * w[..., None, :] + sa[..., :, None] * b[..., None, :]
             + v[..., :, None] * k[..., None, :])
    y = jnp.einsum('...ij,...j->...i', state, r)
    return state, y


def rwkv7_bidir_branch(p, mu, w0, w2, a0, a2, k_k, k_a, r_k, lnx_g, lnx_b):
    dtype = p.dtype
    bsz, s, _ = p.shape
    pf = p.astype(jnp.float32)
    shifted = jnp.stack([shift_prev(pf), shift_next(pf)])
    q = pf[None] + mu[:, None, None, :] * (shifted - pf[None])
    r, k, v, wd, ad = jnp.split(q, RWKV_SPLITS, axis=-1)
    z_w = w0[:, None, None, :] + jnp.einsum('dbsl,dlc->dbsc', jnp.tanh(wd), w2)
    decay = jnp.exp(-jnp.exp(-jax.nn.softplus(-z_w) - 0.5))
    a = jax.nn.sigmoid(a0[:, None, None, :] + jnp.einsum('dbsl,dlc->dbsc', ad, a2))
    heads = lambda t: t.reshape(t.shape[:3] + (C_HEADS, C_HEAD_DIM))
    kk = heads(k * k_k)
    kk = kk * lax.rsqrt(jnp.maximum(jnp.sum(kk * kk, axis=-1, keepdims=True), 1e-12))
    k = k * (1.0 + (a - 1.0) * k_a)
    r, k, v, decay, a = heads(r), heads(k), heads(v), heads(decay), heads(a)

    def to_scan(t):
        t = jnp.stack([t[0], jnp.flip(t[1], axis=1)])
        return jnp.moveaxis(t, 2, 0)

    init = jnp.zeros((2, bsz, C_HEADS, C_HEAD_DIM, C_HEAD_DIM), jnp.float32)
    xs = (to_scan(r), to_scan(decay), to_scan(k), to_scan(v), to_scan(-kk), to_scan(kk * a))
    _, y = lax.scan(wkv7_step, init, xs)
    y = jnp.moveaxis(y, 0, 2)
    y_sum = y[0] + jnp.flip(y[1], axis=1)
    out = layer_norm(y_sum, lnx_g.reshape(C_HEADS, C_HEAD_DIM),
                     lnx_b.reshape(C_HEADS, C_HEAD_DIM), GN_EPS)
    bonus = jnp.sum(r * k * r_k, axis=-1, keepdims=True) * v
    out = out + bonus[0] + bonus[1]
    return out.reshape(bsz, s, C_WIDTH).astype(dtype)


def fourier_branch(f, w_f):
    bsz, s, c = f.shape
    fg = f.reshape(bsz, s, D_GROUPS, D_GROUP_DIM).astype(jnp.float32)
    spec = jnp.fft.fft2(fg, axes=(1, 3), norm="ortho").real.astype(f.dtype)
    y = jnp.einsum('bsgd,gde->bsge', spec, w_f)
    return y.reshape(bsz, s, c)


def even_layer(h, w_in, conv_w, sgu_ln_g, sgu_ln_b, sgu_w, sgu_b, w_out):
    p = jnp.einsum('bsd,de->bse', h, w_in)
    xa, ba, ca, za, ub, vb, zb = jnp.split(p, EVEN_SPLITS, axis=-1)
    ya = short_conv_branch(xa, ba, ca, conv_w) * jax.nn.silu(za)
    yb = chunked_sgu_branch(ub, vb, sgu_ln_g, sgu_ln_b, sgu_w, sgu_b) * jax.nn.silu(zb)
    return jnp.einsum('bse,ed->bsd', jnp.concatenate([ya, yb], axis=-1), w_out)


def odd_layer(h, w_in, mu, w0, w2, a0, a2, k_k, k_a, r_k, lnx_g, lnx_b, fnet_w, w_out):
    p = jnp.einsum('bsd,de->bse', h, w_in)
    pc, zc, fd, zd = jnp.split(p, ODD_SPLITS, axis=-1)
    yc = rwkv7_bidir_branch(pc, mu, w0, w2, a0, a2, k_k, k_a, r_k, lnx_g, lnx_b) * jax.nn.silu(zc)
    yd = fourier_branch(fd, fnet_w) * jax.nn.silu(zd)
    return jnp.einsum('bse,ed->bsd', jnp.concatenate([yc, yd], axis=-1), w_out)


def setup_inputs(seed: int = 0) -> dict:
    key = jax.random.key(seed)
    ks = iter(jax.random.split(key, 32))
    nrm = lambda shape, scale: scale * jax.random.normal(next(ks), shape, jnp.float32)
    NE, NO = N_EVEN, N_ODD
    return {
        "x": nrm((BATCH, SEQ, D_MODEL), 1.0),
        "e_norm_g": 1.0 + nrm((NE, D_MODEL), 0.02),
        "e_w_in": nrm((NE, D_MODEL, EVEN_PROJ), D_MODEL ** -0.5),
        "e_conv_w": nrm((NE, CONV_WIDTH, A_WIDTH), CONV_WIDTH ** -0.5),
        "e_sgu_ln_g": 1.0 + nrm((NE, B_WIDTH), 0.02),
        "e_sgu_ln_b": nrm((NE, B_WIDTH), 0.02),
        "e_sgu_w": nrm((NE, B_GROUPS, CHUNK, CHUNK), CHUNK ** -0.5),
        "e_sgu_b": 1.0 + nrm((NE, B_GROUPS, CHUNK), 0.01),
        "e_w_out": nrm((NE, A_WIDTH + B_WIDTH, D_MODEL), (A_WIDTH + B_WIDTH) ** -0.5),
        "o_norm_g": 1.0 + nrm((NO, D_MODEL), 0.02),
        "o_w_in": nrm((NO, D_MODEL, ODD_PROJ), D_MODEL ** -0.5),
        "o_mu": jax.random.uniform(next(ks), (NO, 2, RWKV_STREAM), jnp.float32),
        "o_w0": nrm((NO, 2, C_WIDTH), 0.5),
        "o_w2": nrm((NO, 2, DECAY_LORA, C_WIDTH), 0.5 * DECAY_LORA ** -0.5),
        "o_a0": nrm((NO, 2, C_WIDTH), 0.1),
        "o_a2": nrm((NO, 2, AAA_LORA, C_WIDTH), 0.5 * AAA_LORA ** -0.5),
        "o_k_k": 0.85 + nrm((NO, C_WIDTH), 0.05),
        "o_k_a": 1.0 + nrm((NO, C_WIDTH), 0.05),
        "o_r_k": nrm((NO, C_HEADS, C_HEAD_DIM), 0.1),
        "o_lnx_g": 1.0 + nrm((NO, C_WIDTH), 0.02),
        "o_lnx_b": nrm((NO, C_WIDTH), 0.02),
        "o_fnet_w": nrm((NO, D_GROUPS, D_GROUP_DIM, D_GROUP_DIM), D_GROUP_DIM ** -0.5),
        "o_w_out": nrm((NO, C_WIDTH + D_WIDTH, D_MODEL), (C_WIDTH + D_WIDTH) ** -0.5),
        "final_norm_g": 1.0 + nrm((D_MODEL,), 0.02),
    }


def reference(x, e_norm_g, e_w_in, e_conv_w, e_sgu_ln_g, e_sgu_ln_b, e_sgu_w, e_sgu_b, e_w_out,
              o_norm_g, o_w_in, o_mu, o_w0, o_w2, o_a0, o_a2, o_k_k, o_k_a, o_r_k,
              o_lnx_g, o_lnx_b, o_fnet_w, o_w_out, final_norm_g):
    h = x
    for layer in range(DEPTH):
        i = layer // 2
        if layer % 2 == 0:
            h = h + even_layer(rms_norm(h, e_norm_g[i]), e_w_in[i], e_conv_w[i],
                               e_sgu_ln_g[i], e_sgu_ln_b[i], e_sgu_w[i], e_sgu_b[i], e_w_out[i])
        else:
            h = h + odd_layer(rms_norm(h, o_norm_g[i]), o_w_in[i], o_mu[i], o_w0[i], o_w2[i],
                              o_a0[i], o_a2[i], o_k_k[i], o_k_a[i], o_r_k[i],
                              o_lnx_g[i], o_lnx_b[i], o_fnet_w[i], o_w_out[i])
    return rms_norm(h, final_norm_g)
```

```cpp
#include <hip/hip_runtime.h>
#include <hip/hip_cooperative_groups.h>
#include <cstdio>
#include <cstdint>
namespace cg = cooperative_groups;

#ifndef N_LAUNCH_MODE
#define N_LAUNCH_MODE 1
#endif

#define LAS __attribute__((address_space(3)))
typedef _Float16 h16;
typedef _Float16 h16x8 __attribute__((ext_vector_type(8)));
typedef _Float16 h16x4 __attribute__((ext_vector_type(4)));
typedef float f32x2 __attribute__((ext_vector_type(2)));
typedef float f32x4 __attribute__((ext_vector_type(4)));
typedef float f32x16 __attribute__((ext_vector_type(16)));

constexpr int NTOK = 16384, DM = 1024, SEQ = 8192;
constexpr int LDS_BYTES = 131072;
constexpr int NPHASE = 13;
constexpr size_t MiB = 1024 * 1024;
constexpr size_t WS_W1T = 0;
constexpr size_t WS_W2T = WS_W1T + (size_t)7168 * 1024 * 2;
constexpr size_t WS_W3T = WS_W2T + (size_t)1024 * 2048 * 2;
constexpr size_t WS_W4T = WS_W3T + (size_t)5376 * 1024 * 2;
constexpr size_t WS_STATS = 32 * MiB;
constexpr size_t WS_WSH = WS_STATS + 131072;
constexpr size_t WS_CWT = WS_WSH + 262144;
constexpr size_t WS_SBON = WS_CWT + 262144;
constexpr size_t WS_XC = 36 * MiB, WS_G = 68 * MiB, WS_U = 100 * MiB, WS_V = 132 * MiB, WS_YCAT = 164 * MiB;
constexpr size_t WS_O1 = 36 * MiB, WS_PC = 68 * MiB, WS_ZCD = 168 * MiB, WS_FD = 216 * MiB;

namespace pg8 {
constexpr int BM = 256, BK = 64, HALF = 128, HTB = HALF * BK * 2, STAGE_BYTES = 8 * HTB, NXCD = 8, WGM = 8;
__host__ __device__ __forceinline__ int lds_byte(int r, int c) { const int st = (r >> 4) * 2 + (c >> 5), rr = r & 15, cc = c & 31, ob = rr * 64 + cc * 2; return st * 1024 + (ob ^ (((ob >> 9) & 1) << 5)); }
__host__ __device__ __forceinline__ void stage_rc(int b, int& R, int& C) { const int st = b / 1024, sb = b % 1024, swz = sb ^ (((sb >> 9) & 1) << 5); R = (st >> 1) * 16 + swz / 64; C = (st & 1) * 32 + (swz % 64) / 2; }
struct Unit { int pm, pn; };
struct Gemm { const h16* A; const h16* Bt; int M, N, K; };
struct StaticOrder {
    int nM, nN, nwg, G, c;
    __host__ __device__ void init(int M, int N, int G_, int c_) { nM = M / BM; nN = N / BM; nwg = nM * nN; G = G_; c = c_; }
    __host__ __device__ bool next(int i, Unit& u) const {
        const long L = (long)i * G + c; if (L >= nwg) return false;
        int wgid = (int)L; { const int q = nwg / NXCD, r = nwg % NXCD, xcd = wgid % NXCD, off = wgid / NXCD; wgid = (xcd < r ? xcd * (q + 1) : r * (q + 1) + (xcd - r) * q) + off; }
        const int nig = WGM * nN, gid = wgid / nig, fm = gid * WGM, gsz = (nM - fm) < WGM ? (nM - fm) : WGM;
        u.pm = fm + ((wgid % nig) % gsz); u.pn = (wgid % nig) / gsz; return true;
    }
};
template <class Epi>
__device__ __forceinline__ void gemm_phase(LAS unsigned char* lds, const Gemm g, const StaticOrder& S, const Epi& E) {
    const int tid = threadIdx.x, wid = __builtin_amdgcn_readfirstlane(tid >> 6), lane = tid & 63, wr = wid >> 2, wc = wid & 3, fr = lane & 15, fq = lane >> 4;
    const int K = g.K, nt = K / BK;
    unsigned voffA[2], voffB[2];
#pragma unroll
    for (int i = 0; i < 2; ++i) { int R, C; stage_rc(tid * 16 + i * 8192, R, C); voffA[i] = (unsigned)(R * K + C) * 2u; voffB[i] = voffA[i]; }
    const size_t kstep = (size_t)(BK * 2);
    const size_t hstep = (size_t)HALF * K * 2;
    const size_t tstep = 2 * hstep;
    const unsigned ldsw = (unsigned)wid * 1024u;
    const int aoff = lds_byte(wr * 64 + fr, fq * 8), boff = lds_byte(wc * 32 + fr, fq * 8);
#define PG8_SA(b, h) (((b) * 2 + (h)) * HTB)
#define PG8_SB(b, h) ((4 + (b) * 2 + (h)) * HTB)
#define PG8_STAGE(bufoff, gbase, voff) do { _Pragma("unroll") for (int _i = 0; _i < 2; ++_i) \
        __builtin_amdgcn_global_load_lds((const unsigned*)((const char*)(gbase) + (voff)[_i]), (LAS unsigned*)(lds + (bufoff) + ldsw + _i * 8192), 16, 0, 0); } while (0)
#define PG8_LDA(dst, b, h) do { _Pragma("unroll") for (int m = 0; m < 4; ++m) _Pragma("unroll") for (int k = 0; k < 2; ++k) dst[m][k] = *(const LAS h16x8*)(lds + PG8_SA(b, h) + aoff + m * 2048 + k * 1024); } while (0)
#define PG8_LDB(dst, b, h) do { _Pragma("unroll") for (int n = 0; n < 2; ++n) _Pragma("unroll") for (int k = 0; k < 2; ++k) dst[n][k] = *(const LAS h16x8*)(lds + PG8_SB(b, h) + boff + n * 2048 + k * 1024); } while (0)
#define PG8_MMA(ai, bj, At, Bt) do { __builtin_amdgcn_s_setprio(1); _Pragma("unroll") for (int m = 0; m < 4; ++m) _Pragma("unroll") for (int n = 0; n < 2; ++n) _Pragma("unroll") for (int k = 0; k < 2; ++k) \
        acc[ai][bj][m][n] = __builtin_amdgcn_mfma_f32_16x16x32_f16(Bt[n][k], At[m][k], acc[ai][bj][m][n], 0, 0, 0); __builtin_amdgcn_s_setprio(0); } while (0)
#define PG8_WAIT_V(n) asm volatile("s_waitcnt vmcnt(" #n ")" ::: "memory")
#define PG8_WAIT_L(n) asm volatile("s_waitcnt lgkmcnt(" #n ")" ::: "memory")
#define PG8_BAR __builtin_amdgcn_s_barrier()
#define PG8_SCHED __builtin_amdgcn_sched_barrier(0)
    Unit cur, nxt; int ui = 0;
    if (!S.next(0, cur)) return;
    f32x4 acc[2][2][4][2];
#pragma unroll
    for (int a = 0; a < 2; ++a)
#pragma unroll
        for (int b = 0; b < 2; ++b)
#pragma unroll
            for (int m = 0; m < 4; ++m)
#pragma unroll
                for (int n = 0; n < 2; ++n) acc[a][b][m][n] = (f32x4){0.f, 0.f, 0.f, 0.f};
    h16x8 At[4][2], B0[2][2], B1[2][2];
    const char* cA = (const char*)g.A + (size_t)cur.pm * tstep; const char* cB = (const char*)g.Bt + (size_t)cur.pn * tstep;
    PG8_STAGE(PG8_SB(0, 0), cB, voffB); PG8_STAGE(PG8_SA(0, 0), cA, voffA); PG8_STAGE(PG8_SB(0, 1), cB + hstep, voffB); PG8_STAGE(PG8_SA(0, 1), cA + hstep, voffA);
    if (wr == 1) PG8_BAR;
    PG8_WAIT_V(4); PG8_BAR;
    PG8_STAGE(PG8_SB(1, 0), cB + kstep, voffB); PG8_STAGE(PG8_SA(1, 0), cA + kstep, voffA); PG8_STAGE(PG8_SB(1, 1), cB + hstep + kstep, voffB);
    PG8_WAIT_V(6); PG8_BAR;
    for (;;) {
        const bool has_next = S.next(ui + 1, nxt);
        const char* nA = has_next ? (const char*)g.A + (size_t)nxt.pm * tstep : cA; const char* nB = has_next ? (const char*)g.Bt + (size_t)nxt.pn * tstep : cB;
        for (int t = 0; t < nt; t += 2) {
            const bool last = (t == nt - 2);
            const char* a1 = cA + (size_t)(t + 1) * kstep;
            const char* a2 = last ? nA : cA + (size_t)(t + 2) * kstep; const char* b2 = last ? nB : cB + (size_t)(t + 2) * kstep;
            const char* a3 = a2 + kstep; const char* b3 = b2 + kstep;
            PG8_LDB(B0, 0, 0); PG8_SCHED; PG8_LDA(At, 0, 0); PG8_STAGE(PG8_SA(1, 1), a1 + hstep, voffA);
            PG8_WAIT_L(8); PG8_BAR; PG8_WAIT_L(0); PG8_MMA(0, 0, At, B0); PG8_BAR; PG8_SCHED;
            PG8_LDB(B1, 0, 1); PG8_STAGE(PG8_SB(0, 0), b2, voffB);
            PG8_BAR; PG8_WAIT_L(0); PG8_MMA(0, 1, At, B1); PG8_BAR;
            PG8_LDA(At, 0, 1); PG8_STAGE(PG8_SA(0, 0), a2, voffA);
            PG8_BAR; PG8_WAIT_L(0); PG8_MMA(1, 0, At, B0); PG8_BAR; PG8_SCHED;
            PG8_STAGE(PG8_SB(0, 1), b2 + hstep, voffB);
            PG8_WAIT_V(6); PG8_BAR; PG8_MMA(1, 1, At, B1); PG8_BAR;
            PG8_LDB(B0, 1, 0); PG8_SCHED; PG8_LDA(At, 1, 0); PG8_STAGE(PG8_SA(0, 1), a2 + hstep, voffA);
            PG8_WAIT_L(8); PG8_BAR; PG8_WAIT_L(0); PG8_MMA(0, 0, At, B0); PG8_BAR; PG8_SCHED;
            PG8_LDB(B1, 1, 1); PG8_STAGE(PG8_SB(1, 0), b3, voffB);
            PG8_BAR; PG8_WAIT_L(0); PG8_MMA(0, 1, At, B1); PG8_BAR;
            PG8_LDA(At, 1, 1); PG8_STAGE(PG8_SA(1, 0), a3, voffA);
            PG8_BAR; PG8_WAIT_L(0); PG8_MMA(1, 0, At, B0); PG8_BAR; PG8_SCHED;
            PG8_STAGE(PG8_SB(1, 1), b3 + hstep, voffB);
            PG8_WAIT_V(6); PG8_BAR; PG8_MMA(1, 1, At, B1); PG8_BAR;
        }
        E(acc, cur, wr, wc, fr, fq);
        if (!has_next) break;
#pragma unroll
        for (int a = 0; a < 2; ++a)
#pragma unroll
            for (int b = 0; b < 2; ++b)
#pragma unroll
                for (int m = 0; m < 4; ++m)
#pragma unroll
                    for (int n = 0; n < 2; ++n) acc[a][b][m][n] = (f32x4){0.f, 0.f, 0.f, 0.f};
        cur = nxt; cA = nA; cB = nB; ++ui;
    }
    PG8_WAIT_V(0);
    if (wr == 0) PG8_BAR;
    PG8_BAR;
#undef PG8_SA
#undef PG8_SB
#undef PG8_STAGE
#undef PG8_LDA
#undef PG8_LDB
#undef PG8_MMA
#undef PG8_WAIT_V
#undef PG8_WAIT_L
#undef PG8_BAR
#undef PG8_SCHED
}
}

struct Params { const float* in[24]; float* out; unsigned char* ws; int ph_lo, ph_hi; };

__device__ __forceinline__ float silu_f(float x) { return x / (1.f + __expf(-x)); }
__device__ __forceinline__ float sigmoid_f(float x) { return 1.f / (1.f + __expf(-x)); }
__device__ __forceinline__ float tanh_f(float x) { return 1.f - 2.f / (__expf(2.f * x) + 1.f); }
__device__ __forceinline__ float wave_sum(float v) {
#pragma unroll
    for (int o = 1; o < 64; o <<= 1) v += __shfl_xor(v, o);
    return v;
}
template <int CTRL> __device__ __forceinline__ float dpp_f(float x) { return __int_as_float(__builtin_amdgcn_update_dpp(0, __float_as_int(x), CTRL, 0xf, 0xf, false)); }
__device__ __forceinline__ float red8(float x) {
    x += dpp_f<0xB1>(x); x += dpp_f<0x4E>(x); x += dpp_f<0x141>(x); return x;
}
__device__ __forceinline__ float red16(float x) {
    x += dpp_f<0xB1>(x); x += dpp_f<0x4E>(x); x += dpp_f<0x141>(x); x += dpp_f<0x140>(x); return x;
}

__device__ __forceinline__ int sigma1(int np) {
    const int T = np >> 8, c = np & 255;
    if (T < 16) { const int bj = c >> 7, wc = (c >> 5) & 3, n = (c >> 4) & 1, r = c & 15; return 1024 * (2 * bj + n) + 64 * T + 16 * wc + r; }
    if (T < 24) { return ((c >> 7) ? 6144 : 4096) + 128 * (T - 16) + (c & 127); }
    return 5120 + 256 * (T - 24) + c;
}

template <int MODE>
__device__ __forceinline__ void tr_item(const float* W, int K, int N, h16* WT, LAS float* scr, int item, int nblk, int lane) {
    const int kb = item / nblk, nb = item % nblk, k0 = 64 * kb, n0 = 32 * nb;
    const int np = n0 + (lane & 31);
    const int sc = (MODE == 1) ? sigma1(np) : np;
    const bool valid = (MODE != 2) || (np < 5248);
#pragma unroll 8
    for (int i = 0; i < 32; ++i) { const int kk = 2 * i + (lane >> 5); scr[kk * 33 + (lane & 31)] = valid ? W[(size_t)(k0 + kk) * N + sc] : 0.f; }
    asm volatile("s_waitcnt lgkmcnt(0)" ::: "memory");
    const int c = lane & 7;
#pragma unroll
    for (int j = 0; j < 4; ++j) { const int n = (lane >> 3) + 8 * j; const LAS float* s = scr + (8 * c) * 33 + n;
        h16x8 o;
#pragma unroll
        for (int e = 0; e < 8; ++e) o[e] = (h16)s[e * 33];
        *(h16x8*)(WT + (size_t)(n0 + n) * K + k0 + 8 * c) = o; }
    asm volatile("s_waitcnt lgkmcnt(0)" ::: "memory");
}

__device__ __forceinline__ void rms_row_f16(const float* xr, const h16* addr, const float* g, h16* orow, int lane) {
    f32x4 v[4]; float ss = 0.f;
#pragma unroll
    for (int j = 0; j < 4; ++j) { v[j] = *(const f32x4*)(xr + 4 * lane + 256 * j);
        if (addr) { const h16x4 a = *(const h16x4*)(addr + 4 * lane + 256 * j); v[j][0] += (float)a[0]; v[j][1] += (float)a[1]; v[j][2] += (float)a[2]; v[j][3] += (float)a[3]; }
        ss += v[j][0] * v[j][0] + v[j][1] * v[j][1] + v[j][2] * v[j][2] + v[j][3] * v[j][3]; }
    const float rs = rsqrtf(wave_sum(ss) * (1.f / 1024.f) + 1e-6f);
#pragma unroll
    for (int j = 0; j < 4; ++j) { const f32x4 gg = *(const f32x4*)(g + 4 * lane + 256 * j); h16x4 o;
        o[0] = (h16)(v[j][0] * rs * gg[0]); o[1] = (h16)(v[j][1] * rs * gg[1]); o[2] = (h16)(v[j][2] * rs * gg[2]); o[3] = (h16)(v[j][3] * rs * gg[3]);
        *(h16x4*)(orow + 4 * lane + 256 * j) = o; }
}

__device__ __forceinline__ void phase0(const Params& p, LAS unsigned char* lds) {
    const int tid = threadIdx.x, lane = tid & 63, wave = tid >> 6;
    const int gw = blockIdx.x * 8 + wave, NGW = gridDim.x * 8;
    LAS float* scr = (LAS float*)(lds + wave * 8448);
    h16* W1T = (h16*)(p.ws + WS_W1T); h16* W2T = (h16*)(p.ws + WS_W2T); h16* W3T = (h16*)(p.ws + WS_W3T); h16* W4T = (h16*)(p.ws + WS_W4T);
    constexpr int I1 = 16 * 224, I2 = 32 * 32, I3 = 16 * 168, I4 = 24 * 32;
    for (int it = gw; it < I1 + I2 + I3 + I4; it += NGW) {
        int r = it;
        if (r < I1) { tr_item<1>(p.in[2], 1024, 7168, W1T, scr, r, 224, lane); continue; } r -= I1;
        if (r < I2) { tr_item<0>(p.in[8], 2048, 1024, W2T, scr, r, 32, lane); continue; } r -= I2;
        if (r < I3) { tr_item<2>(p.in[10], 1024, 5248, W3T, scr, r, 168, lane); continue; } r -= I3;
        tr_item<0>(p.in[22], 1536, 1024, W4T, scr, r, 32, lane);
    }
    h16* H0 = (h16*)p.out;
    for (int r = gw; r < NTOK; r += NGW) rms_row_f16(p.in[0] + (size_t)r * DM, nullptr, p.in[1], H0 + (size_t)r * DM, lane);
    const int gt = blockIdx.x * 512 + tid, NGT = gridDim.x * 512;
    h16* WSH = (h16*)(p.ws + WS_WSH);
    for (int i = gt; i < 8 * 128 * 128; i += NGT) WSH[i] = (h16)p.in[6][i];
    h16* CWT = (h16*)(p.ws + WS_CWT);
    const float* wf = p.in[21];
    for (int i = gt; i < 4 * 128 * 256; i += NGT) {
        const int k = i & 255, e = (i >> 8) & 127, g = i >> 15, d = k & 127; const bool sn = k >= 128;
        float s = 0.f;
        for (int dp = 0; dp < 128; ++dp) { const float fr = (float)((d * dp) & 127) * (1.f / 128.f);
            const float tw = sn ? __builtin_amdgcn_sinf(fr) : __builtin_amdgcn_cosf(fr);
            s += tw * wf[(g * 128 + dp) * 128 + e]; }
        CWT[i] = (h16)(s * 0.08838834764831845f);
    }
}

struct Epi1 {
    h16 *XC, *G, *U, *V;
    __device__ __forceinline__ void operator()(const f32x4 (&acc)[2][2][4][2], const pg8::Unit& u, int wr, int wc, int fr, int fq) const {
        const int T = u.pn; const int row0 = u.pm * 256 + wr * 64 + fr;
        if (T < 16) {
            const int ch = 64 * T + 16 * wc + 4 * fq;
#pragma unroll
            for (int ai = 0; ai < 2; ++ai)
#pragma unroll
                for (int m = 0; m < 4; ++m) { const size_t r = (size_t)(row0 + ai * 128 + m * 16);
                    const f32x4 xa = acc[ai][0][m][0], ba = acc[ai][0][m][1], ca = acc[ai][1][m][0], za = acc[ai][1][m][1];
                    h16x4 xc, gg;
#pragma unroll
                    for (int e = 0; e < 4; ++e) { xc[e] = (h16)(ca[e] * xa[e]); gg[e] = (h16)(ba[e] * silu_f(za[e])); }
                    *(h16x4*)(XC + r * 1024 + ch) = xc; *(h16x4*)(G + r * 1024 + ch) = gg; }
        } else if (T < 24) {
#pragma unroll
            for (int ai = 0; ai < 2; ++ai)
#pragma unroll
                for (int m = 0; m < 4; ++m) { const size_t r = (size_t)(row0 + ai * 128 + m * 16);
#pragma unroll
                    for (int n = 0; n < 2; ++n) { const int ch = 128 * (T - 16) + 32 * wc + 16 * n + 4 * fq;
                        const f32x4 ub = acc[ai][0][m][n], zb = acc[ai][1][m][n]; h16x4 o;
#pragma unroll
                        for (int e = 0; e < 4; ++e) o[e] = (h16)(ub[e] * silu_f(zb[e]));
                        *(h16x4*)(U + r * 1024 + ch) = o; } }
        } else {
#pragma unroll
            for (int ai = 0; ai < 2; ++ai)
#pragma unroll
                for (int m = 0; m < 4; ++m) { const size_t r = (size_t)(row0 + ai * 128 + m * 16);
#pragma unroll
                    for (int bj = 0; bj < 2; ++bj)
#pragma unroll
                        for (int n = 0; n < 2; ++n) { const int ch = 256 * (T - 24) + 128 * bj + 32 * wc + 16 * n + 4 * fq;
                            const f32x4 v = acc[ai][bj][m][n]; h16x4 o;
#pragma unroll
                            for (int e = 0; e < 4; ++e) o[e] = (h16)v[e];
                            *(h16x4*)(V + r * 1024 + ch) = o; } }
        }
    }
};
struct Epi2 {
    h16* O1;
    __device__ __forceinline__ void operator()(const f32x4 (&acc)[2][2][4][2], const pg8::Unit& u, int wr, int wc, int fr, int fq) const {
        const int row0 = u.pm * 256 + wr * 64 + fr, col0 = u.pn * 256 + wc * 32 + 4 * fq;
#pragma unroll
        for (int ai = 0; ai < 2; ++ai)
#pragma unroll
            for (int m = 0; m < 4; ++m) { const size_t r = (size_t)(row0 + ai * 128 + m * 16);
#pragma unroll
                for (int bj = 0; bj < 2; ++bj)
#pragma unroll
                    for (int n = 0; n < 2; ++n) { const f32x4 v = acc[ai][bj][m][n]; h16x4 o;
#pragma unroll
                        for (int e = 0; e < 4; ++e) o[e] = (h16)v[e];
                        *(h16x4*)(O1 + r * 1024 + col0 + bj * 128 + n * 16) = o; } }
    }
};
struct Epi3 {
    h16 *PC, *ZCD, *FD;
    __device__ __forceinline__ void operator()(const f32x4 (&acc)[2][2][4][2], const pg8::Unit& u, int wr, int wc, int fr, int fq) const {
        const int row0 = u.pm * 256 + wr * 64 + fr, col0 = u.pn * 256 + wc * 32 + 4 * fq;
#pragma unroll
        for (int bj = 0; bj < 2; ++bj)
#pragma unroll
            for (int n = 0; n < 2; ++n) { const int c = col0 + bj * 128 + n * 16;
                h16* base; size_t ld;
                if (c < 3200) { base = PC + c; ld = 3200; }
                else if (c < 4224) { base = ZCD + (c - 3200); ld = 1536; }
                else if (c < 4736) { base = FD + (c - 4224); ld = 512; }
                else if (c < 5248) { base = ZCD + 1024 + (c - 4736); ld = 1536; }
                else continue;
#pragma unroll
                for (int ai = 0; ai < 2; ++ai)
#pragma unroll
                    for (int m = 0; m < 4; ++m) { const size_t r = (size_t)(row0 + ai * 128 + m * 16); const f32x4 v = acc[ai][bj][m][n]; h16x4 o;
#pragma unroll
                        for (int e = 0; e < 4; ++e) o[e] = (h16)v[e];
                        *(h16x4*)(base + r * ld) = o; } }
    }
};
struct Epi4 {
    const float* X; const h16* O1; float* OUT;
    __device__ __forceinline__ void operator()(const f32x4 (&acc)[2][2][4][2], const pg8::Unit& u, int wr, int wc, int fr, int fq) const {
        const int row0 = u.pm * 256 + wr * 64 + fr, col0 = u.pn * 256 + wc * 32 + 4 * fq;
#pragma unroll
        for (int ai = 0; ai < 2; ++ai)
#pragma unroll
            for (int m = 0; m < 4; ++m) { const size_t r = (size_t)(row0 + ai * 128 + m * 16);
#pragma unroll
                for (int bj = 0; bj < 2; ++bj)
#pragma unroll
                    for (int n = 0; n < 2; ++n) { const size_t o = r * 1024 + col0 + bj * 128 + n * 16;
                        const f32x4 xv = *(const f32x4*)(X + o); const h16x4 ov = *(const h16x4*)(O1 + o); f32x4 v = acc[ai][bj][m][n];
                        v[0] += xv[0] + (float)ov[0]; v[1] += xv[1] + (float)ov[1]; v[2] += xv[2] + (float)ov[2]; v[3] += xv[3] + (float)ov[3];
                        *(f32x4*)(OUT + o) = v; } }
    }
};

__device__ __forceinline__ void phase_stats(const Params& p) {
    const int tid = threadIdx.x, lane = tid & 63, wave = tid >> 6;
    const int gw = blockIdx.x * 8 + wave, NGW = gridDim.x * 8;
    const h16* V = (const h16*)(p.ws + WS_V); float* ST = (float*)(p.ws + WS_STATS);
    for (int r = gw; r < NTOK; r += NGW) {
        const h16x8 a = *(const h16x8*)(V + (size_t)r * 1024 + 8 * lane), b = *(const h16x8*)(V + (size_t)r * 1024 + 512 + 8 * lane);
        float s = 0.f;
#pragma unroll
        for (int e = 0; e < 8; ++e) s += (float)a[e] + (float)b[e];
        const float mu = wave_sum(s) * (1.f / 1024.f); float q = 0.f;
#pragma unroll
        for (int e = 0; e < 8; ++e) { const float x = (float)a[e] - mu, y = (float)b[e] - mu; q += x * x + y * y; }
        const float rs = rsqrtf(wave_sum(q) * (1.f / 1024.f) + 1e-5f);
        if (lane == 0) { ST[2 * r] = mu; ST[2 * r + 1] = rs; }
    }
}

__device__ __forceinline__ void phase_mix0(const Params& p, LAS unsigned char* lds) {
    const int tid = threadIdx.x, lane = tid & 63, wave = tid >> 6;
    const h16* XC = (const h16*)(p.ws + WS_XC); const h16* G = (const h16*)(p.ws + WS_G); const h16* U = (const h16*)(p.ws + WS_U); const h16* V = (const h16*)(p.ws + WS_V);
    h16* YC = (h16*)(p.ws + WS_YCAT);
    const float* cw = p.in[3];
    const int gt = blockIdx.x * 512 + tid, NGT = gridDim.x * 512;
    for (int idx = gt; idx < NTOK * 128; idx += NGT) {
        const int t = idx >> 7, c8 = (idx & 127) * 8, tp = t & (SEQ - 1);
        const h16x8 zero = {0, 0, 0, 0, 0, 0, 0, 0};
        const h16x8 x0 = *(const h16x8*)(XC + (size_t)t * 1024 + c8);
        const h16x8 xm = tp > 0 ? *(const h16x8*)(XC + (size_t)(t - 1) * 1024 + c8) : zero;
        const h16x8 xp = tp < SEQ - 1 ? *(const h16x8*)(XC + (size_t)(t + 1) * 1024 + c8) : zero;
        const h16x8 gg = *(const h16x8*)(G + (size_t)t * 1024 + c8);
        h16x8 o;
#pragma unroll
        for (int e = 0; e < 8; ++e) { const float y = cw[c8 + e] * (float)xm[e] + cw[1024 + c8 + e] * (float)x0[e] + cw[2048 + c8 + e] * (float)xp[e]; o[e] = (h16)(y * (float)gg[e]); }
        *(h16x8*)(YC + (size_t)t * 2048 + c8) = o;
    }
    const float* ST = (const float*)(p.ws + WS_STATS); const h16* WSH = (const h16*)(p.ws + WS_WSH);
    const float* lng = p.in[4]; const float* lnb = p.in[5]; const float* bs = p.in[7];
    LAS h16* vnT = (LAS h16*)lds;
    for (int it = blockIdx.x; it < 1024; it += gridDim.x) {
        const int g = it & 7, bn = it >> 3, t0 = bn * 128;
        __syncthreads();
#pragma unroll
        for (int q = 0; q < 4; ++q) { const int pc = tid + 512 * q, j = pc >> 4, d8 = (pc & 15) * 8;
            const h16x8 v = *(const h16x8*)(V + (size_t)(t0 + j) * 1024 + g * 128 + d8);
            const float mu = ST[2 * (t0 + j)], rs = ST[2 * (t0 + j) + 1];
#pragma unroll
            for (int e = 0; e < 8; ++e) vnT[(d8 + e) * 136 + j] = (h16)(((float)v[e] - mu) * rs * lng[g * 128 + d8 + e] + lnb[g * 128 + d8 + e]); }
        __syncthreads();
        const int itile = wave >> 1, dt0 = (wave & 1) * 2;
        f32x16 acc0, acc1;
#pragma unroll
        for (int e = 0; e < 16; ++e) { acc0[e] = 0.f; acc1[e] = 0.f; }
        const h16* Arow = WSH + ((size_t)g * 128 + itile * 32 + (lane & 31)) * 128 + 8 * (lane >> 5);
        const LAS h16* B0p = vnT + (dt0 * 32 + (lane & 31)) * 136 + 8 * (lane >> 5);
        const LAS h16* B1p = B0p + 32 * 136;
#pragma unroll
        for (int ks = 0; ks < 8; ++ks) {
            const h16x8 a = *(const h16x8*)(Arow + 16 * ks);
            const h16x8 b0 = *(const LAS h16x8*)(B0p + 16 * ks), b1 = *(const LAS h16x8*)(B1p + 16 * ks);
            acc0 = __builtin_amdgcn_mfma_f32_32x32x16_f16(a, b0, acc0, 0, 0, 0);
            acc1 = __builtin_amdgcn_mfma_f32_32x32x16_f16(a, b1, acc1, 0, 0, 0);
        }
#pragma unroll
        for (int r = 0; r < 16; ++r) { const int i = itile * 32 + (r & 3) + 8 * (r >> 2) + 4 * (lane >> 5); const size_t t = (size_t)(t0 + i);
            const float bias = bs[g * 128 + i];
            const int d0 = g * 128 + dt0 * 32 + (lane & 31);
            YC[t * 2048 + 1024 + d0] = (h16)((acc0[r] + bias) * (float)U[t * 1024 + d0]);
            YC[t * 2048 + 1024 + d0 + 32] = (h16)((acc1[r] + bias) * (float)U[t * 1024 + d0 + 32]); }
    }
}

__device__ __forceinline__ void phase_norm1(const Params& p) {
    const int tid = threadIdx.x, lane = tid & 63, wave = tid >> 6;
    const int gw = blockIdx.x * 8 + wave, NGW = gridDim.x * 8;
    const h16* O1 = (const h16*)(p.ws + WS_O1); h16* H1 = (h16*)p.out;
    for (int r = gw; r < NTOK; r += NGW) rms_row_f16(p.in[0] + (size_t)r * DM, O1 + (size_t)r * DM, p.in[9], H1 + (size_t)r * DM, lane);
}

__device__ __forceinline__ void phase_fft(const Params& p, LAS unsigned char* lds) {
    const int tid = threadIdx.x;
    const h16* FD = (const h16*)(p.ws + WS_FD);
    h16* SPr = (h16*)((unsigned char*)p.out + 32 * MiB); h16* SPi = (h16*)((unsigned char*)p.out + 48 * MiB);
    LAS f32x2* X0 = (LAS f32x2*)lds; LAS f32x2* X1 = X0 + 8192;
    for (int it = blockIdx.x; it < 256; it += gridDim.x) {
        const int b = it >> 7, c0 = 4 * (it & 127);
        __syncthreads();
        for (int t = tid; t < SEQ; t += 512) { const h16x4 v = *(const h16x4*)(FD + (size_t)(b * SEQ + t) * 512 + c0);
            X0[t] = (f32x2){(float)v[0], (float)v[1]}; X1[t] = (f32x2){(float)v[2], (float)v[3]}; }
        __syncthreads();
        for (int s = 0; s < 13; ++s) {
            const int half = 4096 >> s;
#pragma unroll 2
            for (int j = tid; j < 4096; j += 512) {
                const int pos = j & (half - 1), grp = j >> (12 - s), i0 = (grp << (13 - s)) + pos, i1 = i0 + half;
                const float fr = (float)(pos << s) * (1.f / 8192.f);
                const float c = __builtin_amdgcn_cosf(fr), sn = __builtin_amdgcn_sinf(fr);
                { const f32x2 a = X0[i0], bb = X0[i1]; const f32x2 d = a - bb; X0[i0] = a + bb; X0[i1] = (f32x2){d[0] * c + d[1] * sn, d[1] * c - d[0] * sn}; }
                { const f32x2 a = X1[i0], bb = X1[i1]; const f32x2 d = a - bb; X1[i0] = a + bb; X1[i1] = (f32x2){d[0] * c + d[1] * sn, d[1] * c - d[0] * sn}; }
            }
            __syncthreads();
        }
        const float sc = 0.5f * 0.011048543456039806f;
        for (int k = tid; k < SEQ; k += 512) {
            const int ra = __brev((unsigned)k) >> 19, rb = __brev((unsigned)((SEQ - k) & (SEQ - 1))) >> 19;
            const f32x2 za = X0[ra], zb = X0[rb], ya = X1[ra], yb = X1[rb];
            h16x4 orr, oi;
            orr[0] = (h16)((za[0] + zb[0]) * sc); oi[0] = (h16)((za[1] - zb[1]) * sc);
            orr[1] = (h16)((za[1] + zb[1]) * sc); oi[1] = (h16)((zb[0] - za[0]) * sc);
            orr[2] = (h16)((ya[0] + yb[0]) * sc); oi[2] = (h16)((ya[1] - yb[1]) * sc);
            orr[3] = (h16)((ya[1] + yb[1]) * sc); oi[3] = (h16)((yb[0] - ya[0]) * sc);
            *(h16x4*)(SPr + (size_t)(b * SEQ + k) * 512 + c0) = orr; *(h16x4*)(SPi + (size_t)(b * SEQ + k) * 512 + c0) = oi;
        }
    }
}

__device__ __forceinline__ void phase_fnet_out(const Params& p) {
    const int tid = threadIdx.x, lane = tid & 63, wave = tid >> 6;
    const int gw = blockIdx.x * 8 + wave, NGW = gridDim.x * 8;
    const h16* SPr = (const h16*)((const unsigned char*)p.out + 32 * MiB); const h16* SPi = (const h16*)((const unsigned char*)p.out + 48 * MiB);
    const h16* CWT = (const h16*)(p.ws + WS_CWT); h16* ZCD = (h16*)(p.ws + WS_ZCD);
    for (int w = gw; w < 8192; w += NGW) {
        const int et = w & 3, g = (w >> 2) & 3, tt = w >> 4;
        const size_t trow = (size_t)(tt * 32 + (lane & 31));
        const h16* Ar = SPr + trow * 512 + g * 128 + 8 * (lane >> 5); const h16* Ai = SPi + trow * 512 + g * 128 + 8 * (lane >> 5);
        const h16* Bp = CWT + ((size_t)(g * 128 + et * 32 + (lane & 31))) * 256 + 8 * (lane >> 5);
        f32x16 acc;
#pragma unroll
        for (int e = 0; e < 16; ++e) acc[e] = 0.f;
#pragma unroll
        for (int ks = 0; ks < 8; ++ks) acc = __builtin_amdgcn_mfma_f32_32x32x16_f16(*(const h16x8*)(Ar + 16 * ks), *(const h16x8*)(Bp + 16 * ks), acc, 0, 0, 0);
#pragma unroll
        for (int ks = 0; ks < 8; ++ks) acc = __builtin_amdgcn_mfma_f32_32x32x16_f16(*(const h16x8*)(Ai + 16 * ks), *(const h16x8*)(Bp + 128 + 16 * ks), acc, 0, 0, 0);
#pragma unroll
        for (int r = 0; r < 16; ++r) { const size_t t = (size_t)(tt * 32 + (r & 3) + 8 * (r >> 2) + 4 * (lane >> 5));
            h16* zp = ZCD + t * 1536 + 1024 + g * 128 + et * 32 + (lane & 31);
            *zp = (h16)(acc[r] * silu_f((float)*zp)); }
    }
}

__device__ __forceinline__ void phase_scan(const Params& p, LAS unsigned char* lds) {
    if (blockIdx.x >= 64) return;
    const int tid = threadIdx.x, lane = tid & 63, wave = tid >> 6;
    const int dir = blockIdx.x >> 5, b = (blockIdx.x >> 4) & 1, h = blockIdx.x & 15;
    const h16* PC = (const h16*)(p.ws + WS_PC);
    h16* Yd = (h16*)((unsigned char*)p.out + (size_t)dir * 32 * MiB);
    float* SB = (float*)(p.ws + WS_SBON) + (size_t)dir * NTOK * 16;
    const float* mu = p.in[11] + dir * 3200; const float* w0 = p.in[12] + dir * 1024 + 64 * h; const float* w2 = p.in[13] + (size_t)dir * 65536 + 64 * h;
    const float* a0 = p.in[14] + dir * 1024 + 64 * h; const float* a2 = p.in[15] + (size_t)dir * 65536 + 64 * h;
    const float* kkw = p.in[16] + 64 * h; const float* kaw = p.in[17] + 64 * h; const float* rkw = p.in[18] + 64 * h;
    LAS float* W2s = (LAS float*)lds;
    LAS float* A2s = W2s + 4096;
    LAS float* TW = A2s + 4096;
    LAS float* QA = TW + 2048;
    LAS float* sR = QA + 2048; LAS float* sW = sR + 2048; LAS float* sK = sW + 2048; LAS float* sV = sK + 2048; LAS float* sA = sV + 2048; LAS float* sB = sA + 2048;
    LAS float* sY = sB + 2048;
    for (int i = tid; i < 4096; i += 512) { W2s[i] = w2[(i >> 6) * 1024 + (i & 63)]; A2s[i] = a2[(i >> 6) * 1024 + (i & 63)]; }
    const int s_l = tid >> 4, c4 = (tid & 15) * 4;
    float mr[4], mk[4], mv[4], mw[4], ma[4], w0r[4], a0r[4], kkr[4], kar[4], rkr[4];
#pragma unroll
    for (int e = 0; e < 4; ++e) { mr[e] = mu[64 * h + c4 + e]; mk[e] = mu[1024 + 64 * h + c4 + e]; mv[e] = mu[2048 + 64 * h + c4 + e]; mw[e] = mu[3072 + c4 + e]; ma[e] = mu[3136 + c4 + e];
        w0r[e] = w0[c4 + e]; a0r[e] = a0[c4 + e]; kkr[e] = kkw[c4 + e]; kar[e] = kaw[c4 + e]; rkr[e] = rkw[c4 + e]; }
    float S[8];
#pragma unroll
    for (int e = 0; e < 8; ++e) S[e] = 0.f;
    const int row = 8 * wave + (lane >> 3), j0 = 8 * (lane & 7);
    for (int ch = 0; ch < SEQ / 32; ++ch) {
        const int sg = ch * 32 + s_l;
        const int t = dir ? (SEQ - 1 - sg) : sg;
        const size_t rowc = (size_t)(b * SEQ + t) * 3200;
        const size_t rowp = (size_t)(b * SEQ + (dir ? t + 1 : t - 1)) * 3200;
        const bool hp = sg > 0;
        const h16x4 z4 = {0, 0, 0, 0};
        const h16x4 pr = *(const h16x4*)(PC + rowc + 64 * h + c4), pk = *(const h16x4*)(PC + rowc + 1024 + 64 * h + c4), pv = *(const h16x4*)(PC + rowc + 2048 + 64 * h + c4);
        const h16x4 pw = *(const h16x4*)(PC + rowc + 3072 + c4), pa = *(const h16x4*)(PC + rowc + 3136 + c4);
        const h16x4 qr_ = hp ? *(const h16x4*)(PC + rowp + 64 * h + c4) : z4, qk_ = hp ? *(const h16x4*)(PC + rowp + 1024 + 64 * h + c4) : z4, qv_ = hp ? *(const h16x4*)(PC + rowp + 2048 + 64 * h + c4) : z4;
        const h16x4 qw_ = hp ? *(const h16x4*)(PC + rowp + 3072 + c4) : z4, qa_ = hp ? *(const h16x4*)(PC + rowp + 3136 + c4) : z4;
        float qr[4], qk[4], qv[4];
#pragma unroll
        for (int e = 0; e < 4; ++e) {
            const float r0 = (float)pr[e], k0 = (float)pk[e], v0 = (float)pv[e], wd0 = (float)pw[e], ad0 = (float)pa[e];
            qr[e] = r0 + mr[e] * ((float)qr_[e] - r0); qk[e] = k0 + mk[e] * ((float)qk_[e] - k0); qv[e] = v0 + mv[e] * ((float)qv_[e] - v0);
            TW[s_l * 64 + c4 + e] = tanh_f(wd0 + mw[e] * ((float)qw_[e] - wd0)); QA[s_l * 64 + c4 + e] = ad0 + ma[e] * ((float)qa_[e] - ad0);
        }
        __syncthreads();
        float zw[4], za[4];
#pragma unroll
        for (int e = 0; e < 4; ++e) { zw[e] = w0r[e]; za[e] = a0r[e]; }
#pragma unroll 4
        for (int l = 0; l < 64; ++l) { const float tw = TW[s_l * 64 + l], qa = QA[s_l * 64 + l];
            const f32x4 wv = *(const LAS f32x4*)(W2s + l * 64 + c4), av = *(const LAS f32x4*)(A2s + l * 64 + c4);
#pragma unroll
            for (int e = 0; e < 4; ++e) { zw[e] += tw * wv[e]; za[e] += qa * av[e]; } }
        float kk[4], av_[4], kn = 0.f, sbn = 0.f, kp[4], dec[4];
#pragma unroll
        for (int e = 0; e < 4; ++e) { dec[e] = __expf(-0.6065306597126334f * sigmoid_f(zw[e])); av_[e] = sigmoid_f(za[e]);
            kk[e] = qk[e] * kkr[e]; kn += kk[e] * kk[e]; kp[e] = qk[e] * (1.f + (av_[e] - 1.f) * kar[e]); sbn += qr[e] * kp[e] * rkr[e]; }
        kn = red16(kn); sbn = red16(sbn);
        const float inv = rsqrtf(fmaxf(kn, 1e-12f));
#pragma unroll
        for (int e = 0; e < 4; ++e) { const int o = s_l * 64 + c4 + e; const float kn_ = kk[e] * inv;
            sR[o] = qr[e]; sW[o] = dec[e]; sK[o] = kp[e]; sV[o] = qv[e]; sA[o] = -kn_; sB[o] = kn_ * av_[e]; }
        if ((tid & 15) == 0) SB[(size_t)(b * SEQ + t) * 16 + h] = sbn;
        __syncthreads();
#pragma unroll 2
        for (int s = 0; s < 32; ++s) {
            const f32x4 a_0 = *(const LAS f32x4*)(sA + s * 64 + j0), a_1 = *(const LAS f32x4*)(sA + s * 64 + j0 + 4);
            const f32x4 w_0 = *(const LAS f32x4*)(sW + s * 64 + j0), w_1 = *(const LAS f32x4*)(sW + s * 64 + j0 + 4);
            const f32x4 b_0 = *(const LAS f32x4*)(sB + s * 64 + j0), b_1 = *(const LAS f32x4*)(sB + s * 64 + j0 + 4);
            const f32x4 k_0 = *(const LAS f32x4*)(sK + s * 64 + j0), k_1 = *(const LAS f32x4*)(sK + s * 64 + j0 + 4);
            const f32x4 r_0 = *(const LAS f32x4*)(sR + s * 64 + j0), r_1 = *(const LAS f32x4*)(sR + s * 64 + j0 + 4);
            const float v = sV[s * 64 + row];
            float sa = (S[0] * a_0[0] + S[1] * a_0[1]) + (S[2] * a_0[2] + S[3] * a_0[3]) + (S[4] * a_1[0] + S[5] * a_1[1]) + (S[6] * a_1[2] + S[7] * a_1[3]);
            sa = red8(sa);
            S[0] = S[0] * w_0[0] + (sa * b_0[0] + v * k_0[0]); S[1] = S[1] * w_0[1] + (sa * b_0[1] + v * k_0[1]);
            S[2] = S[2] * w_0[2] + (sa * b_0[2] + v * k_0[2]); S[3] = S[3] * w_0[3] + (sa * b_0[3] + v * k_0[3]);
            S[4] = S[4] * w_1[0] + (sa * b_1[0] + v * k_1[0]); S[5] = S[5] * w_1[1] + (sa * b_1[1] + v * k_1[1]);
            S[6] = S[6] * w_1[2] + (sa * b_1[2] + v * k_1[2]); S[7] = S[7] * w_1[3] + (sa * b_1[3] + v * k_1[3]);
            float y = (S[0] * r_0[0] + S[1] * r_0[1]) + (S[2] * r_0[2] + S[3] * r_0[3]) + (S[4] * r_1[0] + S[5] * r_1[1]) + (S[6] * r_1[2] + S[7] * r_1[3]);
            y = red8(y);
            if ((lane & 7) == 0) sY[s * 64 + row] = y;
        }
        __syncthreads();
        { const f32x4 yv = *(const LAS f32x4*)(sY + s_l * 64 + c4); h16x4 o; o[0] = (h16)yv[0]; o[1] = (h16)yv[1]; o[2] = (h16)yv[2]; o[3] = (h16)yv[3];
          *(h16x4*)(Yd + (size_t)(b * SEQ + t) * 1024 + 64 * h + c4) = o; }
    }
}

__device__ __forceinline__ void phase_post(const Params& p) {
    const int tid = threadIdx.x;
    const h16* Y0 = (const h16*)p.out; const h16* Y1 = (const h16*)((const unsigned char*)p.out + 32 * MiB);
    const h16* PC = (const h16*)(p.ws + WS_PC); h16* ZCD = (h16*)(p.ws + WS_ZCD);
    const float* SB0 = (const float*)(p.ws + WS_SBON); const float* SB1 = SB0 + (size_t)NTOK * 16;
    const float* mu0 = p.in[11] + 2048; const float* mu1 = p.in[11] + 3200 + 2048;
    const float* lg = p.in[19]; const float* lb = p.in[20];
    const int gt = blockIdx.x * 512 + tid, NGT = gridDim.x * 512;
    for (int idx = gt; idx < NTOK * 256; idx += NGT) {
        const int t = idx >> 8, c = (idx & 255) * 4, hh = c >> 6, tp = t & (SEQ - 1);
        const h16x4 y0 = *(const h16x4*)(Y0 + (size_t)t * 1024 + c), y1 = *(const h16x4*)(Y1 + (size_t)t * 1024 + c);
        float y[4], s = 0.f;
#pragma unroll
        for (int e = 0; e < 4; ++e) { y[e] = (float)y0[e] + (float)y1[e]; s += y[e]; }
        const float mean = red16(s) * (1.f / 64.f); float q = 0.f;
#pragma unroll
        for (int e = 0; e < 4; ++e) { y[e] -= mean; q += y[e] * y[e]; }
        const float rs = rsqrtf(red16(q) * (1.f / 64.f) + 64e-5f);
        const h16x4 z4 = {0, 0, 0, 0};
        const h16x4 v0 = *(const h16x4*)(PC + (size_t)t * 3200 + 2048 + c);
        const h16x4 vm = tp > 0 ? *(const h16x4*)(PC + (size_t)(t - 1) * 3200 + 2048 + c) : z4;
        const h16x4 vp = tp < SEQ - 1 ? *(const h16x4*)(PC + (size_t)(t + 1) * 3200 + 2048 + c) : z4;
        const float s0 = SB0[(size_t)t * 16 + hh], s1 = SB1[(size_t)t * 16 + hh];
        const h16x4 zc = *(const h16x4*)(ZCD + (size_t)t * 1536 + c);
        h16x4 o;
#pragma unroll
        for (int e = 0; e < 4; ++e) { const float vv = (float)v0[e];
            const float vd0 = vv + mu0[c + e] * ((float)vm[e] - vv), vd1 = vv + mu1[c + e] * ((float)vp[e] - vv);
            const float val = y[e] * rs * lg[c + e] + lb[c + e] + s0 * vd0 + s1 * vd1;
            o[e] = (h16)(val * silu_f((float)zc[e])); }
        *(h16x4*)(ZCD + (size_t)t * 1536 + c) = o;
    }
}

__device__ __forceinline__ void phase_final(const Params& p) {
    const int tid = threadIdx.x, lane = tid & 63, wave = tid >> 6;
    const int gw = blockIdx.x * 8 + wave, NGW = gridDim.x * 8;
    const float* g = p.in[23];
    for (int r = gw; r < NTOK; r += NGW) {
        float* xr = p.out + (size_t)r * DM; f32x4 v[4]; float ss = 0.f;
#pragma unroll
        for (int j = 0; j < 4; ++j) { v[j] = *(const f32x4*)(xr + 4 * lane + 256 * j); ss += v[j][0] * v[j][0] + v[j][1] * v[j][1] + v[j][2] * v[j][2] + v[j][3] * v[j][3]; }
        const float rs = rsqrtf(wave_sum(ss) * (1.f / 1024.f) + 1e-6f);
#pragma unroll
        for (int j = 0; j < 4; ++j) { const f32x4 gg = *(const f32x4*)(g + 4 * lane + 256 * j); f32x4 o = v[j] * rs; o = o * gg; *(f32x4*)(xr + 4 * lane + 256 * j) = o; }
    }
}

__global__ void __launch_bounds__(512, 2) mega(Params p) {
    extern __shared__ __attribute__((aligned(16))) unsigned char smem[];
    LAS unsigned char* lds = (LAS unsigned char*)smem;
    cg::grid_group grid = cg::this_grid();
    unsigned char* ws = p.ws;
    const int lo = p.ph_lo, hi = p.ph_hi;
#define IN(k) (lo <= (k) && (k) < hi)
#define SEAM(k) do { if (IN(k) && IN((k) + 1)) grid.sync(); } while (0)
    if (IN(0)) { phase0(p, lds); } SEAM(0);
    if (IN(1)) { pg8::Gemm g{(const h16*)p.out, (const h16*)(ws + WS_W1T), NTOK, 7168, 1024}; pg8::StaticOrder S; S.init(NTOK, 7168, gridDim.x, blockIdx.x);
                 Epi1 E{(h16*)(ws + WS_XC), (h16*)(ws + WS_G), (h16*)(ws + WS_U), (h16*)(ws + WS_V)}; pg8::gemm_phase<Epi1>(lds, g, S, E); } SEAM(1);
    if (IN(2)) { phase_stats(p); } SEAM(2);
    if (IN(3)) { phase_mix0(p, lds); } SEAM(3);
    if (IN(4)) { pg8::Gemm g{(const h16*)(ws + WS_YCAT), (const h16*)(ws + WS_W2T), NTOK, 1024, 2048}; pg8::StaticOrder S; S.init(NTOK, 1024, gridDim.x, blockIdx.x);
                 Epi2 E{(h16*)(ws + WS_O1)}; pg8::gemm_phase<Epi2>(lds, g, S, E); } SEAM(4);
    if (IN(5)) { phase_norm1(p); } SEAM(5);
    if (IN(6)) { pg8::Gemm g{(const h16*)p.out, (const h16*)(ws + WS_W3T), NTOK, 5376, 1024}; pg8::StaticOrder S; S.init(NTOK, 5376, gridDim.x, blockIdx.x);
                 Epi3 E{(h16*)(ws + WS_PC), (h16*)(ws + WS_ZCD), (h16*)(ws + WS_FD)}; pg8::gemm_phase<Epi3>(lds, g, S, E); } SEAM(6);
    if (IN(7)) { phase_fft(p, lds); } SEAM(7);
    if (IN(8)) { phase_fnet_out(p); } SEAM(8);
    if (IN(9)) { phase_scan(p, lds); } SEAM(9);
    if (IN(10)) { phase_post(p); } SEAM(10);
    if (IN(11)) { pg8::Gemm g{(const h16*)(ws + WS_ZCD), (const h16*)(ws + WS_W4T), NTOK, 1024, 1536}; pg8::StaticOrder S; S.init(NTOK, 1024, gridDim.x, blockIdx.x);
                  Epi4 E{p.in[0], (const h16*)(ws + WS_O1), p.out}; pg8::gemm_phase<Epi4>(lds, g, S, E); } SEAM(11);
    if (IN(12)) { phase_final(p); }
}

extern "C" void kernel_launch(void* const* d_in, const int* in_sizes, int n_in, void* d_out, int out_size, void* d_ws, size_t ws_size, hipStream_t stream) {
    static int grid = 0;
    if (grid == 0) {
        int dev = 0, cus = 0, per_cu = 0;
        hipGetDevice(&dev);
        hipDeviceGetAttribute(&cus, hipDeviceAttributeMultiprocessorCount, dev);
        if (hipFuncSetAttribute((const void*)mega, hipFuncAttributeMaxDynamicSharedMemorySize, LDS_BYTES) != hipSuccess) fprintf(stderr, "kernel_launch: hipFuncSetAttribute failed\n");
        hipOccupancyMaxActiveBlocksPerMultiprocessor(&per_cu, (const void*)mega, 512, LDS_BYTES);
        if (per_cu < 1) { fprintf(stderr, "kernel_launch: occupancy query says %d blocks per CU\n", per_cu); per_cu = 1; }
        (void)hipGetLastError();
        grid = cus;
        if (grid < 64) grid = 64;
    }
    Params p{};
    for (int i = 0; i < 24; ++i) p.in[i] = (const float*)d_in[i];
    p.out = (float*)d_out; p.ws = (unsigned char*)d_ws;
#if N_LAUNCH_MODE == 1
    p.ph_lo = 0; p.ph_hi = NPHASE;
    void* args[] = {&p};
    hipError_t e = hipLaunchCooperativeKernel((const void*)mega, dim3(grid), dim3(512), args, LDS_BYTES, stream);
    if (e != hipSuccess) fprintf(stderr, "kernel_launch: cooperative launch failed: %s (grid %d)\n", hipGetErrorString(e), grid);
#else
    for (int ph = 0; ph < NPHASE; ++ph) { p.ph_lo = ph; p.ph_hi = ph + 1; hipLaunchKernelGGL(mega, dim3(grid), dim3(512), LDS_BYTES, stream, p); }
#endif
}
```

```cpp
#include <hip/hip_runtime.h>
#include <hip/hip_cooperative_groups.h>
#include <cstdio>
#include <cstdint>
namespace cg = cooperative_groups;

#ifndef N_LAUNCH_MODE
#define N_LAUNCH_MODE 1
#endif

#define LAS __attribute__((address_space(3)))
typedef _Float16 h16;
typedef _Float16 h16x8 __attribute__((ext_vector_type(8)));
typedef _Float16 h16x4 __attribute__((ext_vector_type(4)));
typedef float f32x2 __attribute__((ext_vector_type(2)));
typedef float f32x4 __attribute__((ext_vector_type(4)));
typedef float f32x16 __attribute__((ext_vector_type(16)));

constexpr int NTOK = 16384, DM = 1024, SEQ = 8192;
constexpr int LDS_BYTES = 131072;
constexpr int NPHASE = 13;
constexpr size_t MiB = 1024 * 1024;
constexpr size_t WS_W1T = 0;
constexpr size_t WS_W2T = WS_W1T + (size_t)7168 * 1024 * 2;
constexpr size_t WS_W3T = WS_W2T + (size_t)1024 * 2048 * 2;
constexpr size_t WS_W4T = WS_W3T + (size_t)5376 * 1024 * 2;
constexpr size_t WS_STATS = 32 * MiB;
constexpr size_t WS_WSH = WS_STATS + 131072;
constexpr size_t WS_CWT = WS_WSH + 262144;
constexpr size_t WS_SBON = WS_CWT + 262144;
constexpr size_t WS_XC = 36 * MiB, WS_G = 68 * MiB, WS_U = 100 * MiB, WS_V = 132 * MiB, WS_YCAT = 164 * MiB;
constexpr size_t WS_O1 = 36 * MiB, WS_PC = 68 * MiB, WS_ZCD = 168 * MiB, WS_FD = 216 * MiB;

namespace pg8 {
constexpr int BM = 256, BK = 64, HALF = 128, HTB = HALF * BK * 2, STAGE_BYTES = 8 * HTB, NXCD = 8, WGM = 8;
__host__ __device__ __forceinline__ int lds_byte(int r, int c) { const int st = (r >> 4) * 2 + (c >> 5), rr = r & 15, cc = c & 31, ob = rr * 64 + cc * 2; return st * 1024 + (ob ^ (((ob >> 9) & 1) << 5)); }
__host__ __device__ __forceinline__ void stage_rc(int b, int& R, int& C) { const int st = b / 1024, sb = b % 1024, swz = sb ^ (((sb >> 9) & 1) << 5); R = (st >> 1) * 16 + swz / 64; C = (st & 1) * 32 + (swz % 64) / 2; }
struct Unit { int pm, pn; };
struct Gemm { const h16* A; const h16* Bt; int M, N, K; };
struct StaticOrder {
    int nM, nN, nwg, G, c;
    __host__ __device__ void init(int M, int N, int G_, int c_) { nM = M / BM; nN = N / BM; nwg = nM * nN; G = G_; c = c_; }
    __host__ __device__ bool next(int i, Unit& u) const {
        const long L = (long)i * G + c; if (L >= nwg) return false;
        int wgid = (int)L; { const int q = nwg / NXCD, r = nwg % NXCD, xcd = wgid % NXCD, off = wgid / NXCD; wgid = (xcd < r ? xcd * (q + 1) : r * (q + 1) + (xcd - r) * q) + off; }
        const int nig = WGM * nN, gid = wgid / nig, fm = gid * WGM, gsz = (nM - fm) < WGM ? (nM - fm) : WGM;
        u.pm = fm + ((wgid % nig) % gsz); u.pn = (wgid % nig) / gsz; return true;
    }
};
template <class Epi>
__device__ __forceinline__ void gemm_phase(LAS unsigned char* lds, const Gemm g, const StaticOrder& S, const Epi& E) {
    const int tid = threadIdx.x, wid = __builtin_amdgcn_readfirstlane(tid >> 6), lane = tid & 63, wr = wid >> 2, wc = wid & 3, fr = lane & 15, fq = lane >> 4;
    const int K = g.K, nt = K / BK;
    unsigned voffA[2], voffB[2];
#pragma unroll
    for (int i = 0; i < 2; ++i) { int R, C; stage_rc(tid * 16 + i * 8192, R, C); voffA[i] = (unsigned)(R * K + C) * 2u; voffB[i] = voffA[i]; }
    const size_t kstep = (size_t)(BK * 2);
    const size_t hstep = (size_t)HALF * K * 2;
    const size_t tstep = 2 * hstep;
    const unsigned ldsw = (unsigned)wid * 1024u;
    const int aoff = lds_byte(wr * 64 + fr, fq * 8), boff = lds_byte(wc * 32 + fr, fq * 8);
#define PG8_SA(b, h) (((b) * 2 + (h)) * HTB)
#define PG8_SB(b, h) ((4 + (b) * 2 + (h)) * HTB)
#define PG8_STAGE(bufoff, gbase, voff) do { _Pragma("unroll") for (int _i = 0; _i < 2; ++_i) \
        __builtin_amdgcn_global_load_lds((const unsigned*)((const char*)(gbase) + (voff)[_i]), (LAS unsigned*)(lds + (bufoff) + ldsw + _i * 8192), 16, 0, 0); } while (0)
#define PG8_LDA(dst, b, h) do { _Pragma("unroll") for (int m = 0; m < 4; ++m) _Pragma("unroll") for (int k = 0; k < 2; ++k) dst[m][k] = *(const LAS h16x8*)(lds + PG8_SA(b, h) + aoff + m * 2048 + k * 1024); } while (0)
#define PG8_LDB(dst, b, h) do { _Pragma("unroll") for (int n = 0; n < 2; ++n) _Pragma("unroll") for (int k = 0; k < 2; ++k) dst[n][k] = *(const LAS h16x8*)(lds + PG8_SB(b, h) + boff + n * 2048 + k * 1024); } while (0)
#define PG8_MMA(ai, bj, At, Bt) do { __builtin_amdgcn_s_setprio(1); _Pragma("unroll") for (int m = 0; m < 4; ++m) _Pragma("unroll") for (int n = 0; n < 2; ++n) _Pragma("unroll") for (int k = 0; k < 2; ++k) \
        acc[ai][bj][m][n] = __builtin_amdgcn_mfma_f32_16x16x32_f16(Bt[n][k], At[m][k], acc[ai][bj][m][n], 0, 0, 0); __builtin_amdgcn_s_setprio(0); } while (0)
#define PG8_WAIT_V(n) asm volatile("s_waitcnt vmcnt(" #n ")" ::: "memory")
#define PG8_WAIT_L(n) asm volatile("s_waitcnt lgkmcnt(" #n ")" ::: "memory")
#define PG8_BAR __builtin_amdgcn_s_barrier()
#define PG8_SCHED __builtin_amdgcn_sched_barrier(0)
    Unit cur, nxt; int ui = 0;
    if (!S.next(0, cur)) return;
    f32x4 acc[2][2][4][2];
#pragma unroll
    for (int a = 0; a < 2; ++a)
#pragma unroll
        for (int b = 0; b < 2; ++b)
#pragma unroll
            for (int m = 0; m < 4; ++m)
#pragma unroll
                for (int n = 0; n < 2; ++n) acc[a][b][m][n] = (f32x4){0.f, 0.f, 0.f, 0.f};
    h16x8 At[4][2], B0[2][2], B1[2][2];
    const char* cA = (const char*)g.A + (size_t)cur.pm * tstep; const char* cB = (const char*)g.Bt + (size_t)cur.pn * tstep;
    PG8_STAGE(PG8_SB(0, 0), cB, voffB); PG8_STAGE(PG8_SA(0, 0), cA, voffA); PG8_STAGE(PG8_SB(0, 1), cB + hstep, voffB); PG8_STAGE(PG8_SA(0, 1), cA + hstep, voffA);
    if (wr == 1) PG8_BAR;
    PG8_WAIT_V(4); PG8_BAR;
    PG8_STAGE(PG8_SB(1, 0), cB + kstep, voffB); PG8_STAGE(PG8_SA(1, 0), cA + kstep, voffA); PG8_STAGE(PG8_SB(1, 1), cB + hstep + kstep, voffB);
    PG8_WAIT_V(6); PG8_BAR;
    for (;;) {
        const bool has_next = S.next(ui + 1, nxt);
        const char* nA = has_next ? (const char*)g.A + (size_t)nxt.pm * tstep : cA; const char* nB = has_next ? (const char*)g.Bt + (size_t)nxt.pn * tstep : cB;
        for (int t = 0; t < nt; t += 2) {
            const bool last = (t == nt - 2);
            const char* a1 = cA + (size_t)(t + 1) * kstep;
            const char* a2 = last ? nA : cA + (size_t)(t + 2) * kstep; const char* b2 = last ? nB : cB + (size_t)(t + 2) * kstep;
            const char* a3 = a2 + kstep; const char* b3 = b2 + kstep;
            PG8_LDB(B0, 0, 0); PG8_SCHED; PG8_LDA(At, 0, 0); PG8_STAGE(PG8_SA(1, 1), a1 + hstep, voffA);
            PG8_WAIT_L(8); PG8_BAR; PG8_WAIT_L(0); PG8_MMA(0, 0, At, B0); PG8_BAR; PG8_SCHED;
            PG8_LDB(B1, 0, 1); PG8_STAGE(PG8_SB(0, 0), b2, voffB);
            PG8_BAR; PG8_WAIT_L(0); PG8_MMA(0, 1, At, B1); PG8_BAR;
            PG8_LDA(At, 0, 1); PG8_STAGE(PG8_SA(0, 0), a2, voffA);
            PG8_BAR; PG8_WAIT_L(0); PG8_MMA(1, 0, At, B0); PG8_BAR; PG8_SCHED;
            PG8_STAGE(PG8_SB(0, 1), b2 + hstep, voffB);
            PG8_WAIT_V(6); PG8_BAR; PG8_MMA(1, 1, At, B1); PG8_BAR;
            PG8_LDB(B0, 1, 0); PG8_SCHED; PG8_LDA(At, 1, 0); PG8_STAGE(PG8_SA(0, 1), a2 + hstep, voffA);
            PG8_WAIT_L(8); PG8_BAR; PG8_WAIT_L(0); PG8_MMA(0, 0, At, B0); PG8_BAR; PG8_SCHED;
            PG8_LDB(B1, 1, 1); PG8_STAGE(PG8_SB(1, 0), b3, voffB);
            PG8_BAR; PG8_WAIT_L(0); PG8_MMA(0, 1, At, B1); PG8_BAR;
            PG8_LDA(At, 1, 1); PG8_STAGE(PG8_SA(1, 0), a3, voffA);
            PG8_BAR; PG8_WAIT_L(0); PG8_MMA(1, 0, At, B0); PG8_BAR; PG8_SCHED;
            PG8_STAGE(PG8_SB(1, 1), b3 + hstep, voffB);
            PG8_WAIT_V(6); PG8_BAR; PG8_MMA(1, 1, At, B1); PG8_BAR;
        }
        E(acc, cur, wr, wc, fr, fq);
        if (!has_next) break;
#pragma unroll
        for (int a = 0; a < 2; ++a)
#pragma unroll
            for (int b = 0; b < 2; ++b)
#pragma unroll
                for (int m = 0; m < 4; ++m)
#pragma unroll
                    for (int n = 0; n < 2; ++n) acc[a][b][m][n] = (f32x4){0.f, 0.f, 0.f, 0.f};
        cur = nxt; cA = nA; cB = nB; ++ui;
    }
    PG8_WAIT_V(0);
    if (wr == 0) PG8_BAR;
    PG8_BAR;
#undef PG8_SA
#undef PG8_SB
#undef PG8_STAGE
#undef PG8_LDA
#undef PG8_LDB
#undef PG8_MMA
#undef PG8_WAIT_V
#undef PG8_WAIT_L
#undef PG8_BAR
#undef PG8_SCHED
}
}

struct Params { const float* in[24]; float* out; unsigned char* ws; int ph_lo, ph_hi; };

__device__ __forceinline__ float silu_f(float x) { return x / (1.f + __expf(-x)); }
__device__ __forceinline__ float sigmoid_f(float x) { return 1.f / (1.f + __expf(-x)); }
__device__ __forceinline__ float tanh_f(float x) { return 1.f - 2.f / (__expf(2.f * x) + 1.f); }
__device__ __forceinline__ float wave_sum(float v) {
#pragma unroll
    for (int o = 1; o < 64; o <<= 1) v += __shfl_xor(v, o);
    return v;
}
template <int CTRL> __device__ __forceinline__ float dpp_f(float x) { return __int_as_float(__builtin_amdgcn_update_dpp(0, __float_as_int(x), CTRL, 0xf, 0xf, false)); }
__device__ __forceinline__ float red8(float x) {
    x += dpp_f<0xB1>(x); x += dpp_f<0x4E>(x); x += dpp_f<0x141>(x); return x;
}
__device__ __forceinline__ float red16(float x) {
    x += dpp_f<0xB1>(x); x += dpp_f<0x4E>(x); x += dpp_f<0x141>(x); x += dpp_f<0x140>(x); return x;
}

__device__ __forceinline__ int sigma1(int np) {
    const int T = np >> 8, c = np & 255;
    if (T < 16) { const int bj = c >> 7, wc = (c >> 5) & 3, n = (c >> 4) & 1, r = c & 15; return 1024 * (2 * bj + n) + 64 * T + 16 * wc + r; }
    if (T < 24) { return ((c >> 7) ? 6144 : 4096) + 128 * (T - 16) + (c & 127); }
    return 5120 + 256 * (T - 24) + c;
}

template <int MODE>
__device__ __forceinline__ void tr_item(const float* W, int K, int N, h16* WT, LAS float* scr, int item, int nblk, int lane) {
    const int kb = item / nblk, nb = item % nblk, k0 = 64 * kb, n0 = 32 * nb;
    const int np = n0 + (lane & 31);
    const int sc = (MODE == 1) ? sigma1(np) : np;
    const bool valid = (MODE != 2) || (np < 5248);
#pragma unroll 8
    for (int i = 0; i < 32; ++i) { const int kk = 2 * i + (lane >> 5); scr[kk * 33 + (lane & 31)] = valid ? W[(size_t)(k0 + kk) * N + sc] : 0.f; }
    asm volatile("s_waitcnt lgkmcnt(0)" ::: "memory");
    const int c = lane & 7;
#pragma unroll
    for (int j = 0; j < 4; ++j) { const int n = (lane >> 3) + 8 * j; const LAS float* s = scr + (8 * c) * 33 + n;
        h16x8 o;
#pragma unroll
        for (int e = 0; e < 8; ++e) o[e] = (h16)s[e * 33];
        *(h16x8*)(WT + (size_t)(n0 + n) * K + k0 + 8 * c) = o; }
    asm volatile("s_waitcnt lgkmcnt(0)" ::: "memory");
}

__device__ __forceinline__ void rms_row_f16(const float* xr, const h16* addr, const float* g, h16* orow, int lane) {
    f32x4 v[4]; float ss = 0.f;
#pragma unroll
    for (int j = 0; j < 4; ++j) { v[j] = *(const f32x4*)(xr + 4 * lane + 256 * j);
        if (addr) { const h16x4 a = *(const h16x4*)(addr + 4 * lane + 256 * j); v[j][0] += (float)a[0]; v[j][1] += (float)a[1]; v[j][2] += (float)a[2]; v[j][3] += (float)a[3]; }
        ss += v[j][0] * v[j][0] + v[j][1] * v[j][1] + v[j][2] * v[j][2] + v[j][3] * v[j][3]; }
    const float rs = rsqrtf(wave_sum(ss) * (1.f / 1024.f) + 1e-6f);
#pragma unroll
    for (int j = 0; j < 4; ++j) { const f32x4 gg = *(const f32x4*)(g + 4 * lane + 256 * j); h16x4 o;
        o[0] = (h16)(v[j][0] * rs * gg[0]); o[1] = (h16)(v[j][1] * rs * gg[1]); o[2] = (h16)(v[j][2] * rs * gg[2]); o[3] = (h16)(v[j][3] * rs * gg[3]);
        *(h16x4*)(orow + 4 * lane + 256 * j) = o; }
}

__device__ __forceinline__ void phase0(const Params& p, LAS unsigned char* lds) {
    const int tid = threadIdx.x, lane = tid & 63, wave = tid >> 6;
    const int gw = blockIdx.x * 8 + wave, NGW = gridDim.x * 8;
    LAS float* scr = (LAS float*)(lds + wave * 8448);
    h16* W1T = (h16*)(p.ws + WS_W1T); h16* W2T = (h16*)(p.ws + WS_W2T); h16* W3T = (h16*)(p.ws + WS_W3T); h16* W4T = (h16*)(p.ws + WS_W4T);
    constexpr int I1 = 16 * 224, I2 = 32 * 32, I3 = 16 * 168, I4 = 24 * 32;
    for (int it = gw; it < I1 + I2 + I3 + I4; it += NGW) {
        int r = it;
        if (r < I1) { tr_item<1>(p.in[2], 1024, 7168, W1T, scr, r, 224, lane); continue; } r -= I1;
        if (r < I2) { tr_item<0>(p.in[8], 2048, 1024, W2T, scr, r, 32, lane); continue; } r -= I2;
        if (r < I3) { tr_item<2>(p.in[10], 1024, 5248, W3T, scr, r, 168, lane); continue; } r -= I3;
        tr_item<0>(p.in[22], 1536, 1024, W4T, scr, r, 32, lane);
    }
    h16* H0 = (h16*)p.out;
    for (int r = gw; r < NTOK; r += NGW) rms_row_f16(p.in[0] + (size_t)r * DM, nullptr, p.in[1], H0 + (size_t)r * DM, lane);
    const int gt = blockIdx.x * 512 + tid, NGT = gridDim.x * 512;
    h16* WSH = (h16*)(p.ws + WS_WSH);
    for (int i = gt; i < 8 * 128 * 128; i += NGT) WSH[i] = (h16)p.in[6][i];
    h16* CWT = (h16*)(p.ws + WS_CWT);
    const float* wf = p.in[21];
    for (int i = gt; i < 4 * 128 * 256; i += NGT) {
        const int k = i & 255, e = (i >> 8) & 127, g = i >> 15, d = k & 127; const bool sn = k >= 128;
        float s = 0.f;
        for (int dp = 0; dp < 128; ++dp) { const float fr = (float)((d * dp) & 127) * (1.f / 128.f);
            const float tw = sn ? __builtin_amdgcn_sinf(fr) : __builtin_amdgcn_cosf(fr);
            s += tw * wf[(g * 128 + dp) * 128 + e]; }
        CWT[i] = (h16)(s * 0.08838834764831845f);
    }
}

struct Epi1 {
    h16 *XC, *G, *U, *V;
    __device__ __forceinline__ void operator()(const f32x4 (&acc)[2][2][4][2], const pg8::Unit& u, int wr, int wc, int fr, int fq) const {
        const int T = u.pn; const int row0 = u.pm * 256 + wr * 64 + fr;
        if (T < 16) {
            const int ch = 64 * T + 16 * wc + 4 * fq;
#pragma unroll
            for (int ai = 0; ai < 2; ++ai)
#pragma unroll
                for (int m = 0; m < 4; ++m) { const size_t r = (size_t)(row0 + ai * 128 + m * 16);
                    const f32x4 xa = acc[ai][0][m][0], ba = acc[ai][0][m][1], ca = acc[ai][1][m][0], za = acc[ai][1][m][1];
                    h16x4 xc, gg;
#pragma unroll
                    for (int e = 0; e < 4; ++e) { xc[e] = (h16)(ca[e] * xa[e]); gg[e] = (h16)(ba[e] * silu_f(za[e])); }
                    *(h16x4*)(XC + r * 1024 + ch) = xc; *(h16x4*)(G + r * 1024 + ch) = gg; }
        } else if (T < 24) {
#pragma unroll
            for (int ai = 0; ai < 2; ++ai)
#pragma unroll
                for (int m = 0; m < 4; ++m) { const size_t r = (size_t)(row0 + ai * 128 + m * 16);
#pragma unroll
                    for (int n = 0; n < 2; ++n) { const int ch = 128 * (T - 16) + 32 * wc + 16 * n + 4 * fq;
                        const f32x4 ub = acc[ai][0][m][n], zb = acc[ai][1][m][n]; h16x4 o;
#pragma unroll
                        for (int e = 0; e < 4; ++e) o[e] = (h16)(ub[e] * silu_f(zb[e]));
                        *(h16x4*)(U + r * 1024 + ch) = o; } }
        } else {
#pragma unroll
            for (int ai = 0; ai < 2; ++ai)
#pragma unroll
                for (int m = 0; m < 4; ++m) { const size_t r = (size_t)(row0 + ai * 128 + m * 16);
#pragma unroll
                    for (int bj = 0; bj < 2; ++bj)
#pragma unroll
                        for (int n = 0; n < 2; ++n) { const int ch = 256 * (T - 24) + 128 * bj + 32 * wc + 16 * n + 4 * fq;
                            const f32x4 v = acc[ai][bj][m][n]; h16x4 o;
#pragma unroll
                            for (int e = 0; e < 4; ++e) o[e] = (h16)v[e];
                            *(h16x4*)(V + r * 1024 + ch) = o; } }
        }
    }
};
struct Epi2 {
    h16* O1;
    __device__ __forceinline__ void operator()(const f32x4 (&acc)[2][2][4][2], const pg8::Unit& u, int wr, int wc, int fr, int fq) const {
        const int row0 = u.pm * 256 + wr * 64 + fr, col0 = u.pn * 256 + wc * 32 + 4 * fq;
#pragma unroll
        for (int ai = 0; ai < 2; ++ai)
#pragma unroll
            for (int m = 0; m < 4; ++m) { const size_t r = (size_t)(row0 + ai * 128 + m * 16);
#pragma unroll
                for (int bj = 0; bj < 2; ++bj)
#pragma unroll
                    for (int n = 0; n < 2; ++n) { const f32x4 v = acc[ai][bj][m][n]; h16x4 o;
#pragma unroll
                        for (int e = 0; e < 4; ++e) o[e] = (h16)v[e];
                        *(h16x4*)(O1 + r * 1024 + col0 + bj * 128 + n * 16) = o; } }
    }
};
struct Epi3 {
    h16 *PC, *ZCD, *FD;
    __device__ __forceinline__ void operator()(const f32x4 (&acc)[2][2][4][2], const pg8::Unit& u, int wr, int wc, int fr, int fq) const {
        const int row0 = u.pm * 256 + wr * 64 + fr, col0 = u.pn * 256 + wc * 32 + 4 * fq;
#pragma unroll
        for (int bj = 0; bj < 2; ++bj)
#pragma unroll
            for (int n = 0; n < 2; ++n) { const int c = col0 + bj * 128 + n * 16;
                h16* base; size_t ld;
                if (c < 3200) { base = PC + c; ld = 3200; }
                else if (c < 4224) { base = ZCD + (c - 3200); ld = 1536; }
                else if (c < 4736) { base = FD + (c - 4224); ld = 512; }
                else if (c < 5248) { base = ZCD + 1024 + (c - 4736); ld = 1536; }
                else continue;
#pragma unroll
                for (int ai = 0; ai < 2; ++ai)
#pragma unroll
                    for (int m = 0; m < 4; ++m) { const size_t r = (size_t)(row0 + ai * 128 + m * 16); const f32x4 v = acc[ai][bj][m][n]; h16x4 o;
#pragma unroll
                        for (int e = 0; e < 4; ++e) o[e] = (h16)v[e];
                        *(h16x4*)(base + r * ld) = o; } }
    }
};
struct Epi4 {
    const float* X; const h16* O1; float* OUT;
    __device__ __forceinline__ void operator()(const f32x4 (&acc)[2][2][4][2], const pg8::Unit& u, int wr, int wc, int fr, int fq) const {
        const int row0 = u.pm * 256 + wr * 64 + fr, col0 = u.pn * 256 + wc * 32 + 4 * fq;
#pragma unroll
        for (int ai = 0; ai < 2; ++ai)
#pragma unroll
            for (int m = 0; m < 4; ++m) { const size_t r = (size_t)(row0 + ai * 128 + m * 16);
#pragma unroll
                for (int bj = 0; bj < 2; ++bj)
#pragma unroll
                    for (int n = 0; n < 2; ++n) { const size_t o = r * 1024 + col0 + bj * 128 + n * 16;
                        const f32x4 xv = *(const f32x4*)(X + o); const h16x4 ov = *(const h16x4*)(O1 + o); f32x4 v = acc[ai][bj][m][n];
                        v[0] += xv[0] + (float)ov[0]; v[1] += xv[1] + (float)ov[1]; v[2] += xv[2] + (float)ov[2]; v[3] += xv[3] + (float)ov[3];
                        *(f32x4*)(OUT + o) = v; } }
    }
};

__device__ __forceinline__ void phase_stats(const Params& p) {
    const int tid = threadIdx.x, lane = tid & 63, wave = tid >> 6;
    const int gw = blockIdx.x * 8 + wave, NGW = gridDim.x * 8;
    const h16* V = (const h16*)(p.ws + WS_V); float* ST = (float*)(p.ws + WS_STATS);
    for (int r = gw; r < NTOK; r += NGW) {
        const h16x8 a = *(const h16x8*)(V + (size_t)r * 1024 + 8 * lane), b = *(const h16x8*)(V + (size_t)r * 1024 + 512 + 8 * lane);
        float s = 0.f;
#pragma unroll
        for (int e = 0; e < 8; ++e) s += (float)a[e] + (float)b[e];
        const float mu = wave_sum(s) * (1.f / 1024.f); float q = 0.f;
#pragma unroll
        for (int e = 0; e < 8; ++e) { const float x = (float)a[e] - mu, y = (float)b[e] - mu; q += x * x + y * y; }
        const float rs = rsqrtf(wave_sum(q) * (1.f / 1024.f) + 1e-5f);
        if (lane == 0) { ST[2 * r] = mu; ST[2 * r + 1] = rs; }
    }
}

__device__ __forceinline__ void phase_mix0(const Params& p, LAS unsigned char* lds) {
    const int tid = threadIdx.x, lane = tid & 63, wave = tid >> 6;
    const h16* XC = (const h16*)(p.ws + WS_XC); const h16* G = (const h16*)(p.ws + WS_G); const h16* U = (const h16*)(p.ws + WS_U); const h16* V = (const h16*)(p.ws + WS_V);
    h16* YC = (h16*)(p.ws + WS_YCAT);
    const float* cw = p.in[3];
    const int gt = blockIdx.x * 512 + tid, NGT = gridDim.x * 512;
    for (int idx = gt; idx < NTOK * 128; idx += NGT) {
        const int t = idx >> 7, c8 = (idx & 127) * 8, tp = t & (SEQ - 1);
        const h16x8 zero = {0, 0, 0, 0, 0, 0, 0, 0};
        const h16x8 x0 = *(const h16x8*)(XC + (size_t)t * 1024 + c8);
        const h16x8 xm = tp > 0 ? *(const h16x8*)(XC + (size_t)(t - 1) * 1024 + c8) : zero;
        const h16x8 xp = tp < SEQ - 1 ? *(const h16x8*)(XC + (size_t)(t + 1) * 1024 + c8) : zero;
        const h16x8 gg = *(const h16x8*)(G + (size_t)t * 1024 + c8);
        h16x8 o;
#pragma unroll
        for (int e = 0; e < 8; ++e) { const float y = cw[c8 + e] * (float)xm[e] + cw[1024 + c8 + e] * (float)x0[e] + cw[2048 + c8 + e] * (float)xp[e]; o[e] = (h16)(y * (float)gg[e]); }
        *(h16x8*)(YC + (size_t)t * 2048 + c8) = o;
    }
    const float* ST = (const float*)(p.ws + WS_STATS); const h16* WSH = (const h16*)(p.ws + WS_WSH);
    const float* lng = p.in[4]; const float* lnb = p.in[5]; const float* bs = p.in[7];
    LAS h16* vnT = (LAS h16*)lds;
    for (int it = blockIdx.x; it < 1024; it += gridDim.x) {
        const int g = it & 7, bn = it >> 3, t0 = bn * 128;
        __syncthreads();
#pragma unroll
        for (int q = 0; q < 4; ++q) { const int pc = tid + 512 * q, j = pc >> 4, d8 = (pc & 15) * 8;
            const h16x8 v = *(const h16x8*)(V + (size_t)(t0 + j) * 1024 + g * 128 + d8);
            const float mu = ST[2 * (t0 + j)], rs = ST[2 * (t0 + j) + 1];
#pragma unroll
            for (int e = 0; e < 8; ++e) vnT[(d8 + e) * 136 + j] = (h16)(((float)v[e] - mu) * rs * lng[g * 128 + d8 + e] + lnb[g * 128 + d8 + e]); }
        __syncthreads();
        const int itile = wave >> 1, dt0 = (wave & 1) * 2;
        f32x16 acc0, acc1;
#pragma unroll
        for (int e = 0; e < 16; ++e) { acc0[e] = 0.f; acc1[e] = 0.f; }
        const h16* Arow = WSH + ((size_t)g * 128 + itile * 32 + (lane & 31)) * 128 + 8 * (lane >> 5);
        const LAS h16* B0p = vnT + (dt0 * 32 + (lane & 31)) * 136 + 8 * (lane >> 5);
        const LAS h16* B1p = B0p + 32 * 136;
#pragma unroll
        for (int ks = 0; ks < 8; ++ks) {
            const h16x8 a = *(const h16x8*)(Arow + 16 * ks);
            const h16x8 b0 = *(const LAS h16x8*)(B0p + 16 * ks), b1 = *(const LAS h16x8*)(B1p + 16 * ks);
            acc0 = __builtin_amdgcn_mfma_f32_32x32x16_f16(a, b0, acc0, 0, 0, 0);
            acc1 = __builtin_amdgcn_mfma_f32_32x32x16_f16(a, b1, acc1, 0, 0, 0);
        }
#pragma unroll
        for (int r = 0; r < 16; ++r) { const int i = itile * 32 + (r & 3) + 8 * (r >> 2) + 4 * (lane >> 5); const size_t t = (size_t)(t0 + i);
            const float bias = bs[g * 128 + i];
            const int d0 = g * 128 + dt0 * 32 + (lane & 31);
            YC[t * 2048 + 1024 + d0] = (h16)((acc0[r] + bias) * (float)U[t * 1024 + d0]);
            YC[t * 2048 + 1024 + d0 + 32] = (h16)((acc1[r] + bias) * (float)U[t * 1024 + d0 + 32]); }
    }
}

__device__ __forceinline__ void phase_norm1(const Params& p) {
    const int tid = threadIdx.x, lane = tid & 63, wave = tid >> 6;
    const int gw = blockIdx.x * 8 + wave, NGW = gridDim.x * 8;
    const h16* O1 = (const h16*)(p.ws + WS_O1); h16* H1 = (h16*)p.out;
    for (int r = gw; r < NTOK; r += NGW) rms_row_f16(p.in[0] + (size_t)r * DM, O1 + (size_t)r * DM, p.in[9], H1 + (size_t)r * DM, lane);
}

__device__ __forceinline__ void phase_fft(const Params& p, LAS unsigned char* lds) {
    const int tid = threadIdx.x;
    const h16* FD = (const h16*)(p.ws + WS_FD);
    h16* SPr = (h16*)((unsigned char*)p.out + 32 * MiB); h16* SPi = (h16*)((unsigned char*)p.out + 48 * MiB);
    LAS f32x2* X0 = (LAS f32x2*)lds; LAS f32x2* X1 = X0 + 8192;
    for (int it = blockIdx.x; it < 256; it += gridDim.x) {
        const int b = it >> 7, c0 = 4 * (it & 127);
        __syncthreads();
        for (int t = tid; t < SEQ; t += 512) { const h16x4 v = *(const h16x4*)(FD + (size_t)(b * SEQ + t) * 512 + c0);
            X0[t] = (f32x2){(float)v[0], (float)v[1]}; X1[t] = (f32x2){(float)v[2], (float)v[3]}; }
        __syncthreads();
        for (int s = 0; s < 13; ++s) {
            const int half = 4096 >> s;
#pragma unroll 2
            for (int j = tid; j < 4096; j += 512) {
                const int pos = j & (half - 1), grp = j >> (12 - s), i0 = (grp << (13 - s)) + pos, i1 = i0 + half;
                const float fr = (float)(pos << s) * (1.f / 8192.f);
                const float c = __builtin_amdgcn_cosf(fr), sn = __builtin_amdgcn_sinf(fr);
                { const f32x2 a = X0[i0], bb = X0[i1]; const f32x2 d = a - bb; X0[i0] = a + bb; X0[i1] = (f32x2){d[0] * c + d[1] * sn, d[1] * c - d[0] * sn}; }
                { const f32x2 a = X1[i0], bb = X1[i1]; const f32x2 d = a - bb; X1[i0] = a + bb; X1[i1] = (f32x2){d[0] * c + d[1] * sn, d[1] * c - d[0] * sn}; }
            }
            __syncthreads();
        }
        const float sc = 0.5f * 0.011048543456039806f;
        for (int k = tid; k < SEQ; k += 512) {
            const int ra = __brev((unsigned)k) >> 19, rb = __brev((unsigned)((SEQ - k) & (SEQ - 1))) >> 19;
            const f32x2 za = X0[ra], zb = X0[rb], ya = X1[ra], yb = X1[rb];
            h16x4 orr, oi;
            orr[0] = (h16)((za[0] + zb[0]) * sc); oi[0] = (h16)((za[1] - zb[1]) * sc);
            orr[1] = (h16)((za[1] + zb[1]) * sc); oi[1] = (h16)((zb[0] - za[0]) * sc);
            orr[2] = (h16)((ya[0] + yb[0]) * sc); oi[2] = (h16)((ya[1] - yb[1]) * sc);
            orr[3] = (h16)((ya[1] + yb[1]) * sc); oi[3] = (h16)((yb[0] - ya[0]) * sc);
            *(h16x4*)(SPr + (size_t)(b * SEQ + k) * 512 + c0) = orr; *(h16x4*)(SPi + (size_t)(b * SEQ + k) * 512 + c0) = oi;
        }
    }
}

__device__ __forceinline__ void phase_fnet_out(const Params& p) {
    const int tid = threadIdx.x, lane = tid & 63, wave = tid >> 6;
    const int gw = blockIdx.x * 8 + wave, NGW = gridDim.x * 8;
    const h16* SPr = (const h16*)((const unsigned char*)p.out + 32 * MiB); const h16* SPi = (const h16*)((const unsigned char*)p.out + 48 * MiB);
    const h16* CWT = (const h16*)(p.ws + WS_CWT); h16* ZCD = (h16*)(p.ws + WS_ZCD);
    for (int w = gw; w < 8192; w += NGW) {
        const int et = w & 3, g = (w >> 2) & 3, tt = w >> 4;
        const size_t trow = (size_t)(tt * 32 + (lane & 31));
        const h16* Ar = SPr + trow * 512 + g * 128 + 8 * (lane >> 5); const h16* Ai = SPi + trow * 512 + g * 128 + 8 * (lane >> 5);
        const h16* Bp = CWT + ((size_t)(g * 128 + et * 32 + (lane & 31))) * 256 + 8 * (lane >> 5);
        f32x16 acc;
#pragma unroll
        for (int e = 0; e < 16; ++e) acc[e] = 0.f;
#pragma unroll
        for (int ks = 0; ks < 8; ++ks) acc = __builtin_amdgcn_mfma_f32_32x32x16_f16(*(const h16x8*)(Ar + 16 * ks), *(const h16x8*)(Bp + 16 * ks), acc, 0, 0, 0);
#pragma unroll
        for (int ks = 0; ks < 8; ++ks) acc = __builtin_amdgcn_mfma_f32_32x32x16_f16(*(const h16x8*)(Ai + 16 * ks), *(const h16x8*)(Bp + 128 + 16 * ks), acc, 0, 0, 0);
#pragma unroll
        for (int r = 0; r < 16; ++r) { const size_t t = (size_t)(tt * 32 + (r & 3) + 8 * (r >> 2) + 4 * (lane >> 5));
            h16* zp = ZCD + t * 1536 + 1024 + g * 128 + et * 32 + (lane & 31);
            *zp = (h16)(acc[r] * silu_f((float)*zp)); }
    }
}

__device__ __forceinline__ void phase_scan(const Params& p, LAS unsigned char* lds) {
    const int tid = threadIdx.x, lane = tid & 63, wave = tid >> 6;
    const h16* PC = (const h16*)(p.ws + WS_PC);
    LAS h16* w2T = (LAS h16*)lds;
    LAS h16* a2T = w2T + 64 * 72;
    LAS h16* TWh = a2T + 64 * 72;
    LAS h16* QAh = TWh + 32 * 72;
    LAS float* ZW = (LAS float*)(QAh + 32 * 72);
    LAS float* ZA = ZW + 2048;
    LAS float* sR = ZA + 2048; LAS float* sW = sR + 2048; LAS float* sK = sW + 2048; LAS float* sV = sK + 2048; LAS float* sA = sV + 2048; LAS float* sB = sA + 2048;
    LAS float* sY = sB + 2048;
    for (int item = blockIdx.x; item < 256; item += gridDim.x) {
        const int xcd = item & 7, slot = item >> 3, gidx = xcd * 8 + (slot >> 2), q = slot & 3;
        const int dir = gidx >> 5, b = (gidx >> 4) & 1, h = gidx & 15;
        h16* Yd = (h16*)((unsigned char*)p.out + (size_t)dir * 32 * MiB);
        float* SB = (float*)(p.ws + WS_SBON) + (size_t)dir * NTOK * 16;
        const float* mu = p.in[11] + dir * 3200; const float* w0 = p.in[12] + dir * 1024 + 64 * h; const float* w2 = p.in[13] + (size_t)dir * 65536 + 64 * h;
        const float* a0 = p.in[14] + dir * 1024 + 64 * h; const float* a2 = p.in[15] + (size_t)dir * 65536 + 64 * h;
        const float* kkw = p.in[16] + 64 * h; const float* kaw = p.in[17] + 64 * h; const float* rkw = p.in[18] + 64 * h;
        __syncthreads();
        for (int i = tid; i < 4096; i += 512) { const int l = i >> 6, c = i & 63; w2T[c * 72 + l] = (h16)w2[l * 1024 + c]; a2T[c * 72 + l] = (h16)a2[l * 1024 + c]; }
        const int s_l = tid >> 4, c4 = (tid & 15) * 4;
        float mr[4], mk[4], mv[4], mw[4], ma[4], w0r[4], a0r[4], kkr[4], kar[4], rkr[4];
#pragma unroll
        for (int e = 0; e < 4; ++e) { mr[e] = mu[64 * h + c4 + e]; mk[e] = mu[1024 + 64 * h + c4 + e]; mv[e] = mu[2048 + 64 * h + c4 + e]; mw[e] = mu[3072 + c4 + e]; ma[e] = mu[3136 + c4 + e];
            w0r[e] = w0[c4 + e]; a0r[e] = a0[c4 + e]; kkr[e] = kkw[c4 + e]; kar[e] = kaw[c4 + e]; rkr[e] = rkw[c4 + e]; }
        f32x2 S01 = {0.f, 0.f}, S23 = {0.f, 0.f};
        const int srow = 4 * (wave & 3) + (lane >> 4), j0 = 4 * (lane & 15);
        const h16x4 z4 = {0, 0, 0, 0};
        h16x4 pr, pk, pv, pw, pa, qr_, qk_, qv_, qw_, qa_;
#define SCAN_LOAD(chn) do { const int sg_ = (chn) * 32 + s_l; const int t_ = dir ? (SEQ - 1 - sg_) : sg_; \
            const size_t rowc_ = (size_t)(b * SEQ + t_) * 3200; const size_t rowp_ = (size_t)(b * SEQ + (dir ? t_ + 1 : t_ - 1)) * 3200; const bool hp_ = sg_ > 0; \
            pr = *(const h16x4*)(PC + rowc_ + 64 * h + c4); pk = *(const h16x4*)(PC + rowc_ + 1024 + 64 * h + c4); pv = *(const h16x4*)(PC + rowc_ + 2048 + 64 * h + c4); \
            pw = *(const h16x4*)(PC + rowc_ + 3072 + c4); pa = *(const h16x4*)(PC + rowc_ + 3136 + c4); \
            qr_ = hp_ ? *(const h16x4*)(PC + rowp_ + 64 * h + c4) : z4; qk_ = hp_ ? *(const h16x4*)(PC + rowp_ + 1024 + 64 * h + c4) : z4; qv_ = hp_ ? *(const h16x4*)(PC + rowp_ + 2048 + 64 * h + c4) : z4; \
            qw_ = hp_ ? *(const h16x4*)(PC + rowp_ + 3072 + c4) : z4; qa_ = hp_ ? *(const h16x4*)(PC + rowp_ + 3136 + c4) : z4; } while (0)
        SCAN_LOAD(0);
        for (int ch = 0; ch < SEQ / 32; ++ch) {
            const int sg = ch * 32 + s_l;
            const int t = dir ? (SEQ - 1 - sg) : sg;
            float qr[4], qk[4], qv[4];
            { h16x4 tw4, qa4;
#pragma unroll
              for (int e = 0; e < 4; ++e) {
                const float r0 = (float)pr[e], k0 = (float)pk[e], v0 = (float)pv[e], wd0 = (float)pw[e], ad0 = (float)pa[e];
                qr[e] = r0 + mr[e] * ((float)qr_[e] - r0); qk[e] = k0 + mk[e] * ((float)qk_[e] - k0); qv[e] = v0 + mv[e] * ((float)qv_[e] - v0);
                tw4[e] = (h16)tanh_f(wd0 + mw[e] * ((float)qw_[e] - wd0)); qa4[e] = (h16)(ad0 + ma[e] * ((float)qa_[e] - ad0)); }
              *(LAS h16x4*)(TWh + s_l * 72 + c4) = tw4; *(LAS h16x4*)(QAh + s_l * 72 + c4) = qa4; }
            __syncthreads();
            if (wave < 4) {
                const LAS h16* Ap = ((wave & 2) ? QAh : TWh) + (lane & 31) * 72 + 8 * (lane >> 5);
                const LAS h16* Bp = ((wave & 2) ? a2T : w2T) + ((wave & 1) * 32 + (lane & 31)) * 72 + 8 * (lane >> 5);
                f32x16 acc;
#pragma unroll
                for (int e = 0; e < 16; ++e) acc[e] = 0.f;
#pragma unroll
                for (int ks = 0; ks < 4; ++ks) acc = __builtin_amdgcn_mfma_f32_32x32x16_f16(*(const LAS h16x8*)(Ap + 16 * ks), *(const LAS h16x8*)(Bp + 16 * ks), acc, 0, 0, 0);
                LAS float* Z = ((wave & 2) ? ZA : ZW) + (wave & 1) * 32 + (lane & 31);
#pragma unroll
                for (int r = 0; r < 16; ++r) Z[((r & 3) + 8 * (r >> 2) + 4 * (lane >> 5)) * 64] = acc[r];
            }
            __syncthreads();
            {
                const f32x4 zw4 = *(const LAS f32x4*)(ZW + s_l * 64 + c4), za4 = *(const LAS f32x4*)(ZA + s_l * 64 + c4);
                float kk[4], av_[4], kn = 0.f, sbn = 0.f, kp[4], dec[4];
#pragma unroll
                for (int e = 0; e < 4; ++e) { dec[e] = __expf(-0.6065306597126334f * sigmoid_f(zw4[e] + w0r[e])); av_[e] = sigmoid_f(za4[e] + a0r[e]);
                    kk[e] = qk[e] * kkr[e]; kn += kk[e] * kk[e]; kp[e] = qk[e] * (1.f + (av_[e] - 1.f) * kar[e]); sbn += qr[e] * kp[e] * rkr[e]; }
                kn = red16(kn); sbn = red16(sbn);
                const float inv = rsqrtf(fmaxf(kn, 1e-12f));
                f32x4 oR, oW, oK, oV, oA, oB;
#pragma unroll
                for (int e = 0; e < 4; ++e) { const float kn_ = kk[e] * inv; oR[e] = qr[e]; oW[e] = dec[e]; oK[e] = kp[e]; oV[e] = qv[e]; oA[e] = -kn_; oB[e] = kn_ * av_[e]; }
                const int o = s_l * 64 + c4;
                *(LAS f32x4*)(sR + o) = oR; *(LAS f32x4*)(sW + o) = oW; *(LAS f32x4*)(sK + o) = oK; *(LAS f32x4*)(sV + o) = oV; *(LAS f32x4*)(sA + o) = oA; *(LAS f32x4*)(sB + o) = oB;
                if (q == 0 && (tid & 15) == 0) SB[(size_t)(b * SEQ + t) * 16 + h] = sbn;
            }
            if (ch + 1 < SEQ / 32) SCAN_LOAD(ch + 1);
            __syncthreads();
            if (wave < 4) {
                f32x4 a_ = *(const LAS f32x4*)(sA + j0), w_ = *(const LAS f32x4*)(sW + j0), b_ = *(const LAS f32x4*)(sB + j0);
                f32x4 k_ = *(const LAS f32x4*)(sK + j0), r_ = *(const LAS f32x4*)(sR + j0);
                float v = sV[16 * q + srow];
#pragma unroll 4
                for (int s = 0; s < 32; ++s) {
                    const int sn = ((s + 1) & 31) * 64;
                    const f32x4 a_n = *(const LAS f32x4*)(sA + sn + j0), w_n = *(const LAS f32x4*)(sW + sn + j0), b_n = *(const LAS f32x4*)(sB + sn + j0);
                    const f32x4 k_n = *(const LAS f32x4*)(sK + sn + j0), r_n = *(const LAS f32x4*)(sR + sn + j0);
                    const float v_n = sV[sn + 16 * q + srow];
                    const f32x2 vv = {v, v};
                    f32x2 pp = S01 * (f32x2){a_[0], a_[1]}; pp = S23 * (f32x2){a_[2], a_[3]} + pp;
                    const float sa = red16(pp[0] + pp[1]);
                    const f32x2 sv = {sa, sa};
                    S01 = S01 * (f32x2){w_[0], w_[1]} + vv * (f32x2){k_[0], k_[1]};
                    S23 = S23 * (f32x2){w_[2], w_[3]} + vv * (f32x2){k_[2], k_[3]};
                    S01 = sv * (f32x2){b_[0], b_[1]} + S01;
                    S23 = sv * (f32x2){b_[2], b_[3]} + S23;
                    f32x2 yy = S01 * (f32x2){r_[0], r_[1]}; yy = S23 * (f32x2){r_[2], r_[3]} + yy;
                    const float y = red16(yy[0] + yy[1]);
                    if ((lane & 15) == 0) sY[s * 16 + srow] = y;
                    a_ = a_n; w_ = w_n; b_ = b_n; k_ = k_n; r_ = r_n; v = v_n;
                }
            }
            __syncthreads();
            Yd[(size_t)(b * SEQ + t) * 1024 + 64 * h + 16 * q + (tid & 15)] = (h16)sY[s_l * 16 + (tid & 15)];
        }
#undef SCAN_LOAD
    }
}

__device__ __forceinline__ void phase_post(const Params& p) {
    const int tid = threadIdx.x;
    const h16* Y0 = (const h16*)p.out; const h16* Y1 = (const h16*)((const unsigned char*)p.out + 32 * MiB);
    const h16* PC = (const h16*)(p.ws + WS_PC); h16* ZCD = (h16*)(p.ws + WS_ZCD);
    const float* SB0 = (const float*)(p.ws + WS_SBON); const float* SB1 = SB0 + (size_t)NTOK * 16;
    const float* mu0 = p.in[11] + 2048; const float* mu1 = p.in[11] + 3200 + 2048;
    const float* lg = p.in[19]; const float* lb = p.in[20];
    const int gt = blockIdx.x * 512 + tid, NGT = gridDim.x * 512;
    for (int idx = gt; idx < NTOK * 256; idx += NGT) {
        const int t = idx >> 8, c = (idx & 255) * 4, hh = c >> 6, tp = t & (SEQ - 1);
        const h16x4 y0 = *(const h16x4*)(Y0 + (size_t)t * 1024 + c), y1 = *(const h16x4*)(Y1 + (size_t)t * 1024 + c);
        float y[4], s = 0.f;
#pragma unroll
        for (int e = 0; e < 4; ++e) { y[e] = (float)y0[e] + (float)y1[e]; s += y[e]; }
        const float mean = red16(s) * (1.f / 64.f); float q = 0.f;
#pragma unroll
        for (int e = 0; e < 4; ++e) { y[e] -= mean; q += y[e] * y[e]; }
        const float rs = rsqrtf(red16(q) * (1.f / 64.f) + 64e-5f);
        const h16x4 z4 = {0, 0, 0, 0};
        const h16x4 v0 = *(const h16x4*)(PC + (size_t)t * 3200 + 2048 + c);
        const h16x4 vm = tp > 0 ? *(const h16x4*)(PC + (size_t)(t - 1) * 3200 + 2048 + c) : z4;
        const h16x4 vp = tp < SEQ - 1 ? *(const h16x4*)(PC + (size_t)(t + 1) * 3200 + 2048 + c) : z4;
        const float s0 = SB0[(size_t)t * 16 + hh], s1 = SB1[(size_t)t * 16 + hh];
        const h16x4 zc = *(const h16x4*)(ZCD + (size_t)t * 1536 + c);
        h16x4 o;
#pragma unroll
        for (int e = 0; e < 4; ++e) { const float vv = (float)v0[e];
            const float vd0 = vv + mu0[c + e] * ((float)vm[e] - vv), vd1 = vv + mu1[c + e] * ((float)vp[e] - vv);
            const float val = y[e] * rs * lg[c + e] + lb[c + e] + s0 * vd0 + s1 * vd1;
            o[e] = (h16)(val * silu_f((float)zc[e])); }
        *(h16x4*)(ZCD + (size_t)t * 1536 + c) = o;
    }
}

__device__ __forceinline__ void phase_final(const Params& p) {
    const int tid = threadIdx.x, lane = tid & 63, wave = tid >> 6;
    const int gw = blockIdx.x * 8 + wave, NGW = gridDim.x * 8;
    const float* g = p.in[23];
    for (int r = gw; r < NTOK; r += NGW) {
        float* xr = p.out + (size_t)r * DM; f32x4 v[4]; float ss = 0.f;
#pragma unroll
        for (int j = 0; j < 4; ++j) { v[j] = *(const f32x4*)(xr + 4 * lane + 256 * j); ss += v[j][0] * v[j][0] + v[j][1] * v[j][1] + v[j][2] * v[j][2] + v[j][3] * v[j][3]; }
        const float rs = rsqrtf(wave_sum(ss) * (1.f / 1024.f) + 1e-6f);
#pragma unroll
        for (int j = 0; j < 4; ++j) { const f32x4 gg = *(const f32x4*)(g + 4 * lane + 256 * j); f32x4 o = v[j] * rs; o = o * gg; *(f32x4*)(xr + 4 * lane + 256 * j) = o; }
    }
}

__global__ void __launch_bounds__(512, 2) mega(Params p) {
    extern __shared__ __attribute__((aligned(16))) unsigned char smem[];
    LAS unsigned char* lds = (LAS unsigned char*)smem;
    cg::grid_group grid = cg::this_grid();
    unsigned char* ws = p.ws;
    const int lo = p.ph_lo, hi = p.ph_hi;
#define IN(k) (lo <= (k) && (k) < hi)
#define SEAM(k) do { if (IN(k) && IN((k) + 1)) grid.sync(); } while (0)
    if (IN(0)) { phase0(p, lds); } SEAM(0);
    if (IN(1)) { pg8::Gemm g{(const h16*)p.out, (const h16*)(ws + WS_W1T), NTOK, 7168, 1024}; pg8::StaticOrder S; S.init(NTOK, 7168, gridDim.x, blockIdx.x);
                 Epi1 E{(h16*)(ws + WS_XC), (h16*)(ws + WS_G), (h16*)(ws + WS_U), (h16*)(ws + WS_V)}; pg8::gemm_phase<Epi1>(lds, g, S, E); } SEAM(1);
    if (IN(2)) { phase_stats(p); } SEAM(2);
    if (IN(3)) { phase_mix0(p, lds); } SEAM(3);
    if (IN(4)) { pg8::Gemm g{(const h16*)(ws + WS_YCAT), (const h16*)(ws + WS_W2T), NTOK, 1024, 2048}; pg8::StaticOrder S; S.init(NTOK, 1024, gridDim.x, blockIdx.x);
                 Epi2 E{(h16*)(ws + WS_O1)}; pg8::gemm_phase<Epi2>(lds, g, S, E); } SEAM(4);
    if (IN(5)) { phase_norm1(p); } SEAM(5);
    if (IN(6)) { pg8::Gemm g{(const h16*)p.out, (const h16*)(ws + WS_W3T), NTOK, 5376, 1024}; pg8::StaticOrder S; S.init(NTOK, 5376, gridDim.x, blockIdx.x);
                 Epi3 E{(h16*)(ws + WS_PC), (h16*)(ws + WS_ZCD), (h16*)(ws + WS_FD)}; pg8::gemm_phase<Epi3>(lds, g, S, E); } SEAM(6);
    if (IN(7)) { phase_fft(p, lds); } SEAM(7);
    if (IN(8)) { phase_fnet_out(p); } SEAM(8);
    if (IN(9)) { phase_scan(p, lds); } SEAM(9);
    if (IN(10)) { phase_post(p); } SEAM(10);
    if (IN(11)) { pg8::Gemm g{(const h16*)(ws + WS_ZCD), (const h16*)(ws + WS_W4T), NTOK, 1024, 1536}; pg8::StaticOrder S; S.init(NTOK, 1024, gridDim.x, blockIdx.x);
                  Epi4 E{p.in[0], (const h16*)(ws + WS_O1), p.out}; pg8::gemm_phase<Epi4>(lds, g, S, E); } SEAM(11);
    if (IN(12)) { phase_final(p); }
}

extern "C" void kernel_launch(void* const* d_in, const int* in_sizes, int n_in, void* d_out, int out_size, void* d_ws, size_t ws_size, hipStream_t stream) {
    static int grid = 0;
    if (grid == 0) {
        int dev = 0, cus = 0, per_cu = 0;
        hipGetDevice(&dev);
        hipDeviceGetAttribute(&cus, hipDeviceAttributeMultiprocessorCount, dev);
        if (hipFuncSetAttribute((const void*)mega, hipFuncAttributeMaxDynamicSharedMemorySize, LDS_BYTES) != hipSuccess) fprintf(stderr, "kernel_launch: hipFuncSetAttribute failed\n");
        hipOccupancyMaxActiveBlocksPerMultiprocessor(&per_cu, (const void*)mega, 512, LDS_BYTES);
        if (per_cu < 1) { fprintf(stderr, "kernel_launch: occupancy query says %d blocks per CU\n", per_cu); per_cu = 1; }
        (void)hipGetLastError();
        grid = cus;
        if (grid < 64) grid = 64;
    }
    Params p{};
    for (int i = 0; i < 24; ++i) p.in[i] = (const float*)d_in[i];
    p.out = (float*)d_out; p.ws = (unsigned char*)d_ws;
#if N_LAUNCH_MODE == 1
    p.ph_lo = 0; p.ph_hi = NPHASE;
    void* args[] = {&p};
    hipError_t e = hipLaunchCooperativeKernel((const void*)mega, dim3(grid), dim3(512), args, LDS_BYTES, stream);
    if (e != hipSuccess) fprintf(stderr, "kernel_launch: cooperative launch failed: %s (grid %d)\n", hipGetErrorString(e), grid);
#else
    for (int ph = 0; ph < NPHASE; ++ph) { p.ph_lo = ph; p.ph_hi = ph + 1; hipLaunchKernelGGL(mega, dim3(grid), dim3(512), LDS_BYTES, stream, p); }
#endif
}
```

```cpp
#include <hip/hip_runtime.h>
#include <hip/hip_cooperative_groups.h>
#include <cstdio>
#include <cstdint>
namespace cg = cooperative_groups;

#ifndef N_LAUNCH_MODE
#define N_LAUNCH_MODE 1
#endif

#ifndef REPMASK
#define REPMASK 0
#endif
#define LAS __attribute__((address_space(3)))
typedef _Float16 h16;
typedef _Float16 h16x8 __attribute__((ext_vector_type(8)));
typedef _Float16 h16x4 __attribute__((ext_vector_type(4)));
typedef float f32x2 __attribute__((ext_vector_type(2)));
typedef float f32x4 __attribute__((ext_vector_type(4)));
typedef float f32x16 __attribute__((ext_vector_type(16)));

constexpr int NTOK = 16384, DM = 1024, SEQ = 8192;
constexpr int LDS_MAIN = 131072;
constexpr int LDS_BYTES = LDS_MAIN + 16;
constexpr int NPHASE = 13;
constexpr size_t MiB = 1024 * 1024;
constexpr size_t WS_W1T = 0;
constexpr size_t WS_W2T = WS_W1T + (size_t)7168 * 1024 * 2;
constexpr size_t WS_W3T = WS_W2T + (size_t)1024 * 2048 * 2;
constexpr size_t WS_W4T = WS_W3T + (size_t)5376 * 1024 * 2;
constexpr size_t WS_STATS = 32 * MiB;
constexpr size_t WS_WSH = WS_STATS + 131072;
constexpr size_t WS_CWT = WS_WSH + 262144;
constexpr size_t WS_SBON = WS_CWT + 262144;
constexpr size_t WS_BAR = 35 * MiB;
constexpr size_t WS_XC = 36 * MiB, WS_G = 68 * MiB, WS_U = 100 * MiB, WS_V = 132 * MiB, WS_YCAT = 164 * MiB;
constexpr size_t WS_O1 = 36 * MiB, WS_PC = 68 * MiB, WS_ZCD = 168 * MiB, WS_FD = 216 * MiB;

namespace pg8 {
constexpr int BM = 256, BK = 64, HALF = 128, HTB = HALF * BK * 2, STAGE_BYTES = 8 * HTB, NXCD = 8, WGM = 8;
__host__ __device__ __forceinline__ int lds_byte(int r, int c) { const int st = (r >> 4) * 2 + (c >> 5), rr = r & 15, cc = c & 31, ob = rr * 64 + cc * 2; return st * 1024 + (ob ^ (((ob >> 9) & 1) << 5)); }
__host__ __device__ __forceinline__ void stage_rc(int b, int& R, int& C) { const int st = b / 1024, sb = b % 1024, swz = sb ^ (((sb >> 9) & 1) << 5); R = (st >> 1) * 16 + swz / 64; C = (st & 1) * 32 + (swz % 64) / 2; }
struct Unit { int pm, pn; };
struct Gemm { const h16* A; const h16* Bt; int M, N, K; };
struct StaticOrder {
    int nM, nN, nwg, G, c;
    __host__ __device__ void init(int M, int N, int G_, int c_) { nM = M / BM; nN = N / BM; nwg = nM * nN; G = G_; c = c_; }
    __host__ __device__ bool next(int i, Unit& u) const {
        const long L = (long)i * G + c; if (L >= nwg) return false;
        int wgid = (int)L; { const int q = nwg / NXCD, r = nwg % NXCD, xcd = wgid % NXCD, off = wgid / NXCD; wgid = (xcd < r ? xcd * (q + 1) : r * (q + 1) + (xcd - r) * q) + off; }
        const int nig = WGM * nN, gid = wgid / nig, fm = gid * WGM, gsz = (nM - fm) < WGM ? (nM - fm) : WGM;
        u.pm = fm + ((wgid % nig) % gsz); u.pn = (wgid % nig) / gsz; return true;
    }
};
template <class Epi>
__device__ __forceinline__ void gemm_phase(LAS unsigned char* lds, const Gemm g, const StaticOrder& S, const Epi& E) {
    const int tid = threadIdx.x, wid = __builtin_amdgcn_readfirstlane(tid >> 6), lane = tid & 63, wr = wid >> 2, wc = wid & 3, fr = lane & 15, fq = lane >> 4;
    const int K = g.K, nt = K / BK;
    unsigned voffA[2], voffB[2];
#pragma unroll
    for (int i = 0; i < 2; ++i) { int R, C; stage_rc(tid * 16 + i * 8192, R, C); voffA[i] = (unsigned)(R * K + C) * 2u; voffB[i] = voffA[i]; }
    const size_t kstep = (size_t)(BK * 2);
    const size_t hstep = (size_t)HALF * K * 2;
    const size_t tstep = 2 * hstep;
    const unsigned ldsw = (unsigned)wid * 1024u;
    const int aoff = lds_byte(wr * 64 + fr, fq * 8), boff = lds_byte(wc * 32 + fr, fq * 8);
#define PG8_SA(b, h) (((b) * 2 + (h)) * HTB)
#define PG8_SB(b, h) ((4 + (b) * 2 + (h)) * HTB)
#define PG8_STAGE(bufoff, gbase, voff) do { _Pragma("unroll") for (int _i = 0; _i < 2; ++_i) \
        __builtin_amdgcn_global_load_lds((const unsigned*)((const char*)(gbase) + (voff)[_i]), (LAS unsigned*)(lds + (bufoff) + ldsw + _i * 8192), 16, 0, 0); } while (0)
#define PG8_LDA(dst, b, h) do { _Pragma("unroll") for (int m = 0; m < 4; ++m) _Pragma("unroll") for (int k = 0; k < 2; ++k) dst[m][k] = *(const LAS h16x8*)(lds + PG8_SA(b, h) + aoff + m * 2048 + k * 1024); } while (0)
#define PG8_LDB(dst, b, h) do { _Pragma("unroll") for (int n = 0; n < 2; ++n) _Pragma("unroll") for (int k = 0; k < 2; ++k) dst[n][k] = *(const LAS h16x8*)(lds + PG8_SB(b, h) + boff + n * 2048 + k * 1024); } while (0)
#define PG8_MMA(ai, bj, At, Bt) do { __builtin_amdgcn_s_setprio(1); _Pragma("unroll") for (int m = 0; m < 4; ++m) _Pragma("unroll") for (int n = 0; n < 2; ++n) _Pragma("unroll") for (int k = 0; k < 2; ++k) \
        acc[ai][bj][m][n] = __builtin_amdgcn_mfma_f32_16x16x32_f16(Bt[n][k], At[m][k], acc[ai][bj][m][n], 0, 0, 0); __builtin_amdgcn_s_setprio(0); } while (0)
#define PG8_WAIT_V(n) asm volatile("s_waitcnt vmcnt(" #n ")" ::: "memory")
#define PG8_WAIT_L(n) asm volatile("s_waitcnt lgkmcnt(" #n ")" ::: "memory")
#define PG8_BAR __builtin_amdgcn_s_barrier()
#define PG8_SCHED __builtin_amdgcn_sched_barrier(0)
    Unit cur, nxt; int ui = 0;
    if (!S.next(0, cur)) return;
    f32x4 acc[2][2][4][2];
#pragma unroll
    for (int a = 0; a < 2; ++a)
#pragma unroll
        for (int b = 0; b < 2; ++b)
#pragma unroll
            for (int m = 0; m < 4; ++m)
#pragma unroll
                for (int n = 0; n < 2; ++n) acc[a][b][m][n] = (f32x4){0.f, 0.f, 0.f, 0.f};
    h16x8 At[4][2], B0[2][2], B1[2][2];
    const char* cA = (const char*)g.A + (size_t)cur.pm * tstep; const char* cB = (const char*)g.Bt + (size_t)cur.pn * tstep;
    PG8_STAGE(PG8_SB(0, 0), cB, voffB); PG8_STAGE(PG8_SA(0, 0), cA, voffA); PG8_STAGE(PG8_SB(0, 1), cB + hstep, voffB); PG8_STAGE(PG8_SA(0, 1), cA + hstep, voffA);
    if (wr == 1) PG8_BAR;
    PG8_WAIT_V(4); PG8_BAR;
    PG8_STAGE(PG8_SB(1, 0), cB + kstep, voffB); PG8_STAGE(PG8_SA(1, 0), cA + kstep, voffA); PG8_STAGE(PG8_SB(1, 1), cB + hstep + kstep, voffB);
    PG8_WAIT_V(6); PG8_BAR;
    for (;;) {
        const bool has_next = S.next(ui + 1, nxt);
        const char* nA = has_next ? (const char*)g.A + (size_t)nxt.pm * tstep : cA; const char* nB = has_next ? (const char*)g.Bt + (size_t)nxt.pn * tstep : cB;
        for (int t = 0; t < nt; t += 2) {
            const bool last = (t == nt - 2);
            const char* a1 = cA + (size_t)(t + 1) * kstep;
            const char* a2 = last ? nA : cA + (size_t)(t + 2) * kstep; const char* b2 = last ? nB : cB + (size_t)(t + 2) * kstep;
            const char* a3 = a2 + kstep; const char* b3 = b2 + kstep;
            PG8_LDB(B0, 0, 0); PG8_SCHED; PG8_LDA(At, 0, 0); PG8_STAGE(PG8_SA(1, 1), a1 + hstep, voffA);
            PG8_WAIT_L(8); PG8_BAR; PG8_WAIT_L(0); PG8_MMA(0, 0, At, B0); PG8_BAR; PG8_SCHED;
            PG8_LDB(B1, 0, 1); PG8_STAGE(PG8_SB(0, 0), b2, voffB);
            PG8_BAR; PG8_WAIT_L(0); PG8_MMA(0, 1, At, B1); PG8_BAR;
            PG8_LDA(At, 0, 1); PG8_STAGE(PG8_SA(0, 0), a2, voffA);
            PG8_BAR; PG8_WAIT_L(0); PG8_MMA(1, 0, At, B0); PG8_BAR; PG8_SCHED;
            PG8_STAGE(PG8_SB(0, 1), b2 + hstep, voffB);
            PG8_WAIT_V(6); PG8_BAR; PG8_MMA(1, 1, At, B1); PG8_BAR;
            PG8_LDB(B0, 1, 0); PG8_SCHED; PG8_LDA(At, 1, 0); PG8_STAGE(PG8_SA(0, 1), a2 + hstep, voffA);
            PG8_WAIT_L(8); PG8_BAR; PG8_WAIT_L(0); PG8_MMA(0, 0, At, B0); PG8_BAR; PG8_SCHED;
            PG8_LDB(B1, 1, 1); PG8_STAGE(PG8_SB(1, 0), b3, voffB);
            PG8_BAR; PG8_WAIT_L(0); PG8_MMA(0, 1, At, B1); PG8_BAR;
            PG8_LDA(At, 1, 1); PG8_STAGE(PG8_SA(1, 0), a3, voffA);
            PG8_BAR; PG8_WAIT_L(0); PG8_MMA(1, 0, At, B0); PG8_BAR; PG8_SCHED;
            PG8_STAGE(PG8_SB(1, 1), b3 + hstep, voffB);
            PG8_WAIT_V(6); PG8_BAR; PG8_MMA(1, 1, At, B1); PG8_BAR;
        }
        E(acc, cur, wr, wc, fr, fq);
        if (!has_next) break;
#pragma unroll
        for (int a = 0; a < 2; ++a)
#pragma unroll
            for (int b = 0; b < 2; ++b)
#pragma unroll
                for (int m = 0; m < 4; ++m)
#pragma unroll
                    for (int n = 0; n < 2; ++n) acc[a][b][m][n] = (f32x4){0.f, 0.f, 0.f, 0.f};
        cur = nxt; cA = nA; cB = nB; ++ui;
    }
    PG8_WAIT_V(0);
    if (wr == 0) PG8_BAR;
    PG8_BAR;
#undef PG8_SA
#undef PG8_SB
#undef PG8_STAGE
#undef PG8_LDA
#undef PG8_LDB
#undef PG8_MMA
#undef PG8_WAIT_V
#undef PG8_WAIT_L
#undef PG8_BAR
#undef PG8_SCHED
}
}


#define XB_TMO      128
#define XB_XCNT(j)  (256  + 64 * (j))
#define XB_XSUB(j)  (1280 + 64 * (j))
#define XB_XGEN(j)  (2304 + 64 * (j))
#define XB_TOP      3328
#define XB_TOPGEN   3392
#define XCD_BAR_WORDS 3456
#define XB_SPIN_CAP (1u << 18)
__device__ __forceinline__ unsigned xb_ld(unsigned* p)              { return __hip_atomic_load(p, __ATOMIC_RELAXED, __HIP_MEMORY_SCOPE_AGENT); }
__device__ __forceinline__ unsigned xb_add(unsigned* p, unsigned v) { return __hip_atomic_fetch_add(p, v, __ATOMIC_RELAXED, __HIP_MEMORY_SCOPE_AGENT); }
__device__ __forceinline__ unsigned xb_xcc_id() { return (unsigned)__builtin_amdgcn_s_getreg((3 << 11) | 20) & 0xFu; }
#define XB_SPIN(cond, bar) do { unsigned _sp = 0; while (cond) { __builtin_amdgcn_s_sleep(1); \
    if ((++_sp & 255u) == 0u) { if (xb_ld(&(bar)[XB_TMO])) break; if (_sp > XB_SPIN_CAP) { atomicAdd(&(bar)[XB_TMO], 1u); break; } } } } while (0)
struct XcdBarrier { unsigned* bar; unsigned x; volatile LAS unsigned* st; };
__device__ __forceinline__ XcdBarrier xcd_barrier_post(unsigned* bar, volatile LAS unsigned* st) {
    XcdBarrier b; b.bar = bar; b.x = xb_xcc_id(); b.st = st;
    if (threadIdx.x == 0) (void)xb_add(&bar[XB_XCNT(b.x)], 1u);
    return b;
}
__device__ __forceinline__ void xcd_barrier_complete(unsigned* bar, unsigned x, unsigned& nloc, unsigned& nx) {
    const unsigned G = gridDim.x * gridDim.y * gridDim.z;
    unsigned sum, cnt, mine, sp = 0u;
    for (;;) {
        sum = 0u; cnt = 0u; mine = 0u;
#pragma unroll
        for (unsigned j = 0; j < 16; ++j) { const unsigned c = xb_ld(&bar[XB_XCNT(j)]); sum += c; cnt += (c > 0u) ? 1u : 0u; mine = (j == x) ? c : mine; }
        if (sum == G) break;
        __builtin_amdgcn_s_sleep(1);
        if ((++sp & 255u) == 0u) { if (xb_ld(&bar[XB_TMO])) break; if (sp > XB_SPIN_CAP) { atomicAdd(&bar[XB_TMO], 1u); break; } }
    }
    nloc = mine > 0u ? mine : 1u; nx = cnt > 0u ? cnt : 1u;
}
__device__ __forceinline__ void xcd_barrier(const XcdBarrier& b) {
    asm volatile("s_waitcnt vmcnt(0)" ::: "memory");
    __syncthreads();
    if (threadIdx.x == 0) {
        unsigned* bar = b.bar;
        __builtin_amdgcn_s_waitcnt(0);
        unsigned nloc = b.st[0], nx = b.st[1];
        if (nloc == 0u) { xcd_barrier_complete(bar, b.x, nloc, nx); b.st[0] = nloc; b.st[1] = nx; }
        const unsigned old = xb_add(&bar[XB_XSUB(b.x)], 1u);
        const unsigned gen = old / nloc;
        if (old + 1u == (gen + 1u) * nloc) {
            __builtin_amdgcn_fence(__ATOMIC_RELEASE, "agent");
            asm volatile("s_waitcnt vmcnt(0)" ::: "memory");
            const unsigned og = xb_add(&bar[XB_TOP], 1u);
            const unsigned tg = og / nx;
            if (og + 1u == (tg + 1u) * nx) xb_add(&bar[XB_TOPGEN], 1u);
            else XB_SPIN(xb_ld(&bar[XB_TOPGEN]) == tg, bar);
            __builtin_amdgcn_fence(__ATOMIC_ACQUIRE, "agent");
            xb_add(&bar[XB_XGEN(b.x)], 1u);
            asm volatile("s_waitcnt vmcnt(0)" ::: "memory");
        } else {
            XB_SPIN(xb_ld(&bar[XB_XGEN(b.x)]) == gen, bar);
            __builtin_amdgcn_fence(__ATOMIC_ACQUIRE, "agent");
            asm volatile("s_waitcnt vmcnt(0)" ::: "memory");
        }
    }
    __syncthreads();
}

struct Params { const float* in[24]; float* out; unsigned char* ws; int ph_lo, ph_hi; };

__device__ __forceinline__ float silu_f(float x) { return x / (1.f + __expf(-x)); }
__device__ __forceinline__ float sigmoid_f(float x) { return 1.f / (1.f + __expf(-x)); }
__device__ __forceinline__ float tanh_f(float x) { return 1.f - 2.f / (__expf(2.f * x) + 1.f); }
__device__ __forceinline__ float wave_sum(float v) {
#pragma unroll
    for (int o = 1; o < 64; o <<= 1) v += __shfl_xor(v, o);
    return v;
}
template <int CTRL> __device__ __forceinline__ float dpp_f(float x) { return __int_as_float(__builtin_amdgcn_update_dpp(0, __float_as_int(x), CTRL, 0xf, 0xf, false)); }
__device__ __forceinline__ float red8(float x) {
    x += dpp_f<0xB1>(x); x += dpp_f<0x4E>(x); x += dpp_f<0x141>(x); return x;
}
__device__ __forceinline__ float red16(float x) {
    x += dpp_f<0xB1>(x); x += dpp_f<0x4E>(x); x += dpp_f<0x141>(x); x += dpp_f<0x140>(x); return x;
}

__device__ __forceinline__ int sigma1(int np) {
    const int T = np >> 8, c = np & 255;
    if (T < 16) { const int bj = c >> 7, wc = (c >> 5) & 3, n = (c >> 4) & 1, r = c & 15; return 1024 * (2 * bj + n) + 64 * T + 16 * wc + r; }
    if (T < 24) { return ((c >> 7) ? 6144 : 4096) + 128 * (T - 16) + (c & 127); }
    return 5120 + 256 * (T - 24) + c;
}

template <int MODE>
__device__ __forceinline__ void tr_item(const float* W, int K, int N, h16* WT, LAS float* scr, int item, int nblk, int lane) {
    const int kb = item / nblk, nb = item % nblk, k0 = 64 * kb, n0 = 32 * nb;
    const int np = n0 + (lane & 31);
    const int sc = (MODE == 1) ? sigma1(np) : np;
    const bool valid = (MODE != 2) || (np < 5248);
#pragma unroll 8
    for (int i = 0; i < 32; ++i) { const int kk = 2 * i + (lane >> 5); scr[kk * 33 + (lane & 31)] = valid ? W[(size_t)(k0 + kk) * N + sc] : 0.f; }
    asm volatile("s_waitcnt lgkmcnt(0)" ::: "memory");
    const int c = lane & 7;
#pragma unroll
    for (int j = 0; j < 4; ++j) { const int n = (lane >> 3) + 8 * j; const LAS float* s = scr + (8 * c) * 33 + n;
        h16x8 o;
#pragma unroll
        for (int e = 0; e < 8; ++e) o[e] = (h16)s[e * 33];
        *(h16x8*)(WT + (size_t)(n0 + n) * K + k0 + 8 * c) = o; }
    asm volatile("s_waitcnt lgkmcnt(0)" ::: "memory");
}

__device__ __forceinline__ void rms_row_f16(const float* xr, const h16* addr, const float* g, h16* orow, int lane) {
    f32x4 v[4]; float ss = 0.f;
#pragma unroll
    for (int j = 0; j < 4; ++j) { v[j] = *(const f32x4*)(xr + 4 * lane + 256 * j);
        if (addr) { const h16x4 a = *(const h16x4*)(addr + 4 * lane + 256 * j); v[j][0] += (float)a[0]; v[j][1] += (float)a[1]; v[j][2] += (float)a[2]; v[j][3] += (float)a[3]; }
        ss += v[j][0] * v[j][0] + v[j][1] * v[j][1] + v[j][2] * v[j][2] + v[j][3] * v[j][3]; }
    const float rs = rsqrtf(wave_sum(ss) * (1.f / 1024.f) + 1e-6f);
#pragma unroll
    for (int j = 0; j < 4; ++j) { const f32x4 gg = *(const f32x4*)(g + 4 * lane + 256 * j); h16x4 o;
        o[0] = (h16)(v[j][0] * rs * gg[0]); o[1] = (h16)(v[j][1] * rs * gg[1]); o[2] = (h16)(v[j][2] * rs * gg[2]); o[3] = (h16)(v[j][3] * rs * gg[3]);
        *(h16x4*)(orow + 4 * lane + 256 * j) = o; }
}

__device__ __forceinline__ void phase0(const Params& p, LAS unsigned char* lds) {
    const int tid = threadIdx.x, lane = tid & 63, wave = tid >> 6;
    const int gw = blockIdx.x * 8 + wave, NGW = gridDim.x * 8;
    LAS float* scr = (LAS float*)(lds + wave * 8448);
    h16* W1T = (h16*)(p.ws + WS_W1T); h16* W2T = (h16*)(p.ws + WS_W2T); h16* W3T = (h16*)(p.ws + WS_W3T); h16* W4T = (h16*)(p.ws + WS_W4T);
    constexpr int I1 = 16 * 224, I2 = 32 * 32, I3 = 16 * 168, I4 = 24 * 32;
    for (int it = gw; it < I1 + I2 + I3 + I4; it += NGW) {
        int r = it;
        if (r < I1) { tr_item<1>(p.in[2], 1024, 7168, W1T, scr, r, 224, lane); continue; } r -= I1;
        if (r < I2) { tr_item<0>(p.in[8], 2048, 1024, W2T, scr, r, 32, lane); continue; } r -= I2;
        if (r < I3) { tr_item<2>(p.in[10], 1024, 5248, W3T, scr, r, 168, lane); continue; } r -= I3;
        tr_item<0>(p.in[22], 1536, 1024, W4T, scr, r, 32, lane);
    }
    h16* H0 = (h16*)p.out;
    for (int r = gw; r < NTOK; r += NGW) rms_row_f16(p.in[0] + (size_t)r * DM, nullptr, p.in[1], H0 + (size_t)r * DM, lane);
    const int gt = blockIdx.x * 512 + tid, NGT = gridDim.x * 512;
    h16* WSH = (h16*)(p.ws + WS_WSH);
    for (int i = gt; i < 8 * 128 * 128; i += NGT) WSH[i] = (h16)p.in[6][i];
    h16* CWT = (h16*)(p.ws + WS_CWT);
    const float* wf = p.in[21];
    for (int i = gt; i < 4 * 128 * 256; i += NGT) {
        const int k = i & 255, e = (i >> 8) & 127, g = i >> 15, d = k & 127; const bool sn = k >= 128;
        float s = 0.f;
        for (int dp = 0; dp < 128; ++dp) { const float fr = (float)((d * dp) & 127) * (1.f / 128.f);
            const float tw = sn ? __builtin_amdgcn_sinf(fr) : __builtin_amdgcn_cosf(fr);
            s += tw * wf[(g * 128 + dp) * 128 + e]; }
        CWT[i] = (h16)(s * 0.08838834764831845f);
    }
}

struct Epi1 {
    h16 *XC, *G, *U, *V;
    __device__ __forceinline__ void operator()(const f32x4 (&acc)[2][2][4][2], const pg8::Unit& u, int wr, int wc, int fr, int fq) const {
        const int T = u.pn; const int row0 = u.pm * 256 + wr * 64 + fr;
        if (T < 16) {
            const int ch = 64 * T + 16 * wc + 4 * fq;
#pragma unroll
            for (int ai = 0; ai < 2; ++ai)
#pragma unroll
                for (int m = 0; m < 4; ++m) { const size_t r = (size_t)(row0 + ai * 128 + m * 16);
                    const f32x4 xa = acc[ai][0][m][0], ba = acc[ai][0][m][1], ca = acc[ai][1][m][0], za = acc[ai][1][m][1];
                    h16x4 xc, gg;
#pragma unroll
                    for (int e = 0; e < 4; ++e) { xc[e] = (h16)(ca[e] * xa[e]); gg[e] = (h16)(ba[e] * silu_f(za[e])); }
                    *(h16x4*)(XC + r * 1024 + ch) = xc; *(h16x4*)(G + r * 1024 + ch) = gg; }
        } else if (T < 24) {
#pragma unroll
            for (int ai = 0; ai < 2; ++ai)
#pragma unroll
                for (int m = 0; m < 4; ++m) { const size_t r = (size_t)(row0 + ai * 128 + m * 16);
#pragma unroll
                    for (int n = 0; n < 2; ++n) { const int ch = 128 * (T - 16) + 32 * wc + 16 * n + 4 * fq;
                        const f32x4 ub = acc[ai][0][m][n], zb = acc[ai][1][m][n]; h16x4 o;
#pragma unroll
                        for (int e = 0; e < 4; ++e) o[e] = (h16)(ub[e] * silu_f(zb[e]));
                        *(h16x4*)(U + r * 1024 + ch) = o; } }
        } else {
#pragma unroll
            for (int ai = 0; ai < 2; ++ai)
#pragma unroll
                for (int m = 0; m < 4; ++m) { const size_t r = (size_t)(row0 + ai * 128 + m * 16);
#pragma unroll
                    for (int bj = 0; bj < 2; ++bj)
#pragma unroll
                        for (int n = 0; n < 2; ++n) { const int ch = 256 * (T - 24) + 128 * bj + 32 * wc + 16 * n + 4 * fq;
                            const f32x4 v = acc[ai][bj][m][n]; h16x4 o;
#pragma unroll
                            for (int e = 0; e < 4; ++e) o[e] = (h16)v[e];
                            *(h16x4*)(V + r * 1024 + ch) = o; } }
        }
    }
};
struct Epi2 {
    h16* O1;
    __device__ __forceinline__ void operator()(const f32x4 (&acc)[2][2][4][2], const pg8::Unit& u, int wr, int wc, int fr, int fq) const {
        const int row0 = u.pm * 256 + wr * 64 + fr, col0 = u.pn * 256 + wc * 32 + 4 * fq;
#pragma unroll
        for (int ai = 0; ai < 2; ++ai)
#pragma unroll
            for (int m = 0; m < 4; ++m) { const size_t r = (size_t)(row0 + ai * 128 + m * 16);
#pragma unroll
                for (int bj = 0; bj < 2; ++bj)
#pragma unroll
                    for (int n = 0; n < 2; ++n) { const f32x4 v = acc[ai][bj][m][n]; h16x4 o;
#pragma unroll
                        for (int e = 0; e < 4; ++e) o[e] = (h16)v[e];
                        *(h16x4*)(O1 + r * 1024 + col0 + bj * 128 + n * 16) = o; } }
    }
};
struct Epi3 {
    h16 *PC, *ZCD, *FD;
    __device__ __forceinline__ void operator()(const f32x4 (&acc)[2][2][4][2], const pg8::Unit& u, int wr, int wc, int fr, int fq) const {
        const int row0 = u.pm * 256 + wr * 64 + fr, col0 = u.pn * 256 + wc * 32 + 4 * fq;
#pragma unroll
        for (int bj = 0; bj < 2; ++bj)
#pragma unroll
            for (int n = 0; n < 2; ++n) { const int c = col0 + bj * 128 + n * 16;
                h16* base; size_t ld;
                if (c < 3200) { base = PC + c; ld = 3200; }
                else if (c < 4224) { base = ZCD + (c - 3200); ld = 1536; }
                else if (c < 4736) { base = FD + (c - 4224); ld = 512; }
                else if (c < 5248) { base = ZCD + 1024 + (c - 4736); ld = 1536; }
                else continue;
#pragma unroll
                for (int ai = 0; ai < 2; ++ai)
#pragma unroll
                    for (int m = 0; m < 4; ++m) { const size_t r = (size_t)(row0 + ai * 128 + m * 16); const f32x4 v = acc[ai][bj][m][n]; h16x4 o;
#pragma unroll
                        for (int e = 0; e < 4; ++e) o[e] = (h16)v[e];
                        *(h16x4*)(base + r * ld) = o; } }
    }
};
struct Epi4 {
    const float* X; const h16* O1; float* OUT;
    __device__ __forceinline__ void operator()(const f32x4 (&acc)[2][2][4][2], const pg8::Unit& u, int wr, int wc, int fr, int fq) const {
        const int row0 = u.pm * 256 + wr * 64 + fr, col0 = u.pn * 256 + wc * 32 + 4 * fq;
#pragma unroll
        for (int ai = 0; ai < 2; ++ai)
#pragma unroll
            for (int m = 0; m < 4; ++m) { const size_t r = (size_t)(row0 + ai * 128 + m * 16);
#pragma unroll
                for (int bj = 0; bj < 2; ++bj)
#pragma unroll
                    for (int n = 0; n < 2; ++n) { const size_t o = r * 1024 + col0 + bj * 128 + n * 16;
                        const f32x4 xv = *(const f32x4*)(X + o); const h16x4 ov = *(const h16x4*)(O1 + o); f32x4 v = acc[ai][bj][m][n];
                        v[0] += xv[0] + (float)ov[0]; v[1] += xv[1] + (float)ov[1]; v[2] += xv[2] + (float)ov[2]; v[3] += xv[3] + (float)ov[3];
                        *(f32x4*)(OUT + o) = v; } }
    }
};

__device__ __forceinline__ void phase_stats(const Params& p) {
    const int tid = threadIdx.x, lane = tid & 63, wave = tid >> 6;
    const int gw = blockIdx.x * 8 + wave, NGW = gridDim.x * 8;
    const h16* V = (const h16*)(p.ws + WS_V); float* ST = (float*)(p.ws + WS_STATS);
    for (int r = gw; r < NTOK; r += NGW) {
        const h16x8 a = *(const h16x8*)(V + (size_t)r * 1024 + 8 * lane), b = *(const h16x8*)(V + (size_t)r * 1024 + 512 + 8 * lane);
        float s = 0.f;
#pragma unroll
        for (int e = 0; e < 8; ++e) s += (float)a[e] + (float)b[e];
        const float mu = wave_sum(s) * (1.f / 1024.f); float q = 0.f;
#pragma unroll
        for (int e = 0; e < 8; ++e) { const float x = (float)a[e] - mu, y = (float)b[e] - mu; q += x * x + y * y; }
        const float rs = rsqrtf(wave_sum(q) * (1.f / 1024.f) + 1e-5f);
        if (lane == 0) { ST[2 * r] = mu; ST[2 * r + 1] = rs; }
    }
}

__device__ __forceinline__ void phase_mix0(const Params& p, LAS unsigned char* lds) {
    const int tid = threadIdx.x, lane = tid & 63, wave = tid >> 6;
    const h16* XC = (const h16*)(p.ws + WS_XC); const h16* G = (const h16*)(p.ws + WS_G); const h16* U = (const h16*)(p.ws + WS_U); const h16* V = (const h16*)(p.ws + WS_V);
    h16* YC = (h16*)(p.ws + WS_YCAT);
    const float* cw = p.in[3];
    const int gt = blockIdx.x * 512 + tid, NGT = gridDim.x * 512;
    for (int idx = gt; idx < NTOK * 128; idx += NGT) {
        const int t = idx >> 7, c8 = (idx & 127) * 8, tp = t & (SEQ - 1);
        const h16x8 zero = {0, 0, 0, 0, 0, 0, 0, 0};
        const h16x8 x0 = *(const h16x8*)(XC + (size_t)t * 1024 + c8);
        const h16x8 xm = tp > 0 ? *(const h16x8*)(XC + (size_t)(t - 1) * 1024 + c8) : zero;
        const h16x8 xp = tp < SEQ - 1 ? *(const h16x8*)(XC + (size_t)(t + 1) * 1024 + c8) : zero;
        const h16x8 gg = *(const h16x8*)(G + (size_t)t * 1024 + c8);
        h16x8 o;
#pragma unroll
        for (int e = 0; e < 8; ++e) { const float y = cw[c8 + e] * (float)xm[e] + cw[1024 + c8 + e] * (float)x0[e] + cw[2048 + c8 + e] * (float)xp[e]; o[e] = (h16)(y * (float)gg[e]); }
        *(h16x8*)(YC + (size_t)t * 2048 + c8) = o;
    }
    const float* ST = (const float*)(p.ws + WS_STATS); const h16* WSH = (const h16*)(p.ws + WS_WSH);
    const float* lng = p.in[4]; const float* lnb = p.in[5]; const float* bs = p.in[7];
    LAS h16* vnT = (LAS h16*)lds;
    for (int it = blockIdx.x; it < 1024; it += gridDim.x) {
        const int g = it & 7, bn = it >> 3, t0 = bn * 128;
        __syncthreads();
#pragma unroll
        for (int q = 0; q < 4; ++q) { const int pc = tid + 512 * q, j = pc >> 4, d8 = (pc & 15) * 8;
            const h16x8 v = *(const h16x8*)(V + (size_t)(t0 + j) * 1024 + g * 128 + d8);
            const float mu = ST[2 * (t0 + j)], rs = ST[2 * (t0 + j) + 1];
#pragma unroll
            for (int e = 0; e < 8; ++e) vnT[(d8 + e) * 136 + j] = (h16)(((float)v[e] - mu) * rs * lng[g * 128 + d8 + e] + lnb[g * 128 + d8 + e]); }
        __syncthreads();
        const int itile = wave >> 1, dt0 = (wave & 1) * 2;
        f32x16 acc0, acc1;
#pragma unroll
        for (int e = 0; e < 16; ++e) { acc0[e] = 0.f; acc1[e] = 0.f; }
        const h16* Arow = WSH + ((size_t)g * 128 + itile * 32 + (lane & 31)) * 128 + 8 * (lane >> 5);
        const LAS h16* B0p = vnT + (dt0 * 32 + (lane & 31)) * 136 + 8 * (lane >> 5);
        const LAS h16* B1p = B0p + 32 * 136;
#pragma unroll
        for (int ks = 0; ks < 8; ++ks) {
            const h16x8 a = *(const h16x8*)(Arow + 16 * ks);
            const h16x8 b0 = *(const LAS h16x8*)(B0p + 16 * ks), b1 = *(const LAS h16x8*)(B1p + 16 * ks);
            acc0 = __builtin_amdgcn_mfma_f32_32x32x16_f16(a, b0, acc0, 0, 0, 0);
            acc1 = __builtin_amdgcn_mfma_f32_32x32x16_f16(a, b1, acc1, 0, 0, 0);
        }
#pragma unroll
        for (int r = 0; r < 16; ++r) { const int i = itile * 32 + (r & 3) + 8 * (r >> 2) + 4 * (lane >> 5); const size_t t = (size_t)(t0 + i);
            const float bias = bs[g * 128 + i];
            const int d0 = g * 128 + dt0 * 32 + (lane & 31);
            YC[t * 2048 + 1024 + d0] = (h16)((acc0[r] + bias) * (float)U[t * 1024 + d0]);
            YC[t * 2048 + 1024 + d0 + 32] = (h16)((acc1[r] + bias) * (float)U[t * 1024 + d0 + 32]); }
    }
}

__device__ __forceinline__ void phase_norm1(const Params& p) {
    const int tid = threadIdx.x, lane = tid & 63, wave = tid >> 6;
    const int gw = blockIdx.x * 8 + wave, NGW = gridDim.x * 8;
    const h16* O1 = (const h16*)(p.ws + WS_O1); h16* H1 = (h16*)p.out;
    for (int r = gw; r < NTOK; r += NGW) rms_row_f16(p.in[0] + (size_t)r * DM, O1 + (size_t)r * DM, p.in[9], H1 + (size_t)r * DM, lane);
}

__device__ __forceinline__ void phase_fft(const Params& p, LAS unsigned char* lds) {
    const int tid = threadIdx.x;
    const h16* FD = (const h16*)(p.ws + WS_FD);
    h16* SPr = (h16*)((unsigned char*)p.out + 32 * MiB); h16* SPi = (h16*)((unsigned char*)p.out + 48 * MiB);
    LAS f32x2* X0 = (LAS f32x2*)lds; LAS f32x2* X1 = X0 + 8192;
    for (int it = blockIdx.x; it < 256; it += gridDim.x) {
        const int b = it >> 7, c0 = 4 * (it & 127);
        __syncthreads();
        for (int t = tid; t < SEQ; t += 512) { const h16x4 v = *(const h16x4*)(FD + (size_t)(b * SEQ + t) * 512 + c0);
            X0[t] = (f32x2){(float)v[0], (float)v[1]}; X1[t] = (f32x2){(float)v[2], (float)v[3]}; }
        __syncthreads();
        for (int s = 0; s < 13; ++s) {
            const int half = 4096 >> s;
#pragma unroll 2
            for (int j = tid; j < 4096; j += 512) {
                const int pos = j & (half - 1), grp = j >> (12 - s), i0 = (grp << (13 - s)) + pos, i1 = i0 + half;
                const float fr = (float)(pos << s) * (1.f / 8192.f);
                const float c = __builtin_amdgcn_cosf(fr), sn = __builtin_amdgcn_sinf(fr);
                { const f32x2 a = X0[i0], bb = X0[i1]; const f32x2 d = a - bb; X0[i0] = a + bb; X0[i1] = (f32x2){d[0] * c + d[1] * sn, d[1] * c - d[0] * sn}; }
                { const f32x2 a = X1[i0], bb = X1[i1]; const f32x2 d = a - bb; X1[i0] = a + bb; X1[i1] = (f32x2){d[0] * c + d[1] * sn, d[1] * c - d[0] * sn}; }
            }
            __syncthreads();
        }
        const float sc = 0.5f * 0.011048543456039806f;
        for (int k = tid; k < SEQ; k += 512) {
            const int ra = __brev((unsigned)k) >> 19, rb = __brev((unsigned)((SEQ - k) & (SEQ - 1))) >> 19;
            const f32x2 za = X0[ra], zb = X0[rb], ya = X1[ra], yb = X1[rb];
            h16x4 orr, oi;
            orr[0] = (h16)((za[0] + zb[0]) * sc); oi[0] = (h16)((za[1] - zb[1]) * sc);
            orr[1] = (h16)((za[1] + zb[1]) * sc); oi[1] = (h16)((zb[0] - za[0]) * sc);
            orr[2] = (h16)((ya[0] + yb[0]) * sc); oi[2] = (h16)((ya[1] - yb[1]) * sc);
            orr[3] = (h16)((ya[1] + yb[1]) * sc); oi[3] = (h16)((yb[0] - ya[0]) * sc);
            *(h16x4*)(SPr + (size_t)(b * SEQ + k) * 512 + c0) = orr; *(h16x4*)(SPi + (size_t)(b * SEQ + k) * 512 + c0) = oi;
        }
    }
}

__device__ __forceinline__ void phase_fnet_out(const Params& p) {
    const int tid = threadIdx.x, lane = tid & 63, wave = tid >> 6;
    const int gw = blockIdx.x * 8 + wave, NGW = gridDim.x * 8;
    const h16* SPr = (const h16*)((const unsigned char*)p.out + 32 * MiB); const h16* SPi = (const h16*)((const unsigned char*)p.out + 48 * MiB);
    const h16* CWT = (const h16*)(p.ws + WS_CWT); h16* ZCD = (h16*)(p.ws + WS_ZCD);
    for (int w = gw; w < 8192; w += NGW) {
        const int et = w & 3, g = (w >> 2) & 3, tt = w >> 4;
        const size_t trow = (size_t)(tt * 32 + (lane & 31));
        const h16* Ar = SPr + trow * 512 + g * 128 + 8 * (lane >> 5); const h16* Ai = SPi + trow * 512 + g * 128 + 8 * (lane >> 5);
        const h16* Bp = CWT + ((size_t)(g * 128 + et * 32 + (lane & 31))) * 256 + 8 * (lane >> 5);
        f32x16 acc;
#pragma unroll
        for (int e = 0; e < 16; ++e) acc[e] = 0.f;
#pragma unroll
        for (int ks = 0; ks < 8; ++ks) acc = __builtin_amdgcn_mfma_f32_32x32x16_f16(*(const h16x8*)(Ar + 16 * ks), *(const h16x8*)(Bp + 16 * ks), acc, 0, 0, 0);
#pragma unroll
        for (int ks = 0; ks < 8; ++ks) acc = __builtin_amdgcn_mfma_f32_32x32x16_f16(*(const h16x8*)(Ai + 16 * ks), *(const h16x8*)(Bp + 128 + 16 * ks), acc, 0, 0, 0);
#pragma unroll
        for (int r = 0; r < 16; ++r) { const size_t t = (size_t)(tt * 32 + (r & 3) + 8 * (r >> 2) + 4 * (lane >> 5));
            h16* zp = ZCD + t * 1536 + 1024 + g * 128 + et * 32 + (lane & 31);
            *zp = (h16)(acc[r] * silu_f((float)*zp)); }
    }
}

__device__ __forceinline__ void phase_scan(const Params& p, LAS unsigned char* lds) {
    const int tid = threadIdx.x, lane = tid & 63, wave = tid >> 6;
    const h16* PC = (const h16*)(p.ws + WS_PC);
    LAS h16* w2T = (LAS h16*)lds;
    LAS h16* a2T = w2T + 64 * 72;
    LAS h16* TWh = a2T + 64 * 72;
    LAS h16* QAh = TWh + 32 * 72;
    LAS float* ZW = (LAS float*)(QAh + 32 * 72);
    LAS float* ZA = ZW + 2048;
    LAS float* sR = ZA + 2048; LAS float* sW = sR + 2048; LAS float* sK = sW + 2048; LAS float* sV = sK + 2048; LAS float* sA = sV + 2048; LAS float* sB = sA + 2048;
    LAS float* sY = sB + 2048;
    for (int item = blockIdx.x; item < 256; item += gridDim.x) {
        const int xcd = item & 7, slot = item >> 3, gidx = xcd * 8 + (slot >> 2), q = slot & 3;
        const int dir = gidx >> 5, b = (gidx >> 4) & 1, h = gidx & 15;
        h16* Yd = (h16*)((unsigned char*)p.out + (size_t)dir * 32 * MiB);
        float* SB = (float*)(p.ws + WS_SBON) + (size_t)dir * NTOK * 16;
        const float* mu = p.in[11] + dir * 3200; const float* w0 = p.in[12] + dir * 1024 + 64 * h; const float* w2 = p.in[13] + (size_t)dir * 65536 + 64 * h;
        const float* a0 = p.in[14] + dir * 1024 + 64 * h; const float* a2 = p.in[15] + (size_t)dir * 65536 + 64 * h;
        const float* kkw = p.in[16] + 64 * h; const float* kaw = p.in[17] + 64 * h; const float* rkw = p.in[18] + 64 * h;
        __syncthreads();
        for (int i = tid; i < 4096; i += 512) { const int l = i >> 6, c = i & 63; w2T[c * 72 + l] = (h16)w2[l * 1024 + c]; a2T[c * 72 + l] = (h16)a2[l * 1024 + c]; }
        const int s_l = tid >> 4, c4 = (tid & 15) * 4;
        float mr[4], mk[4], mv[4], mw[4], ma[4], w0r[4], a0r[4], kkr[4], kar[4], rkr[4];
#pragma unroll
        for (int e = 0; e < 4; ++e) { mr[e] = mu[64 * h + c4 + e]; mk[e] = mu[1024 + 64 * h + c4 + e]; mv[e] = mu[2048 + 64 * h + c4 + e]; mw[e] = mu[3072 + c4 + e]; ma[e] = mu[3136 + c4 + e];
            w0r[e] = w0[c4 + e]; a0r[e] = a0[c4 + e]; kkr[e] = kkw[c4 + e]; kar[e] = kaw[c4 + e]; rkr[e] = rkw[c4 + e]; }
        f32x2 S01 = {0.f, 0.f}, S23 = {0.f, 0.f};
        const int srow = 4 * (wave & 3) + (lane >> 4), j0 = 4 * (lane & 15);
        const h16x4 z4 = {0, 0, 0, 0};
        h16x4 pr, pk, pv, pw, pa, qr_, qk_, qv_, qw_, qa_;
#define SCAN_LOAD(chn) do { const int sg_ = (chn) * 32 + s_l; const int t_ = dir ? (SEQ - 1 - sg_) : sg_; \
            const size_t rowc_ = (size_t)(b * SEQ + t_) * 3200; const size_t rowp_ = (size_t)(b * SEQ + (dir ? t_ + 1 : t_ - 1)) * 3200; const bool hp_ = sg_ > 0; \
            pr = *(const h16x4*)(PC + rowc_ + 64 * h + c4); pk = *(const h16x4*)(PC + rowc_ + 1024 + 64 * h + c4); pv = *(const h16x4*)(PC + rowc_ + 2048 + 64 * h + c4); \
            pw = *(const h16x4*)(PC + rowc_ + 3072 + c4); pa = *(const h16x4*)(PC + rowc_ + 3136 + c4); \
            qr_ = hp_ ? *(const h16x4*)(PC + rowp_ + 64 * h + c4) : z4; qk_ = hp_ ? *(const h16x4*)(PC + rowp_ + 1024 + 64 * h + c4) : z4; qv_ = hp_ ? *(const h16x4*)(PC + rowp_ + 2048 + 64 * h + c4) : z4; \
            qw_ = hp_ ? *(const h16x4*)(PC + rowp_ + 3072 + c4) : z4; qa_ = hp_ ? *(const h16x4*)(PC + rowp_ + 3136 + c4) : z4; } while (0)
        SCAN_LOAD(0);
        for (int ch = 0; ch < SEQ / 32; ++ch) {
            const int sg = ch * 32 + s_l;
            const int t = dir ? (SEQ - 1 - sg) : sg;
            float qr[4], qk[4], qv[4];
            { h16x4 tw4, qa4;
#pragma unroll
              for (int e = 0; e < 4; ++e) {
                const float r0 = (float)pr[e], k0 = (float)pk[e], v0 = (float)pv[e], wd0 = (float)pw[e], ad0 = (float)pa[e];
                qr[e] = r0 + mr[e] * ((float)qr_[e] - r0); qk[e] = k0 + mk[e] * ((float)qk_[e] - k0); qv[e] = v0 + mv[e] * ((float)qv_[e] - v0);
                tw4[e] = (h16)tanh_f(wd0 + mw[e] * ((float)qw_[e] - wd0)); qa4[e] = (h16)(ad0 + ma[e] * ((float)qa_[e] - ad0)); }
              *(LAS h16x4*)(TWh + s_l * 72 + c4) = tw4; *(LAS h16x4*)(QAh + s_l * 72 + c4) = qa4; }
            __syncthreads();
            if (wave < 4) {
                const LAS h16* Ap = ((wave & 2) ? QAh : TWh) + (lane & 31) * 72 + 8 * (lane >> 5);
                const LAS h16* Bp = ((wave & 2) ? a2T : w2T) + ((wave & 1) * 32 + (lane & 31)) * 72 + 8 * (lane >> 5);
                f32x16 acc;
#pragma unroll
                for (int e = 0; e < 16; ++e) acc[e] = 0.f;
#pragma unroll
                for (int ks = 0; ks < 4; ++ks) acc = __builtin_amdgcn_mfma_f32_32x32x16_f16(*(const LAS h16x8*)(Ap + 16 * ks), *(const LAS h16x8*)(Bp + 16 * ks), acc, 0, 0, 0);
                LAS float* Z = ((wave & 2) ? ZA : ZW) + (wave & 1) * 32 + (lane & 31);
#pragma unroll
                for (int r = 0; r < 16; ++r) Z[((r & 3) + 8 * (r >> 2) + 4 * (lane >> 5)) * 64] = acc[r];
            }
            __syncthreads();
            {
                const f32x4 zw4 = *(const LAS f32x4*)(ZW + s_l * 64 + c4), za4 = *(const LAS f32x4*)(ZA + s_l * 64 + c4);
                float kk[4], av_[4], kn = 0.f, sbn = 0.f, kp[4], dec[4];
#pragma unroll
                for (int e = 0; e < 4; ++e) { dec[e] = __expf(-0.6065306597126334f * sigmoid_f(zw4[e] + w0r[e])); av_[e] = sigmoid_f(za4[e] + a0r[e]);
                    kk[e] = qk[e] * kkr[e]; kn += kk[e] * kk[e]; kp[e] = qk[e] * (1.f + (av_[e] - 1.f) * kar[e]); sbn += qr[e] * kp[e] * rkr[e]; }
                kn = red16(kn); sbn = red16(sbn);
                const float inv = rsqrtf(fmaxf(kn, 1e-12f));
                f32x4 oR, oW, oK, oV, oA, oB;
#pragma unroll
                for (int e = 0; e < 4; ++e) { const float kn_ = kk[e] * inv; oR[e] = qr[e]; oW[e] = dec[e]; oK[e] = kp[e]; oV[e] = qv[e]; oA[e] = -kn_; oB[e] = kn_ * av_[e]; }
                const int o = s_l * 64 + c4;
                *(LAS f32x4*)(sR + o) = oR; *(LAS f32x4*)(sW + o) = oW; *(LAS f32x4*)(sK + o) = oK; *(LAS f32x4*)(sV + o) = oV; *(LAS f32x4*)(sA + o) = oA; *(LAS f32x4*)(sB + o) = oB;
                if (q == 0 && (tid & 15) == 0) SB[(size_t)(b * SEQ + t) * 16 + h] = sbn;
            }
            if (ch + 1 < SEQ / 32) SCAN_LOAD(ch + 1);
            __syncthreads();
            if (wave < 4) {
                f32x4 a_ = *(const LAS f32x4*)(sA + j0), w_ = *(const LAS f32x4*)(sW + j0), b_ = *(const LAS f32x4*)(sB + j0);
                f32x4 k_ = *(const LAS f32x4*)(sK + j0), r_ = *(const LAS f32x4*)(sR + j0);
                float v = sV[16 * q + srow];
#pragma unroll 4
                for (int s = 0; s < 32; ++s) {
                    const int sn = ((s + 1) & 31) * 64;
                    const f32x4 a_n = *(const LAS f32x4*)(sA + sn + j0), w_n = *(const LAS f32x4*)(sW + sn + j0), b_n = *(const LAS f32x4*)(sB + sn + j0);
                    const f32x4 k_n = *(const LAS f32x4*)(sK + sn + j0), r_n = *(const LAS f32x4*)(sR + sn + j0);
                    const float v_n = sV[sn + 16 * q + srow];
                    const f32x2 vv = {v, v};
                    f32x2 pp = S01 * (f32x2){a_[0], a_[1]}; pp = S23 * (f32x2){a_[2], a_[3]} + pp;
                    const float sa = red16(pp[0] + pp[1]);
                    const f32x2 sv = {sa, sa};
                    S01 = S01 * (f32x2){w_[0], w_[1]} + vv * (f32x2){k_[0], k_[1]};
                    S23 = S23 * (f32x2){w_[2], w_[3]} + vv * (f32x2){k_[2], k_[3]};
                    S01 = sv * (f32x2){b_[0], b_[1]} + S01;
                    S23 = sv * (f32x2){b_[2], b_[3]} + S23;
                    f32x2 yy = S01 * (f32x2){r_[0], r_[1]}; yy = S23 * (f32x2){r_[2], r_[3]} + yy;
                    const float y = red16(yy[0] + yy[1]);
                    if ((lane & 15) == 0) sY[s * 16 + srow] = y;
                    a_ = a_n; w_ = w_n; b_ = b_n; k_ = k_n; r_ = r_n; v = v_n;
                }
            }
            __syncthreads();
            Yd[(size_t)(b * SEQ + t) * 1024 + 64 * h + 16 * q + (tid & 15)] = (h16)sY[s_l * 16 + (tid & 15)];
        }
#undef SCAN_LOAD
    }
}

__device__ __forceinline__ void phase_post(const Params& p) {
    const int tid = threadIdx.x;
    const h16* Y0 = (const h16*)p.out; const h16* Y1 = (const h16*)((const unsigned char*)p.out + 32 * MiB);
    const h16* PC = (const h16*)(p.ws + WS_PC); h16* ZCD = (h16*)(p.ws + WS_ZCD);
    const float* SB0 = (const float*)(p.ws + WS_SBON); const float* SB1 = SB0 + (size_t)NTOK * 16;
    const float* mu0 = p.in[11] + 2048; const float* mu1 = p.in[11] + 3200 + 2048;
    const float* lg = p.in[19]; const float* lb = p.in[20];
    const int gt = blockIdx.x * 512 + tid, NGT = gridDim.x * 512;
    for (int idx = gt; idx < NTOK * 256; idx += NGT) {
        const int t = idx >> 8, c = (idx & 255) * 4, hh = c >> 6, tp = t & (SEQ - 1);
        const h16x4 y0 = *(const h16x4*)(Y0 + (size_t)t * 1024 + c), y1 = *(const h16x4*)(Y1 + (size_t)t * 1024 + c);
        float y[4], s = 0.f;
#pragma unroll
        for (int e = 0; e < 4; ++e) { y[e] = (float)y0[e] + (float)y1[e]; s += y[e]; }
        const float mean = red16(s) * (1.f / 64.f); float q = 0.f;
#pragma unroll
        for (int e = 0; e < 4; ++e) { y[e] -= mean; q += y[e] * y[e]; }
        const float rs = rsqrtf(red16(q) * (1.f / 64.f) + 64e-5f);
        const h16x4 z4 = {0, 0, 0, 0};
        const h16x4 v0 = *(const h16x4*)(PC + (size_t)t * 3200 + 2048 + c);
        const h16x4 vm = tp > 0 ? *(const h16x4*)(PC + (size_t)(t - 1) * 3200 + 2048 + c) : z4;
        const h16x4 vp = tp < SEQ - 1 ? *(const h16x4*)(PC + (size_t)(t + 1) * 3200 + 2048 + c) : z4;
        const float s0 = SB0[(size_t)t * 16 + hh], s1 = SB1[(size_t)t * 16 + hh];
        const h16x4 zc = *(const h16x4*)(ZCD + (size_t)t * 1536 + c);
        h16x4 o;
#pragma unroll
        for (int e = 0; e < 4; ++e) { const float vv = (float)v0[e];
            const float vd0 = vv + mu0[c + e] * ((float)vm[e] - vv), vd1 = vv + mu1[c + e] * ((float)vp[e] - vv);
            const float val = y[e] * rs * lg[c + e] + lb[c + e] + s0 * vd0 + s1 * vd1;
            o[e] = (h16)(val * silu_f((float)zc[e])); }
        *(h16x4*)(ZCD + (size_t)t * 1536 + c) = o;
    }
}

__device__ __forceinline__ void phase_final(const Params& p) {
    const int tid = threadIdx.x, lane = tid & 63, wave = tid >> 6;
    const int gw = blockIdx.x * 8 + wave, NGW = gridDim.x * 8;
    const float* g = p.in[23];
    for (int r = gw; r < NTOK; r += NGW) {
        float* xr = p.out + (size_t)r * DM; f32x4 v[4]; float ss = 0.f;
#pragma unroll
        for (int j = 0; j < 4; ++j) { v[j] = *(const f32x4*)(xr + 4 * lane + 256 * j); ss += v[j][0] * v[j][0] + v[j][1] * v[j][1] + v[j][2] * v[j][2] + v[j][3] * v[j][3]; }
        const float rs = rsqrtf(wave_sum(ss) * (1.f / 1024.f) + 1e-6f);
#pragma unroll
        for (int j = 0; j < 4; ++j) { const f32x4 gg = *(const f32x4*)(g + 4 * lane + 256 * j); f32x4 o = v[j] * rs; o = o * gg; *(f32x4*)(xr + 4 * lane + 256 * j) = o; }
    }
}

__global__ void __launch_bounds__(512, 2) mega(Params p) {
    extern __shared__ __attribute__((aligned(16))) unsigned char smem[];
    LAS unsigned char* lds = (LAS unsigned char*)smem;
    cg::grid_group grid = cg::this_grid();
    unsigned char* ws = p.ws;
    const int lo = p.ph_lo, hi = p.ph_hi;
#define IN(k) (lo <= (k) && (k) < hi)
    volatile LAS unsigned* bst = (volatile LAS unsigned*)(lds + LDS_MAIN);
    if (threadIdx.x < 4) bst[threadIdx.x] = 0u;
    __syncthreads();
    const XcdBarrier bar = xcd_barrier_post((unsigned*)(ws + WS_BAR), bst);
    if (hi > 1000) grid.sync();
#define SEAM(k) do { if (IN(k) && IN((k) + 1)) { xcd_barrier(bar); if ((REPMASK >> 13) & 1) xcd_barrier(bar); } } while (0)
    if (IN(0)) for (int rep_ = 0; rep_ <= ((REPMASK >> 0) & 1); ++rep_) { phase0(p, lds); } SEAM(0);
    if (IN(1)) for (int rep_ = 0; rep_ <= ((REPMASK >> 1) & 1); ++rep_) { pg8::Gemm g{(const h16*)p.out, (const h16*)(ws + WS_W1T), NTOK, 7168, 1024}; pg8::StaticOrder S; S.init(NTOK, 7168, gridDim.x, blockIdx.x);
                 Epi1 E{(h16*)(ws + WS_XC), (h16*)(ws + WS_G), (h16*)(ws + WS_U), (h16*)(ws + WS_V)}; pg8::gemm_phase<Epi1>(lds, g, S, E); } SEAM(1);
    if (IN(2)) for (int rep_ = 0; rep_ <= ((REPMASK >> 2) & 1); ++rep_) { phase_stats(p); } SEAM(2);
    if (IN(3)) for (int rep_ = 0; rep_ <= ((REPMASK >> 3) & 1); ++rep_) { phase_mix0(p, lds); } SEAM(3);
    if (IN(4)) for (int rep_ = 0; rep_ <= ((REPMASK >> 4) & 1); ++rep_) { pg8::Gemm g{(const h16*)(ws + WS_YCAT), (const h16*)(ws + WS_W2T), NTOK, 1024, 2048}; pg8::StaticOrder S; S.init(NTOK, 1024, gridDim.x, blockIdx.x);
                 Epi2 E{(h16*)(ws + WS_O1)}; pg8::gemm_phase<Epi2>(lds, g, S, E); } SEAM(4);
    if (IN(5)) for (int rep_ = 0; rep_ <= ((REPMASK >> 5) & 1); ++rep_) { phase_norm1(p); } SEAM(5);
    if (IN(6)) for (int rep_ = 0; rep_ <= ((REPMASK >> 6) & 1); ++rep_) { pg8::Gemm g{(const h16*)p.out, (const h16*)(ws + WS_W3T), NTOK, 5376, 1024}; pg8::StaticOrder S; S.init(NTOK, 5376, gridDim.x, blockIdx.x);
                 Epi3 E{(h16*)(ws + WS_PC), (h16*)(ws + WS_ZCD), (h16*)(ws + WS_FD)}; pg8::gemm_phase<Epi3>(lds, g, S, E); } SEAM(6);
    if (IN(7)) for (int rep_ = 0; rep_ <= ((REPMASK >> 7) & 1); ++rep_) { phase_fft(p, lds); } SEAM(7);
    if (IN(8)) for (int rep_ = 0; rep_ <= ((REPMASK >> 8) & 1); ++rep_) { phase_fnet_out(p); } SEAM(8);
    if (IN(9)) for (int rep_ = 0; rep_ <= ((REPMASK >> 9) & 1); ++rep_) { phase_scan(p, lds); } SEAM(9);
    if (IN(10)) for (int rep_ = 0; rep_ <= ((REPMASK >> 10) & 1); ++rep_) { phase_post(p); } SEAM(10);
    if (IN(11)) for (int rep_ = 0; rep_ <= ((REPMASK >> 11) & 1); ++rep_) { pg8::Gemm g{(const h16*)(ws + WS_ZCD), (const h16*)(ws + WS_W4T), NTOK, 1024, 1536}; pg8::StaticOrder S; S.init(NTOK, 1024, gridDim.x, blockIdx.x);
                  Epi4 E{p.in[0], (const h16*)(ws + WS_O1), p.out}; pg8::gemm_phase<Epi4>(lds, g, S, E); } SEAM(11);
    if (IN(12)) for (int rep_ = 0; rep_ <= ((REPMASK >> 12) & 1); ++rep_) { phase_final(p); }
}

extern "C" void kernel_launch(void* const* d_in, const int* in_sizes, int n_in, void* d_out, int out_size, void* d_ws, size_t ws_size, hipStream_t stream) {
    static int grid = 0;
    if (grid == 0) {
        int dev = 0, cus = 0, per_cu = 0;
        hipGetDevice(&dev);
        hipDeviceGetAttribute(&cus, hipDeviceAttributeMultiprocessorCount, dev);
        if (hipFuncSetAttribute((const void*)mega, hipFuncAttributeMaxDynamicSharedMemorySize, LDS_BYTES) != hipSuccess) fprintf(stderr, "kernel_launch: hipFuncSetAttribute failed\n");
        hipOccupancyMaxActiveBlocksPerMultiprocessor(&per_cu, (const void*)mega, 512, LDS_BYTES);
        if (per_cu < 1) { fprintf(stderr, "kernel_launch: occupancy query says %d blocks per CU\n", per_cu); per_cu = 1; }
        (void)hipGetLastError();
        grid = cus;
        if (grid < 64) grid = 64;
    }
    if (hipMemsetAsync((unsigned char*)d_ws + WS_BAR, 0, XCD_BAR_WORDS * 4, stream) != hipSuccess) fprintf(stderr, "kernel_launch: memset of the barrier words failed\n");
    Params p{};
    for (int i = 0; i < 24; ++i) p.in[i] = (const float*)d_in[i];
    p.out = (float*)d_out; p.ws = (unsigned char*)d_ws;
#if N_LAUNCH_MODE == 1
    p.ph_lo = 0; p.ph_hi = NPHASE;
    void* args[] = {&p};
    hipError_t e = hipLaunchCooperativeKernel((const void*)mega, dim3(grid), dim3(512), args, LDS_BYTES, stream);
    if (e != hipSuccess) fprintf(stderr, "kernel_launch: cooperative launch failed: %s (grid %d)\n", hipGetErrorString(e), grid);
#else
    for (int ph = 0; ph < NPHASE; ++ph) { p.ph_lo = ph; p.ph_hi = ph + 1; hipLaunchKernelGGL(mega, dim3(grid), dim3(512), LDS_BYTES, stream, p); }
#endif
}
```

```cpp
#include <hip/hip_runtime.h>
#include <hip/hip_cooperative_groups.h>
#include <cstdio>
#include <cstdint>
namespace cg = cooperative_groups;

#ifndef N_LAUNCH_MODE
#define N_LAUNCH_MODE 1
#endif

#ifndef REPMASK
#define REPMASK 0
#endif
#define LAS __attribute__((address_space(3)))
typedef _Float16 h16;
typedef _Float16 h16x8 __attribute__((ext_vector_type(8)));
typedef _Float16 h16x4 __attribute__((ext_vector_type(4)));
typedef float f32x2 __attribute__((ext_vector_type(2)));
typedef float f32x4 __attribute__((ext_vector_type(4)));
typedef float f32x16 __attribute__((ext_vector_type(16)));

constexpr int NTOK = 16384, DM = 1024, SEQ = 8192;
constexpr int LDS_MAIN = 131072;
constexpr int LDS_BYTES = LDS_MAIN + 16;
constexpr int NPHASE = 13;
constexpr size_t MiB = 1024 * 1024;
constexpr size_t WS_W1T = 0;
constexpr size_t WS_W2T = WS_W1T + (size_t)7168 * 1024 * 2;
constexpr size_t WS_W3T = WS_W2T + (size_t)1024 * 2048 * 2;
constexpr size_t WS_W4T = WS_W3T + (size_t)5376 * 1024 * 2;
constexpr size_t WS_STATS = 32 * MiB;
constexpr size_t WS_WSH = WS_STATS + 131072;
constexpr size_t WS_CWT = WS_WSH + 262144;
constexpr size_t WS_SBON = WS_CWT + 262144;
constexpr size_t WS_BAR = 35 * MiB;
constexpr size_t WS_XC = 36 * MiB, WS_G = 68 * MiB, WS_U = 100 * MiB, WS_V = 132 * MiB, WS_YCAT = 164 * MiB;
constexpr size_t WS_O1 = 36 * MiB, WS_PC = 68 * MiB, WS_ZCD = 168 * MiB, WS_FD = 216 * MiB;

namespace pg8 {
constexpr int BM = 256, BK = 64, HALF = 128, HTB = HALF * BK * 2, STAGE_BYTES = 8 * HTB, NXCD = 8, WGM = 8;
__host__ __device__ __forceinline__ int lds_byte(int r, int c) { const int st = (r >> 4) * 2 + (c >> 5), rr = r & 15, cc = c & 31, ob = rr * 64 + cc * 2; return st * 1024 + (ob ^ (((ob >> 9) & 1) << 5)); }
__host__ __device__ __forceinline__ void stage_rc(int b, int& R, int& C) { const int st = b / 1024, sb = b % 1024, swz = sb ^ (((sb >> 9) & 1) << 5); R = (st >> 1) * 16 + swz / 64; C = (st & 1) * 32 + (swz % 64) / 2; }
struct Unit { int pm, pn; };
struct Gemm { const h16* A; const h16* Bt; int M, N, K; };
struct StaticOrder {
    int nM, nN, nwg, G, c;
    __host__ __device__ void init(int M, int N, int G_, int c_) { nM = M / BM; nN = N / BM; nwg = nM * nN; G = G_; c = c_; }
    __host__ __device__ bool next(int i, Unit& u) const {
        const long L = (long)i * G + c; if (L >= nwg) return false;
        int wgid = (int)L; { const int q = nwg / NXCD, r = nwg % NXCD, xcd = wgid % NXCD, off = wgid / NXCD; wgid = (xcd < r ? xcd * (q + 1) : r * (q + 1) + (xcd - r) * q) + off; }
        const int nig = WGM * nN, gid = wgid / nig, fm = gid * WGM, gsz = (nM - fm) < WGM ? (nM - fm) : WGM;
        u.pm = fm + ((wgid % nig) % gsz); u.pn = (wgid % nig) / gsz; return true;
    }
};
template <class Epi>
__device__ __forceinline__ void gemm_phase(LAS unsigned char* lds, const Gemm g, const StaticOrder& S, const Epi& E) {
    const int tid = threadIdx.x, wid = __builtin_amdgcn_readfirstlane(tid >> 6), lane = tid & 63, wr = wid >> 2, wc = wid & 3, fr = lane & 15, fq = lane >> 4;
    const int K = g.K, nt = K / BK;
    unsigned voffA[2], voffB[2];
#pragma unroll
    for (int i = 0; i < 2; ++i) { int R, C; stage_rc(tid * 16 + i * 8192, R, C); voffA[i] = (unsigned)(R * K + C) * 2u; voffB[i] = voffA[i]; }
    const size_t kstep = (size_t)(BK * 2);
    const size_t hstep = (size_t)HALF * K * 2;
    const size_t tstep = 2 * hstep;
    const unsigned ldsw = (unsigned)wid * 1024u;
    const int aoff = lds_byte(wr * 64 + fr, fq * 8), boff = lds_byte(wc * 32 + fr, fq * 8);
#define PG8_SA(b, h) (((b) * 2 + (h)) * HTB)
#define PG8_SB(b, h) ((4 + (b) * 2 + (h)) * HTB)
#define PG8_STAGE(bufoff, gbase, voff) do { _Pragma("unroll") for (int _i = 0; _i < 2; ++_i) \
        __builtin_amdgcn_global_load_lds((const unsigned*)((const char*)(gbase) + (voff)[_i]), (LAS unsigned*)(lds + (bufoff) + ldsw + _i * 8192), 16, 0, 0); } while (0)
#define PG8_LDA(dst, b, h) do { _Pragma("unroll") for (int m = 0; m < 4; ++m) _Pragma("unroll") for (int k = 0; k < 2; ++k) dst[m][k] = *(const LAS h16x8*)(lds + PG8_SA(b, h) + aoff + m * 2048 + k * 1024); } while (0)
#define PG8_LDB(dst, b, h) do { _Pragma("unroll") for (int n = 0; n < 2; ++n) _Pragma("unroll") for (int k = 0; k < 2; ++k) dst[n][k] = *(const LAS h16x8*)(lds + PG8_SB(b, h) + boff + n * 2048 + k * 1024); } while (0)
#define PG8_MMA(ai, bj, At, Bt) do { __builtin_amdgcn_s_setprio(1); _Pragma("unroll") for (int m = 0; m < 4; ++m) _Pragma("unroll") for (int n = 0; n < 2; ++n) _Pragma("unroll") for (int k = 0; k < 2; ++k) \
        acc[ai][bj][m][n] = __builtin_amdgcn_mfma_f32_16x16x32_f16(Bt[n][k], At[m][k], acc[ai][bj][m][n], 0, 0, 0); __builtin_amdgcn_s_setprio(0); } while (0)
#define PG8_WAIT_V(n) asm volatile("s_waitcnt vmcnt(" #n ")" ::: "memory")
#define PG8_WAIT_L(n) asm volatile("s_waitcnt lgkmcnt(" #n ")" ::: "memory")
#define PG8_BAR __builtin_amdgcn_s_barrier()
#define PG8_SCHED __builtin_amdgcn_sched_barrier(0)
    Unit cur, nxt; int ui = 0;
    if (!S.next(0, cur)) return;
    f32x4 acc[2][2][4][2];
#pragma unroll
    for (int a = 0; a < 2; ++a)
#pragma unroll
        for (int b = 0; b < 2; ++b)
#pragma unroll
            for (int m = 0; m < 4; ++m)
#pragma unroll
                for (int n = 0; n < 2; ++n) acc[a][b][m][n] = (f32x4){0.f, 0.f, 0.f, 0.f};
    h16x8 At[4][2], B0[2][2], B1[2][2];
    const char* cA = (const char*)g.A + (size_t)cur.pm * tstep; const char* cB = (const char*)g.Bt + (size_t)cur.pn * tstep;
    PG8_STAGE(PG8_SB(0, 0), cB, voffB); PG8_STAGE(PG8_SA(0, 0), cA, voffA); PG8_STAGE(PG8_SB(0, 1), cB + hstep, voffB); PG8_STAGE(PG8_SA(0, 1), cA + hstep, voffA);
    if (wr == 1) PG8_BAR;
    PG8_WAIT_V(4); PG8_BAR;
    PG8_STAGE(PG8_SB(1, 0), cB + kstep, voffB); PG8_STAGE(PG8_SA(1, 0), cA + kstep, voffA); PG8_STAGE(PG8_SB(1, 1), cB + hstep + kstep, voffB);
    PG8_WAIT_V(6); PG8_BAR;
    for (;;) {
        const bool has_next = S.next(ui + 1, nxt);
        const char* nA = has_next ? (const char*)g.A + (size_t)nxt.pm * tstep : cA; const char* nB = has_next ? (const char*)g.Bt + (size_t)nxt.pn * tstep : cB;
        for (int t = 0; t < nt; t += 2) {
            const bool last = (t == nt - 2);
            const char* a1 = cA + (size_t)(t + 1) * kstep;
            const char* a2 = last ? nA : cA + (size_t)(t + 2) * kstep; const char* b2 = last ? nB : cB + (size_t)(t + 2) * kstep;
            const char* a3 = a2 + kstep; const char* b3 = b2 + kstep;
            PG8_LDB(B0, 0, 0); PG8_SCHED; PG8_LDA(At, 0, 0); PG8_STAGE(PG8_SA(1, 1), a1 + hstep, voffA);
            PG8_WAIT_L(8); PG8_BAR; PG8_WAIT_L(0); PG8_MMA(0, 0, At, B0); PG8_BAR; PG8_SCHED;
            PG8_LDB(B1, 0, 1); PG8_STAGE(PG8_SB(0, 0), b2, voffB);
            PG8_BAR; PG8_WAIT_L(0); PG8_MMA(0, 1, At, B1); PG8_BAR;
            PG8_LDA(At, 0, 1); PG8_STAGE(PG8_SA(0, 0), a2, voffA);
            PG8_BAR; PG8_WAIT_L(0); PG8_MMA(1, 0, At, B0); PG8_BAR; PG8_SCHED;
            PG8_STAGE(PG8_SB(0, 1), b2 + hstep, voffB);
            PG8_WAIT_V(6); PG8_BAR; PG8_MMA(1, 1, At, B1); PG8_BAR;
            PG8_LDB(B0, 1, 0); PG8_SCHED; PG8_LDA(At, 1, 0); PG8_STAGE(PG8_SA(0, 1), a2 + hstep, voffA);
            PG8_WAIT_L(8); PG8_BAR; PG8_WAIT_L(0); PG8_MMA(0, 0, At, B0); PG8_BAR; PG8_SCHED;
            PG8_LDB(B1, 1, 1); PG8_STAGE(PG8_SB(1, 0), b3, voffB);
            PG8_BAR; PG8_WAIT_L(0); PG8_MMA(0, 1, At, B1); PG8_BAR;
            PG8_LDA(At, 1, 1); PG8_STAGE(PG8_SA(1, 0), a3, voffA);
            PG8_BAR; PG8_WAIT_L(0); PG8_MMA(1, 0, At, B0); PG8_BAR; PG8_SCHED;
            PG8_STAGE(PG8_SB(1, 1), b3 + hstep, voffB);
            PG8_WAIT_V(6); PG8_BAR; PG8_MMA(1, 1, At, B1); PG8_BAR;
        }
        E(acc, cur, wr, wc, fr, fq);
        if (!has_next) break;
#pragma unroll
        for (int a = 0; a < 2; ++a)
#pragma unroll
            for (int b = 0; b < 2; ++b)
#pragma unroll
                for (int m = 0; m < 4; ++m)
#pragma unroll
                    for (int n = 0; n < 2; ++n) acc[a][b][m][n] = (f32x4){0.f, 0.f, 0.f, 0.f};
        cur = nxt; cA = nA; cB = nB; ++ui;
    }
    PG8_WAIT_V(0);
    if (wr == 0) PG8_BAR;
    PG8_BAR;
#undef PG8_SA
#undef PG8_SB
#undef PG8_STAGE
#undef PG8_LDA
#undef PG8_LDB
#undef PG8_MMA
#undef PG8_WAIT_V
#undef PG8_WAIT_L
#undef PG8_BAR
#undef PG8_SCHED
}
}


#define XB_TMO      128
#define XB_XCNT(j)  (256  + 64 * (j))
#define XB_XSUB(j)  (1280 + 64 * (j))
#define XB_XGEN(j)  (2304 + 64 * (j))
#define XB_TOP      3328
#define XB_TOPGEN   3392
#define XCD_BAR_WORDS 3456
#define XB_SPIN_CAP (1u << 18)
__device__ __forceinline__ unsigned xb_ld(unsigned* p)              { return __hip_atomic_load(p, __ATOMIC_RELAXED, __HIP_MEMORY_SCOPE_AGENT); }
__device__ __forceinline__ unsigned xb_add(unsigned* p, unsigned v) { return __hip_atomic_fetch_add(p, v, __ATOMIC_RELAXED, __HIP_MEMORY_SCOPE_AGENT); }
__device__ __forceinline__ unsigned xb_xcc_id() { return (unsigned)__builtin_amdgcn_s_getreg((3 << 11) | 20) & 0xFu; }
#define XB_SPIN(cond, bar) do { unsigned _sp = 0; while (cond) { __builtin_amdgcn_s_sleep(1); \
    if ((++_sp & 255u) == 0u) { if (xb_ld(&(bar)[XB_TMO])) break; if (_sp > XB_SPIN_CAP) { atomicAdd(&(bar)[XB_TMO], 1u); break; } } } } while (0)
struct XcdBarrier { unsigned* bar; unsigned x; volatile LAS unsigned* st; };
__device__ __forceinline__ XcdBarrier xcd_barrier_post(unsigned* bar, volatile LAS unsigned* st) {
    XcdBarrier b; b.bar = bar; b.x = xb_xcc_id(); b.st = st;
    if (threadIdx.x == 0) (void)xb_add(&bar[XB_XCNT(b.x)], 1u);
    return b;
}
__device__ __forceinline__ void xcd_barrier_complete(unsigned* bar, unsigned x, unsigned& nloc, unsigned& nx) {
    const unsigned G = gridDim.x * gridDim.y * gridDim.z;
    unsigned sum, cnt, mine, sp = 0u;
    for (;;) {
        sum = 0u; cnt = 0u; mine = 0u;
#pragma unroll
        for (unsigned j = 0; j < 16; ++j) { const unsigned c = xb_ld(&bar[XB_XCNT(j)]); sum += c; cnt += (c > 0u) ? 1u : 0u; mine = (j == x) ? c : mine; }
        if (sum == G) break;
        __builtin_amdgcn_s_sleep(1);
        if ((++sp & 255u) == 0u) { if (xb_ld(&bar[XB_TMO])) break; if (sp > XB_SPIN_CAP) { atomicAdd(&bar[XB_TMO], 1u); break; } }
    }
    nloc = mine > 0u ? mine : 1u; nx = cnt > 0u ? cnt : 1u;
}
__device__ __forceinline__ void xcd_barrier(const XcdBarrier& b) {
    asm volatile("s_waitcnt vmcnt(0)" ::: "memory");
    __syncthreads();
    if (threadIdx.x == 0) {
        unsigned* bar = b.bar;
        __builtin_amdgcn_s_waitcnt(0);
        unsigned nloc = b.st[0], nx = b.st[1];
        if (nloc == 0u) { xcd_barrier_complete(bar, b.x, nloc, nx); b.st[0] = nloc; b.st[1] = nx; }
        const unsigned old = xb_add(&bar[XB_XSUB(b.x)], 1u);
        const unsigned gen = old / nloc;
        if (old + 1u == (gen + 1u) * nloc) {
            __builtin_amdgcn_fence(__ATOMIC_RELEASE, "agent");
            asm volatile("s_waitcnt vmcnt(0)" ::: "memory");
            const unsigned og = xb_add(&bar[XB_TOP], 1u);
            const unsigned tg = og / nx;
            if (og + 1u == (tg + 1u) * nx) xb_add(&bar[XB_TOPGEN], 1u);
            else XB_SPIN(xb_ld(&bar[XB_TOPGEN]) == tg, bar);
            __builtin_amdgcn_fence(__ATOMIC_ACQUIRE, "agent");
            xb_add(&bar[XB_XGEN(b.x)], 1u);
            asm volatile("s_waitcnt vmcnt(0)" ::: "memory");
        } else {
            XB_SPIN(xb_ld(&bar[XB_XGEN(b.x)]) == gen, bar);
            __builtin_amdgcn_fence(__ATOMIC_ACQUIRE, "agent");
            asm volatile("s_waitcnt vmcnt(0)" ::: "memory");
        }
    }
    __syncthreads();
}

struct Params { const float* in[24]; float* out; unsigned char* ws; int ph_lo, ph_hi; };

__device__ __forceinline__ float silu_f(float x) { return x * __builtin_amdgcn_rcpf(1.f + __expf(-x)); }
__device__ __forceinline__ float sigmoid_f(float x) { return __builtin_amdgcn_rcpf(1.f + __expf(-x)); }
__device__ __forceinline__ float tanh_f(float x) { return 1.f - 2.f * __builtin_amdgcn_rcpf(__expf(2.f * x) + 1.f); }
__device__ __forceinline__ float wave_sum(float v) {
#pragma unroll
    for (int o = 1; o < 64; o <<= 1) v += __shfl_xor(v, o);
    return v;
}
template <int CTRL> __device__ __forceinline__ float dpp_f(float x) { return __int_as_float(__builtin_amdgcn_update_dpp(0, __float_as_int(x), CTRL, 0xf, 0xf, false)); }
__device__ __forceinline__ float red8(float x) {
    x += dpp_f<0xB1>(x); x += dpp_f<0x4E>(x); x += dpp_f<0x141>(x); return x;
}
__device__ __forceinline__ float red16(float x) {
    x += dpp_f<0xB1>(x); x += dpp_f<0x4E>(x); x += dpp_f<0x141>(x); x += dpp_f<0x140>(x); return x;
}

__device__ __forceinline__ int sigma1(int np) {
    const int T = np >> 8, c = np & 255;
    if (T < 16) { const int bj = c >> 7, wc = (c >> 5) & 3, n = (c >> 4) & 1, r = c & 15; return 1024 * (2 * bj + n) + 64 * T + 16 * wc + r; }
    if (T < 24) { return ((c >> 7) ? 6144 : 4096) + 128 * (T - 16) + (c & 127); }
    return 5120 + 256 * (T - 24) + c;
}

template <int MODE>
__device__ __forceinline__ void tr_item(const float* W, int K, int N, h16* WT, LAS float* scr, int item, int nblk, int lane) {
    const int kb = item / nblk, nb = item % nblk, k0 = 64 * kb, n0 = 32 * nb;
    const int np = n0 + (lane & 31);
    const int sc = (MODE == 1) ? sigma1(np) : np;
    const bool valid = (MODE != 2) || (np < 5248);
#pragma unroll 8
    for (int i = 0; i < 32; ++i) { const int kk = 2 * i + (lane >> 5); scr[kk * 33 + (lane & 31)] = valid ? W[(size_t)(k0 + kk) * N + sc] : 0.f; }
    asm volatile("s_waitcnt lgkmcnt(0)" ::: "memory");
    const int c = lane & 7;
#pragma unroll
    for (int j = 0; j < 4; ++j) { const int n = (lane >> 3) + 8 * j; const LAS float* s = scr + (8 * c) * 33 + n;
        h16x8 o;
#pragma unroll
        for (int e = 0; e < 8; ++e) o[e] = (h16)s[e * 33];
        *(h16x8*)(WT + (size_t)(n0 + n) * K + k0 + 8 * c) = o; }
    asm volatile("s_waitcnt lgkmcnt(0)" ::: "memory");
}

__device__ __forceinline__ void rms_row_f16(const float* xr, const h16* addr, const float* g, h16* orow, int lane) {
    f32x4 v[4]; float ss = 0.f;
#pragma unroll
    for (int j = 0; j < 4; ++j) { v[j] = *(const f32x4*)(xr + 4 * lane + 256 * j);
        if (addr) { const h16x4 a = *(const h16x4*)(addr + 4 * lane + 256 * j); v[j][0] += (float)a[0]; v[j][1] += (float)a[1]; v[j][2] += (float)a[2]; v[j][3] += (float)a[3]; }
        ss += v[j][0] * v[j][0] + v[j][1] * v[j][1] + v[j][2] * v[j][2] + v[j][3] * v[j][3]; }
    const float rs = rsqrtf(wave_sum(ss) * (1.f / 1024.f) + 1e-6f);
#pragma unroll
    for (int j = 0; j < 4; ++j) { const f32x4 gg = *(const f32x4*)(g + 4 * lane + 256 * j); h16x4 o;
        o[0] = (h16)(v[j][0] * rs * gg[0]); o[1] = (h16)(v[j][1] * rs * gg[1]); o[2] = (h16)(v[j][2] * rs * gg[2]); o[3] = (h16)(v[j][3] * rs * gg[3]);
        *(h16x4*)(orow + 4 * lane + 256 * j) = o; }
}

__device__ __forceinline__ void phase0(const Params& p, LAS unsigned char* lds) {
    const int tid = threadIdx.x, lane = tid & 63, wave = tid >> 6;
    const int gw = blockIdx.x * 8 + wave, NGW = gridDim.x * 8;
    LAS float* scr = (LAS float*)(lds + wave * 8448);
    h16* W1T = (h16*)(p.ws + WS_W1T); h16* W2T = (h16*)(p.ws + WS_W2T); h16* W3T = (h16*)(p.ws + WS_W3T); h16* W4T = (h16*)(p.ws + WS_W4T);
    constexpr int I1 = 16 * 224, I2 = 32 * 32, I3 = 16 * 168, I4 = 24 * 32;
    for (int it = gw; it < I1 + I2 + I3 + I4; it += NGW) {
        int r = it;
        if (r < I1) { tr_item<1>(p.in[2], 1024, 7168, W1T, scr, r, 224, lane); continue; } r -= I1;
        if (r < I2) { tr_item<0>(p.in[8], 2048, 1024, W2T, scr, r, 32, lane); continue; } r -= I2;
        if (r < I3) { tr_item<2>(p.in[10], 1024, 5248, W3T, scr, r, 168, lane); continue; } r -= I3;
        tr_item<0>(p.in[22], 1536, 1024, W4T, scr, r, 32, lane);
    }
    h16* H0 = (h16*)p.out;
    for (int r = gw; r < NTOK; r += NGW) rms_row_f16(p.in[0] + (size_t)r * DM, nullptr, p.in[1], H0 + (size_t)r * DM, lane);
    const int gt = blockIdx.x * 512 + tid, NGT = gridDim.x * 512;
    h16* WSH = (h16*)(p.ws + WS_WSH);
    for (int i = gt; i < 8 * 128 * 128; i += NGT) WSH[i] = (h16)p.in[6][i];
    h16* CWT = (h16*)(p.ws + WS_CWT);
    const float* wf = p.in[21];
    for (int i = gt; i < 4 * 128 * 256; i += NGT) {
        const int k = i & 255, e = (i >> 8) & 127, g = i >> 15, d = k & 127; const bool sn = k >= 128;
        float s = 0.f;
        for (int dp = 0; dp < 128; ++dp) { const float fr = (float)((d * dp) & 127) * (1.f / 128.f);
            const float tw = sn ? __builtin_amdgcn_sinf(fr) : __builtin_amdgcn_cosf(fr);
            s += tw * wf[(g * 128 + dp) * 128 + e]; }
        CWT[i] = (h16)(s * 0.08838834764831845f);
    }
}

struct Epi1 {
    h16 *XC, *G, *U, *V;
    __device__ __forceinline__ void operator()(const f32x4 (&acc)[2][2][4][2], const pg8::Unit& u, int wr, int wc, int fr, int fq) const {
        const int T = u.pn; const int row0 = u.pm * 256 + wr * 64 + fr;
        if (T < 16) {
            const int ch = 64 * T + 16 * wc + 4 * fq;
#pragma unroll
            for (int ai = 0; ai < 2; ++ai)
#pragma unroll
                for (int m = 0; m < 4; ++m) { const size_t r = (size_t)(row0 + ai * 128 + m * 16);
                    const f32x4 xa = acc[ai][0][m][0], ba = acc[ai][0][m][1], ca = acc[ai][1][m][0], za = acc[ai][1][m][1];
                    h16x4 xc, gg;
#pragma unroll
                    for (int e = 0; e < 4; ++e) { xc[e] = (h16)(ca[e] * xa[e]); gg[e] = (h16)(ba[e] * silu_f(za[e])); }
                    *(h16x4*)(XC + r * 1024 + ch) = xc; *(h16x4*)(G + r * 1024 + ch) = gg; }
        } else if (T < 24) {
#pragma unroll
            for (int ai = 0; ai < 2; ++ai)
#pragma unroll
                for (int m = 0; m < 4; ++m) { const size_t r = (size_t)(row0 + ai * 128 + m * 16);
#pragma unroll
                    for (int n = 0; n < 2; ++n) { const int ch = 128 * (T - 16) + 32 * wc + 16 * n + 4 * fq;
                        const f32x4 ub = acc[ai][0][m][n], zb = acc[ai][1][m][n]; h16x4 o;
#pragma unroll
                        for (int e = 0; e < 4; ++e) o[e] = (h16)(ub[e] * silu_f(zb[e]));
                        *(h16x4*)(U + r * 1024 + ch) = o; } }
        } else {
#pragma unroll
            for (int ai = 0; ai < 2; ++ai)
#pragma unroll
                for (int m = 0; m < 4; ++m) { const size_t r = (size_t)(row0 + ai * 128 + m * 16);
#pragma unroll
                    for (int bj = 0; bj < 2; ++bj)
#pragma unroll
                        for (int n = 0; n < 2; ++n) { const int ch = 256 * (T - 24) + 128 * bj + 32 * wc + 16 * n + 4 * fq;
                            const f32x4 v = acc[ai][bj][m][n]; h16x4 o;
#pragma unroll
                            for (int e = 0; e < 4; ++e) o[e] = (h16)v[e];
                            *(h16x4*)(V + r * 1024 + ch) = o; } }
        }
    }
};
struct Epi2 {
    h16* O1;
    __device__ __forceinline__ void operator()(const f32x4 (&acc)[2][2][4][2], const pg8::Unit& u, int wr, int wc, int fr, int fq) const {
        const int row0 = u.pm * 256 + wr * 64 + fr, col0 = u.pn * 256 + wc * 32 + 4 * fq;
#pragma unroll
        for (int ai = 0; ai < 2; ++ai)
#pragma unroll
            for (int m = 0; m < 4; ++m) { const size_t r = (size_t)(row0 + ai * 128 + m * 16);
#pragma unroll
                for (int bj = 0; bj < 2; ++bj)
#pragma unroll
                    for (int n = 0; n < 2; ++n) { const f32x4 v = acc[ai][bj][m][n]; h16x4 o;
#pragma unroll
                        for (int e = 0; e < 4; ++e) o[e] = (h16)v[e];
                        *(h16x4*)(O1 + r * 1024 + col0 + bj * 128 + n * 16) = o; } }
    }
};
struct Epi3 {
    h16 *PC, *ZCD, *FD;
    __device__ __forceinline__ void operator()(const f32x4 (&acc)[2][2][4][2], const pg8::Unit& u, int wr, int wc, int fr, int fq) const {
        const int row0 = u.pm * 256 + wr * 64 + fr, col0 = u.pn * 256 + wc * 32 + 4 * fq;
#pragma unroll
        for (int bj = 0; bj < 2; ++bj)
#pragma unroll
            for (int n = 0; n < 2; ++n) { const int c = col0 + bj * 128 + n * 16;
                h16* base; size_t ld;
                if (c < 3200) { base = PC + c; ld = 3200; }
                else if (c < 4224) { base = ZCD + (c - 3200); ld = 1536; }
                else if (c < 4736) { base = FD + (c - 4224); ld = 512; }
                else if (c < 5248) { base = ZCD + 1024 + (c - 4736); ld = 1536; }
                else continue;
#pragma unroll
                for (int ai = 0; ai < 2; ++ai)
#pragma unroll
                    for (int m = 0; m < 4; ++m) { const size_t r = (size_t)(row0 + ai * 128 + m * 16); const f32x4 v = acc[ai][bj][m][n]; h16x4 o;
#pragma unroll
                        for (int e = 0; e < 4; ++e) o[e] = (h16)v[e];
                        *(h16x4*)(base + r * ld) = o; } }
    }
};
struct Epi4 {
    const float* X; const h16* O1; float* OUT;
    __device__ __forceinline__ void operator()(const f32x4 (&acc)[2][2][4][2], const pg8::Unit& u, int wr, int wc, int fr, int fq) const {
        const int row0 = u.pm * 256 + wr * 64 + fr, col0 = u.pn * 256 + wc * 32 + 4 * fq;
#pragma unroll
        for (int ai = 0; ai < 2; ++ai)
#pragma unroll
            for (int m = 0; m < 4; ++m) { const size_t r = (size_t)(row0 + ai * 128 + m * 16);
#pragma unroll
                for (int bj = 0; bj < 2; ++bj)
#pragma unroll
                    for (int n = 0; n < 2; ++n) { const size_t o = r * 1024 + col0 + bj * 128 + n * 16;
                        const f32x4 xv = *(const f32x4*)(X + o); const h16x4 ov = *(const h16x4*)(O1 + o); f32x4 v = acc[ai][bj][m][n];
                        v[0] += xv[0] + (float)ov[0]; v[1] += xv[1] + (float)ov[1]; v[2] += xv[2] + (float)ov[2]; v[3] += xv[3] + (float)ov[3];
                        *(f32x4*)(OUT + o) = v; } }
    }
};

__device__ __forceinline__ void phase_stats(const Params& p) {
    const int tid = threadIdx.x, lane = tid & 63, wave = tid >> 6;
    const int gw = blockIdx.x * 8 + wave, NGW = gridDim.x * 8;
    const h16* V = (const h16*)(p.ws + WS_V); float* ST = (float*)(p.ws + WS_STATS);
    for (int r = gw; r < NTOK; r += NGW) {
        const h16x8 a = *(const h16x8*)(V + (size_t)r * 1024 + 8 * lane), b = *(const h16x8*)(V + (size_t)r * 1024 + 512 + 8 * lane);
        float s = 0.f;
#pragma unroll
        for (int e = 0; e < 8; ++e) s += (float)a[e] + (float)b[e];
        const float mu = wave_sum(s) * (1.f / 1024.f); float q = 0.f;
#pragma unroll
        for (int e = 0; e < 8; ++e) { const float x = (float)a[e] - mu, y = (float)b[e] - mu; q += x * x + y * y; }
        const float rs = rsqrtf(wave_sum(q) * (1.f / 1024.f) + 1e-5f);
        if (lane == 0) { ST[2 * r] = mu; ST[2 * r + 1] = rs; }
    }
}

__device__ __forceinline__ void phase_mix0(const Params& p, LAS unsigned char* lds) {
    const int tid = threadIdx.x, lane = tid & 63, wave = tid >> 6;
    const h16* XC = (const h16*)(p.ws + WS_XC); const h16* G = (const h16*)(p.ws + WS_G); const h16* U = (const h16*)(p.ws + WS_U); const h16* V = (const h16*)(p.ws + WS_V);
    h16* YC = (h16*)(p.ws + WS_YCAT);
    const float* cw = p.in[3];
    const int gt = blockIdx.x * 512 + tid, NGT = gridDim.x * 512;
    for (int idx = gt; idx < NTOK * 128; idx += NGT) {
        const int t = idx >> 7, c8 = (idx & 127) * 8, tp = t & (SEQ - 1);
        const h16x8 zero = {0, 0, 0, 0, 0, 0, 0, 0};
        const h16x8 x0 = *(const h16x8*)(XC + (size_t)t * 1024 + c8);
        const h16x8 xm = tp > 0 ? *(const h16x8*)(XC + (size_t)(t - 1) * 1024 + c8) : zero;
        const h16x8 xp = tp < SEQ - 1 ? *(const h16x8*)(XC + (size_t)(t + 1) * 1024 + c8) : zero;
        const h16x8 gg = *(const h16x8*)(G + (size_t)t * 1024 + c8);
        h16x8 o;
#pragma unroll
        for (int e = 0; e < 8; ++e) { const float y = cw[c8 + e] * (float)xm[e] + cw[1024 + c8 + e] * (float)x0[e] + cw[2048 + c8 + e] * (float)xp[e]; o[e] = (h16)(y * (float)gg[e]); }
        *(h16x8*)(YC + (size_t)t * 2048 + c8) = o;
    }
    const float* ST = (const float*)(p.ws + WS_STATS); const h16* WSH = (const h16*)(p.ws + WS_WSH);
    const float* lng = p.in[4]; const float* lnb = p.in[5]; const float* bs = p.in[7];
    LAS h16* vnT = (LAS h16*)lds;
    for (int it = blockIdx.x; it < 1024; it += gridDim.x) {
        const int g = it & 7, bn = it >> 3, t0 = bn * 128;
        __syncthreads();
#pragma unroll
        for (int q = 0; q < 4; ++q) { const int pc = tid + 512 * q, j = pc >> 4, d8 = (pc & 15) * 8;
            const h16x8 v = *(const h16x8*)(V + (size_t)(t0 + j) * 1024 + g * 128 + d8);
            const float mu = ST[2 * (t0 + j)], rs = ST[2 * (t0 + j) + 1];
#pragma unroll
            for (int e = 0; e < 8; ++e) vnT[(d8 + e) * 136 + j] = (h16)(((float)v[e] - mu) * rs * lng[g * 128 + d8 + e] + lnb[g * 128 + d8 + e]); }
        __syncthreads();
        const int itile = wave >> 1, dt0 = (wave & 1) * 2;
        f32x16 acc0, acc1;
#pragma unroll
        for (int e = 0; e < 16; ++e) { acc0[e] = 0.f; acc1[e] = 0.f; }
        const h16* Arow = WSH + ((size_t)g * 128 + itile * 32 + (lane & 31)) * 128 + 8 * (lane >> 5);
        const LAS h16* B0p = vnT + (dt0 * 32 + (lane & 31)) * 136 + 8 * (lane >> 5);
        const LAS h16* B1p = B0p + 32 * 136;
#pragma unroll
        for (int ks = 0; ks < 8; ++ks) {
            const h16x8 a = *(const h16x8*)(Arow + 16 * ks);
            const h16x8 b0 = *(const LAS h16x8*)(B0p + 16 * ks), b1 = *(const LAS h16x8*)(B1p + 16 * ks);
            acc0 = __builtin_amdgcn_mfma_f32_32x32x16_f16(a, b0, acc0, 0, 0, 0);
            acc1 = __builtin_amdgcn_mfma_f32_32x32x16_f16(a, b1, acc1, 0, 0, 0);
        }
#pragma unroll
        for (int r = 0; r < 16; ++r) { const int i = itile * 32 + (r & 3) + 8 * (r >> 2) + 4 * (lane >> 5); const size_t t = (size_t)(t0 + i);
            const float bias = bs[g * 128 + i];
            const int d0 = g * 128 + dt0 * 32 + (lane & 31);
            YC[t * 2048 + 1024 + d0] = (h16)((acc0[r] + bias) * (float)U[t * 1024 + d0]);
            YC[t * 2048 + 1024 + d0 + 32] = (h16)((acc1[r] + bias) * (float)U[t * 1024 + d0 + 32]); }
    }
}

__device__ __forceinline__ void phase_norm1(const Params& p) {
    const int tid = threadIdx.x, lane = tid & 63, wave = tid >> 6;
    const int gw = blockIdx.x * 8 + wave, NGW = gridDim.x * 8;
    const h16* O1 = (const h16*)(p.ws + WS_O1); h16* H1 = (h16*)p.out;
    for (int r = gw; r < NTOK; r += NGW) rms_row_f16(p.in[0] + (size_t)r * DM, O1 + (size_t)r * DM, p.in[9], H1 + (size_t)r * DM, lane);
}

__device__ __forceinline__ void phase_fft(const Params& p, LAS unsigned char* lds) {
    const int tid = threadIdx.x;
    const h16* FD = (const h16*)(p.ws + WS_FD);
    h16* SPr = (h16*)((unsigned char*)p.out + 32 * MiB); h16* SPi = (h16*)((unsigned char*)p.out + 48 * MiB);
    LAS f32x2* X0 = (LAS f32x2*)lds; LAS f32x2* X1 = X0 + 8192;
    for (int it = blockIdx.x; it < 256; it += gridDim.x) {
        const int b = it >> 7, c0 = 4 * (it & 127);
        __syncthreads();
        for (int t = tid; t < SEQ; t += 512) { const h16x4 v = *(const h16x4*)(FD + (size_t)(b * SEQ + t) * 512 + c0);
            X0[t] = (f32x2){(float)v[0], (float)v[1]}; X1[t] = (f32x2){(float)v[2], (float)v[3]}; }
        __syncthreads();
        for (int s = 0; s < 13; ++s) {
            const int half = 4096 >> s;
#pragma unroll 2
            for (int j = tid; j < 4096; j += 512) {
                const int pos = j & (half - 1), grp = j >> (12 - s), i0 = (grp << (13 - s)) + pos, i1 = i0 + half;
                const float fr = (float)(pos << s) * (1.f / 8192.f);
                const float c = __builtin_amdgcn_cosf(fr), sn = __builtin_amdgcn_sinf(fr);
                { const f32x2 a = X0[i0], bb = X0[i1]; const f32x2 d = a - bb; X0[i0] = a + bb; X0[i1] = (f32x2){d[0] * c + d[1] * sn, d[1] * c - d[0] * sn}; }
                { const f32x2 a = X1[i0], bb = X1[i1]; const f32x2 d = a - bb; X1[i0] = a + bb; X1[i1] = (f32x2){d[0] * c + d[1] * sn, d[1] * c - d[0] * sn}; }
            }
            __syncthreads();
        }
        const float sc = 0.5f * 0.011048543456039806f;
        for (int k = tid; k < SEQ; k += 512) {
            const int ra = __brev((unsigned)k) >> 19, rb = __brev((unsigned)((SEQ - k) & (SEQ - 1))) >> 19;
            const f32x2 za = X0[ra], zb = X0[rb], ya = X1[ra], yb = X1[rb];
            h16x4 orr, oi;
            orr[0] = (h16)((za[0] + zb[0]) * sc); oi[0] = (h16)((za[1] - zb[1]) * sc);
            orr[1] = (h16)((za[1] + zb[1]) * sc); oi[1] = (h16)((zb[0] - za[0]) * sc);
            orr[2] = (h16)((ya[0] + yb[0]) * sc); oi[2] = (h16)((ya[1] - yb[1]) * sc);
            orr[3] = (h16)((ya[1] + yb[1]) * sc); oi[3] = (h16)((yb[0] - ya[0]) * sc);
            *(h16x4*)(SPr + (size_t)(b * SEQ + k) * 512 + c0) = orr; *(h16x4*)(SPi + (size_t)(b * SEQ + k) * 512 + c0) = oi;
        }
    }
}

__device__ __forceinline__ void phase_fnet_out(const Params& p) {
    const int tid = threadIdx.x, lane = tid & 63, wave = tid >> 6;
    const int gw = blockIdx.x * 8 + wave, NGW = gridDim.x * 8;
    const h16* SPr = (const h16*)((const unsigned char*)p.out + 32 * MiB); const h16* SPi = (const h16*)((const unsigned char*)p.out + 48 * MiB);
    const h16* CWT = (const h16*)(p.ws + WS_CWT); h16* ZCD = (h16*)(p.ws + WS_ZCD);
    for (int w = gw; w < 8192; w += NGW) {
        const int et = w & 3, g = (w >> 2) & 3, tt = w >> 4;
        const size_t trow = (size_t)(tt * 32 + (lane & 31));
        const h16* Ar = SPr + trow * 512 + g * 128 + 8 * (lane >> 5); const h16* Ai = SPi + trow * 512 + g * 128 + 8 * (lane >> 5);
        const h16* Bp = CWT + ((size_t)(g * 128 + et * 32 + (lane & 31))) * 256 + 8 * (lane >> 5);
        f32x16 acc;
#pragma unroll
        for (int e = 0; e < 16; ++e) acc[e] = 0.f;
#pragma unroll
        for (int ks = 0; ks < 8; ++ks) acc = __builtin_amdgcn_mfma_f32_32x32x16_f16(*(const h16x8*)(Ar + 16 * ks), *(const h16x8*)(Bp + 16 * ks), acc, 0, 0, 0);
#pragma unroll
        for (int ks = 0; ks < 8; ++ks) acc = __builtin_amdgcn_mfma_f32_32x32x16_f16(*(const h16x8*)(Ai + 16 * ks), *(const h16x8*)(Bp + 128 + 16 * ks), acc, 0, 0, 0);
#pragma unroll
        for (int r = 0; r < 16; ++r) { const size_t t = (size_t)(tt * 32 + (r & 3) + 8 * (r >> 2) + 4 * (lane >> 5));
            h16* zp = ZCD + t * 1536 + 1024 + g * 128 + et * 32 + (lane & 31);
            *zp = (h16)(acc[r] * silu_f((float)*zp)); }
    }
}

#define LDS_BAR() do { asm volatile("s_waitcnt lgkmcnt(0)" ::: "memory"); __builtin_amdgcn_s_barrier(); asm volatile("" ::: "memory"); } while (0)
#define LDS_WAIT() asm volatile("s_waitcnt lgkmcnt(0)" ::: "memory")
__device__ __forceinline__ void phase_scan(const Params& p, LAS unsigned char* lds) {
    const int tid = threadIdx.x, lane = tid & 63, wave = tid >> 6;
    const h16* PC = (const h16*)(p.ws + WS_PC);
    LAS h16* w2T = (LAS h16*)lds;
    LAS h16* a2T = w2T + 64 * 72;
    LAS unsigned char* priv = lds + 18432 + (wave & 3) * 4096;
    constexpr int SET_F = 5 * 2048 + 512;
    LAS float* OPS = (LAS float*)(lds + 18432 + 16384);
    LAS float* sYb = OPS + 2 * SET_F;
    for (int item = blockIdx.x; item < 256; item += gridDim.x) {
        const int xcd = item & 7, slot = item >> 3, gidx = xcd * 8 + (slot >> 2), q = slot & 3;
        const int dir = gidx >> 5, b = (gidx >> 4) & 1, h = gidx & 15;
        h16* Yd = (h16*)((unsigned char*)p.out + (size_t)dir * 32 * MiB);
        float* SB = (float*)(p.ws + WS_SBON) + (size_t)dir * NTOK * 16;
        const float* mu = p.in[11] + dir * 3200; const float* w0 = p.in[12] + dir * 1024 + 64 * h; const float* w2 = p.in[13] + (size_t)dir * 65536 + 64 * h;
        const float* a0 = p.in[14] + dir * 1024 + 64 * h; const float* a2 = p.in[15] + (size_t)dir * 65536 + 64 * h;
        const float* kkw = p.in[16] + 64 * h; const float* kaw = p.in[17] + 64 * h; const float* rkw = p.in[18] + 64 * h;
        __syncthreads();
        for (int i = tid; i < 4096; i += 512) { const int l = i >> 6, c = i & 63; w2T[c * 72 + l] = (h16)w2[l * 1024 + c]; a2T[c * 72 + l] = (h16)a2[l * 1024 + c]; }
        const int pw_ = wave & 3, s_sub = lane >> 3, c8 = (lane & 7) * 8, s_l = 8 * pw_ + s_sub;
        f32x2 S01 = {0.f, 0.f}, S23 = {0.f, 0.f};
        const int srow = 4 * (wave & 3) + (lane >> 4), j0 = 4 * (lane & 15);
        const h16x8 z8 = {0, 0, 0, 0, 0, 0, 0, 0};
        h16x8 pr, pk, pv, pw, pa, qr_, qk_, qv_, qw_, qa_;
#define SCAN_LOAD(chn) do { const int sg_ = (chn) * 32 + s_l; const int t_ = dir ? (SEQ - 1 - sg_) : sg_; \
            const size_t rowc_ = (size_t)(b * SEQ + t_) * 3200; const size_t rowp_ = (size_t)(b * SEQ + (dir ? t_ + 1 : t_ - 1)) * 3200; const bool hp_ = sg_ > 0; \
            pr = *(const h16x8*)(PC + rowc_ + 64 * h + c8); pk = *(const h16x8*)(PC + rowc_ + 1024 + 64 * h + c8); pv = *(const h16x8*)(PC + rowc_ + 2048 + 64 * h + c8); \
            pw = *(const h16x8*)(PC + rowc_ + 3072 + c8); pa = *(const h16x8*)(PC + rowc_ + 3136 + c8); \
            qr_ = hp_ ? *(const h16x8*)(PC + rowp_ + 64 * h + c8) : z8; qk_ = hp_ ? *(const h16x8*)(PC + rowp_ + 1024 + 64 * h + c8) : z8; qv_ = hp_ ? *(const h16x8*)(PC + rowp_ + 2048 + 64 * h + c8) : z8; \
            qw_ = hp_ ? *(const h16x8*)(PC + rowp_ + 3072 + c8) : z8; qa_ = hp_ ? *(const h16x8*)(PC + rowp_ + 3136 + c8) : z8; } while (0)
#define SCAN_YSTORE(chn) do { const int sg_ = (chn) * 32 + s_l; const int t_ = dir ? (SEQ - 1 - sg_) : sg_; \
            const f32x2 y2_ = *(const LAS f32x2*)(sYb + ((chn) & 1) * 512 + s_l * 16 + 2 * (lane & 7)); \
            typedef _Float16 h16x2_ __attribute__((ext_vector_type(2))); h16x2_ o_; o_[0] = (h16)y2_[0]; o_[1] = (h16)y2_[1]; \
            *(h16x2_*)(Yd + (size_t)(b * SEQ + t_) * 1024 + 64 * h + 16 * q + 2 * (lane & 7)) = o_; } while (0)
        if (wave >= 4) SCAN_LOAD(0);
        __syncthreads();
        for (int n = -1; n < SEQ / 32; ++n) {
            if (wave < 4) {
                if (n >= 0) {
                    const LAS float* sR = OPS + (n & 1) * SET_F; const LAS float* sW = sR + 2048; const LAS float* sK = sW + 2048; const LAS float* sA = sK + 2048; const LAS float* sB = sA + 2048; const LAS float* sV = sB + 2048;
                    LAS float* sY = sYb + (n & 1) * 512;
                    f32x4 a_ = *(const LAS f32x4*)(sA + j0), w_ = *(const LAS f32x4*)(sW + j0), b_ = *(const LAS f32x4*)(sB + j0);
                    f32x4 k_ = *(const LAS f32x4*)(sK + j0), r_ = *(const LAS f32x4*)(sR + j0);
                    float v = sV[srow];
                    f32x4 rp = r_;
#pragma unroll 4
                    for (int s = 0; s < 32; ++s) {
                        const int sn = (s + 1) & 31;
                        const f32x4 a_n = *(const LAS f32x4*)(sA + sn * 64 + j0), w_n = *(const LAS f32x4*)(sW + sn * 64 + j0), b_n = *(const LAS f32x4*)(sB + sn * 64 + j0);
                        const f32x4 k_n = *(const LAS f32x4*)(sK + sn * 64 + j0), r_n = *(const LAS f32x4*)(sR + sn * 64 + j0);
                        const float v_n = sV[sn * 16 + srow];
                        const f32x2 vv = {v, v};
                        f32x2 pp = S01 * (f32x2){a_[0], a_[1]}; pp = S23 * (f32x2){a_[2], a_[3]} + pp;
                        f32x2 yy = S01 * (f32x2){rp[0], rp[1]}; yy = S23 * (f32x2){rp[2], rp[3]} + yy;
                        float sa = pp[0] + pp[1], y = yy[0] + yy[1];
                        sa += dpp_f<0xB1>(sa); y += dpp_f<0xB1>(y);
                        sa += dpp_f<0x4E>(sa); y += dpp_f<0x4E>(y);
                        sa += dpp_f<0x141>(sa); y += dpp_f<0x141>(y);
                        sa += dpp_f<0x140>(sa); y += dpp_f<0x140>(y);
                        sY[((s - 1) & 31) * 16 + srow] = y;
                        const f32x2 sv = {sa, sa};
                        S01 = S01 * (f32x2){w_[0], w_[1]} + vv * (f32x2){k_[0], k_[1]};
                        S23 = S23 * (f32x2){w_[2], w_[3]} + vv * (f32x2){k_[2], k_[3]};
                        S01 = sv * (f32x2){b_[0], b_[1]} + S01;
                        S23 = sv * (f32x2){b_[2], b_[3]} + S23;
                        rp = r_;
                        a_ = a_n; w_ = w_n; b_ = b_n; k_ = k_n; r_ = r_n; v = v_n;
                    }
                    { f32x2 yy = S01 * (f32x2){rp[0], rp[1]}; yy = S23 * (f32x2){rp[2], rp[3]} + yy; sY[31 * 16 + srow] = red16(yy[0] + yy[1]); }
                }
            } else {
                if (n + 1 < SEQ / 32) {
                    const int cn = n + 1;
                    const int sg = cn * 32 + s_l; const int t = dir ? (SEQ - 1 - sg) : sg;
                    float qr[8], qk[8], qv[8];
                    LAS h16* TWp = (LAS h16*)priv; LAS h16* QAp = TWp + 8 * 72;
                    { h16x8 tw8, qa8;
#pragma unroll
                      for (int e = 0; e < 8; ++e) {
                        const float r0 = (float)pr[e], k0 = (float)pk[e], v0 = (float)pv[e], wd0 = (float)pw[e], ad0 = (float)pa[e];
                        qr[e] = r0 + mu[64 * h + c8 + e] * ((float)qr_[e] - r0); qk[e] = k0 + mu[1024 + 64 * h + c8 + e] * ((float)qk_[e] - k0); qv[e] = v0 + mu[2048 + 64 * h + c8 + e] * ((float)qv_[e] - v0);
                        tw8[e] = (h16)tanh_f(wd0 + mu[3072 + c8 + e] * ((float)qw_[e] - wd0)); qa8[e] = (h16)(ad0 + mu[3136 + c8 + e] * ((float)qa_[e] - ad0)); }
                      *(LAS h16x8*)(TWp + s_sub * 72 + c8) = tw8; *(LAS h16x8*)(QAp + s_sub * 72 + c8) = qa8; }
                    if (cn + 1 < SEQ / 32) SCAN_LOAD(cn + 1);
                    LDS_WAIT();
                    f32x4 accw[4], acca[4];
#pragma unroll
                    for (int ct = 0; ct < 4; ++ct) { accw[ct] = (f32x4){0.f, 0.f, 0.f, 0.f}; acca[ct] = (f32x4){0.f, 0.f, 0.f, 0.f}; }
#pragma unroll
                    for (int ks = 0; ks < 2; ++ks) {
                        const h16x8 atw = *(const LAS h16x8*)(TWp + (lane & 7) * 72 + 32 * ks + 8 * (lane >> 4));
                        const h16x8 aqa = *(const LAS h16x8*)(QAp + (lane & 7) * 72 + 32 * ks + 8 * (lane >> 4));
#pragma unroll
                        for (int ct = 0; ct < 4; ++ct) {
                            const h16x8 bw = *(const LAS h16x8*)(w2T + (16 * ct + (lane & 15)) * 72 + 32 * ks + 8 * (lane >> 4));
                            const h16x8 ba = *(const LAS h16x8*)(a2T + (16 * ct + (lane & 15)) * 72 + 32 * ks + 8 * (lane >> 4));
                            accw[ct] = __builtin_amdgcn_mfma_f32_16x16x32_f16(atw, bw, accw[ct], 0, 0, 0);
                            acca[ct] = __builtin_amdgcn_mfma_f32_16x16x32_f16(aqa, ba, acca[ct], 0, 0, 0);
                        }
                    }
                    LDS_WAIT();
                    { LAS float* Zd = (LAS float*)priv + (lane >> 5) * 512 + (4 * ((lane >> 4) & 1)) * 64 + (lane & 15);
#pragma unroll
                      for (int ct = 0; ct < 4; ++ct)
#pragma unroll
                          for (int r = 0; r < 4; ++r) Zd[r * 64 + 16 * ct] = (lane < 32) ? accw[ct][r] : acca[ct][r]; }
                    LDS_WAIT();
                    const LAS float* Zw = (const LAS float*)priv + s_sub * 64 + c8; const LAS float* Za = Zw + 512;
                    const f32x4 zw0 = *(const LAS f32x4*)Zw, zw1 = *(const LAS f32x4*)(Zw + 4), za0 = *(const LAS f32x4*)Za, za1 = *(const LAS f32x4*)(Za + 4);
                    LDS_WAIT();
                    float kk[8], av_[8], kn = 0.f, sbn = 0.f, kp[8], dec[8];
#pragma unroll
                    for (int e = 0; e < 8; ++e) { const float zw = (e < 4 ? zw0[e & 3] : zw1[e & 3]) + w0[c8 + e], za = (e < 4 ? za0[e & 3] : za1[e & 3]) + a0[c8 + e];
                        dec[e] = __expf(-0.6065306597126334f * sigmoid_f(zw)); av_[e] = sigmoid_f(za);
                        kk[e] = qk[e] * kkw[c8 + e]; kn += kk[e] * kk[e]; kp[e] = qk[e] * (1.f + (av_[e] - 1.f) * kaw[c8 + e]); sbn += qr[e] * kp[e] * rkw[c8 + e]; }
                    kn = red8(kn); sbn = red8(sbn);
                    const float inv = rsqrtf(fmaxf(kn, 1e-12f));
                    LAS float* dR = OPS + (cn & 1) * SET_F + s_l * 64 + c8;
#pragma unroll
                    for (int hf = 0; hf < 2; ++hf) { f32x4 oR, oW, oK, oA, oB;
#pragma unroll
                        for (int e = 0; e < 4; ++e) { const int g = 4 * hf + e; const float kn_ = kk[g] * inv; oR[e] = qr[g]; oW[e] = dec[g]; oK[e] = kp[g]; oA[e] = -kn_; oB[e] = kn_ * av_[g]; }
                        *(LAS f32x4*)(dR + 4 * hf) = oR; *(LAS f32x4*)(dR + 2048 + 4 * hf) = oW; *(LAS f32x4*)(dR + 4096 + 4 * hf) = oK; *(LAS f32x4*)(dR + 6144 + 4 * hf) = oA; *(LAS f32x4*)(dR + 8192 + 4 * hf) = oB; }
                    if ((c8 >> 4) == q) { LAS float* dV = OPS + (cn & 1) * SET_F + 10240 + s_l * 16 + (c8 & 15);
                        *(LAS f32x4*)dV = (f32x4){qv[0], qv[1], qv[2], qv[3]}; *(LAS f32x4*)(dV + 4) = (f32x4){qv[4], qv[5], qv[6], qv[7]}; }
                    if (q == 0 && (lane & 7) == 0) SB[(size_t)(b * SEQ + t) * 16 + h] = sbn;
                }
                if (n >= 1) SCAN_YSTORE(n - 1);
            }
            LDS_BAR();
        }
        if (wave >= 4) SCAN_YSTORE(SEQ / 32 - 1);
#undef SCAN_LOAD
#undef SCAN_YSTORE
    }
}

__device__ __forceinline__ void phase_post(const Params& p) {
    const int tid = threadIdx.x;
    const h16* Y0 = (const h16*)p.out; const h16* Y1 = (const h16*)((const unsigned char*)p.out + 32 * MiB);
    const h16* PC = (const h16*)(p.ws + WS_PC); h16* ZCD = (h16*)(p.ws + WS_ZCD);
    const float* SB0 = (const float*)(p.ws + WS_SBON); const float* SB1 = SB0 + (size_t)NTOK * 16;
    const float* mu0 = p.in[11] + 2048; const float* mu1 = p.in[11] + 3200 + 2048;
    const float* lg = p.in[19]; const float* lb = p.in[20];
    const int gt = blockIdx.x * 512 + tid, NGT = gridDim.x * 512;
    for (int idx = gt; idx < NTOK * 256; idx += NGT) {
        const int t = idx >> 8, c = (idx & 255) * 4, hh = c >> 6, tp = t & (SEQ - 1);
        const h16x4 y0 = *(const h16x4*)(Y0 + (size_t)t * 1024 + c), y1 = *(const h16x4*)(Y1 + (size_t)t * 1024 + c);
        float y[4], s = 0.f;
#pragma unroll
        for (int e = 0; e < 4; ++e) { y[e] = (float)y0[e] + (float)y1[e]; s += y[e]; }
        const float mean = red16(s) * (1.f / 64.f); float q = 0.f;
#pragma unroll
        for (int e = 0; e < 4; ++e) { y[e] -= mean; q += y[e] * y[e]; }
        const float rs = rsqrtf(red16(q) * (1.f / 64.f) + 64e-5f);
        const h16x4 z4 = {0, 0, 0, 0};
        const h16x4 v0 = *(const h16x4*)(PC + (size_t)t * 3200 + 2048 + c);
        const h16x4 vm = tp > 0 ? *(const h16x4*)(PC + (size_t)(t - 1) * 3200 + 2048 + c) : z4;
        const h16x4 vp = tp < SEQ - 1 ? *(const h16x4*)(PC + (size_t)(t + 1) * 3200 + 2048 + c) : z4;
        const float s0 = SB0[(size_t)t * 16 + hh], s1 = SB1[(size_t)t * 16 + hh];
        const h16x4 zc = *(const h16x4*)(ZCD + (size_t)t * 1536 + c);
        h16x4 o;
#pragma unroll
        for (int e = 0; e < 4; ++e) { const float vv = (float)v0[e];
            const float vd0 = vv + mu0[c + e] * ((float)vm[e] - vv), vd1 = vv + mu1[c + e] * ((float)vp[e] - vv);
            const float val = y[e] * rs * lg[c + e] + lb[c + e] + s0 * vd0 + s1 * vd1;
            o[e] = (h16)(val * silu_f((float)zc[e])); }
        *(h16x4*)(ZCD + (size_t)t * 1536 + c) = o;
    }
}

__device__ __forceinline__ void phase_final(const Params& p) {
    const int tid = threadIdx.x, lane = tid & 63, wave = tid >> 6;
    const int gw = blockIdx.x * 8 + wave, NGW = gridDim.x * 8;
    const float* g = p.in[23];
    for (int r = gw; r < NTOK; r += NGW) {
        float* xr = p.out + (size_t)r * DM; f32x4 v[4]; float ss = 0.f;
#pragma unroll
        for (int j = 0; j < 4; ++j) { v[j] = *(const f32x4*)(xr + 4 * lane + 256 * j); ss += v[j][0] * v[j][0] + v[j][1] * v[j][1] + v[j][2] * v[j][2] + v[j][3] * v[j][3]; }
        const float rs = rsqrtf(wave_sum(ss) * (1.f / 1024.f) + 1e-6f);
#pragma unroll
        for (int j = 0; j < 4; ++j) { const f32x4 gg = *(const f32x4*)(g + 4 * lane + 256 * j); f32x4 o = v[j] * rs; o = o * gg; *(f32x4*)(xr + 4 * lane + 256 * j) = o; }
    }
}

__global__ void __launch_bounds__(512, 2) mega(Params p) {
    extern __shared__ __attribute__((aligned(16))) unsigned char smem[];
    LAS unsigned char* lds = (LAS unsigned char*)smem;
    cg::grid_group grid = cg::this_grid();
    unsigned char* ws = p.ws;
    const int lo = p.ph_lo, hi = p.ph_hi;
#define IN(k) (lo <= (k) && (k) < hi)
    volatile LAS unsigned* bst = (volatile LAS unsigned*)(lds + LDS_MAIN);
    if (threadIdx.x < 4) bst[threadIdx.x] = 0u;
    __syncthreads();
    const XcdBarrier bar = xcd_barrier_post((unsigned*)(ws + WS_BAR), bst);
    if (hi > 1000) grid.sync();
#define SEAM(k) do { if (IN(k) && IN((k) + 1)) { xcd_barrier(bar); if ((REPMASK >> 13) & 1) xcd_barrier(bar); } } while (0)
    if (IN(0)) for (int rep_ = 0; rep_ <= ((REPMASK >> 0) & 1); ++rep_) { phase0(p, lds); } SEAM(0);
    if (IN(1)) for (int rep_ = 0; rep_ <= ((REPMASK >> 1) & 1); ++rep_) { pg8::Gemm g{(const h16*)p.out, (const h16*)(ws + WS_W1T), NTOK, 7168, 1024}; pg8::StaticOrder S; S.init(NTOK, 7168, gridDim.x, blockIdx.x);
                 Epi1 E{(h16*)(ws + WS_XC), (h16*)(ws + WS_G), (h16*)(ws + WS_U), (h16*)(ws + WS_V)}; pg8::gemm_phase<Epi1>(lds, g, S, E); } SEAM(1);
    if (IN(2)) for (int rep_ = 0; rep_ <= ((REPMASK >> 2) & 1); ++rep_) { phase_stats(p); } SEAM(2);
    if (IN(3)) for (int rep_ = 0; rep_ <= ((REPMASK >> 3) & 1); ++rep_) { phase_mix0(p, lds); } SEAM(3);
    if (IN(4)) for (int rep_ = 0; rep_ <= ((REPMASK >> 4) & 1); ++rep_) { pg8::Gemm g{(const h16*)(ws + WS_YCAT), (const h16*)(ws + WS_W2T), NTOK, 1024, 2048}; pg8::StaticOrder S; S.init(NTOK, 1024, gridDim.x, blockIdx.x);
                 Epi2 E{(h16*)(ws + WS_O1)}; pg8::gemm_phase<Epi2>(lds, g, S, E); } SEAM(4);
    if (IN(5)) for (int rep_ = 0; rep_ <= ((REPMASK >> 5) & 1); ++rep_) { phase_norm1(p); } SEAM(5);
    if (IN(6)) for (int rep_ = 0; rep_ <= ((REPMASK >> 6) & 1); ++rep_) { pg8::Gemm g{(const h16*)p.out, (const h16*)(ws + WS_W3T), NTOK, 5376, 1024}; pg8::StaticOrder S; S.init(NTOK, 5376, gridDim.x, blockIdx.x);
                 Epi3 E{(h16*)(ws + WS_PC), (h16*)(ws + WS_ZCD), (h16*)(ws + WS_FD)}; pg8::gemm_phase<Epi3>(lds, g, S, E); } SEAM(6);
    if (IN(7)) for (int rep_ = 0; rep_ <= ((REPMASK >> 7) & 1); ++rep_) { phase_fft(p, lds); } SEAM(7);
    if (IN(8)) for (int rep_ = 0; rep_ <= ((REPMASK >> 8) & 1); ++rep_) { phase_fnet_out(p); } SEAM(8);
    if (IN(9)) for (int rep_ = 0; rep_ <= ((REPMASK >> 9) & 1); ++rep_) { phase_scan(p, lds); } SEAM(9);
    if (IN(10)) for (int rep_ = 0; rep_ <= ((REPMASK >> 10) & 1); ++rep_) { phase_post(p); } SEAM(10);
    if (IN(11)) for (int rep_ = 0; rep_ <= ((REPMASK >> 11) & 1); ++rep_) { pg8::Gemm g{(const h16*)(ws + WS_ZCD), (const h16*)(ws + WS_W4T), NTOK, 1024, 1536}; pg8::StaticOrder S; S.init(NTOK, 1024, gridDim.x, blockIdx.x);
                  Epi4 E{p.in[0], (const h16*)(ws + WS_O1), p.out}; pg8::gemm_phase<Epi4>(lds, g, S, E); } SEAM(11);
    if (IN(12)) for (int rep_ = 0; rep_ <= ((REPMASK >> 12) & 1); ++rep_) { phase_final(p); }
}

extern "C" void kernel_launch(void* const* d_in, const int* in_sizes, int n_in, void* d_out, int out_size, void* d_ws, size_t ws_size, hipStream_t stream) {
    static int grid = 0;
    if (grid == 0) {
        int dev = 0, cus = 0, per_cu = 0;
        hipGetDevice(&dev);
        hipDeviceGetAttribute(&cus, hipDeviceAttributeMultiprocessorCount, dev);
        if (hipFuncSetAttribute((const void*)mega, hipFuncAttributeMaxDynamicSharedMemorySize, LDS_BYTES) != hipSuccess) fprintf(stderr, "kernel_launch: hipFuncSetAttribute failed\n");
        hipOccupancyMaxActiveBlocksPerMultiprocessor(&per_cu, (const void*)mega, 512, LDS_BYTES);
        if (per_cu < 1) { fprintf(stderr, "kernel_launch: occupancy query says %d blocks per CU\n", per_cu); per_cu = 1; }
        (void)hipGetLastError();
        grid = cus;
        if (grid < 64) grid = 64;
    }
    if (hipMemsetAsync((unsigned char*)d_ws + WS_BAR, 0, XCD_BAR_WORDS * 4, stream) != hipSuccess) fprintf(stderr, "kernel_launch: memset of the barrier words failed\n");
    Params p{};
    for (int i = 0; i < 24; ++i) p.in[i] = (const float*)d_in[i];
    p.out = (float*)d_out; p.ws = (unsigned char*)d_ws;
#if N_LAUNCH_MODE == 1
    p.ph_lo = 0; p.ph_hi = NPHASE;
    void* args[] = {&p};
    hipError_t e = hipLaunchCooperativeKernel((const void*)mega, dim3(grid), dim3(512), args, LDS_BYTES, stream);
    if (e != hipSuccess) fprintf(stderr, "kernel_launch: cooperative launch failed: %s (grid %d)\n", hipGetErrorString(e), grid);
#else
    for (int ph = 0; ph < NPHASE; ++ph) { p.ph_lo = ph; p.ph_hi = ph + 1; hipLaunchKernelGGL(mega, dim3(grid), dim3(512), LDS_BYTES, stream, p); }
#endif
}
```

```cpp
#include <hip/hip_runtime.h>
#include <hip/hip_cooperative_groups.h>
#include <cstdio>
#include <cstdint>
namespace cg = cooperative_groups;

#ifndef N_LAUNCH_MODE
#define N_LAUNCH_MODE 1
#endif

#ifndef REPMASK
#define REPMASK 0
#endif
#define LAS __attribute__((address_space(3)))
typedef _Float16 h16;
typedef _Float16 h16x8 __attribute__((ext_vector_type(8)));
typedef _Float16 h16x4 __attribute__((ext_vector_type(4)));
typedef float f32x2 __attribute__((ext_vector_type(2)));
typedef float f32x4 __attribute__((ext_vector_type(4)));
typedef float f32x16 __attribute__((ext_vector_type(16)));

constexpr int NTOK = 16384, DM = 1024, SEQ = 8192;
constexpr int LDS_MAIN = 131072;
constexpr int LDS_BYTES = LDS_MAIN + 16;
constexpr int NPHASE = 13;
constexpr size_t MiB = 1024 * 1024;
constexpr size_t WS_W1T = 0;
constexpr size_t WS_W2T = WS_W1T + (size_t)7168 * 1024 * 2;
constexpr size_t WS_W3T = WS_W2T + (size_t)1024 * 2048 * 2;
constexpr size_t WS_W4T = WS_W3T + (size_t)5376 * 1024 * 2;
constexpr size_t WS_STATS = 32 * MiB;
constexpr size_t WS_WSH = WS_STATS + 131072;
constexpr size_t WS_CWT = WS_WSH + 262144;
constexpr size_t WS_SBON = WS_CWT + 262144;
constexpr size_t WS_BAR = 35 * MiB;
constexpr size_t WS_XC = 36 * MiB, WS_G = 68 * MiB, WS_U = 100 * MiB, WS_V = 132 * MiB, WS_YCAT = 164 * MiB;
constexpr size_t WS_SPR = 0, WS_SPI = 232 * MiB;
constexpr size_t WS_O1 = 36 * MiB, WS_PC = 68 * MiB, WS_ZCD = 168 * MiB, WS_FD = 216 * MiB;

namespace pg8 {
constexpr int BM = 256, BK = 64, HALF = 128, HTB = HALF * BK * 2, STAGE_BYTES = 8 * HTB, NXCD = 8, WGM = 8;
__host__ __device__ __forceinline__ int lds_byte(int r, int c) { const int st = (r >> 4) * 2 + (c >> 5), rr = r & 15, cc = c & 31, ob = rr * 64 + cc * 2; return st * 1024 + (ob ^ (((ob >> 9) & 1) << 5)); }
__host__ __device__ __forceinline__ void stage_rc(int b, int& R, int& C) { const int st = b / 1024, sb = b % 1024, swz = sb ^ (((sb >> 9) & 1) << 5); R = (st >> 1) * 16 + swz / 64; C = (st & 1) * 32 + (swz % 64) / 2; }
struct Unit { int pm, pn; };
struct Gemm { const h16* A; const h16* Bt; int M, N, K; };
struct StaticOrder {
    int nM, nN, nwg, G, c;
    __host__ __device__ void init(int M, int N, int G_, int c_) { nM = M / BM; nN = N / BM; nwg = nM * nN; G = G_; c = c_; }
    __host__ __device__ bool next(int i, Unit& u) const {
        const long L = (long)i * G + c; if (L >= nwg) return false;
        int wgid = (int)L; { const int q = nwg / NXCD, r = nwg % NXCD, xcd = wgid % NXCD, off = wgid / NXCD; wgid = (xcd < r ? xcd * (q + 1) : r * (q + 1) + (xcd - r) * q) + off; }
        const int nig = WGM * nN, gid = wgid / nig, fm = gid * WGM, gsz = (nM - fm) < WGM ? (nM - fm) : WGM;
        u.pm = fm + ((wgid % nig) % gsz); u.pn = (wgid % nig) / gsz; return true;
    }
};
template <class Epi>
__device__ __forceinline__ void gemm_phase(LAS unsigned char* lds, const Gemm g, const StaticOrder& S, const Epi& E) {
    const int tid = threadIdx.x, wid = __builtin_amdgcn_readfirstlane(tid >> 6), lane = tid & 63, wr = wid >> 2, wc = wid & 3, fr = lane & 15, fq = lane >> 4;
    const int K = g.K, nt = K / BK;
    unsigned voffA[2], voffB[2];
#pragma unroll
    for (int i = 0; i < 2; ++i) { int R, C; stage_rc(tid * 16 + i * 8192, R, C); voffA[i] = (unsigned)(R * K + C) * 2u; voffB[i] = voffA[i]; }
    const size_t kstep = (size_t)(BK * 2);
    const size_t hstep = (size_t)HALF * K * 2;
    const size_t tstep = 2 * hstep;
    const unsigned ldsw = (unsigned)wid * 1024u;
    const int aoff = lds_byte(wr * 64 + fr, fq * 8), boff = lds_byte(wc * 32 + fr, fq * 8);
#define PG8_SA(b, h) (((b) * 2 + (h)) * HTB)
#define PG8_SB(b, h) ((4 + (b) * 2 + (h)) * HTB)
#define PG8_STAGE(bufoff, gbase, voff) do { _Pragma("unroll") for (int _i = 0; _i < 2; ++_i) \
        __builtin_amdgcn_global_load_lds((const unsigned*)((const char*)(gbase) + (voff)[_i]), (LAS unsigned*)(lds + (bufoff) + ldsw + _i * 8192), 16, 0, 0); } while (0)
#define PG8_LDA(dst, b, h) do { _Pragma("unroll") for (int m = 0; m < 4; ++m) _Pragma("unroll") for (int k = 0; k < 2; ++k) dst[m][k] = *(const LAS h16x8*)(lds + PG8_SA(b, h) + aoff + m * 2048 + k * 1024); } while (0)
#define PG8_LDB(dst, b, h) do { _Pragma("unroll") for (int n = 0; n < 2; ++n) _Pragma("unroll") for (int k = 0; k < 2; ++k) dst[n][k] = *(const LAS h16x8*)(lds + PG8_SB(b, h) + boff + n * 2048 + k * 1024); } while (0)
#define PG8_MMA(ai, bj, At, Bt) do { __builtin_amdgcn_s_setprio(1); _Pragma("unroll") for (int m = 0; m < 4; ++m) _Pragma("unroll") for (int n = 0; n < 2; ++n) _Pragma("unroll") for (int k = 0; k < 2; ++k) \
        acc[ai][bj][m][n] = __builtin_amdgcn_mfma_f32_16x16x32_f16(Bt[n][k], At[m][k], acc[ai][bj][m][n], 0, 0, 0); __builtin_amdgcn_s_setprio(0); } while (0)
#define PG8_WAIT_V(n) asm volatile("s_waitcnt vmcnt(" #n ")" ::: "memory")
#define PG8_WAIT_L(n) asm volatile("s_waitcnt lgkmcnt(" #n ")" ::: "memory")
#define PG8_BAR __builtin_amdgcn_s_barrier()
#define PG8_SCHED __builtin_amdgcn_sched_barrier(0)
    Unit cur, nxt; int ui = 0;
    if (!S.next(0, cur)) return;
    f32x4 acc[2][2][4][2];
#pragma unroll
    for (int a = 0; a < 2; ++a)
#pragma unroll
        for (int b = 0; b < 2; ++b)
#pragma unroll
            for (int m = 0; m < 4; ++m)
#pragma unroll
                for (int n = 0; n < 2; ++n) acc[a][b][m][n] = (f32x4){0.f, 0.f, 0.f, 0.f};
    h16x8 At[4][2], B0[2][2], B1[2][2];
    const char* cA = (const char*)g.A + (size_t)cur.pm * tstep; const char* cB = (const char*)g.Bt + (size_t)cur.pn * tstep;
    PG8_STAGE(PG8_SB(0, 0), cB, voffB); PG8_STAGE(PG8_SA(0, 0), cA, voffA); PG8_STAGE(PG8_SB(0, 1), cB + hstep, voffB); PG8_STAGE(PG8_SA(0, 1), cA + hstep, voffA);
    if (wr == 1) PG8_BAR;
    PG8_WAIT_V(4); PG8_BAR;
    PG8_STAGE(PG8_SB(1, 0), cB + kstep, voffB); PG8_STAGE(PG8_SA(1, 0), cA + kstep, voffA); PG8_STAGE(PG8_SB(1, 1), cB + hstep + kstep, voffB);
    PG8_WAIT_V(6); PG8_BAR;
    for (;;) {
        const bool has_next = S.next(ui + 1, nxt);
        const char* nA = has_next ? (const char*)g.A + (size_t)nxt.pm * tstep : cA; const char* nB = has_next ? (const char*)g.Bt + (size_t)nxt.pn * tstep : cB;
        for (int t = 0; t < nt; t += 2) {
            const bool last = (t == nt - 2);
            const char* a1 = cA + (size_t)(t + 1) * kstep;
            const char* a2 = last ? nA : cA + (size_t)(t + 2) * kstep; const char* b2 = last ? nB : cB + (size_t)(t + 2) * kstep;
            const char* a3 = a2 + kstep; const char* b3 = b2 + kstep;
            PG8_LDB(B0, 0, 0); PG8_SCHED; PG8_LDA(At, 0, 0); PG8_STAGE(PG8_SA(1, 1), a1 + hstep, voffA);
            PG8_WAIT_L(8); PG8_BAR; PG8_WAIT_L(0); PG8_MMA(0, 0, At, B0); PG8_BAR; PG8_SCHED;
            PG8_LDB(B1, 0, 1); PG8_STAGE(PG8_SB(0, 0), b2, voffB);
            PG8_BAR; PG8_WAIT_L(0); PG8_MMA(0, 1, At, B1); PG8_BAR;
            PG8_LDA(At, 0, 1); PG8_STAGE(PG8_SA(0, 0), a2, voffA);
            PG8_BAR; PG8_WAIT_L(0); PG8_MMA(1, 0, At, B0); PG8_BAR; PG8_SCHED;
            PG8_STAGE(PG8_SB(0, 1), b2 + hstep, voffB);
            PG8_WAIT_V(6); PG8_BAR; PG8_MMA(1, 1, At, B1); PG8_BAR;
            PG8_LDB(B0, 1, 0); PG8_SCHED; PG8_LDA(At, 1, 0); PG8_STAGE(PG8_SA(0, 1), a2 + hstep, voffA);
            PG8_WAIT_L(8); PG8_BAR; PG8_WAIT_L(0); PG8_MMA(0, 0, At, B0); PG8_BAR; PG8_SCHED;
            PG8_LDB(B1, 1, 1); PG8_STAGE(PG8_SB(1, 0), b3, voffB);
            PG8_BAR; PG8_WAIT_L(0); PG8_MMA(0, 1, At, B1); PG8_BAR;
            PG8_LDA(At, 1, 1); PG8_STAGE(PG8_SA(1, 0), a3, voffA);
            PG8_BAR; PG8_WAIT_L(0); PG8_MMA(1, 0, At, B0); PG8_BAR; PG8_SCHED;
            PG8_STAGE(PG8_SB(1, 1), b3 + hstep, voffB);
            PG8_WAIT_V(6); PG8_BAR; PG8_MMA(1, 1, At, B1); PG8_BAR;
        }
        E(acc, cur, wr, wc, fr, fq);
        if (!has_next) break;
#pragma unroll
        for (int a = 0; a < 2; ++a)
#pragma unroll
            for (int b = 0; b < 2; ++b)
#pragma unroll
                for (int m = 0; m < 4; ++m)
#pragma unroll
                    for (int n = 0; n < 2; ++n) acc[a][b][m][n] = (f32x4){0.f, 0.f, 0.f, 0.f};
        cur = nxt; cA = nA; cB = nB; ++ui;
    }
    PG8_WAIT_V(0);
    if (wr == 0) PG8_BAR;
    PG8_BAR;
#undef PG8_SA
#undef PG8_SB
#undef PG8_STAGE
#undef PG8_LDA
#undef PG8_LDB
#undef PG8_MMA
#undef PG8_WAIT_V
#undef PG8_WAIT_L
#undef PG8_BAR
#undef PG8_SCHED
}
}


#define XB_TMO      128
#define XB_XCNT(j)  (256  + 64 * (j))
#define XB_XSUB(j)  (1280 + 64 * (j))
#define XB_XGEN(j)  (2304 + 64 * (j))
#define XB_TOP      3328
#define XB_TOPGEN   3392
#define XCD_BAR_WORDS 3456
#define XB_SPIN_CAP (1u << 18)
__device__ __forceinline__ unsigned xb_ld(unsigned* p)              { return __hip_atomic_load(p, __ATOMIC_RELAXED, __HIP_MEMORY_SCOPE_AGENT); }
__device__ __forceinline__ unsigned xb_add(unsigned* p, unsigned v) { return __hip_atomic_fetch_add(p, v, __ATOMIC_RELAXED, __HIP_MEMORY_SCOPE_AGENT); }
__device__ __forceinline__ unsigned xb_xcc_id() { return (unsigned)__builtin_amdgcn_s_getreg((3 << 11) | 20) & 0xFu; }
#define XB_SPIN(cond, bar) do { unsigned _sp = 0; while (cond) { __builtin_amdgcn_s_sleep(1); \
    if ((++_sp & 255u) == 0u) { if (xb_ld(&(bar)[XB_TMO])) break; if (_sp > XB_SPIN_CAP) { atomicAdd(&(bar)[XB_TMO], 1u); break; } } } } while (0)
struct XcdBarrier { unsigned* bar; unsigned x; volatile LAS unsigned* st; };
__device__ __forceinline__ XcdBarrier xcd_barrier_post(unsigned* bar, volatile LAS unsigned* st) {
    XcdBarrier b; b.bar = bar; b.x = xb_xcc_id(); b.st = st;
    if (threadIdx.x == 0) (void)xb_add(&bar[XB_XCNT(b.x)], 1u);
    return b;
}
__device__ __forceinline__ void xcd_barrier_complete(unsigned* bar, unsigned x, unsigned& nloc, unsigned& nx) {
    const unsigned G = gridDim.x * gridDim.y * gridDim.z;
    unsigned sum, cnt, mine, sp = 0u;
    for (;;) {
        sum = 0u; cnt = 0u; mine = 0u;
#pragma unroll
        for (unsigned j = 0; j < 16; ++j) { const unsigned c = xb_ld(&bar[XB_XCNT(j)]); sum += c; cnt += (c > 0u) ? 1u : 0u; mine = (j == x) ? c : mine; }
        if (sum == G) break;
        __builtin_amdgcn_s_sleep(1);
        if ((++sp & 255u) == 0u) { if (xb_ld(&bar[XB_TMO])) break; if (sp > XB_SPIN_CAP) { atomicAdd(&bar[XB_TMO], 1u); break; } }
    }
    nloc = mine > 0u ? mine : 1u; nx = cnt > 0u ? cnt : 1u;
}
__device__ __forceinline__ void xcd_barrier(const XcdBarrier& b) {
    asm volatile("s_waitcnt vmcnt(0)" ::: "memory");
    __syncthreads();
    if (threadIdx.x == 0) {
        unsigned* bar = b.bar;
        __builtin_amdgcn_s_waitcnt(0);
        unsigned nloc = b.st[0], nx = b.st[1];
        if (nloc == 0u) { xcd_barrier_complete(bar, b.x, nloc, nx); b.st[0] = nloc; b.st[1] = nx; }
        const unsigned old = xb_add(&bar[XB_XSUB(b.x)], 1u);
        const unsigned gen = old / nloc;
        if (old + 1u == (gen + 1u) * nloc) {
            __builtin_amdgcn_fence(__ATOMIC_RELEASE, "agent");
            asm volatile("s_waitcnt vmcnt(0)" ::: "memory");
            const unsigned og = xb_add(&bar[XB_TOP], 1u);
            const unsigned tg = og / nx;
            if (og + 1u == (tg + 1u) * nx) xb_add(&bar[XB_TOPGEN], 1u);
            else XB_SPIN(xb_ld(&bar[XB_TOPGEN]) == tg, bar);
            __builtin_amdgcn_fence(__ATOMIC_ACQUIRE, "agent");
            xb_add(&bar[XB_XGEN(b.x)], 1u);
            asm volatile("s_waitcnt vmcnt(0)" ::: "memory");
        } else {
            XB_SPIN(xb_ld(&bar[XB_XGEN(b.x)]) == gen, bar);
            __builtin_amdgcn_fence(__ATOMIC_ACQUIRE, "agent");
            asm volatile("s_waitcnt vmcnt(0)" ::: "memory");
        }
    }
    __syncthreads();
}

struct Params { const float* in[24]; float* out; unsigned char* ws; int ph_lo, ph_hi; };

__device__ __forceinline__ float silu_f(float x) { return x * __builtin_amdgcn_rcpf(1.f + __expf(-x)); }
__device__ __forceinline__ float sigmoid_f(float x) { return __builtin_amdgcn_rcpf(1.f + __expf(-x)); }
__device__ __forceinline__ float tanh_f(float x) { return 1.f - 2.f * __builtin_amdgcn_rcpf(__expf(2.f * x) + 1.f); }
__device__ __forceinline__ float wave_sum(float v) {
#pragma unroll
    for (int o = 1; o < 64; o <<= 1) v += __shfl_xor(v, o);
    return v;
}
template <int CTRL> __device__ __forceinline__ float dpp_f(float x) { return __int_as_float(__builtin_amdgcn_update_dpp(0, __float_as_int(x), CTRL, 0xf, 0xf, false)); }
__device__ __forceinline__ float red8(float x) {
    x += dpp_f<0xB1>(x); x += dpp_f<0x4E>(x); x += dpp_f<0x141>(x); return x;
}
__device__ __forceinline__ float red16(float x) {
    x += dpp_f<0xB1>(x); x += dpp_f<0x4E>(x); x += dpp_f<0x141>(x); x += dpp_f<0x140>(x); return x;
}

__device__ __forceinline__ int sigma1(int np) {
    const int T = np >> 8, c = np & 255;
    if (T < 16) { const int bj = c >> 7, wc = (c >> 5) & 3, n = (c >> 4) & 1, r = c & 15; return 1024 * (2 * bj + n) + 64 * T + 16 * wc + r; }
    if (T < 24) { return ((c >> 7) ? 6144 : 4096) + 128 * (T - 16) + (c & 127); }
    return 5120 + 256 * (T - 24) + c;
}

template <int MODE>
__device__ __forceinline__ void tr_item(const float* W, int K, int N, h16* WT, LAS float* scr, int item, int nblk, int lane) {
    const int kb = item / nblk, nb = item % nblk, k0 = 64 * kb, n0 = 32 * nb;
    const int np = n0 + (lane & 31);
    const int sc = (MODE == 1) ? sigma1(np) : np;
    const bool valid = (MODE != 2) || (np < 5248);
#pragma unroll 8
    for (int i = 0; i < 32; ++i) { const int kk = 2 * i + (lane >> 5); scr[kk * 33 + (lane & 31)] = valid ? W[(size_t)(k0 + kk) * N + sc] : 0.f; }
    asm volatile("s_waitcnt lgkmcnt(0)" ::: "memory");
    const int c = lane & 7;
#pragma unroll
    for (int j = 0; j < 4; ++j) { const int n = (lane >> 3) + 8 * j; const LAS float* s = scr + (8 * c) * 33 + n;
        h16x8 o;
#pragma unroll
        for (int e = 0; e < 8; ++e) o[e] = (h16)s[e * 33];
        *(h16x8*)(WT + (size_t)(n0 + n) * K + k0 + 8 * c) = o; }
    asm volatile("s_waitcnt lgkmcnt(0)" ::: "memory");
}

__device__ __forceinline__ void rms_row_f16(const float* xr, const h16* addr, const float* g, h16* orow, int lane) {
    f32x4 v[4]; float ss = 0.f;
#pragma unroll
    for (int j = 0; j < 4; ++j) { v[j] = *(const f32x4*)(xr + 4 * lane + 256 * j);
        if (addr) { const h16x4 a = *(const h16x4*)(addr + 4 * lane + 256 * j); v[j][0] += (float)a[0]; v[j][1] += (float)a[1]; v[j][2] += (float)a[2]; v[j][3] += (float)a[3]; }
        ss += v[j][0] * v[j][0] + v[j][1] * v[j][1] + v[j][2] * v[j][2] + v[j][3] * v[j][3]; }
    const float rs = rsqrtf(wave_sum(ss) * (1.f / 1024.f) + 1e-6f);
#pragma unroll
    for (int j = 0; j < 4; ++j) { const f32x4 gg = *(const f32x4*)(g + 4 * lane + 256 * j); h16x4 o;
        o[0] = (h16)(v[j][0] * rs * gg[0]); o[1] = (h16)(v[j][1] * rs * gg[1]); o[2] = (h16)(v[j][2] * rs * gg[2]); o[3] = (h16)(v[j][3] * rs * gg[3]);
        *(h16x4*)(orow + 4 * lane + 256 * j) = o; }
}

__device__ __forceinline__ void phase0(const Params& p, LAS unsigned char* lds) {
    const int tid = threadIdx.x, lane = tid & 63, wave = tid >> 6;
    const int gw = blockIdx.x * 8 + wave, NGW = gridDim.x * 8;
    LAS float* scr = (LAS float*)(lds + wave * 8448);
    h16* W1T = (h16*)(p.ws + WS_W1T); h16* W2T = (h16*)(p.ws + WS_W2T); h16* W3T = (h16*)(p.ws + WS_W3T); h16* W4T = (h16*)(p.ws + WS_W4T);
    constexpr int I1 = 16 * 224, I2 = 32 * 32, I3 = 16 * 168, I4 = 24 * 32;
    for (int it = gw; it < I1 + I2 + I3 + I4; it += NGW) {
        int r = it;
        if (r < I1) { tr_item<1>(p.in[2], 1024, 7168, W1T, scr, r, 224, lane); continue; } r -= I1;
        if (r < I2) { tr_item<0>(p.in[8], 2048, 1024, W2T, scr, r, 32, lane); continue; } r -= I2;
        if (r < I3) { tr_item<2>(p.in[10], 1024, 5248, W3T, scr, r, 168, lane); continue; } r -= I3;
        tr_item<0>(p.in[22], 1536, 1024, W4T, scr, r, 32, lane);
    }
    h16* H0 = (h16*)p.out;
    for (int r = gw; r < NTOK; r += NGW) rms_row_f16(p.in[0] + (size_t)r * DM, nullptr, p.in[1], H0 + (size_t)r * DM, lane);
    const int gt = blockIdx.x * 512 + tid, NGT = gridDim.x * 512;
    h16* WSH = (h16*)(p.ws + WS_WSH);
    for (int i = gt; i < 8 * 128 * 128; i += NGT) WSH[i] = (h16)p.in[6][i];
    h16* CWT = (h16*)(p.ws + WS_CWT);
    const float* wf = p.in[21];
    for (int i = gt; i < 4 * 128 * 256; i += NGT) {
        const int k = i & 255, e = (i >> 8) & 127, g = i >> 15, d = k & 127; const bool sn = k >= 128;
        float s = 0.f;
        for (int dp = 0; dp < 128; ++dp) { const float fr = (float)((d * dp) & 127) * (1.f / 128.f);
            const float tw = sn ? __builtin_amdgcn_sinf(fr) : __builtin_amdgcn_cosf(fr);
            s += tw * wf[(g * 128 + dp) * 128 + e]; }
        CWT[i] = (h16)(s * 0.08838834764831845f);
    }
}

struct Epi1 {
    h16 *XC, *G, *U, *V;
    __device__ __forceinline__ void operator()(const f32x4 (&acc)[2][2][4][2], const pg8::Unit& u, int wr, int wc, int fr, int fq) const {
        const int T = u.pn; const int row0 = u.pm * 256 + wr * 64 + fr;
        if (T < 16) {
            const int ch = 64 * T + 16 * wc + 4 * fq;
#pragma unroll
            for (int ai = 0; ai < 2; ++ai)
#pragma unroll
                for (int m = 0; m < 4; ++m) { const size_t r = (size_t)(row0 + ai * 128 + m * 16);
                    const f32x4 xa = acc[ai][0][m][0], ba = acc[ai][0][m][1], ca = acc[ai][1][m][0], za = acc[ai][1][m][1];
                    h16x4 xc, gg;
#pragma unroll
                    for (int e = 0; e < 4; ++e) { xc[e] = (h16)(ca[e] * xa[e]); gg[e] = (h16)(ba[e] * silu_f(za[e])); }
                    *(h16x4*)(XC + r * 1024 + ch) = xc; *(h16x4*)(G + r * 1024 + ch) = gg; }
        } else if (T < 24) {
#pragma unroll
            for (int ai = 0; ai < 2; ++ai)
#pragma unroll
                for (int m = 0; m < 4; ++m) { const size_t r = (size_t)(row0 + ai * 128 + m * 16);
#pragma unroll
                    for (int n = 0; n < 2; ++n) { const int ch = 128 * (T - 16) + 32 * wc + 16 * n + 4 * fq;
                        const f32x4 ub = acc[ai][0][m][n], zb = acc[ai][1][m][n]; h16x4 o;
#pragma unroll
                        for (int e = 0; e < 4; ++e) o[e] = (h16)(ub[e] * silu_f(zb[e]));
                        *(h16x4*)(U + r * 1024 + ch) = o; } }
        } else {
#pragma unroll
            for (int ai = 0; ai < 2; ++ai)
#pragma unroll
                for (int m = 0; m < 4; ++m) { const size_t r = (size_t)(row0 + ai * 128 + m * 16);
#pragma unroll
                    for (int bj = 0; bj < 2; ++bj)
#pragma unroll
                        for (int n = 0; n < 2; ++n) { const int ch = 256 * (T - 24) + 128 * bj + 32 * wc + 16 * n + 4 * fq;
                            const f32x4 v = acc[ai][bj][m][n]; h16x4 o;
#pragma unroll
                            for (int e = 0; e < 4; ++e) o[e] = (h16)v[e];
                            *(h16x4*)(V + r * 1024 + ch) = o; } }
        }
    }
};
struct Epi2 {
    h16* O1;
    __device__ __forceinline__ void operator()(const f32x4 (&acc)[2][2][4][2], const pg8::Unit& u, int wr, int wc, int fr, int fq) const {
        const int row0 = u.pm * 256 + wr * 64 + fr, col0 = u.pn * 256 + wc * 32 + 4 * fq;
#pragma unroll
        for (int ai = 0; ai < 2; ++ai)
#pragma unroll
            for (int m = 0; m < 4; ++m) { const size_t r = (size_t)(row0 + ai * 128 + m * 16);
#pragma unroll
                for (int bj = 0; bj < 2; ++bj)
#pragma unroll
                    for (int n = 0; n < 2; ++n) { const f32x4 v = acc[ai][bj][m][n]; h16x4 o;
#pragma unroll
                        for (int e = 0; e < 4; ++e) o[e] = (h16)v[e];
                        *(h16x4*)(O1 + r * 1024 + col0 + bj * 128 + n * 16) = o; } }
    }
};
struct Epi3 {
    h16 *PC, *ZCD, *FD;
    __device__ __forceinline__ void operator()(const f32x4 (&acc)[2][2][4][2], const pg8::Unit& u, int wr, int wc, int fr, int fq) const {
        const int row0 = u.pm * 256 + wr * 64 + fr, col0 = u.pn * 256 + wc * 32 + 4 * fq;
#pragma unroll
        for (int bj = 0; bj < 2; ++bj)
#pragma unroll
            for (int n = 0; n < 2; ++n) { const int c = col0 + bj * 128 + n * 16;
                h16* base; size_t ld;
                if (c < 3200) { base = PC + c; ld = 3200; }
                else if (c < 4224) { base = ZCD + (c - 3200); ld = 1536; }
                else if (c < 4736) { base = FD + (c - 4224); ld = 512; }
                else if (c < 5248) { base = ZCD + 1024 + (c - 4736); ld = 1536; }
                else continue;
#pragma unroll
                for (int ai = 0; ai < 2; ++ai)
#pragma unroll
                    for (int m = 0; m < 4; ++m) { const size_t r = (size_t)(row0 + ai * 128 + m * 16); const f32x4 v = acc[ai][bj][m][n]; h16x4 o;
#pragma unroll
                        for (int e = 0; e < 4; ++e) o[e] = (h16)v[e];
                        *(h16x4*)(base + r * ld) = o; } }
    }
};
struct Epi4 {
    const float* X; const h16* O1; float* OUT;
    __device__ __forceinline__ void operator()(const f32x4 (&acc)[2][2][4][2], const pg8::Unit& u, int wr, int wc, int fr, int fq) const {
        const int row0 = u.pm * 256 + wr * 64 + fr, col0 = u.pn * 256 + wc * 32 + 4 * fq;
#pragma unroll
        for (int ai = 0; ai < 2; ++ai)
#pragma unroll
            for (int m = 0; m < 4; ++m) { const size_t r = (size_t)(row0 + ai * 128 + m * 16);
#pragma unroll
                for (int bj = 0; bj < 2; ++bj)
#pragma unroll
                    for (int n = 0; n < 2; ++n) { const size_t o = r * 1024 + col0 + bj * 128 + n * 16;
                        const f32x4 xv = *(const f32x4*)(X + o); const h16x4 ov = *(const h16x4*)(O1 + o); f32x4 v = acc[ai][bj][m][n];
                        v[0] += xv[0] + (float)ov[0]; v[1] += xv[1] + (float)ov[1]; v[2] += xv[2] + (float)ov[2]; v[3] += xv[3] + (float)ov[3];
                        *(f32x4*)(OUT + o) = v; } }
    }
};

__device__ __forceinline__ void phase_stats(const Params& p) {
    const int tid = threadIdx.x, lane = tid & 63, wave = tid >> 6;
    const int gw = blockIdx.x * 8 + wave, NGW = gridDim.x * 8;
    const h16* V = (const h16*)(p.ws + WS_V); float* ST = (float*)(p.ws + WS_STATS);
    for (int r = gw; r < NTOK; r += NGW) {
        const h16x8 a = *(const h16x8*)(V + (size_t)r * 1024 + 8 * lane), b = *(const h16x8*)(V + (size_t)r * 1024 + 512 + 8 * lane);
        float s = 0.f;
#pragma unroll
        for (int e = 0; e < 8; ++e) s += (float)a[e] + (float)b[e];
        const float mu = wave_sum(s) * (1.f / 1024.f); float q = 0.f;
#pragma unroll
        for (int e = 0; e < 8; ++e) { const float x = (float)a[e] - mu, y = (float)b[e] - mu; q += x * x + y * y; }
        const float rs = rsqrtf(wave_sum(q) * (1.f / 1024.f) + 1e-5f);
        if (lane == 0) { ST[2 * r] = mu; ST[2 * r + 1] = rs; }
    }
}

__device__ __forceinline__ void phase_mix0(const Params& p, LAS unsigned char* lds) {
    const int tid = threadIdx.x, lane = tid & 63, wave = tid >> 6;
    const h16* XC = (const h16*)(p.ws + WS_XC); const h16* G = (const h16*)(p.ws + WS_G); const h16* U = (const h16*)(p.ws + WS_U); const h16* V = (const h16*)(p.ws + WS_V);
    h16* YC = (h16*)(p.ws + WS_YCAT);
    const float* cw = p.in[3];
    const int gt = blockIdx.x * 512 + tid, NGT = gridDim.x * 512;
    for (int idx = gt; idx < NTOK * 128; idx += NGT) {
        const int t = idx >> 7, c8 = (idx & 127) * 8, tp = t & (SEQ - 1);
        const h16x8 zero = {0, 0, 0, 0, 0, 0, 0, 0};
        const h16x8 x0 = *(const h16x8*)(XC + (size_t)t * 1024 + c8);
        const h16x8 xm = tp > 0 ? *(const h16x8*)(XC + (size_t)(t - 1) * 1024 + c8) : zero;
        const h16x8 xp = tp < SEQ - 1 ? *(const h16x8*)(XC + (size_t)(t + 1) * 1024 + c8) : zero;
        const h16x8 gg = *(const h16x8*)(G + (size_t)t * 1024 + c8);
        h16x8 o;
#pragma unroll
        for (int e = 0; e < 8; ++e) { const float y = cw[c8 + e] * (float)xm[e] + cw[1024 + c8 + e] * (float)x0[e] + cw[2048 + c8 + e] * (float)xp[e]; o[e] = (h16)(y * (float)gg[e]); }
        *(h16x8*)(YC + (size_t)t * 2048 + c8) = o;
    }
    const float* ST = (const float*)(p.ws + WS_STATS); const h16* WSH = (const h16*)(p.ws + WS_WSH);
    const float* lng = p.in[4]; const float* lnb = p.in[5]; const float* bs = p.in[7];
    LAS h16* vnT = (LAS h16*)lds;
    for (int it = blockIdx.x; it < 1024; it += gridDim.x) {
        const int g = it & 7, bn = it >> 3, t0 = bn * 128;
        __syncthreads();
#pragma unroll
        for (int q = 0; q < 4; ++q) { const int pc = tid + 512 * q, j = pc >> 4, d8 = (pc & 15) * 8;
            const h16x8 v = *(const h16x8*)(V + (size_t)(t0 + j) * 1024 + g * 128 + d8);
            const float mu = ST[2 * (t0 + j)], rs = ST[2 * (t0 + j) + 1];
#pragma unroll
            for (int e = 0; e < 8; ++e) vnT[(d8 + e) * 136 + j] = (h16)(((float)v[e] - mu) * rs * lng[g * 128 + d8 + e] + lnb[g * 128 + d8 + e]); }
        __syncthreads();
        const int itile = wave >> 1, dt0 = (wave & 1) * 2;
        f32x16 acc0, acc1;
#pragma unroll
        for (int e = 0; e < 16; ++e) { acc0[e] = 0.f; acc1[e] = 0.f; }
        const h16* Arow = WSH + ((size_t)g * 128 + itile * 32 + (lane & 31)) * 128 + 8 * (lane >> 5);
        const LAS h16* B0p = vnT + (dt0 * 32 + (lane & 31)) * 136 + 8 * (lane >> 5);
        const LAS h16* B1p = B0p + 32 * 136;
#pragma unroll
        for (int ks = 0; ks < 8; ++ks) {
            const h16x8 a = *(const h16x8*)(Arow + 16 * ks);
            const h16x8 b0 = *(const LAS h16x8*)(B0p + 16 * ks), b1 = *(const LAS h16x8*)(B1p + 16 * ks);
            acc0 = __builtin_amdgcn_mfma_f32_32x32x16_f16(a, b0, acc0, 0, 0, 0);
            acc1 = __builtin_amdgcn_mfma_f32_32x32x16_f16(a, b1, acc1, 0, 0, 0);
        }
#pragma unroll
        for (int r = 0; r < 16; ++r) { const int i = itile * 32 + (r & 3) + 8 * (r >> 2) + 4 * (lane >> 5); const size_t t = (size_t)(t0 + i);
            const float bias = bs[g * 128 + i];
            const int d0 = g * 128 + dt0 * 32 + (lane & 31);
            YC[t * 2048 + 1024 + d0] = (h16)((acc0[r] + bias) * (float)U[t * 1024 + d0]);
            YC[t * 2048 + 1024 + d0 + 32] = (h16)((acc1[r] + bias) * (float)U[t * 1024 + d0 + 32]); }
    }
}

__device__ __forceinline__ void phase_norm1(const Params& p) {
    const int tid = threadIdx.x, lane = tid & 63, wave = tid >> 6;
    const int gw = blockIdx.x * 8 + wave, NGW = gridDim.x * 8;
    const h16* O1 = (const h16*)(p.ws + WS_O1); h16* H1 = (h16*)p.out;
    for (int r = gw; r < NTOK; r += NGW) rms_row_f16(p.in[0] + (size_t)r * DM, O1 + (size_t)r * DM, p.in[9], H1 + (size_t)r * DM, lane);
}

__device__ __forceinline__ void phase_fft(const Params& p, LAS unsigned char* lds) {
    const int tid = threadIdx.x;
    const h16* FD = (const h16*)(p.ws + WS_FD);
    h16* SPr = (h16*)(p.ws + WS_SPR); h16* SPi = (h16*)(p.ws + WS_SPI);
    LAS f32x2* X0 = (LAS f32x2*)lds; LAS f32x2* X1 = X0 + 8192;
    for (int it = blockIdx.x; it < 256; it += gridDim.x) {
        const int b = it >> 7, c0 = 4 * (it & 127);
        __syncthreads();
        for (int t = tid; t < SEQ; t += 512) { const h16x4 v = *(const h16x4*)(FD + (size_t)(b * SEQ + t) * 512 + c0);
            X0[t] = (f32x2){(float)v[0], (float)v[1]}; X1[t] = (f32x2){(float)v[2], (float)v[3]}; }
        __syncthreads();
        for (int s = 0; s < 13; ++s) {
            const int half = 4096 >> s;
#pragma unroll 2
            for (int j = tid; j < 4096; j += 512) {
                const int pos = j & (half - 1), grp = j >> (12 - s), i0 = (grp << (13 - s)) + pos, i1 = i0 + half;
                const float fr = (float)(pos << s) * (1.f / 8192.f);
                const float c = __builtin_amdgcn_cosf(fr), sn = __builtin_amdgcn_sinf(fr);
                { const f32x2 a = X0[i0], bb = X0[i1]; const f32x2 d = a - bb; X0[i0] = a + bb; X0[i1] = (f32x2){d[0] * c + d[1] * sn, d[1] * c - d[0] * sn}; }
                { const f32x2 a = X1[i0], bb = X1[i1]; const f32x2 d = a - bb; X1[i0] = a + bb; X1[i1] = (f32x2){d[0] * c + d[1] * sn, d[1] * c - d[0] * sn}; }
            }
            __syncthreads();
        }
        const float sc = 0.5f * 0.011048543456039806f;
        for (int k = tid; k < SEQ; k += 512) {
            const int ra = __brev((unsigned)k) >> 19, rb = __brev((unsigned)((SEQ - k) & (SEQ - 1))) >> 19;
            const f32x2 za = X0[ra], zb = X0[rb], ya = X1[ra], yb = X1[rb];
            h16x4 orr, oi;
            orr[0] = (h16)((za[0] + zb[0]) * sc); oi[0] = (h16)((za[1] - zb[1]) * sc);
            orr[1] = (h16)((za[1] + zb[1]) * sc); oi[1] = (h16)((zb[0] - za[0]) * sc);
            orr[2] = (h16)((ya[0] + yb[0]) * sc); oi[2] = (h16)((ya[1] - yb[1]) * sc);
            orr[3] = (h16)((ya[1] + yb[1]) * sc); oi[3] = (h16)((yb[0] - ya[0]) * sc);
            *(h16x4*)(SPr + (size_t)(b * SEQ + k) * 512 + c0) = orr; *(h16x4*)(SPi + (size_t)(b * SEQ + k) * 512 + c0) = oi;
        }
    }
}

__device__ __forceinline__ void phase_fnet_out(const Params& p) {
    const int tid = threadIdx.x, lane = tid & 63, wave = tid >> 6;
    const int gw = blockIdx.x * 8 + wave, NGW = gridDim.x * 8;
    const h16* SPr = (const h16*)(p.ws + WS_SPR); const h16* SPi = (const h16*)(p.ws + WS_SPI);
    const h16* CWT = (const h16*)(p.ws + WS_CWT); h16* ZCD = (h16*)(p.ws + WS_ZCD);
    for (int w = gw; w < 8192; w += NGW) {
        const int et = w & 3, g = (w >> 2) & 3, tt = w >> 4;
        const size_t trow = (size_t)(tt * 32 + (lane & 31));
        const h16* Ar = SPr + trow * 512 + g * 128 + 8 * (lane >> 5); const h16* Ai = SPi + trow * 512 + g * 128 + 8 * (lane >> 5);
        const h16* Bp = CWT + ((size_t)(g * 128 + et * 32 + (lane & 31))) * 256 + 8 * (lane >> 5);
        f32x16 acc;
#pragma unroll
        for (int e = 0; e < 16; ++e) acc[e] = 0.f;
#pragma unroll
        for (int ks = 0; ks < 8; ++ks) acc = __builtin_amdgcn_mfma_f32_32x32x16_f16(*(const h16x8*)(Ar + 16 * ks), *(const h16x8*)(Bp + 16 * ks), acc, 0, 0, 0);
#pragma unroll
        for (int ks = 0; ks < 8; ++ks) acc = __builtin_amdgcn_mfma_f32_32x32x16_f16(*(const h16x8*)(Ai + 16 * ks), *(const h16x8*)(Bp + 128 + 16 * ks), acc, 0, 0, 0);
#pragma unroll
        for (int r = 0; r < 16; ++r) { const size_t t = (size_t)(tt * 32 + (r & 3) + 8 * (r >> 2) + 4 * (lane >> 5));
            h16* zp = ZCD + t * 1536 + 1024 + g * 128 + et * 32 + (lane & 31);
            *zp = (h16)(acc[r] * silu_f((float)*zp)); }
    }
}

#define LDS_BAR() do { asm volatile("s_waitcnt lgkmcnt(0)" ::: "memory"); __builtin_amdgcn_s_barrier(); asm volatile("" ::: "memory"); } while (0)
#define LDS_WAIT() asm volatile("s_waitcnt lgkmcnt(0)" ::: "memory")
__device__ __forceinline__ void phase_scan(const Params& p, LAS unsigned char* lds) {
    const int tid = threadIdx.x, lane = tid & 63, wave = tid >> 6;
    const h16* PC = (const h16*)(p.ws + WS_PC);
    LAS h16* w2T = (LAS h16*)lds;
    LAS h16* a2T = w2T + 64 * 72;
    LAS unsigned char* priv = lds + 18432 + (wave & 3) * 4096;
    constexpr int SET_F = 5 * 2048 + 512;
    LAS float* OPS = (LAS float*)(lds + 18432 + 16384);
    LAS float* sYb = OPS + 2 * SET_F;
    for (int item = blockIdx.x; item < 256; item += gridDim.x) {
        const int xcd = item & 7, slot = item >> 3, gidx = xcd * 8 + (slot >> 2), q = slot & 3;
        const int dir = gidx >> 5, b = (gidx >> 4) & 1, h = gidx & 15;
        h16* Yd = (h16*)((unsigned char*)p.out + (size_t)dir * 32 * MiB);
        float* SB = (float*)(p.ws + WS_SBON) + (size_t)dir * NTOK * 16;
        const float* mu = p.in[11] + dir * 3200; const float* w0 = p.in[12] + dir * 1024 + 64 * h; const float* w2 = p.in[13] + (size_t)dir * 65536 + 64 * h;
        const float* a0 = p.in[14] + dir * 1024 + 64 * h; const float* a2 = p.in[15] + (size_t)dir * 65536 + 64 * h;
        const float* kkw = p.in[16] + 64 * h; const float* kaw = p.in[17] + 64 * h; const float* rkw = p.in[18] + 64 * h;
        __syncthreads();
        for (int i = tid; i < 4096; i += 512) { const int l = i >> 6, c = i & 63; w2T[c * 72 + l] = (h16)w2[l * 1024 + c]; a2T[c * 72 + l] = (h16)a2[l * 1024 + c]; }
        const int pw_ = wave & 3, s_sub = lane >> 3, c8 = (lane & 7) * 8, s_l = 8 * pw_ + s_sub;
        h16x8 mu_r8, mu_k8, mu_v8, mu_w8, mu_a8; float w0r[8], a0r[8], kkr[8], kar[8], rkr[8];
#pragma unroll
        for (int e = 0; e < 8; ++e) { mu_r8[e] = (h16)mu[64 * h + c8 + e]; mu_k8[e] = (h16)mu[1024 + 64 * h + c8 + e]; mu_v8[e] = (h16)mu[2048 + 64 * h + c8 + e]; mu_w8[e] = (h16)mu[3072 + c8 + e]; mu_a8[e] = (h16)mu[3136 + c8 + e];
            w0r[e] = w0[c8 + e]; a0r[e] = a0[c8 + e]; kkr[e] = kkw[c8 + e]; kar[e] = kaw[c8 + e]; rkr[e] = rkw[c8 + e]; }
        f32x2 S01 = {0.f, 0.f}, S23 = {0.f, 0.f};
        const int srow = 4 * (wave & 3) + (lane >> 4), j0 = 4 * (lane & 15);
        const h16x8 z8 = {0, 0, 0, 0, 0, 0, 0, 0};
        h16x8 pr, pk, pv, pw, pa, qr_, qk_, qv_, qw_, qa_;
#define SCAN_LOAD(chn) do { const int sg_ = (chn) * 32 + s_l; const int t_ = dir ? (SEQ - 1 - sg_) : sg_; \
            const size_t rowc_ = (size_t)(b * SEQ + t_) * 3200; const size_t rowp_ = (size_t)(b * SEQ + (dir ? t_ + 1 : t_ - 1)) * 3200; const bool hp_ = sg_ > 0; \
            pr = *(const h16x8*)(PC + rowc_ + 64 * h + c8); pk = *(const h16x8*)(PC + rowc_ + 1024 + 64 * h + c8); pv = *(const h16x8*)(PC + rowc_ + 2048 + 64 * h + c8); \
            pw = *(const h16x8*)(PC + rowc_ + 3072 + c8); pa = *(const h16x8*)(PC + rowc_ + 3136 + c8); \
            qr_ = hp_ ? *(const h16x8*)(PC + rowp_ + 64 * h + c8) : z8; qk_ = hp_ ? *(const h16x8*)(PC + rowp_ + 1024 + 64 * h + c8) : z8; qv_ = hp_ ? *(const h16x8*)(PC + rowp_ + 2048 + 64 * h + c8) : z8; \
            qw_ = hp_ ? *(const h16x8*)(PC + rowp_ + 3072 + c8) : z8; qa_ = hp_ ? *(const h16x8*)(PC + rowp_ + 3136 + c8) : z8; } while (0)
#define SCAN_YSTORE(chn) do { const int sg_ = (chn) * 32 + s_l; const int t_ = dir ? (SEQ - 1 - sg_) : sg_; \
            const f32x2 y2_ = *(const LAS f32x2*)(sYb + ((chn) & 1) * 512 + s_l * 16 + 2 * (lane & 7)); \
            typedef _Float16 h16x2_ __attribute__((ext_vector_type(2))); h16x2_ o_; o_[0] = (h16)y2_[0]; o_[1] = (h16)y2_[1]; \
            *(h16x2_*)(Yd + (size_t)(b * SEQ + t_) * 1024 + 64 * h + 16 * q + 2 * (lane & 7)) = o_; } while (0)
        if (wave >= 4) SCAN_LOAD(0);
        __syncthreads();
        for (int n = -1; n < SEQ / 32; ++n) {
            if (wave < 4) {
                if (n >= 0) {
                    __builtin_amdgcn_s_setprio(3);
                    const LAS float* sR = OPS + (n & 1) * SET_F + j0; const LAS float* sW = sR + 2048; const LAS float* sK = sW + 2048; const LAS float* sA = sK + 2048; const LAS float* sB = sA + 2048; const LAS float* sV = OPS + (n & 1) * SET_F + 10240;
                    LAS float* sY = sYb + (n & 1) * 512;
                    f32x4 a_ = *(const LAS f32x4*)(sA), w_ = *(const LAS f32x4*)(sW), b_ = *(const LAS f32x4*)(sB);
                    f32x4 k_ = *(const LAS f32x4*)(sK), r_ = *(const LAS f32x4*)(sR);
                    f32x4 vq[4];
#pragma unroll
                    for (int u = 0; u < 4; ++u) vq[u] = *(const LAS f32x4*)(sV + srow * 32 + 4 * u);
                    f32x4 rp = r_;
#pragma unroll
                    for (int hb = 0; hb < 2; ++hb) {
                        f32x4 vn[4];
#pragma unroll
                        for (int u = 0; u < 4; ++u) vn[u] = *(const LAS f32x4*)(sV + srow * 32 + ((16 * (hb + 1)) & 31) + 4 * u);
#pragma unroll
                        for (int u16 = 0; u16 < 16; ++u16) {
                            const int s = 16 * hb + u16;
                            const int sn = (s + 1) & 31;
                            const f32x4 a_n = *(const LAS f32x4*)(sA + sn * 64), w_n = *(const LAS f32x4*)(sW + sn * 64), b_n = *(const LAS f32x4*)(sB + sn * 64);
                            const f32x4 k_n = *(const LAS f32x4*)(sK + sn * 64), r_n = *(const LAS f32x4*)(sR + sn * 64);
                            const float v = vq[u16 >> 2][u16 & 3];
                            const f32x2 vv = {v, v};
                            f32x2 pp = S01 * (f32x2){a_[0], a_[1]}; pp = S23 * (f32x2){a_[2], a_[3]} + pp;
                            f32x2 yy = S01 * (f32x2){rp[0], rp[1]}; yy = S23 * (f32x2){rp[2], rp[3]} + yy;
                            float sa = pp[0] + pp[1], y = yy[0] + yy[1];
                            sa += dpp_f<0xB1>(sa); y += dpp_f<0xB1>(y);
                            sa += dpp_f<0x4E>(sa); y += dpp_f<0x4E>(y);
                            sa += dpp_f<0x141>(sa); y += dpp_f<0x141>(y);
                            sa += dpp_f<0x140>(sa); y += dpp_f<0x140>(y);
                            sY[((s - 1) & 31) * 16 + srow] = y;
                            const f32x2 sv = {sa, sa};
                            S01 = S01 * (f32x2){w_[0], w_[1]} + vv * (f32x2){k_[0], k_[1]};
                            S23 = S23 * (f32x2){w_[2], w_[3]} + vv * (f32x2){k_[2], k_[3]};
                            S01 = sv * (f32x2){b_[0], b_[1]} + S01;
                            S23 = sv * (f32x2){b_[2], b_[3]} + S23;
                            rp = r_;
                            a_ = a_n; w_ = w_n; b_ = b_n; k_ = k_n; r_ = r_n;
                        }
#pragma unroll
                        for (int u = 0; u < 4; ++u) vq[u] = vn[u];
                    }
                    { f32x2 yy = S01 * (f32x2){rp[0], rp[1]}; yy = S23 * (f32x2){rp[2], rp[3]} + yy; sY[31 * 16 + srow] = red16(yy[0] + yy[1]); }
                    __builtin_amdgcn_s_setprio(0);
                }
            } else {
                if (n + 1 < SEQ / 32) {
                    const int cn = n + 1;
                    const int sg = cn * 32 + s_l; const int t = dir ? (SEQ - 1 - sg) : sg;
                    float qr[8], qk[8], qv[8];
                    LAS h16* TWp = (LAS h16*)priv; LAS h16* QAp = TWp + 8 * 72;
                    { const h16x8 r8 = pr + mu_r8 * (qr_ - pr), k8 = pk + mu_k8 * (qk_ - pk), v8 = pv + mu_v8 * (qv_ - pv);
                      const h16x8 w8 = pw + mu_w8 * (qw_ - pw), a8 = pa + mu_a8 * (qa_ - pa);
                      h16x8 tw8;
#pragma unroll
                      for (int e = 0; e < 8; ++e) { qr[e] = (float)r8[e]; qk[e] = (float)k8[e]; qv[e] = (float)v8[e]; tw8[e] = (h16)tanh_f((float)w8[e]); }
                      *(LAS h16x8*)(TWp + s_sub * 72 + c8) = tw8; *(LAS h16x8*)(QAp + s_sub * 72 + c8) = a8; }
                    if (cn + 1 < SEQ / 32) SCAN_LOAD(cn + 1);
                    LDS_WAIT();
                    f32x4 accw[4], acca[4];
#pragma unroll
                    for (int ct = 0; ct < 4; ++ct) { accw[ct] = (f32x4){0.f, 0.f, 0.f, 0.f}; acca[ct] = (f32x4){0.f, 0.f, 0.f, 0.f}; }
#pragma unroll
                    for (int ks = 0; ks < 2; ++ks) {
                        const h16x8 atw = *(const LAS h16x8*)(TWp + (lane & 7) * 72 + 32 * ks + 8 * (lane >> 4));
                        const h16x8 aqa = *(const LAS h16x8*)(QAp + (lane & 7) * 72 + 32 * ks + 8 * (lane >> 4));
#pragma unroll
                        for (int ct = 0; ct < 4; ++ct) {
                            const h16x8 bw = *(const LAS h16x8*)(w2T + (16 * ct + (lane & 15)) * 72 + 32 * ks + 8 * (lane >> 4));
                            const h16x8 ba = *(const LAS h16x8*)(a2T + (16 * ct + (lane & 15)) * 72 + 32 * ks + 8 * (lane >> 4));
                            accw[ct] = __builtin_amdgcn_mfma_f32_16x16x32_f16(atw, bw, accw[ct], 0, 0, 0);
                            acca[ct] = __builtin_amdgcn_mfma_f32_16x16x32_f16(aqa, ba, acca[ct], 0, 0, 0);
                        }
                    }
                    LDS_WAIT();
                    { LAS float* Zd = (LAS float*)priv + (lane >> 5) * 512 + (4 * ((lane >> 4) & 1)) * 64 + (lane & 15);
#pragma unroll
                      for (int ct = 0; ct < 4; ++ct)
#pragma unroll
                          for (int r = 0; r < 4; ++r) Zd[r * 64 + 16 * ct] = (lane < 32) ? accw[ct][r] : acca[ct][r]; }
                    LDS_WAIT();
                    const LAS float* Zw = (const LAS float*)priv + s_sub * 64 + c8; const LAS float* Za = Zw + 512;
                    const f32x4 zw0 = *(const LAS f32x4*)Zw, zw1 = *(const LAS f32x4*)(Zw + 4), za0 = *(const LAS f32x4*)Za, za1 = *(const LAS f32x4*)(Za + 4);
                    LDS_WAIT();
                    float kk[8], av_[8], kn = 0.f, sbn = 0.f, kp[8], dec[8];
#pragma unroll
                    for (int e = 0; e < 8; ++e) { const float zw = (e < 4 ? zw0[e & 3] : zw1[e & 3]) + w0r[e], za = (e < 4 ? za0[e & 3] : za1[e & 3]) + a0r[e];
                        dec[e] = __expf(-0.6065306597126334f * sigmoid_f(zw)); av_[e] = sigmoid_f(za);
                        kk[e] = qk[e] * kkr[e]; kn += kk[e] * kk[e]; kp[e] = qk[e] * (1.f + (av_[e] - 1.f) * kar[e]); sbn += qr[e] * kp[e] * rkr[e]; }
                    kn = red8(kn); sbn = red8(sbn);
                    const float inv = rsqrtf(fmaxf(kn, 1e-12f));
                    LAS float* dR = OPS + (cn & 1) * SET_F + s_l * 64 + c8;
#pragma unroll
                    for (int hf = 0; hf < 2; ++hf) { f32x4 oR, oW, oK, oA, oB;
#pragma unroll
                        for (int e = 0; e < 4; ++e) { const int g = 4 * hf + e; const float kn_ = kk[g] * inv; oR[e] = qr[g]; oW[e] = dec[g]; oK[e] = kp[g]; oA[e] = -kn_; oB[e] = kn_ * av_[g]; }
                        *(LAS f32x4*)(dR + 4 * hf) = oR; *(LAS f32x4*)(dR + 2048 + 4 * hf) = oW; *(LAS f32x4*)(dR + 4096 + 4 * hf) = oK; *(LAS f32x4*)(dR + 6144 + 4 * hf) = oA; *(LAS f32x4*)(dR + 8192 + 4 * hf) = oB; }
                    if ((c8 >> 4) == q) { LAS float* dV = OPS + (cn & 1) * SET_F + 10240 + (c8 & 15) * 32 + s_l;
#pragma unroll
                        for (int e = 0; e < 8; ++e) dV[e * 32] = qv[e]; }
                    if (q == 0 && (lane & 7) == 0) SB[(size_t)(b * SEQ + t) * 16 + h] = sbn;
                }
                if (n >= 1) SCAN_YSTORE(n - 1);
            }
            LDS_BAR();
        }
        if (wave >= 4) SCAN_YSTORE(SEQ / 32 - 1);
#undef SCAN_LOAD
#undef SCAN_YSTORE
    }
}

__device__ __forceinline__ void phase_post(const Params& p) {
    const int tid = threadIdx.x;
    const h16* Y0 = (const h16*)p.out; const h16* Y1 = (const h16*)((const unsigned char*)p.out + 32 * MiB);
    const h16* PC = (const h16*)(p.ws + WS_PC); h16* ZCD = (h16*)(p.ws + WS_ZCD);
    const float* SB0 = (const float*)(p.ws + WS_SBON); const float* SB1 = SB0 + (size_t)NTOK * 16;
    const float* mu0 = p.in[11] + 2048; const float* mu1 = p.in[11] + 3200 + 2048;
    const float* lg = p.in[19]; const float* lb = p.in[20];
    const int gt = blockIdx.x * 512 + tid, NGT = gridDim.x * 512;
    for (int idx = gt; idx < NTOK * 256; idx += NGT) {
        const int t = idx >> 8, c = (idx & 255) * 4, hh = c >> 6, tp = t & (SEQ - 1);
        const h16x4 y0 = *(const h16x4*)(Y0 + (size_t)t * 1024 + c), y1 = *(const h16x4*)(Y1 + (size_t)t * 1024 + c);
        float y[4], s = 0.f;
#pragma unroll
        for (int e = 0; e < 4; ++e) { y[e] = (float)y0[e] + (float)y1[e]; s += y[e]; }
        const float mean = red16(s) * (1.f / 64.f); float q = 0.f;
#pragma unroll
        for (int e = 0; e < 4; ++e) { y[e] -= mean; q += y[e] * y[e]; }
        const float rs = rsqrtf(red16(q) * (1.f / 64.f) + 64e-5f);
        const h16x4 z4 = {0, 0, 0, 0};
        const h16x4 v0 = *(const h16x4*)(PC + (size_t)t * 3200 + 2048 + c);
        const h16x4 vm = tp > 0 ? *(const h16x4*)(PC + (size_t)(t - 1) * 3200 + 2048 + c) : z4;
        const h16x4 vp = tp < SEQ - 1 ? *(const h16x4*)(PC + (size_t)(t + 1) * 3200 + 2048 + c) : z4;
        const float s0 = SB0[(size_t)t * 16 + hh], s1 = SB1[(size_t)t * 16 + hh];
        const h16x4 zc = *(const h16x4*)(ZCD + (size_t)t * 1536 + c);
        h16x4 o;
#pragma unroll
        for (int e = 0; e < 4; ++e) { const float vv = (float)v0[e];
            const float vd0 = vv + mu0[c + e] * ((float)vm[e] - vv), vd1 = vv + mu1[c + e] * ((float)vp[e] - vv);
            const float val = y[e] * rs * lg[c + e] + lb[c + e] + s0 * vd0 + s1 * vd1;
            o[e] = (h16)(val * silu_f((float)zc[e])); }
        *(h16x4*)(ZCD + (size_t)t * 1536 + c) = o;
    }
}

__device__ __forceinline__ void phase_final(const Params& p) {
    const int tid = threadIdx.x, lane = tid & 63, wave = tid >> 6;
    const int gw = blockIdx.x * 8 + wave, NGW = gridDim.x * 8;
    const float* g = p.in[23];
    for (int r = gw; r < NTOK; r += NGW) {
        float* xr = p.out + (size_t)r * DM; f32x4 v[4]; float ss = 0.f;
#pragma unroll
        for (int j = 0; j < 4; ++j) { v[j] = *(const f32x4*)(xr + 4 * lane + 256 * j); ss += v[j][0] * v[j][0] + v[j][1] * v[j][1] + v[j][2] * v[j][2] + v[j][3] * v[j][3]; }
        const float rs = rsqrtf(wave_sum(ss) * (1.f / 1024.f) + 1e-6f);
#pragma unroll
        for (int j = 0; j < 4; ++j) { const f32x4 gg = *(const f32x4*)(g + 4 * lane + 256 * j); f32x4 o = v[j] * rs; o = o * gg; *(f32x4*)(xr + 4 * lane + 256 * j) = o; }
    }
}

__global__ void __launch_bounds__(512, 2) mega(Params p) {
    extern __shared__ __attribute__((aligned(16))) unsigned char smem[];
    LAS unsigned char* lds = (LAS unsigned char*)smem;
    cg::grid_group grid = cg::this_grid();
    unsigned char* ws = p.ws;
    const int lo = p.ph_lo, hi = p.ph_hi;
#define IN(k) (lo <= (k) && (k) < hi)
    volatile LAS unsigned* bst = (volatile LAS unsigned*)(lds + LDS_MAIN);
    if (threadIdx.x < 4) bst[threadIdx.x] = 0u;
    __syncthreads();
    const XcdBarrier bar = xcd_barrier_post((unsigned*)(ws + WS_BAR), bst);
    if (hi > 1000) grid.sync();
#define SEAM(k) do { if (IN(k) && IN((k) + 1)) { xcd_barrier(bar); if ((REPMASK >> 13) & 1) xcd_barrier(bar); } } while (0)
    if (IN(0)) for (int rep_ = 0; rep_ <= ((REPMASK >> 0) & 1); ++rep_) { phase0(p, lds); } SEAM(0);
    if (IN(1)) for (int rep_ = 0; rep_ <= ((REPMASK >> 1) & 1); ++rep_) { pg8::Gemm g{(const h16*)p.out, (const h16*)(ws + WS_W1T), NTOK, 7168, 1024}; pg8::StaticOrder S; S.init(NTOK, 7168, gridDim.x, blockIdx.x);
                 Epi1 E{(h16*)(ws + WS_XC), (h16*)(ws + WS_G), (h16*)(ws + WS_U), (h16*)(ws + WS_V)}; pg8::gemm_phase<Epi1>(lds, g, S, E); } SEAM(1);
    if (IN(2)) for (int rep_ = 0; rep_ <= ((REPMASK >> 2) & 1); ++rep_) { phase_stats(p); } SEAM(2);
    if (IN(3)) for (int rep_ = 0; rep_ <= ((REPMASK >> 3) & 1); ++rep_) { phase_mix0(p, lds); } SEAM(3);
    if (IN(4)) for (int rep_ = 0; rep_ <= ((REPMASK >> 4) & 1); ++rep_) { pg8::Gemm g{(const h16*)(ws + WS_YCAT), (const h16*)(ws + WS_W2T), NTOK, 1024, 2048}; pg8::StaticOrder S; S.init(NTOK, 1024, gridDim.x, blockIdx.x);
                 Epi2 E{(h16*)(ws + WS_O1)}; pg8::gemm_phase<Epi2>(lds, g, S, E); } SEAM(4);
    if (IN(5)) for (int rep_ = 0; rep_ <= ((REPMASK >> 5) & 1); ++rep_) { phase_norm1(p); } SEAM(5);
    if (IN(6)) for (int rep_ = 0; rep_ <= ((REPMASK >> 6) & 1); ++rep_) { pg8::Gemm g{(const h16*)p.out, (const h16*)(ws + WS_W3T), NTOK, 5376, 1024}; pg8::StaticOrder S; S.init(NTOK, 5376, gridDim.x, blockIdx.x);
                 Epi3 E{(h16*)(ws + WS_PC), (h16*)(ws + WS_ZCD), (h16*)(ws + WS_FD)}; pg8::gemm_phase<Epi3>(lds, g, S, E); } SEAM(6);
    if (IN(7)) for (int rep_ = 0; rep_ <= ((REPMASK >> 7) & 1); ++rep_) { phase_fft(p, lds); }
    if (IN(8)) for (int rep_ = 0; rep_ <= ((REPMASK >> 8) & 1); ++rep_) { phase_scan(p, lds); } SEAM(8);
    if (IN(9)) for (int rep_ = 0; rep_ <= ((REPMASK >> 9) & 1); ++rep_) { phase_fnet_out(p); }
    if (IN(10)) for (int rep_ = 0; rep_ <= ((REPMASK >> 10) & 1); ++rep_) { phase_post(p); } SEAM(10);
    if (IN(11)) for (int rep_ = 0; rep_ <= ((REPMASK >> 11) & 1); ++rep_) { pg8::Gemm g{(const h16*)(ws + WS_ZCD), (const h16*)(ws + WS_W4T), NTOK, 1024, 1536}; pg8::StaticOrder S; S.init(NTOK, 1024, gridDim.x, blockIdx.x);
                  Epi4 E{p.in[0], (const h16*)(ws + WS_O1), p.out}; pg8::gemm_phase<Epi4>(lds, g, S, E); } SEAM(11);
    if (IN(12)) for (int rep_ = 0; rep_ <= ((REPMASK >> 12) & 1); ++rep_) { phase_final(p); }
}

extern "C" void kernel_launch(void* const* d_in, const int* in_sizes, int n_in, void* d_out, int out_size, void* d_ws, size_t ws_size, hipStream_t stream) {
    static int grid = 0;
    if (grid == 0) {
        int dev = 0, cus = 0, per_cu = 0;
        hipGetDevice(&dev);
        hipDeviceGetAttribute(&cus, hipDeviceAttributeMultiprocessorCount, dev);
        if (hipFuncSetAttribute((const void*)mega, hipFuncAttributeMaxDynamicSharedMemorySize, LDS_BYTES) != hipSuccess) fprintf(stderr, "kernel_launch: hipFuncSetAttribute failed\n");
        hipOccupancyMaxActiveBlocksPerMultiprocessor(&per_cu, (const void*)mega, 512, LDS_BYTES);
        if (per_cu < 1) { fprintf(stderr, "kernel_launch: occupancy query says %d blocks per CU\n", per_cu); per_cu = 1; }
        (void)hipGetLastError();
        grid = cus;
        if (grid < 64) grid = 64;
    }
    if (hipMemsetAsync((unsigned char*)d_ws + WS_BAR, 0, XCD_BAR_WORDS * 4, stream) != hipSuccess) fprintf(stderr, "kernel_launch: memset of the barrier words failed\n");
    Params p{};
    for (int i = 0; i < 24; ++i) p.in[i] = (const float*)d_in[i];
    p.out = (float*)d_out; p.ws = (unsigned char*)d_ws;
#if N_LAUNCH_MODE == 1
    p.ph_lo = 0; p.ph_hi = NPHASE;
    void* args[] = {&p};
    hipError_t e = hipLaunchCooperativeKernel((const void*)mega, dim3(grid), dim3(512), args, LDS_BYTES, stream);
    if (e != hipSuccess) fprintf(stderr, "kernel_launch: cooperative launch failed: %s (grid %d)\n", hipGetErrorString(e), grid);
#else
    for (int ph = 0; ph < NPHASE; ++ph) { p.ph_lo = ph; p.ph_hi = ph + 1; hipLaunchKernelGGL(mega, dim3(grid), dim3(512), LDS_BYTES, stream, p); }
#endif
}
```

```cpp
#include <hip/hip_runtime.h>
#include <hip/hip_cooperative_groups.h>
#include <cstdio>
#include <cstdint>
namespace cg = cooperative_groups;

#ifndef N_LAUNCH_MODE
#define N_LAUNCH_MODE 1
#endif

#ifndef REPMASK
#define REPMASK 0
#endif
#define LAS __attribute__((address_space(3)))
typedef _Float16 h16;
typedef _Float16 h16x8 __attribute__((ext_vector_type(8)));
typedef _Float16 h16x4 __attribute__((ext_vector_type(4)));
typedef float f32x2 __attribute__((ext_vector_type(2)));
typedef float f32x4 __attribute__((ext_vector_type(4)));
typedef float f32x16 __attribute__((ext_vector_type(16)));

constexpr int NTOK = 16384, DM = 1024, SEQ = 8192;
constexpr int LDS_MAIN = 131072;
constexpr int LDS_BYTES = LDS_MAIN + 16;
constexpr int NPHASE = 13;
constexpr size_t MiB = 1024 * 1024;
constexpr size_t WS_W1T = 0;
constexpr size_t WS_W2T = WS_W1T + (size_t)7168 * 1024 * 2;
constexpr size_t WS_W3T = WS_W2T + (size_t)1024 * 2048 * 2;
constexpr size_t WS_W4T = WS_W3T + (size_t)5376 * 1024 * 2;
constexpr size_t WS_STATS = 32 * MiB;
constexpr size_t WS_WSH = WS_STATS + 131072;
constexpr size_t WS_CWT = WS_WSH + 262144;
constexpr size_t WS_SBON = WS_CWT + 262144;
constexpr size_t WS_BAR = 35 * MiB;
constexpr size_t WS_XC = 36 * MiB, WS_G = 68 * MiB, WS_U = 100 * MiB, WS_V = 132 * MiB, WS_YCAT = 164 * MiB;
constexpr size_t WS_SPR = 0, WS_SPI = 232 * MiB;
constexpr size_t WS_O2 = 68 * MiB;
constexpr size_t WS_O1 = 36 * MiB, WS_PC = 68 * MiB, WS_ZCD = 168 * MiB, WS_FD = 216 * MiB;

namespace pg8 {
constexpr int BM = 256, BK = 64, HALF = 128, HTB = HALF * BK * 2, STAGE_BYTES = 8 * HTB, NXCD = 8, WGM = 8;
__host__ __device__ __forceinline__ int lds_byte(int r, int c) { const int st = (r >> 4) * 2 + (c >> 5), rr = r & 15, cc = c & 31, ob = rr * 64 + cc * 2; return st * 1024 + (ob ^ (((ob >> 9) & 1) << 5)); }
__host__ __device__ __forceinline__ void stage_rc(int b, int& R, int& C) { const int st = b / 1024, sb = b % 1024, swz = sb ^ (((sb >> 9) & 1) << 5); R = (st >> 1) * 16 + swz / 64; C = (st & 1) * 32 + (swz % 64) / 2; }
struct Unit { int pm, pn; };
struct Gemm { const h16* A; const h16* Bt; int M, N, K; };
struct StaticOrder {
    int nM, nN, nwg, G, c;
    __host__ __device__ void init(int M, int N, int G_, int c_) { nM = M / BM; nN = N / BM; nwg = nM * nN; G = G_; c = c_; }
    __host__ __device__ bool next(int i, Unit& u) const {
        const long L = (long)i * G + c; if (L >= nwg) return false;
        int wgid = (int)L; { const int q = nwg / NXCD, r = nwg % NXCD, xcd = wgid % NXCD, off = wgid / NXCD; wgid = (xcd < r ? xcd * (q + 1) : r * (q + 1) + (xcd - r) * q) + off; }
        const int nig = WGM * nN, gid = wgid / nig, fm = gid * WGM, gsz = (nM - fm) < WGM ? (nM - fm) : WGM;
        u.pm = fm + ((wgid % nig) % gsz); u.pn = (wgid % nig) / gsz; return true;
    }
};
template <class Epi>
__device__ __forceinline__ void gemm_phase(LAS unsigned char* lds, const Gemm g, const StaticOrder& S, const Epi& E) {
    const int tid = threadIdx.x, wid = __builtin_amdgcn_readfirstlane(tid >> 6), lane = tid & 63, wr = wid >> 2, wc = wid & 3, fr = lane & 15, fq = lane >> 4;
    const int K = g.K, nt = K / BK;
    unsigned voffA[2], voffB[2];
#pragma unroll
    for (int i = 0; i < 2; ++i) { int R, C; stage_rc(tid * 16 + i * 8192, R, C); voffA[i] = (unsigned)(R * K + C) * 2u; voffB[i] = voffA[i]; }
    const size_t kstep = (size_t)(BK * 2);
    const size_t hstep = (size_t)HALF * K * 2;
    const size_t tstep = 2 * hstep;
    const unsigned ldsw = (unsigned)wid * 1024u;
    const int aoff = lds_byte(wr * 64 + fr, fq * 8), boff = lds_byte(wc * 32 + fr, fq * 8);
#define PG8_SA(b, h) (((b) * 2 + (h)) * HTB)
#define PG8_SB(b, h) ((4 + (b) * 2 + (h)) * HTB)
#define PG8_STAGE(bufoff, gbase, voff) do { _Pragma("unroll") for (int _i = 0; _i < 2; ++_i) \
        __builtin_amdgcn_global_load_lds((const unsigned*)((const char*)(gbase) + (voff)[_i]), (LAS unsigned*)(lds + (bufoff) + ldsw + _i * 8192), 16, 0, 0); } while (0)
#define PG8_LDA(dst, b, h) do { _Pragma("unroll") for (int m = 0; m < 4; ++m) _Pragma("unroll") for (int k = 0; k < 2; ++k) dst[m][k] = *(const LAS h16x8*)(lds + PG8_SA(b, h) + aoff + m * 2048 + k * 1024); } while (0)
#define PG8_LDB(dst, b, h) do { _Pragma("unroll") for (int n = 0; n < 2; ++n) _Pragma("unroll") for (int k = 0; k < 2; ++k) dst[n][k] = *(const LAS h16x8*)(lds + PG8_SB(b, h) + boff + n * 2048 + k * 1024); } while (0)
#define PG8_MMA(ai, bj, At, Bt) do { __builtin_amdgcn_s_setprio(1); _Pragma("unroll") for (int m = 0; m < 4; ++m) _Pragma("unroll") for (int n = 0; n < 2; ++n) _Pragma("unroll") for (int k = 0; k < 2; ++k) \
        acc[ai][bj][m][n] = __builtin_amdgcn_mfma_f32_16x16x32_f16(Bt[n][k], At[m][k], acc[ai][bj][m][n], 0, 0, 0); __builtin_amdgcn_s_setprio(0); } while (0)
#define PG8_WAIT_V(n) asm volatile("s_waitcnt vmcnt(" #n ")" ::: "memory")
#define PG8_WAIT_L(n) asm volatile("s_waitcnt lgkmcnt(" #n ")" ::: "memory")
#define PG8_BAR __builtin_amdgcn_s_barrier()
#define PG8_SCHED __builtin_amdgcn_sched_barrier(0)
    Unit cur, nxt; int ui = 0;
    if (!S.next(0, cur)) return;
    f32x4 acc[2][2][4][2];
#pragma unroll
    for (int a = 0; a < 2; ++a)
#pragma unroll
        for (int b = 0; b < 2; ++b)
#pragma unroll
            for (int m = 0; m < 4; ++m)
#pragma unroll
                for (int n = 0; n < 2; ++n) acc[a][b][m][n] = (f32x4){0.f, 0.f, 0.f, 0.f};
    h16x8 At[4][2], B0[2][2], B1[2][2];
    const char* cA = (const char*)g.A + (size_t)cur.pm * tstep; const char* cB = (const char*)g.Bt + (size_t)cur.pn * tstep;
    PG8_STAGE(PG8_SB(0, 0), cB, voffB); PG8_STAGE(PG8_SA(0, 0), cA, voffA); PG8_STAGE(PG8_SB(0, 1), cB + hstep, voffB); PG8_STAGE(PG8_SA(0, 1), cA + hstep, voffA);
    if (wr == 1) PG8_BAR;
    PG8_WAIT_V(4); PG8_BAR;
    PG8_STAGE(PG8_SB(1, 0), cB + kstep, voffB); PG8_STAGE(PG8_SA(1, 0), cA + kstep, voffA); PG8_STAGE(PG8_SB(1, 1), cB + hstep + kstep, voffB);
    PG8_WAIT_V(6); PG8_BAR;
    for (;;) {
        const bool has_next = S.next(ui + 1, nxt);
        const char* nA = has_next ? (const char*)g.A + (size_t)nxt.pm * tstep : cA; const char* nB = has_next ? (const char*)g.Bt + (size_t)nxt.pn * tstep : cB;
        for (int t = 0; t < nt; t += 2) {
            const bool last = (t == nt - 2);
            const char* a1 = cA + (size_t)(t + 1) * kstep;
            const char* a2 = last ? nA : cA + (size_t)(t + 2) * kstep; const char* b2 = last ? nB : cB + (size_t)(t + 2) * kstep;
            const char* a3 = a2 + kstep; const char* b3 = b2 + kstep;
            PG8_LDB(B0, 0, 0); PG8_SCHED; PG8_LDA(At, 0, 0); PG8_STAGE(PG8_SA(1, 1), a1 + hstep, voffA);
            PG8_WAIT_L(8); PG8_BAR; PG8_WAIT_L(0); PG8_MMA(0, 0, At, B0); PG8_BAR; PG8_SCHED;
            PG8_LDB(B1, 0, 1); PG8_STAGE(PG8_SB(0, 0), b2, voffB);
            PG8_BAR; PG8_WAIT_L(0); PG8_MMA(0, 1, At, B1); PG8_BAR;
            PG8_LDA(At, 0, 1); PG8_STAGE(PG8_SA(0, 0), a2, voffA);
            PG8_BAR; PG8_WAIT_L(0); PG8_MMA(1, 0, At, B0); PG8_BAR; PG8_SCHED;
            PG8_STAGE(PG8_SB(0, 1), b2 + hstep, voffB);
            PG8_WAIT_V(6); PG8_BAR; PG8_MMA(1, 1, At, B1); PG8_BAR;
            PG8_LDB(B0, 1, 0); PG8_SCHED; PG8_LDA(At, 1, 0); PG8_STAGE(PG8_SA(0, 1), a2 + hstep, voffA);
            PG8_WAIT_L(8); PG8_BAR; PG8_WAIT_L(0); PG8_MMA(0, 0, At, B0); PG8_BAR; PG8_SCHED;
            PG8_LDB(B1, 1, 1); PG8_STAGE(PG8_SB(1, 0), b3, voffB);
            PG8_BAR; PG8_WAIT_L(0); PG8_MMA(0, 1, At, B1); PG8_BAR;
            PG8_LDA(At, 1, 1); PG8_STAGE(PG8_SA(1, 0), a3, voffA);
            PG8_BAR; PG8_WAIT_L(0); PG8_MMA(1, 0, At, B0); PG8_BAR; PG8_SCHED;
            PG8_STAGE(PG8_SB(1, 1), b3 + hstep, voffB);
            PG8_WAIT_V(6); PG8_BAR; PG8_MMA(1, 1, At, B1); PG8_BAR;
        }
        E(acc, cur, wr, wc, fr, fq);
        if (!has_next) break;
#pragma unroll
        for (int a = 0; a < 2; ++a)
#pragma unroll
            for (int b = 0; b < 2; ++b)
#pragma unroll
                for (int m = 0; m < 4; ++m)
#pragma unroll
                    for (int n = 0; n < 2; ++n) acc[a][b][m][n] = (f32x4){0.f, 0.f, 0.f, 0.f};
        cur = nxt; cA = nA; cB = nB; ++ui;
    }
    PG8_WAIT_V(0);
    if (wr == 0) PG8_BAR;
    PG8_BAR;
#undef PG8_SA
#undef PG8_SB
#undef PG8_STAGE
#undef PG8_LDA
#undef PG8_LDB
#undef PG8_MMA
#undef PG8_WAIT_V
#undef PG8_WAIT_L
#undef PG8_BAR
#undef PG8_SCHED
}
}


#define XB_TMO      128
#define XB_XCNT(j)  (256  + 64 * (j))
#define XB_XSUB(j)  (1280 + 64 * (j))
#define XB_XGEN(j)  (2304 + 64 * (j))
#define XB_TOP      3328
#define XB_TOPGEN   3392
#define XCD_BAR_WORDS 3456
#define XB_SPIN_CAP (1u << 18)
__device__ __forceinline__ unsigned xb_ld(unsigned* p)              { return __hip_atomic_load(p, __ATOMIC_RELAXED, __HIP_MEMORY_SCOPE_AGENT); }
__device__ __forceinline__ unsigned xb_add(unsigned* p, unsigned v) { return __hip_atomic_fetch_add(p, v, __ATOMIC_RELAXED, __HIP_MEMORY_SCOPE_AGENT); }
__device__ __forceinline__ unsigned xb_xcc_id() { return (unsigned)__builtin_amdgcn_s_getreg((3 << 11) | 20) & 0xFu; }
#define XB_SPIN(cond, bar) do { unsigned _sp = 0; while (cond) { __builtin_amdgcn_s_sleep(1); \
    if ((++_sp & 255u) == 0u) { if (xb_ld(&(bar)[XB_TMO])) break; if (_sp > XB_SPIN_CAP) { atomicAdd(&(bar)[XB_TMO], 1u); break; } } } } while (0)
struct XcdBarrier { unsigned* bar; unsigned x; volatile LAS unsigned* st; };
__device__ __forceinline__ XcdBarrier xcd_barrier_post(unsigned* bar, volatile LAS unsigned* st) {
    XcdBarrier b; b.bar = bar; b.x = xb_xcc_id(); b.st = st;
    if (threadIdx.x == 0) (void)xb_add(&bar[XB_XCNT(b.x)], 1u);
    return b;
}
__device__ __forceinline__ void xcd_barrier_complete(unsigned* bar, unsigned x, unsigned& nloc, unsigned& nx) {
    const unsigned G = gridDim.x * gridDim.y * gridDim.z;
    unsigned sum, cnt, mine, sp = 0u;
    for (;;) {
        sum = 0u; cnt = 0u; mine = 0u;
#pragma unroll
        for (unsigned j = 0; j < 16; ++j) { const unsigned c = xb_ld(&bar[XB_XCNT(j)]); sum += c; cnt += (c > 0u) ? 1u : 0u; mine = (j == x) ? c : mine; }
        if (sum == G) break;
        __builtin_amdgcn_s_sleep(1);
        if ((++sp & 255u) == 0u) { if (xb_ld(&bar[XB_TMO])) break; if (sp > XB_SPIN_CAP) { atomicAdd(&bar[XB_TMO], 1u); break; } }
    }
    nloc = mine > 0u ? mine : 1u; nx = cnt > 0u ? cnt : 1u;
}
__device__ __forceinline__ void xcd_barrier(const XcdBarrier& b) {
    asm volatile("s_waitcnt vmcnt(0)" ::: "memory");
    __syncthreads();
    if (threadIdx.x == 0) {
        unsigned* bar = b.bar;
        __builtin_amdgcn_s_waitcnt(0);
        unsigned nloc = b.st[0], nx = b.st[1];
        if (nloc == 0u) { xcd_barrier_complete(bar, b.x, nloc, nx); b.st[0] = nloc; b.st[1] = nx; }
        const unsigned old = xb_add(&bar[XB_XSUB(b.x)], 1u);
        const unsigned gen = old / nloc;
        if (old + 1u == (gen + 1u) * nloc) {
            __builtin_amdgcn_fence(__ATOMIC_RELEASE, "agent");
            asm volatile("s_waitcnt vmcnt(0)" ::: "memory");
            const unsigned og = xb_add(&bar[XB_TOP], 1u);
            const unsigned tg = og / nx;
            if (og + 1u == (tg + 1u) * nx) xb_add(&bar[XB_TOPGEN], 1u);
            else XB_SPIN(xb_ld(&bar[XB_TOPGEN]) == tg, bar);
            __builtin_amdgcn_fence(__ATOMIC_ACQUIRE, "agent");
            xb_add(&bar[XB_XGEN(b.x)], 1u);
            asm volatile("s_waitcnt vmcnt(0)" ::: "memory");
        } else {
            XB_SPIN(xb_ld(&bar[XB_XGEN(b.x)]) == gen, bar);
            __builtin_amdgcn_fence(__ATOMIC_ACQUIRE, "agent");
            asm volatile("s_waitcnt vmcnt(0)" ::: "memory");
        }
    }
    __syncthreads();
}

struct Params { const float* in[24]; float* out; unsigned char* ws; int ph_lo, ph_hi; };

__device__ __forceinline__ float silu_f(float x) { return x * __builtin_amdgcn_rcpf(1.f + __expf(-x)); }
__device__ __forceinline__ float sigmoid_f(float x) { return __builtin_amdgcn_rcpf(1.f + __expf(-x)); }
__device__ __forceinline__ float tanh_f(float x) { return 1.f - 2.f * __builtin_amdgcn_rcpf(__expf(2.f * x) + 1.f); }
__device__ __forceinline__ float wave_sum(float v) {
#pragma unroll
    for (int o = 1; o < 64; o <<= 1) v += __shfl_xor(v, o);
    return v;
}
template <int CTRL> __device__ __forceinline__ float dpp_f(float x) { return __int_as_float(__builtin_amdgcn_update_dpp(0, __float_as_int(x), CTRL, 0xf, 0xf, false)); }
__device__ __forceinline__ float red8(float x) {
    x += dpp_f<0xB1>(x); x += dpp_f<0x4E>(x); x += dpp_f<0x141>(x); return x;
}
__device__ __forceinline__ float red16(float x) {
    x += dpp_f<0xB1>(x); x += dpp_f<0x4E>(x); x += dpp_f<0x141>(x); x += dpp_f<0x140>(x); return x;
}

__device__ __forceinline__ int sigma1(int np) {
    const int T = np >> 8, c = np & 255;
    if (T < 16) { const int bj = c >> 7, wc = (c >> 5) & 3, n = (c >> 4) & 1, r = c & 15; return 1024 * (2 * bj + n) + 64 * T + 16 * wc + r; }
    if (T < 24) { return ((c >> 7) ? 6144 : 4096) + 128 * (T - 16) + (c & 127); }
    return 5120 + 256 * (T - 24) + c;
}

template <int MODE>
__device__ __forceinline__ void tr_item(const float* W, int K, int N, h16* WT, LAS float* scr, int item, int nblk, int lane) {
    const int kb = item / nblk, nb = item % nblk, k0 = 64 * kb, n0 = 32 * nb;
    const int np = n0 + (lane & 31);
    const int sc = (MODE == 1) ? sigma1(np) : np;
    const bool valid = (MODE != 2) || (np < 5248);
#pragma unroll 8
    for (int i = 0; i < 32; ++i) { const int kk = 2 * i + (lane >> 5); scr[kk * 33 + (lane & 31)] = valid ? W[(size_t)(k0 + kk) * N + sc] : 0.f; }
    asm volatile("s_waitcnt lgkmcnt(0)" ::: "memory");
    const int c = lane & 7;
#pragma unroll
    for (int j = 0; j < 4; ++j) { const int n = (lane >> 3) + 8 * j; const LAS float* s = scr + (8 * c) * 33 + n;
        h16x8 o;
#pragma unroll
        for (int e = 0; e < 8; ++e) o[e] = (h16)s[e * 33];
        *(h16x8*)(WT + (size_t)(n0 + n) * K + k0 + 8 * c) = o; }
    asm volatile("s_waitcnt lgkmcnt(0)" ::: "memory");
}

__device__ __forceinline__ void rms_row_f16(const float* xr, const h16* addr, const float* g, h16* orow, int lane) {
    f32x4 v[4]; float ss = 0.f;
#pragma unroll
    for (int j = 0; j < 4; ++j) { v[j] = *(const f32x4*)(xr + 4 * lane + 256 * j);
        if (addr) { const h16x4 a = *(const h16x4*)(addr + 4 * lane + 256 * j); v[j][0] += (float)a[0]; v[j][1] += (float)a[1]; v[j][2] += (float)a[2]; v[j][3] += (float)a[3]; }
        ss += v[j][0] * v[j][0] + v[j][1] * v[j][1] + v[j][2] * v[j][2] + v[j][3] * v[j][3]; }
    const float rs = rsqrtf(wave_sum(ss) * (1.f / 1024.f) + 1e-6f);
#pragma unroll
    for (int j = 0; j < 4; ++j) { const f32x4 gg = *(const f32x4*)(g + 4 * lane + 256 * j); h16x4 o;
        o[0] = (h16)(v[j][0] * rs * gg[0]); o[1] = (h16)(v[j][1] * rs * gg[1]); o[2] = (h16)(v[j][2] * rs * gg[2]); o[3] = (h16)(v[j][3] * rs * gg[3]);
        *(h16x4*)(orow + 4 * lane + 256 * j) = o; }
}

__device__ __forceinline__ void phase0(const Params& p, LAS unsigned char* lds) {
    const int tid = threadIdx.x, lane = tid & 63, wave = tid >> 6;
    const int gw = blockIdx.x * 8 + wave, NGW = gridDim.x * 8;
    LAS float* scr = (LAS float*)(lds + wave * 8448);
    h16* W1T = (h16*)(p.ws + WS_W1T); h16* W2T = (h16*)(p.ws + WS_W2T); h16* W3T = (h16*)(p.ws + WS_W3T); h16* W4T = (h16*)(p.ws + WS_W4T);
    constexpr int I1 = 16 * 224, I2 = 32 * 32, I3 = 16 * 168, I4 = 24 * 32;
    for (int it = gw; it < I1 + I2 + I3 + I4; it += NGW) {
        int r = it;
        if (r < I1) { tr_item<1>(p.in[2], 1024, 7168, W1T, scr, r, 224, lane); continue; } r -= I1;
        if (r < I2) { tr_item<0>(p.in[8], 2048, 1024, W2T, scr, r, 32, lane); continue; } r -= I2;
        if (r < I3) { tr_item<2>(p.in[10], 1024, 5248, W3T, scr, r, 168, lane); continue; } r -= I3;
        tr_item<0>(p.in[22], 1536, 1024, W4T, scr, r, 32, lane);
    }
    h16* H0 = (h16*)p.out;
    for (int r = gw; r < NTOK; r += NGW) rms_row_f16(p.in[0] + (size_t)r * DM, nullptr, p.in[1], H0 + (size_t)r * DM, lane);
    const int gt = blockIdx.x * 512 + tid, NGT = gridDim.x * 512;
    h16* WSH = (h16*)(p.ws + WS_WSH);
    for (int i = gt; i < 8 * 128 * 128; i += NGT) WSH[i] = (h16)p.in[6][i];
    { float* STZ = (float*)(p.ws + WS_STATS); for (int i = gt; i < 2 * NTOK; i += NGT) STZ[i] = 0.f; }
    h16* CWT = (h16*)(p.ws + WS_CWT);
    const float* wf = p.in[21];
    for (int i = gt; i < 4 * 128 * 256; i += NGT) {
        const int k = i & 255, e = (i >> 8) & 127, g = i >> 15, d = k & 127; const bool sn = k >= 128;
        float s = 0.f;
        for (int dp = 0; dp < 128; ++dp) { const float fr = (float)((d * dp) & 127) * (1.f / 128.f);
            const float tw = sn ? __builtin_amdgcn_sinf(fr) : __builtin_amdgcn_cosf(fr);
            s += tw * wf[(g * 128 + dp) * 128 + e]; }
        CWT[i] = (h16)(s * 0.08838834764831845f);
    }
}

struct Epi1 {
    h16 *XC, *G, *U, *V; float* st;
    __device__ __forceinline__ void operator()(const f32x4 (&acc)[2][2][4][2], const pg8::Unit& u, int wr, int wc, int fr, int fq) const {
        const int T = u.pn; const int row0 = u.pm * 256 + wr * 64 + fr;
        if (T < 16) {
            const int ch = 64 * T + 16 * wc + 4 * fq;
#pragma unroll
            for (int ai = 0; ai < 2; ++ai)
#pragma unroll
                for (int m = 0; m < 4; ++m) { const size_t r = (size_t)(row0 + ai * 128 + m * 16);
                    const f32x4 xa = acc[ai][0][m][0], ba = acc[ai][0][m][1], ca = acc[ai][1][m][0], za = acc[ai][1][m][1];
                    h16x4 xc, gg;
#pragma unroll
                    for (int e = 0; e < 4; ++e) { xc[e] = (h16)(ca[e] * xa[e]); gg[e] = (h16)(ba[e] * silu_f(za[e])); }
                    *(h16x4*)(XC + r * 1024 + ch) = xc; *(h16x4*)(G + r * 1024 + ch) = gg; }
        } else if (T < 24) {
#pragma unroll
            for (int ai = 0; ai < 2; ++ai)
#pragma unroll
                for (int m = 0; m < 4; ++m) { const size_t r = (size_t)(row0 + ai * 128 + m * 16);
#pragma unroll
                    for (int n = 0; n < 2; ++n) { const int ch = 128 * (T - 16) + 32 * wc + 16 * n + 4 * fq;
                        const f32x4 ub = acc[ai][0][m][n], zb = acc[ai][1][m][n]; h16x4 o;
#pragma unroll
                        for (int e = 0; e < 4; ++e) o[e] = (h16)(ub[e] * silu_f(zb[e]));
                        *(h16x4*)(U + r * 1024 + ch) = o; } }
        } else {
#pragma unroll
            for (int ai = 0; ai < 2; ++ai)
#pragma unroll
                for (int m = 0; m < 4; ++m) { const size_t r = (size_t)(row0 + ai * 128 + m * 16); float s1 = 0.f, s2 = 0.f;
#pragma unroll
                    for (int bj = 0; bj < 2; ++bj)
#pragma unroll
                        for (int n = 0; n < 2; ++n) { const int ch = 256 * (T - 24) + 128 * bj + 32 * wc + 16 * n + 4 * fq;
                            const f32x4 v = acc[ai][bj][m][n]; h16x4 o;
#pragma unroll
                            for (int e = 0; e < 4; ++e) { o[e] = (h16)v[e]; const float f = (float)o[e]; s1 += f; s2 += f * f; }
                            *(h16x4*)(V + r * 1024 + ch) = o; }
                    s1 += __shfl_xor(s1, 16); s2 += __shfl_xor(s2, 16); s1 += __shfl_xor(s1, 32); s2 += __shfl_xor(s2, 32);
                    if (fq == 0) { atomicAdd(st + 2 * r, s1); atomicAdd(st + 2 * r + 1, s2); } }
        }
    }
};
struct Epi2 {
    h16* O1;
    __device__ __forceinline__ void operator()(const f32x4 (&acc)[2][2][4][2], const pg8::Unit& u, int wr, int wc, int fr, int fq) const {
        const int row0 = u.pm * 256 + wr * 64 + fr, col0 = u.pn * 256 + wc * 32 + 4 * fq;
#pragma unroll
        for (int ai = 0; ai < 2; ++ai)
#pragma unroll
            for (int m = 0; m < 4; ++m) { const size_t r = (size_t)(row0 + ai * 128 + m * 16);
#pragma unroll
                for (int bj = 0; bj < 2; ++bj)
#pragma unroll
                    for (int n = 0; n < 2; ++n) { const f32x4 v = acc[ai][bj][m][n]; h16x4 o;
#pragma unroll
                        for (int e = 0; e < 4; ++e) o[e] = (h16)v[e];
                        *(h16x4*)(O1 + r * 1024 + col0 + bj * 128 + n * 16) = o; } }
    }
};
struct Epi3 {
    h16 *PC, *ZCD, *FD;
    __device__ __forceinline__ void operator()(const f32x4 (&acc)[2][2][4][2], const pg8::Unit& u, int wr, int wc, int fr, int fq) const {
        const int row0 = u.pm * 256 + wr * 64 + fr, col0 = u.pn * 256 + wc * 32 + 4 * fq;
#pragma unroll
        for (int bj = 0; bj < 2; ++bj)
#pragma unroll
            for (int n = 0; n < 2; ++n) { const int c = col0 + bj * 128 + n * 16;
                h16* base; size_t ld;
                if (c < 3200) { base = PC + c; ld = 3200; }
                else if (c < 4224) { base = ZCD + (c - 3200); ld = 1536; }
                else if (c < 4736) { base = FD + (c - 4224); ld = 512; }
                else if (c < 5248) { base = ZCD + 1024 + (c - 4736); ld = 1536; }
                else continue;
#pragma unroll
                for (int ai = 0; ai < 2; ++ai)
#pragma unroll
                    for (int m = 0; m < 4; ++m) { const size_t r = (size_t)(row0 + ai * 128 + m * 16); const f32x4 v = acc[ai][bj][m][n]; h16x4 o;
#pragma unroll
                        for (int e = 0; e < 4; ++e) o[e] = (h16)v[e];
                        *(h16x4*)(base + r * ld) = o; } }
    }
};
struct Epi4 {
    h16* O2;
    __device__ __forceinline__ void operator()(const f32x4 (&acc)[2][2][4][2], const pg8::Unit& u, int wr, int wc, int fr, int fq) const {
        const int row0 = u.pm * 256 + wr * 64 + fr, col0 = u.pn * 256 + wc * 32 + 4 * fq;
#pragma unroll
        for (int ai = 0; ai < 2; ++ai)
#pragma unroll
            for (int m = 0; m < 4; ++m) { const size_t r = (size_t)(row0 + ai * 128 + m * 16);
#pragma unroll
                for (int bj = 0; bj < 2; ++bj)
#pragma unroll
                    for (int n = 0; n < 2; ++n) { const f32x4 v = acc[ai][bj][m][n]; h16x4 o;
#pragma unroll
                        for (int e = 0; e < 4; ++e) o[e] = (h16)v[e];
                        *(h16x4*)(O2 + r * 1024 + col0 + bj * 128 + n * 16) = o; } }
    }
};

__device__ __forceinline__ void phase_stats(const Params& p) {
    const int tid = threadIdx.x, lane = tid & 63, wave = tid >> 6;
    const int gw = blockIdx.x * 8 + wave, NGW = gridDim.x * 8;
    const h16* V = (const h16*)(p.ws + WS_V); float* ST = (float*)(p.ws + WS_STATS);
    for (int r = gw; r < NTOK; r += NGW) {
        const h16x8 a = *(const h16x8*)(V + (size_t)r * 1024 + 8 * lane), b = *(const h16x8*)(V + (size_t)r * 1024 + 512 + 8 * lane);
        float s = 0.f;
#pragma unroll
        for (int e = 0; e < 8; ++e) s += (float)a[e] + (float)b[e];
        const float mu = wave_sum(s) * (1.f / 1024.f); float q = 0.f;
#pragma unroll
        for (int e = 0; e < 8; ++e) { const float x = (float)a[e] - mu, y = (float)b[e] - mu; q += x * x + y * y; }
        const float rs = rsqrtf(wave_sum(q) * (1.f / 1024.f) + 1e-5f);
        if (lane == 0) { ST[2 * r] = mu; ST[2 * r + 1] = rs; }
    }
}

__device__ __forceinline__ void phase_mix0(const Params& p, LAS unsigned char* lds) {
    const int tid = threadIdx.x, lane = tid & 63, wave = tid >> 6;
    const h16* XC = (const h16*)(p.ws + WS_XC); const h16* G = (const h16*)(p.ws + WS_G); const h16* U = (const h16*)(p.ws + WS_U); const h16* V = (const h16*)(p.ws + WS_V);
    h16* YC = (h16*)(p.ws + WS_YCAT);
    const float* cw = p.in[3];
    const int gt = blockIdx.x * 512 + tid, NGT = gridDim.x * 512;
    for (int idx = gt; idx < NTOK * 128; idx += NGT) {
        const int t = idx >> 7, c8 = (idx & 127) * 8, tp = t & (SEQ - 1);
        const h16x8 zero = {0, 0, 0, 0, 0, 0, 0, 0};
        const h16x8 x0 = *(const h16x8*)(XC + (size_t)t * 1024 + c8);
        const h16x8 xm = tp > 0 ? *(const h16x8*)(XC + (size_t)(t - 1) * 1024 + c8) : zero;
        const h16x8 xp = tp < SEQ - 1 ? *(const h16x8*)(XC + (size_t)(t + 1) * 1024 + c8) : zero;
        const h16x8 gg = *(const h16x8*)(G + (size_t)t * 1024 + c8);
        h16x8 o;
#pragma unroll
        for (int e = 0; e < 8; ++e) { const float y = cw[c8 + e] * (float)xm[e] + cw[1024 + c8 + e] * (float)x0[e] + cw[2048 + c8 + e] * (float)xp[e]; o[e] = (h16)(y * (float)gg[e]); }
        *(h16x8*)(YC + (size_t)t * 2048 + c8) = o;
    }
    const float* ST = (const float*)(p.ws + WS_STATS); const h16* WSH = (const h16*)(p.ws + WS_WSH);
    const float* lng = p.in[4]; const float* lnb = p.in[5]; const float* bs = p.in[7];
    LAS h16* vnT = (LAS h16*)lds;
    for (int it = blockIdx.x; it < 1024; it += gridDim.x) {
        const int g = it & 7, bn = it >> 3, t0 = bn * 128;
        __syncthreads();
#pragma unroll
        for (int q = 0; q < 4; ++q) { const int pc = tid + 512 * q, j = pc >> 4, d8 = (pc & 15) * 8;
            const h16x8 v = *(const h16x8*)(V + (size_t)(t0 + j) * 1024 + g * 128 + d8);
            const float mu = ST[2 * (t0 + j)] * (1.f / 1024.f), rs = rsqrtf(fmaxf(ST[2 * (t0 + j) + 1] * (1.f / 1024.f) - mu * mu, 0.f) + 1e-5f);
#pragma unroll
            for (int e = 0; e < 8; ++e) vnT[(d8 + e) * 136 + j] = (h16)(((float)v[e] - mu) * rs * lng[g * 128 + d8 + e] + lnb[g * 128 + d8 + e]); }
        __syncthreads();
        const int itile = wave >> 1, dt0 = (wave & 1) * 2;
        f32x16 acc0, acc1;
#pragma unroll
        for (int e = 0; e < 16; ++e) { acc0[e] = 0.f; acc1[e] = 0.f; }
        const h16* Arow = WSH + ((size_t)g * 128 + itile * 32 + (lane & 31)) * 128 + 8 * (lane >> 5);
        const LAS h16* B0p = vnT + (dt0 * 32 + (lane & 31)) * 136 + 8 * (lane >> 5);
        const LAS h16* B1p = B0p + 32 * 136;
#pragma unroll
        for (int ks = 0; ks < 8; ++ks) {
            const h16x8 a = *(const h16x8*)(Arow + 16 * ks);
            const h16x8 b0 = *(const LAS h16x8*)(B0p + 16 * ks), b1 = *(const LAS h16x8*)(B1p + 16 * ks);
            acc0 = __builtin_amdgcn_mfma_f32_32x32x16_f16(a, b0, acc0, 0, 0, 0);
            acc1 = __builtin_amdgcn_mfma_f32_32x32x16_f16(a, b1, acc1, 0, 0, 0);
        }
#pragma unroll
        for (int r = 0; r < 16; ++r) { const int i = itile * 32 + (r & 3) + 8 * (r >> 2) + 4 * (lane >> 5); const size_t t = (size_t)(t0 + i);
            const float bias = bs[g * 128 + i];
            const int d0 = g * 128 + dt0 * 32 + (lane & 31);
            YC[t * 2048 + 1024 + d0] = (h16)((acc0[r] + bias) * (float)U[t * 1024 + d0]);
            YC[t * 2048 + 1024 + d0 + 32] = (h16)((acc1[r] + bias) * (float)U[t * 1024 + d0 + 32]); }
    }
}

__device__ __forceinline__ void phase_norm1(const Params& p) {
    const int tid = threadIdx.x, lane = tid & 63, wave = tid >> 6;
    const int gw = blockIdx.x * 8 + wave, NGW = gridDim.x * 8;
    const h16* O1 = (const h16*)(p.ws + WS_O1); h16* H1 = (h16*)p.out;
    for (int r = gw; r < NTOK; r += NGW) rms_row_f16(p.in[0] + (size_t)r * DM, O1 + (size_t)r * DM, p.in[9], H1 + (size_t)r * DM, lane);
}

__device__ __forceinline__ void phase_fft(const Params& p, LAS unsigned char* lds) {
    const int tid = threadIdx.x;
    const h16* FD = (const h16*)(p.ws + WS_FD);
    h16* SPr = (h16*)(p.ws + WS_SPR); h16* SPi = (h16*)(p.ws + WS_SPI);
    LAS f32x2* X0 = (LAS f32x2*)lds; LAS f32x2* X1 = X0 + 8192;
    for (int it = blockIdx.x; it < 256; it += gridDim.x) {
        const int b = it >> 7, c0 = 4 * (it & 127);
        __syncthreads();
        for (int t = tid; t < SEQ; t += 512) { const h16x4 v = *(const h16x4*)(FD + (size_t)(b * SEQ + t) * 512 + c0);
            X0[t] = (f32x2){(float)v[0], (float)v[1]}; X1[t] = (f32x2){(float)v[2], (float)v[3]}; }
        __syncthreads();
        for (int s = 0; s < 13; ++s) {
            const int half = 4096 >> s;
#pragma unroll 2
            for (int j = tid; j < 4096; j += 512) {
                const int pos = j & (half - 1), grp = j >> (12 - s), i0 = (grp << (13 - s)) + pos, i1 = i0 + half;
                const float fr = (float)(pos << s) * (1.f / 8192.f);
                const float c = __builtin_amdgcn_cosf(fr), sn = __builtin_amdgcn_sinf(fr);
                { const f32x2 a = X0[i0], bb = X0[i1]; const f32x2 d = a - bb; X0[i0] = a + bb; X0[i1] = (f32x2){d[0] * c + d[1] * sn, d[1] * c - d[0] * sn}; }
                { const f32x2 a = X1[i0], bb = X1[i1]; const f32x2 d = a - bb; X1[i0] = a + bb; X1[i1] = (f32x2){d[0] * c + d[1] * sn, d[1] * c - d[0] * sn}; }
            }
            __syncthreads();
        }
        const float sc = 0.5f * 0.011048543456039806f;
        for (int k = tid; k < SEQ; k += 512) {
            const int ra = __brev((unsigned)k) >> 19, rb = __brev((unsigned)((SEQ - k) & (SEQ - 1))) >> 19;
            const f32x2 za = X0[ra], zb = X0[rb], ya = X1[ra], yb = X1[rb];
            h16x4 orr, oi;
            orr[0] = (h16)((za[0] + zb[0]) * sc); oi[0] = (h16)((za[1] - zb[1]) * sc);
            orr[1] = (h16)((za[1] + zb[1]) * sc); oi[1] = (h16)((zb[0] - za[0]) * sc);
            orr[2] = (h16)((ya[0] + yb[0]) * sc); oi[2] = (h16)((ya[1] - yb[1]) * sc);
            orr[3] = (h16)((ya[1] + yb[1]) * sc); oi[3] = (h16)((yb[0] - ya[0]) * sc);
            *(h16x4*)(SPr + (size_t)(b * SEQ + k) * 512 + c0) = orr; *(h16x4*)(SPi + (size_t)(b * SEQ + k) * 512 + c0) = oi;
        }
    }
}

__device__ __forceinline__ void phase_fnet_out(const Params& p) {
    const int tid = threadIdx.x, lane = tid & 63, wave = tid >> 6;
    const int gw = blockIdx.x * 8 + wave, NGW = gridDim.x * 8;
    const h16* SPr = (const h16*)(p.ws + WS_SPR); const h16* SPi = (const h16*)(p.ws + WS_SPI);
    const h16* CWT = (const h16*)(p.ws + WS_CWT); h16* ZCD = (h16*)(p.ws + WS_ZCD);
    for (int w = gw; w < 8192; w += NGW) {
        const int et = w & 3, g = (w >> 2) & 3, tt = w >> 4;
        const size_t trow = (size_t)(tt * 32 + (lane & 31));
        const h16* Ar = SPr + trow * 512 + g * 128 + 8 * (lane >> 5); const h16* Ai = SPi + trow * 512 + g * 128 + 8 * (lane >> 5);
        const h16* Bp = CWT + ((size_t)(g * 128 + et * 32 + (lane & 31))) * 256 + 8 * (lane >> 5);
        f32x16 acc;
#pragma unroll
        for (int e = 0; e < 16; ++e) acc[e] = 0.f;
#pragma unroll
        for (int ks = 0; ks < 8; ++ks) acc = __builtin_amdgcn_mfma_f32_32x32x16_f16(*(const h16x8*)(Ar + 16 * ks), *(const h16x8*)(Bp + 16 * ks), acc, 0, 0, 0);
#pragma unroll
        for (int ks = 0; ks < 8; ++ks) acc = __builtin_amdgcn_mfma_f32_32x32x16_f16(*(const h16x8*)(Ai + 16 * ks), *(const h16x8*)(Bp + 128 + 16 * ks), acc, 0, 0, 0);
#pragma unroll
        for (int r = 0; r < 16; ++r) { const size_t t = (size_t)(tt * 32 + (r & 3) + 8 * (r >> 2) + 4 * (lane >> 5));
            h16* zp = ZCD + t * 1536 + 1024 + g * 128 + et * 32 + (lane & 31);
            *zp = (h16)(acc[r] * silu_f((float)*zp)); }
    }
}

#define LDS_BAR() do { asm volatile("s_waitcnt lgkmcnt(0)" ::: "memory"); __builtin_amdgcn_s_barrier(); asm volatile("" ::: "memory"); } while (0)
#define LDS_WAIT() asm volatile("s_waitcnt lgkmcnt(0)" ::: "memory")
__device__ __forceinline__ void phase_scan(const Params& p, LAS unsigned char* lds) {
    const int tid = threadIdx.x, lane = tid & 63, wave = tid >> 6;
    const h16* PC = (const h16*)(p.ws + WS_PC);
    LAS h16* w2T = (LAS h16*)lds;
    LAS h16* a2T = w2T + 64 * 72;
    LAS unsigned char* priv = lds + 18432 + (wave & 3) * 4096;
    constexpr int SET_F = 5 * 2048 + 512;
    LAS float* OPS = (LAS float*)(lds + 18432 + 16384);
    LAS float* sYb = OPS + 2 * SET_F;
    for (int item = blockIdx.x; item < 256; item += gridDim.x) {
        const int xcd = item & 7, slot = item >> 3, gidx = xcd * 8 + (slot >> 2), q = slot & 3;
        const int dir = gidx >> 5, b = (gidx >> 4) & 1, h = gidx & 15;
        h16* Yd = (h16*)((unsigned char*)p.out + (size_t)dir * 32 * MiB);
        float* SB = (float*)(p.ws + WS_SBON) + (size_t)dir * NTOK * 16;
        const float* mu = p.in[11] + dir * 3200; const float* w0 = p.in[12] + dir * 1024 + 64 * h; const float* w2 = p.in[13] + (size_t)dir * 65536 + 64 * h;
        const float* a0 = p.in[14] + dir * 1024 + 64 * h; const float* a2 = p.in[15] + (size_t)dir * 65536 + 64 * h;
        const float* kkw = p.in[16] + 64 * h; const float* kaw = p.in[17] + 64 * h; const float* rkw = p.in[18] + 64 * h;
        __syncthreads();
        for (int i = tid; i < 4096; i += 512) { const int l = i >> 6, c = i & 63; w2T[c * 72 + l] = (h16)w2[l * 1024 + c]; a2T[c * 72 + l] = (h16)a2[l * 1024 + c]; }
        const int pw_ = wave & 3, s_sub = lane >> 3, c8 = (lane & 7) * 8, s_l = 8 * pw_ + s_sub;
        h16x8 mu_r8, mu_k8, mu_v8, mu_w8, mu_a8; f32x2 w0r[4], a0r[4], kkr[4], kar[4], omk[4], rkr[4];
#pragma unroll
        for (int e = 0; e < 8; ++e) { mu_r8[e] = (h16)mu[64 * h + c8 + e]; mu_k8[e] = (h16)mu[1024 + 64 * h + c8 + e]; mu_v8[e] = (h16)mu[2048 + 64 * h + c8 + e]; mu_w8[e] = (h16)mu[3072 + c8 + e]; mu_a8[e] = (h16)mu[3136 + c8 + e];
            w0r[e >> 1][e & 1] = w0[c8 + e]; a0r[e >> 1][e & 1] = a0[c8 + e]; kkr[e >> 1][e & 1] = kkw[c8 + e]; kar[e >> 1][e & 1] = kaw[c8 + e]; omk[e >> 1][e & 1] = 1.f - kaw[c8 + e]; rkr[e >> 1][e & 1] = rkw[c8 + e]; }
        f32x2 S01 = {0.f, 0.f}, S23 = {0.f, 0.f};
        const int srow = 4 * (wave & 3) + (lane >> 4), j0 = 4 * (lane & 15);
        const h16x8 z8 = {0, 0, 0, 0, 0, 0, 0, 0};
        h16x8 pr, pk, pv, pw, pa, qr_, qk_, qv_, qw_, qa_;
#define SCAN_LOAD(chn) do { const int sg_ = (chn) * 32 + s_l; const int t_ = dir ? (SEQ - 1 - sg_) : sg_; \
            const size_t rowc_ = (size_t)(b * SEQ + t_) * 3200; const size_t rowp_ = (size_t)(b * SEQ + (dir ? t_ + 1 : t_ - 1)) * 3200; const bool hp_ = sg_ > 0; \
            pr = *(const h16x8*)(PC + rowc_ + 64 * h + c8); pk = *(const h16x8*)(PC + rowc_ + 1024 + 64 * h + c8); pv = *(const h16x8*)(PC + rowc_ + 2048 + 64 * h + c8); \
            pw = *(const h16x8*)(PC + rowc_ + 3072 + c8); pa = *(const h16x8*)(PC + rowc_ + 3136 + c8); \
            qr_ = hp_ ? *(const h16x8*)(PC + rowp_ + 64 * h + c8) : z8; qk_ = hp_ ? *(const h16x8*)(PC + rowp_ + 1024 + 64 * h + c8) : z8; qv_ = hp_ ? *(const h16x8*)(PC + rowp_ + 2048 + 64 * h + c8) : z8; \
            qw_ = hp_ ? *(const h16x8*)(PC + rowp_ + 3072 + c8) : z8; qa_ = hp_ ? *(const h16x8*)(PC + rowp_ + 3136 + c8) : z8; } while (0)
#define SCAN_YSTORE(chn) do { const int sg_ = (chn) * 32 + s_l; const int t_ = dir ? (SEQ - 1 - sg_) : sg_; \
            const f32x2 y2_ = *(const LAS f32x2*)(sYb + ((chn) & 1) * 512 + s_l * 16 + 2 * (lane & 7)); \
            typedef _Float16 h16x2_ __attribute__((ext_vector_type(2))); h16x2_ o_; o_[0] = (h16)y2_[0]; o_[1] = (h16)y2_[1]; \
            *(h16x2_*)(Yd + (size_t)(b * SEQ + t_) * 1024 + 64 * h + 16 * q + 2 * (lane & 7)) = o_; } while (0)
        if (wave >= 4) SCAN_LOAD(0);
        __syncthreads();
        for (int n = -1; n < SEQ / 32; ++n) {
            if (wave < 4) {
                if (n >= 0) {
                    __builtin_amdgcn_s_setprio(3);
                    const LAS float* sR = OPS + (n & 1) * SET_F + j0; const LAS float* sW = sR + 2048; const LAS float* sK = sW + 2048; const LAS float* sA = sK + 2048; const LAS float* sB = sA + 2048; const LAS float* sV = OPS + (n & 1) * SET_F + 10240;
                    LAS float* sY = sYb + (n & 1) * 512;
                    f32x4 a_ = *(const LAS f32x4*)(sA), w_ = *(const LAS f32x4*)(sW), b_ = *(const LAS f32x4*)(sB);
                    f32x4 k_ = *(const LAS f32x4*)(sK), r_ = *(const LAS f32x4*)(sR);
                    f32x4 vq[4];
#pragma unroll
                    for (int u = 0; u < 4; ++u) vq[u] = *(const LAS f32x4*)(sV + srow * 32 + 4 * u);
                    f32x4 rp = r_;
#pragma unroll
                    for (int hb = 0; hb < 2; ++hb) {
                        f32x4 vn[4];
#pragma unroll
                        for (int u = 0; u < 4; ++u) vn[u] = *(const LAS f32x4*)(sV + srow * 32 + ((16 * (hb + 1)) & 31) + 4 * u);
#pragma unroll
                        for (int u16 = 0; u16 < 16; ++u16) {
                            const int s = 16 * hb + u16;
                            const int sn = (s + 1) & 31;
                            const f32x4 a_n = *(const LAS f32x4*)(sA + sn * 64), w_n = *(const LAS f32x4*)(sW + sn * 64), b_n = *(const LAS f32x4*)(sB + sn * 64);
                            const f32x4 k_n = *(const LAS f32x4*)(sK + sn * 64), r_n = *(const LAS f32x4*)(sR + sn * 64);
                            const float v = vq[u16 >> 2][u16 & 3];
                            const f32x2 vv = {v, v};
                            f32x2 pp = S01 * (f32x2){a_[0], a_[1]}; pp = S23 * (f32x2){a_[2], a_[3]} + pp;
                            f32x2 yy = S01 * (f32x2){rp[0], rp[1]}; yy = S23 * (f32x2){rp[2], rp[3]} + yy;
                            float sa = pp[0] + pp[1], y = yy[0] + yy[1];
                            sa += dpp_f<0xB1>(sa); y += dpp_f<0xB1>(y);
                            sa += dpp_f<0x4E>(sa); y += dpp_f<0x4E>(y);
                            sa += dpp_f<0x141>(sa); y += dpp_f<0x141>(y);
                            sa += dpp_f<0x140>(sa); y += dpp_f<0x140>(y);
                            sY[((s - 1) & 31) * 16 + srow] = y;
                            const f32x2 sv = {sa, sa};
                            S01 = S01 * (f32x2){w_[0], w_[1]} + vv * (f32x2){k_[0], k_[1]};
                            S23 = S23 * (f32x2){w_[2], w_[3]} + vv * (f32x2){k_[2], k_[3]};
                            S01 = sv * (f32x2){b_[0], b_[1]} + S01;
                            S23 = sv * (f32x2){b_[2], b_[3]} + S23;
                            rp = r_;
                            a_ = a_n; w_ = w_n; b_ = b_n; k_ = k_n; r_ = r_n;
                        }
#pragma unroll
                        for (int u = 0; u < 4; ++u) vq[u] = vn[u];
                    }
                    { f32x2 yy = S01 * (f32x2){rp[0], rp[1]}; yy = S23 * (f32x2){rp[2], rp[3]} + yy; sY[31 * 16 + srow] = red16(yy[0] + yy[1]); }
                    __builtin_amdgcn_s_setprio(0);
                }
            } else {
                if (n + 1 < SEQ / 32) {
                    const int cn = n + 1;
                    const int sg = cn * 32 + s_l; const int t = dir ? (SEQ - 1 - sg) : sg;
                    f32x2 qr[4], qk[4]; float qv[8];
                    LAS h16* TWp = (LAS h16*)priv; LAS h16* QAp = TWp + 8 * 72;
                    { const h16x8 r8 = pr + mu_r8 * (qr_ - pr), k8 = pk + mu_k8 * (qk_ - pk), v8 = pv + mu_v8 * (qv_ - pv);
                      const h16x8 w8 = pw + mu_w8 * (qw_ - pw), a8 = pa + mu_a8 * (qa_ - pa);
                      h16x8 tw8;
#pragma unroll
                      for (int pi = 0; pi < 4; ++pi) { qr[pi] = (f32x2){(float)r8[2 * pi], (float)r8[2 * pi + 1]}; qk[pi] = (f32x2){(float)k8[2 * pi], (float)k8[2 * pi + 1]};
                          qv[2 * pi] = (float)v8[2 * pi]; qv[2 * pi + 1] = (float)v8[2 * pi + 1];
                          const f32x2 tx = (f32x2){(float)w8[2 * pi], (float)w8[2 * pi + 1]} * 2.8853900817779268f;
                          const f32x2 dn = (f32x2){__builtin_amdgcn_exp2f(tx[0]), __builtin_amdgcn_exp2f(tx[1])} + 1.f;
                          const f32x2 th = (f32x2){__builtin_amdgcn_rcpf(dn[0]), __builtin_amdgcn_rcpf(dn[1])} * -2.f + 1.f;
                          tw8[2 * pi] = (h16)th[0]; tw8[2 * pi + 1] = (h16)th[1]; }
                      *(LAS h16x8*)(TWp + s_sub * 72 + c8) = tw8; *(LAS h16x8*)(QAp + s_sub * 72 + c8) = a8; }
                    if (cn + 1 < SEQ / 32) SCAN_LOAD(cn + 1);
                    LDS_WAIT();
                    f32x4 accw[4], acca[4];
#pragma unroll
                    for (int ct = 0; ct < 4; ++ct) { accw[ct] = (f32x4){0.f, 0.f, 0.f, 0.f}; acca[ct] = (f32x4){0.f, 0.f, 0.f, 0.f}; }
#pragma unroll
                    for (int ks = 0; ks < 2; ++ks) {
                        const h16x8 atw = *(const LAS h16x8*)(TWp + (lane & 7) * 72 + 32 * ks + 8 * (lane >> 4));
                        const h16x8 aqa = *(const LAS h16x8*)(QAp + (lane & 7) * 72 + 32 * ks + 8 * (lane >> 4));
#pragma unroll
                        for (int ct = 0; ct < 4; ++ct) {
                            const h16x8 bw = *(const LAS h16x8*)(w2T + (16 * ct + (lane & 15)) * 72 + 32 * ks + 8 * (lane >> 4));
                            const h16x8 ba = *(const LAS h16x8*)(a2T + (16 * ct + (lane & 15)) * 72 + 32 * ks + 8 * (lane >> 4));
                            accw[ct] = __builtin_amdgcn_mfma_f32_16x16x32_f16(atw, bw, accw[ct], 0, 0, 0);
                            acca[ct] = __builtin_amdgcn_mfma_f32_16x16x32_f16(aqa, ba, acca[ct], 0, 0, 0);
                        }
                    }
                    LDS_WAIT();
                    { LAS float* Zd = (LAS float*)priv + (lane >> 5) * 512 + (4 * ((lane >> 4) & 1)) * 64 + (lane & 15);
#pragma unroll
                      for (int ct = 0; ct < 4; ++ct)
#pragma unroll
                          for (int r = 0; r < 4; ++r) Zd[r * 64 + 16 * ct] = (lane < 32) ? accw[ct][r] : acca[ct][r]; }
                    LDS_WAIT();
                    const LAS float* Zw = (const LAS float*)priv + s_sub * 64 + c8; const LAS float* Za = Zw + 512;
                    const f32x4 zw0 = *(const LAS f32x4*)Zw, zw1 = *(const LAS f32x4*)(Zw + 4), za0 = *(const LAS f32x4*)Za, za1 = *(const LAS f32x4*)(Za + 4);
                    LDS_WAIT();
                    f32x2 kk[4], av_[4], kp[4], dec[4], kn2 = {0.f, 0.f}, sb2 = {0.f, 0.f};
#pragma unroll
                    for (int pi = 0; pi < 4; ++pi) {
                        const f32x2 zw = (pi < 2 ? (f32x2){zw0[2 * pi], zw0[2 * pi + 1]} : (f32x2){zw1[2 * pi - 4], zw1[2 * pi - 3]}) + w0r[pi];
                        const f32x2 za = (pi < 2 ? (f32x2){za0[2 * pi], za0[2 * pi + 1]} : (f32x2){za1[2 * pi - 4], za1[2 * pi - 3]}) + a0r[pi];
                        const f32x2 tw_ = zw * -1.4426950408889634f, ta_ = za * -1.4426950408889634f;
                        const f32x2 dw = (f32x2){__builtin_amdgcn_exp2f(tw_[0]), __builtin_amdgcn_exp2f(tw_[1])} + 1.f, da = (f32x2){__builtin_amdgcn_exp2f(ta_[0]), __builtin_amdgcn_exp2f(ta_[1])} + 1.f;
                        const f32x2 sw = (f32x2){__builtin_amdgcn_rcpf(dw[0]), __builtin_amdgcn_rcpf(dw[1])} * -0.8750387749225136f;
                        dec[pi] = (f32x2){__builtin_amdgcn_exp2f(sw[0]), __builtin_amdgcn_exp2f(sw[1])};
                        av_[pi] = (f32x2){__builtin_amdgcn_rcpf(da[0]), __builtin_amdgcn_rcpf(da[1])};
                        kk[pi] = qk[pi] * kkr[pi]; kn2 = kk[pi] * kk[pi] + kn2;
                        kp[pi] = qk[pi] * (av_[pi] * kar[pi] + omk[pi]);
                        sb2 = (qr[pi] * kp[pi]) * rkr[pi] + sb2; }
                    const float kn = red8(kn2[0] + kn2[1]), sbn = red8(sb2[0] + sb2[1]);
                    const float ninv = -rsqrtf(fmaxf(kn, 1e-12f));
                    LAS float* dR = OPS + (cn & 1) * SET_F + s_l * 64 + c8;
#pragma unroll
                    for (int hf = 0; hf < 2; ++hf) {
                        const f32x2 na0 = kk[2 * hf] * ninv, na1 = kk[2 * hf + 1] * ninv;
                        const f32x2 nb0 = na0 * av_[2 * hf], nb1 = na1 * av_[2 * hf + 1];
                        *(LAS f32x4*)(dR + 4 * hf) = (f32x4){qr[2 * hf][0], qr[2 * hf][1], qr[2 * hf + 1][0], qr[2 * hf + 1][1]};
                        *(LAS f32x4*)(dR + 2048 + 4 * hf) = (f32x4){dec[2 * hf][0], dec[2 * hf][1], dec[2 * hf + 1][0], dec[2 * hf + 1][1]};
                        *(LAS f32x4*)(dR + 4096 + 4 * hf) = (f32x4){kp[2 * hf][0], kp[2 * hf][1], kp[2 * hf + 1][0], kp[2 * hf + 1][1]};
                        *(LAS f32x4*)(dR + 6144 + 4 * hf) = (f32x4){na0[0], na0[1], na1[0], na1[1]};
                        *(LAS f32x4*)(dR + 8192 + 4 * hf) = (f32x4){-nb0[0], -nb0[1], -nb1[0], -nb1[1]}; }
                    if ((c8 >> 4) == q) { LAS float* dV = OPS + (cn & 1) * SET_F + 10240 + (c8 & 15) * 32 + s_l;
#pragma unroll
                        for (int e = 0; e < 8; ++e) dV[e * 32] = qv[e]; }
                    if (q == 0 && (lane & 7) == 0) SB[(size_t)(b * SEQ + t) * 16 + h] = sbn;
                }
                if (n >= 1) SCAN_YSTORE(n - 1);
            }
            LDS_BAR();
        }
        if (wave >= 4) SCAN_YSTORE(SEQ / 32 - 1);
#undef SCAN_LOAD
#undef SCAN_YSTORE
    }
}

__device__ __forceinline__ void phase_post(const Params& p) {
    const int tid = threadIdx.x;
    const h16* Y0 = (const h16*)p.out; const h16* Y1 = (const h16*)((const unsigned char*)p.out + 32 * MiB);
    const h16* PC = (const h16*)(p.ws + WS_PC); h16* ZCD = (h16*)(p.ws + WS_ZCD);
    const float* SB0 = (const float*)(p.ws + WS_SBON); const float* SB1 = SB0 + (size_t)NTOK * 16;
    const float* mu0 = p.in[11] + 2048; const float* mu1 = p.in[11] + 3200 + 2048;
    const float* lg = p.in[19]; const float* lb = p.in[20];
    const int gt = blockIdx.x * 512 + tid, NGT = gridDim.x * 512;
    for (int idx = gt; idx < NTOK * 256; idx += NGT) {
        const int t = idx >> 8, c = (idx & 255) * 4, hh = c >> 6, tp = t & (SEQ - 1);
        const h16x4 y0 = *(const h16x4*)(Y0 + (size_t)t * 1024 + c), y1 = *(const h16x4*)(Y1 + (size_t)t * 1024 + c);
        float y[4], s = 0.f;
#pragma unroll
        for (int e = 0; e < 4; ++e) { y[e] = (float)y0[e] + (float)y1[e]; s += y[e]; }
        const float mean = red16(s) * (1.f / 64.f); float q = 0.f;
#pragma unroll
        for (int e = 0; e < 4; ++e) { y[e] -= mean; q += y[e] * y[e]; }
        const float rs = rsqrtf(red16(q) * (1.f / 64.f) + 64e-5f);
        const h16x4 z4 = {0, 0, 0, 0};
        const h16x4 v0 = *(const h16x4*)(PC + (size_t)t * 3200 + 2048 + c);
        const h16x4 vm = tp > 0 ? *(const h16x4*)(PC + (size_t)(t - 1) * 3200 + 2048 + c) : z4;
        const h16x4 vp = tp < SEQ - 1 ? *(const h16x4*)(PC + (size_t)(t + 1) * 3200 + 2048 + c) : z4;
        const float s0 = SB0[(size_t)t * 16 + hh], s1 = SB1[(size_t)t * 16 + hh];
        const h16x4 zc = *(const h16x4*)(ZCD + (size_t)t * 1536 + c);
        h16x4 o;
#pragma unroll
        for (int e = 0; e < 4; ++e) { const float vv = (float)v0[e];
            const float vd0 = vv + mu0[c + e] * ((float)vm[e] - vv), vd1 = vv + mu1[c + e] * ((float)vp[e] - vv);
            const float val = y[e] * rs * lg[c + e] + lb[c + e] + s0 * vd0 + s1 * vd1;
            o[e] = (h16)(val * silu_f((float)zc[e])); }
        *(h16x4*)(ZCD + (size_t)t * 1536 + c) = o;
    }
}

__device__ __forceinline__ void phase_final(const Params& p) {
    const int tid = threadIdx.x, lane = tid & 63, wave = tid >> 6;
    const int gw = blockIdx.x * 8 + wave, NGW = gridDim.x * 8;
    const float* g = p.in[23]; const h16* O1 = (const h16*)(p.ws + WS_O1); const h16* O2 = (const h16*)(p.ws + WS_O2);
    for (int r = gw; r < NTOK; r += NGW) {
        const float* xr = p.in[0] + (size_t)r * DM; float* orow = p.out + (size_t)r * DM; f32x4 v[4]; float ss = 0.f;
#pragma unroll
        for (int j = 0; j < 4; ++j) { v[j] = *(const f32x4*)(xr + 4 * lane + 256 * j);
            const h16x4 a = *(const h16x4*)(O1 + (size_t)r * DM + 4 * lane + 256 * j), b = *(const h16x4*)(O2 + (size_t)r * DM + 4 * lane + 256 * j);
#pragma unroll
            for (int e = 0; e < 4; ++e) v[j][e] += (float)a[e] + (float)b[e];
            ss += v[j][0] * v[j][0] + v[j][1] * v[j][1] + v[j][2] * v[j][2] + v[j][3] * v[j][3]; }
        const float rs = rsqrtf(wave_sum(ss) * (1.f / 1024.f) + 1e-6f);
#pragma unroll
        for (int j = 0; j < 4; ++j) { const f32x4 gg = *(const f32x4*)(g + 4 * lane + 256 * j); f32x4 o = v[j] * rs; o = o * gg; *(f32x4*)(orow + 4 * lane + 256 * j) = o; }
    }
}

__global__ void __launch_bounds__(512, 2) mega(Params p) {
    extern __shared__ __attribute__((aligned(16))) unsigned char smem[];
    LAS unsigned char* lds = (LAS unsigned char*)smem;
    cg::grid_group grid = cg::this_grid();
    unsigned char* ws = p.ws;
    const int lo = p.ph_lo, hi = p.ph_hi;
#define IN(k) (lo <= (k) && (k) < hi)
    volatile LAS unsigned* bst = (volatile LAS unsigned*)(lds + LDS_MAIN);
    if (threadIdx.x < 4) bst[threadIdx.x] = 0u;
    __syncthreads();
    const XcdBarrier bar = xcd_barrier_post((unsigned*)(ws + WS_BAR), bst);
    if (hi > 1000) grid.sync();
#define SEAM(k) do { if (IN(k) && IN((k) + 1)) { xcd_barrier(bar); if ((REPMASK >> 13) & 1) xcd_barrier(bar); } } while (0)
    if (IN(0)) for (int rep_ = 0; rep_ <= ((REPMASK >> 0) & 1); ++rep_) { phase0(p, lds); } SEAM(0);
    if (IN(1)) for (int rep_ = 0; rep_ <= ((REPMASK >> 1) & 1); ++rep_) { pg8::Gemm g{(const h16*)p.out, (const h16*)(ws + WS_W1T), NTOK, 7168, 1024}; pg8::StaticOrder S; S.init(NTOK, 7168, gridDim.x, blockIdx.x);
                 Epi1 E{(h16*)(ws + WS_XC), (h16*)(ws + WS_G), (h16*)(ws + WS_U), (h16*)(ws + WS_V), (float*)(ws + WS_STATS)}; pg8::gemm_phase<Epi1>(lds, g, S, E); } SEAM(1);
    if (IN(3)) for (int rep_ = 0; rep_ <= ((REPMASK >> 3) & 1); ++rep_) { phase_mix0(p, lds); } SEAM(3);
    if (IN(4)) for (int rep_ = 0; rep_ <= ((REPMASK >> 4) & 1); ++rep_) { pg8::Gemm g{(const h16*)(ws + WS_YCAT), (const h16*)(ws + WS_W2T), NTOK, 1024, 2048}; pg8::StaticOrder S; S.init(NTOK, 1024, gridDim.x, blockIdx.x);
                 Epi2 E{(h16*)(ws + WS_O1)}; pg8::gemm_phase<Epi2>(lds, g, S, E); } SEAM(4);
    if (IN(5)) for (int rep_ = 0; rep_ <= ((REPMASK >> 5) & 1); ++rep_) { phase_norm1(p); } SEAM(5);
    if (IN(6)) for (int rep_ = 0; rep_ <= ((REPMASK >> 6) & 1); ++rep_) { pg8::Gemm g{(const h16*)p.out, (const h16*)(ws + WS_W3T), NTOK, 5376, 1024}; pg8::StaticOrder S; S.init(NTOK, 5376, gridDim.x, blockIdx.x);
                 Epi3 E{(h16*)(ws + WS_PC), (h16*)(ws + WS_ZCD), (h16*)(ws + WS_FD)}; pg8::gemm_phase<Epi3>(lds, g, S, E); } SEAM(6);
    if (IN(7)) for (int rep_ = 0; rep_ <= ((REPMASK >> 7) & 1); ++rep_) { phase_fft(p, lds); }
    if (IN(8)) for (int rep_ = 0; rep_ <= ((REPMASK >> 8) & 1); ++rep_) { phase_scan(p, lds); } SEAM(8);
    if (IN(9)) for (int rep_ = 0; rep_ <= ((REPMASK >> 9) & 1); ++rep_) { phase_fnet_out(p); }
    if (IN(10)) for (int rep_ = 0; rep_ <= ((REPMASK >> 10) & 1); ++rep_) { phase_post(p); } SEAM(10);
    if (IN(11)) for (int rep_ = 0; rep_ <= ((REPMASK >> 11) & 1); ++rep_) { pg8::Gemm g{(const h16*)(ws + WS_ZCD), (const h16*)(ws + WS_W4T), NTOK, 1024, 1536}; pg8::StaticOrder S; S.init(NTOK, 1024, gridDim.x, blockIdx.x);
                  Epi4 E{(h16*)(ws + WS_O2)}; pg8::gemm_phase<Epi4>(lds, g, S, E); } SEAM(11);
    if (IN(12)) for (int rep_ = 0; rep_ <= ((REPMASK >> 12) & 1); ++rep_) { phase_final(p); }
}

extern "C" void kernel_launch(void* const* d_in, const int* in_sizes, int n_in, void* d_out, int out_size, void* d_ws, size_t ws_size, hipStream_t stream) {
    static int grid = 0;
    if (grid == 0) {
        int dev = 0, cus = 0, per_cu = 0;
        hipGetDevice(&dev);
        hipDeviceGetAttribute(&cus, hipDeviceAttributeMultiprocessorCount, dev);
        if (hipFuncSetAttribute((const void*)mega, hipFuncAttributeMaxDynamicSharedMemorySize, LDS_BYTES) != hipSuccess) fprintf(stderr, "kernel_launch: hipFuncSetAttribute failed\n");
        hipOccupancyMaxActiveBlocksPerMultiprocessor(&per_cu, (const void*)mega, 512, LDS_BYTES);
        if (per_cu < 1) { fprintf(stderr, "kernel_launch: occupancy query says %d blocks per CU\n", per_cu); per_cu = 1; }
        (void)hipGetLastError();
        grid = cus;
        if (grid < 64) grid = 64;
    }
    if (hipMemsetAsync((unsigned char*)d_ws + WS_BAR, 0, XCD_BAR_WORDS * 4, stream) != hipSuccess) fprintf(stderr, "kernel_launch: memset of the barrier words failed\n");
    Params p{};
    for (int i = 0; i < 24; ++i) p.in[i] = (const float*)d_in[i];
    p.out = (float*)d_out; p.ws = (unsigned char*)d_ws;
#if N_LAUNCH_MODE == 1
    p.ph_lo = 0; p.ph_hi = NPHASE;
    void* args[] = {&p};
    hipError_t e = hipLaunchCooperativeKernel((const void*)mega, dim3(grid), dim3(512), args, LDS_BYTES, stream);
    if (e != hipSuccess) fprintf(stderr, "kernel_launch: cooperative launch failed: %s (grid %d)\n", hipGetErrorString(e), grid);
#else
    for (int ph = 0; ph < NPHASE; ++ph) { p.ph_lo = ph; p.ph_hi = ph + 1; hipLaunchKernelGGL(mega, dim3(grid), dim3(512), LDS_BYTES, stream, p); }
#endif
}
```

```cpp
#include <hip/hip_runtime.h>
#include <hip/hip_cooperative_groups.h>
#include <cstdio>
#include <cstdint>
namespace cg = cooperative_groups;

#ifndef N_LAUNCH_MODE
#define N_LAUNCH_MODE 1
#endif

#ifndef REPMASK
#define REPMASK 0
#endif
#define LAS __attribute__((address_space(3)))
typedef _Float16 h16;
typedef _Float16 h16x8 __attribute__((ext_vector_type(8)));
typedef _Float16 h16x4 __attribute__((ext_vector_type(4)));
typedef float f32x2 __attribute__((ext_vector_type(2)));
typedef float f32x4 __attribute__((ext_vector_type(4)));
typedef float f32x16 __attribute__((ext_vector_type(16)));

constexpr int NTOK = 16384, DM = 1024, SEQ = 8192;
constexpr int LDS_MAIN = 131072;
constexpr int LDS_BYTES = LDS_MAIN + 16;
constexpr int NPHASE = 13;
constexpr size_t MiB = 1024 * 1024;
constexpr size_t WS_W1T = 0;
constexpr size_t WS_W2T = WS_W1T + (size_t)7168 * 1024 * 2;
constexpr size_t WS_W3T = WS_W2T + (size_t)1024 * 2048 * 2;
constexpr size_t WS_W4T = WS_W3T + (size_t)5376 * 1024 * 2;
constexpr size_t WS_STATS = 32 * MiB;
constexpr size_t WS_WSH = WS_STATS + 131072;
constexpr size_t WS_CWT = WS_WSH + 262144;
constexpr size_t WS_SBON = WS_CWT + 262144;
constexpr size_t WS_BAR = 35 * MiB;
constexpr size_t WS_XC = 36 * MiB, WS_G = 68 * MiB, WS_U = 100 * MiB, WS_V = 132 * MiB, WS_YCAT = 164 * MiB;
constexpr size_t WS_SPR = 0, WS_SPI = 232 * MiB;
constexpr size_t WS_O2 = 68 * MiB;
constexpr size_t WS_O1 = 36 * MiB, WS_PC = 68 * MiB, WS_ZCD = 168 * MiB, WS_FD = 216 * MiB;

namespace pg8 {
constexpr int BM = 256, BK = 64, HALF = 128, HTB = HALF * BK * 2, STAGE_BYTES = 8 * HTB, NXCD = 8, WGM = 8;
__host__ __device__ __forceinline__ int lds_byte(int r, int c) { const int st = (r >> 4) * 2 + (c >> 5), rr = r & 15, cc = c & 31, ob = rr * 64 + cc * 2; return st * 1024 + (ob ^ (((ob >> 9) & 1) << 5)); }
__host__ __device__ __forceinline__ void stage_rc(int b, int& R, int& C) { const int st = b / 1024, sb = b % 1024, swz = sb ^ (((sb >> 9) & 1) << 5); R = (st >> 1) * 16 + swz / 64; C = (st & 1) * 32 + (swz % 64) / 2; }
__host__ __device__ __forceinline__ int perm32(int rho) { const int n = rho >> 4, i = rho & 15; return 8 * (i >> 2) + 4 * n + (i & 3); }
struct Unit { int pm, pn; };
struct Gemm { const h16* A; const h16* Bt; int M, N, K; };
struct StaticOrder {
    int nM, nN, nwg, G, c;
    __host__ __device__ void init(int M, int N, int G_, int c_) { nM = M / BM; nN = N / BM; nwg = nM * nN; G = G_; c = c_; }
    __host__ __device__ bool next(int i, Unit& u) const {
        const long L = (long)i * G + c; if (L >= nwg) return false;
        int wgid = (int)L; { const int q = nwg / NXCD, r = nwg % NXCD, xcd = wgid % NXCD, off = wgid / NXCD; wgid = (xcd < r ? xcd * (q + 1) : r * (q + 1) + (xcd - r) * q) + off; }
        const int nig = WGM * nN, gid = wgid / nig, fm = gid * WGM, gsz = (nM - fm) < WGM ? (nM - fm) : WGM;
        u.pm = fm + ((wgid % nig) % gsz); u.pn = (wgid % nig) / gsz; return true;
    }
};
template <class Epi>
__device__ __forceinline__ void gemm_phase(LAS unsigned char* lds, const Gemm g, const StaticOrder& S, const Epi& E) {
    const int tid = threadIdx.x, wid = __builtin_amdgcn_readfirstlane(tid >> 6), lane = tid & 63, wr = wid >> 2, wc = wid & 3, fr = lane & 15, fq = lane >> 4;
    const int K = g.K, nt = K / BK;
    unsigned voffA[2], voffB[2];
#pragma unroll
    for (int i = 0; i < 2; ++i) { int R, C; stage_rc(tid * 16 + i * 8192, R, C); const int Rb = Epi::PERM ? ((R & ~31) + perm32(R & 31)) : R; voffA[i] = (unsigned)(R * K + C) * 2u; voffB[i] = (unsigned)(Rb * K + C) * 2u; }
    const size_t kstep = (size_t)(BK * 2);
    const size_t hstep = (size_t)HALF * K * 2;
    const size_t tstep = 2 * hstep;
    const unsigned ldsw = (unsigned)wid * 1024u;
    const int aoff = lds_byte(wr * 64 + fr, fq * 8), boff = lds_byte(wc * 32 + fr, fq * 8);
#define PG8_SA(b, h) (((b) * 2 + (h)) * HTB)
#define PG8_SB(b, h) ((4 + (b) * 2 + (h)) * HTB)
#define PG8_STAGE(bufoff, gbase, voff) do { _Pragma("unroll") for (int _i = 0; _i < 2; ++_i) \
        __builtin_amdgcn_global_load_lds((const unsigned*)((const char*)(gbase) + (voff)[_i]), (LAS unsigned*)(lds + (bufoff) + ldsw + _i * 8192), 16, 0, 0); } while (0)
#define PG8_LDA(dst, b, h) do { _Pragma("unroll") for (int m = 0; m < 4; ++m) _Pragma("unroll") for (int k = 0; k < 2; ++k) dst[m][k] = *(const LAS h16x8*)(lds + PG8_SA(b, h) + aoff + m * 2048 + k * 1024); } while (0)
#define PG8_LDB(dst, b, h) do { _Pragma("unroll") for (int n = 0; n < 2; ++n) _Pragma("unroll") for (int k = 0; k < 2; ++k) dst[n][k] = *(const LAS h16x8*)(lds + PG8_SB(b, h) + boff + n * 2048 + k * 1024); } while (0)
#define PG8_MMA(ai, bj, At, Bt) do { __builtin_amdgcn_s_setprio(1); _Pragma("unroll") for (int m = 0; m < 4; ++m) _Pragma("unroll") for (int n = 0; n < 2; ++n) _Pragma("unroll") for (int k = 0; k < 2; ++k) \
        acc[ai][bj][m][n] = __builtin_amdgcn_mfma_f32_16x16x32_f16(Bt[n][k], At[m][k], acc[ai][bj][m][n], 0, 0, 0); __builtin_amdgcn_s_setprio(0); } while (0)
#define PG8_WAIT_V(n) asm volatile("s_waitcnt vmcnt(" #n ")" ::: "memory")
#define PG8_WAIT_L(n) asm volatile("s_waitcnt lgkmcnt(" #n ")" ::: "memory")
#define PG8_BAR __builtin_amdgcn_s_barrier()
#define PG8_SCHED __builtin_amdgcn_sched_barrier(0)
    Unit cur, nxt; int ui = 0;
    if (!S.next(0, cur)) return;
    f32x4 acc[2][2][4][2];
#pragma unroll
    for (int a = 0; a < 2; ++a)
#pragma unroll
        for (int b = 0; b < 2; ++b)
#pragma unroll
            for (int m = 0; m < 4; ++m)
#pragma unroll
                for (int n = 0; n < 2; ++n) acc[a][b][m][n] = (f32x4){0.f, 0.f, 0.f, 0.f};
    h16x8 At[4][2], B0[2][2], B1[2][2];
    const char* cA = (const char*)g.A + (size_t)cur.pm * tstep; const char* cB = (const char*)g.Bt + (size_t)cur.pn * tstep;
    PG8_STAGE(PG8_SB(0, 0), cB, voffB); PG8_STAGE(PG8_SA(0, 0), cA, voffA); PG8_STAGE(PG8_SB(0, 1), cB + hstep, voffB); PG8_STAGE(PG8_SA(0, 1), cA + hstep, voffA);
    if (wr == 1) PG8_BAR;
    PG8_WAIT_V(4); PG8_BAR;
    PG8_STAGE(PG8_SB(1, 0), cB + kstep, voffB); PG8_STAGE(PG8_SA(1, 0), cA + kstep, voffA); PG8_STAGE(PG8_SB(1, 1), cB + hstep + kstep, voffB);
    PG8_WAIT_V(6); PG8_BAR;
    for (;;) {
        const bool has_next = S.next(ui + 1, nxt);
        const char* nA = has_next ? (const char*)g.A + (size_t)nxt.pm * tstep : cA; const char* nB = has_next ? (const char*)g.Bt + (size_t)nxt.pn * tstep : cB;
        for (int t = 0; t < nt; t += 2) {
            const bool last = (t == nt - 2);
            const char* a1 = cA + (size_t)(t + 1) * kstep;
            const char* a2 = last ? nA : cA + (size_t)(t + 2) * kstep; const char* b2 = last ? nB : cB + (size_t)(t + 2) * kstep;
            const char* a3 = a2 + kstep; const char* b3 = b2 + kstep;
            PG8_LDB(B0, 0, 0); PG8_SCHED; PG8_LDA(At, 0, 0); PG8_STAGE(PG8_SA(1, 1), a1 + hstep, voffA);
            PG8_WAIT_L(8); PG8_BAR; PG8_WAIT_L(0); PG8_MMA(0, 0, At, B0); PG8_BAR; PG8_SCHED;
            PG8_LDB(B1, 0, 1); PG8_STAGE(PG8_SB(0, 0), b2, voffB);
            PG8_BAR; PG8_WAIT_L(0); PG8_MMA(0, 1, At, B1); PG8_BAR;
            PG8_LDA(At, 0, 1); PG8_STAGE(PG8_SA(0, 0), a2, voffA);
            PG8_BAR; PG8_WAIT_L(0); PG8_MMA(1, 0, At, B0); PG8_BAR; PG8_SCHED;
            PG8_STAGE(PG8_SB(0, 1), b2 + hstep, voffB);
            PG8_WAIT_V(6); PG8_BAR; PG8_MMA(1, 1, At, B1); PG8_BAR;
            PG8_LDB(B0, 1, 0); PG8_SCHED; PG8_LDA(At, 1, 0); PG8_STAGE(PG8_SA(0, 1), a2 + hstep, voffA);
            PG8_WAIT_L(8); PG8_BAR; PG8_WAIT_L(0); PG8_MMA(0, 0, At, B0); PG8_BAR; PG8_SCHED;
            PG8_LDB(B1, 1, 1); PG8_STAGE(PG8_SB(1, 0), b3, voffB);
            PG8_BAR; PG8_WAIT_L(0); PG8_MMA(0, 1, At, B1); PG8_BAR;
            PG8_LDA(At, 1, 1); PG8_STAGE(PG8_SA(1, 0), a3, voffA);
            PG8_BAR; PG8_WAIT_L(0); PG8_MMA(1, 0, At, B0); PG8_BAR; PG8_SCHED;
            PG8_STAGE(PG8_SB(1, 1), b3 + hstep, voffB);
            PG8_WAIT_V(6); PG8_BAR; PG8_MMA(1, 1, At, B1); PG8_BAR;
        }
        E(acc, cur, wr, wc, fr, fq);
        if (!has_next) break;
#pragma unroll
        for (int a = 0; a < 2; ++a)
#pragma unroll
            for (int b = 0; b < 2; ++b)
#pragma unroll
                for (int m = 0; m < 4; ++m)
#pragma unroll
                    for (int n = 0; n < 2; ++n) acc[a][b][m][n] = (f32x4){0.f, 0.f, 0.f, 0.f};
        cur = nxt; cA = nA; cB = nB; ++ui;
    }
    PG8_WAIT_V(0);
    if (wr == 0) PG8_BAR;
    PG8_BAR;
#undef PG8_SA
#undef PG8_SB
#undef PG8_STAGE
#undef PG8_LDA
#undef PG8_LDB
#undef PG8_MMA
#undef PG8_WAIT_V
#undef PG8_WAIT_L
#undef PG8_BAR
#undef PG8_SCHED
}
}


#define XB_TMO      128
#define XB_XCNT(j)  (256  + 64 * (j))
#define XB_XSUB(j)  (1280 + 64 * (j))
#define XB_XGEN(j)  (2304 + 64 * (j))
#define XB_TOP      3328
#define XB_TOPGEN   3392
#define XCD_BAR_WORDS 3456
#define XB_SPIN_CAP (1u << 18)
__device__ __forceinline__ unsigned xb_ld(unsigned* p)              { return __hip_atomic_load(p, __ATOMIC_RELAXED, __HIP_MEMORY_SCOPE_AGENT); }
__device__ __forceinline__ unsigned xb_add(unsigned* p, unsigned v) { return __hip_atomic_fetch_add(p, v, __ATOMIC_RELAXED, __HIP_MEMORY_SCOPE_AGENT); }
__device__ __forceinline__ unsigned xb_xcc_id() { return (unsigned)__builtin_amdgcn_s_getreg((3 << 11) | 20) & 0xFu; }
#define XB_SPIN(cond, bar) do { unsigned _sp = 0; while (cond) { __builtin_amdgcn_s_sleep(1); \
    if ((++_sp & 255u) == 0u) { if (xb_ld(&(bar)[XB_TMO])) break; if (_sp > XB_SPIN_CAP) { atomicAdd(&(bar)[XB_TMO], 1u); break; } } } } while (0)
struct XcdBarrier { unsigned* bar; unsigned x; volatile LAS unsigned* st; };
__device__ __forceinline__ XcdBarrier xcd_barrier_post(unsigned* bar, volatile LAS unsigned* st) {
    XcdBarrier b; b.bar = bar; b.x = xb_xcc_id(); b.st = st;
    if (threadIdx.x == 0) (void)xb_add(&bar[XB_XCNT(b.x)], 1u);
    return b;
}
__device__ __forceinline__ void xcd_barrier_complete(unsigned* bar, unsigned x, unsigned& nloc, unsigned& nx) {
    const unsigned G = gridDim.x * gridDim.y * gridDim.z;
    unsigned sum, cnt, mine, sp = 0u;
    for (;;) {
        sum = 0u; cnt = 0u; mine = 0u;
#pragma unroll
        for (unsigned j = 0; j < 16; ++j) { const unsigned c = xb_ld(&bar[XB_XCNT(j)]); sum += c; cnt += (c > 0u) ? 1u : 0u; mine = (j == x) ? c : mine; }
        if (sum == G) break;
        __builtin_amdgcn_s_sleep(1);
        if ((++sp & 255u) == 0u) { if (xb_ld(&bar[XB_TMO])) break; if (sp > XB_SPIN_CAP) { atomicAdd(&bar[XB_TMO], 1u); break; } }
    }
    nloc = mine > 0u ? mine : 1u; nx = cnt > 0u ? cnt : 1u;
}
__device__ __forceinline__ void xcd_barrier(const XcdBarrier& b) {
    asm volatile("s_waitcnt vmcnt(0)" ::: "memory");
    __syncthreads();
    if (threadIdx.x == 0) {
        unsigned* bar = b.bar;
        __builtin_amdgcn_s_waitcnt(0);
        unsigned nloc = b.st[0], nx = b.st[1];
        if (nloc == 0u) { xcd_barrier_complete(bar, b.x, nloc, nx); b.st[0] = nloc; b.st[1] = nx; }
        const unsigned old = xb_add(&bar[XB_XSUB(b.x)], 1u);
        const unsigned gen = old / nloc;
        if (old + 1u == (gen + 1u) * nloc) {
            __builtin_amdgcn_fence(__ATOMIC_RELEASE, "agent");
            asm volatile("s_waitcnt vmcnt(0)" ::: "memory");
            const unsigned og = xb_add(&bar[XB_TOP], 1u);
            const unsigned tg = og / nx;
            if (og + 1u == (tg + 1u) * nx) xb_add(&bar[XB_TOPGEN], 1u);
            else XB_SPIN(xb_ld(&bar[XB_TOPGEN]) == tg, bar);
            __builtin_amdgcn_fence(__ATOMIC_ACQUIRE, "agent");
            xb_add(&bar[XB_XGEN(b.x)], 1u);
            asm volatile("s_waitcnt vmcnt(0)" ::: "memory");
        } else {
            XB_SPIN(xb_ld(&bar[XB_XGEN(b.x)]) == gen, bar);
            __builtin_amdgcn_fence(__ATOMIC_ACQUIRE, "agent");
            asm volatile("s_waitcnt vmcnt(0)" ::: "memory");
        }
    }
    __syncthreads();
}

struct Params { const float* in[24]; float* out; unsigned char* ws; int ph_lo, ph_hi; };

__device__ __forceinline__ float silu_f(float x) { return x * __builtin_amdgcn_rcpf(1.f + __expf(-x)); }
__device__ __forceinline__ float sigmoid_f(float x) { return __builtin_amdgcn_rcpf(1.f + __expf(-x)); }
__device__ __forceinline__ float tanh_f(float x) { return 1.f - 2.f * __builtin_amdgcn_rcpf(__expf(2.f * x) + 1.f); }
__device__ __forceinline__ float wave_sum(float v) {
#pragma unroll
    for (int o = 1; o < 64; o <<= 1) v += __shfl_xor(v, o);
    return v;
}
template <int CTRL> __device__ __forceinline__ float dpp_f(float x) { return __int_as_float(__builtin_amdgcn_update_dpp(0, __float_as_int(x), CTRL, 0xf, 0xf, false)); }
__device__ __forceinline__ float red8(float x) {
    x += dpp_f<0xB1>(x); x += dpp_f<0x4E>(x); x += dpp_f<0x141>(x); return x;
}
__device__ __forceinline__ float red16(float x) {
    x += dpp_f<0xB1>(x); x += dpp_f<0x4E>(x); x += dpp_f<0x141>(x); x += dpp_f<0x140>(x); return x;
}

__device__ __forceinline__ int sigma1(int np) {
    const int T = np >> 8, c = np & 255;
    if (T < 16) { const int bj = c >> 7, wc = (c >> 5) & 3, n = (c >> 4) & 1, r = c & 15; return 1024 * (2 * bj + n) + 64 * T + 16 * wc + r; }
    if (T < 24) { return ((c >> 7) ? 6144 : 4096) + 128 * (T - 16) + (c & 127); }
    return 5120 + 256 * (T - 24) + c;
}

template <int MODE>
__device__ __forceinline__ void tr_item(const float* W, int K, int N, h16* WT, LAS float* scr, int item, int nblk, int lane) {
    const int kb = item / nblk, nb = item % nblk, k0 = 64 * kb, n0 = 32 * nb;
    const int np = n0 + (lane & 31);
    const int sc = (MODE == 1) ? sigma1(np) : np;
    const bool valid = (MODE != 2) || (np < 5248);
#pragma unroll 8
    for (int i = 0; i < 32; ++i) { const int kk = 2 * i + (lane >> 5); scr[kk * 33 + (lane & 31)] = valid ? W[(size_t)(k0 + kk) * N + sc] : 0.f; }
    asm volatile("s_waitcnt lgkmcnt(0)" ::: "memory");
    const int c = lane & 7;
#pragma unroll
    for (int j = 0; j < 4; ++j) { const int n = (lane >> 3) + 8 * j; const LAS float* s = scr + (8 * c) * 33 + n;
        h16x8 o;
#pragma unroll
        for (int e = 0; e < 8; ++e) o[e] = (h16)s[e * 33];
        *(h16x8*)(WT + (size_t)(n0 + n) * K + k0 + 8 * c) = o; }
    asm volatile("s_waitcnt lgkmcnt(0)" ::: "memory");
}

__device__ __forceinline__ void rms_row_f16(const float* xr, const h16* addr, const float* g, h16* orow, int lane) {
    f32x4 v[4]; float ss = 0.f;
#pragma unroll
    for (int j = 0; j < 4; ++j) { v[j] = *(const f32x4*)(xr + 4 * lane + 256 * j);
        if (addr) { const h16x4 a = *(const h16x4*)(addr + 4 * lane + 256 * j); v[j][0] += (float)a[0]; v[j][1] += (float)a[1]; v[j][2] += (float)a[2]; v[j][3] += (float)a[3]; }
        ss += v[j][0] * v[j][0] + v[j][1] * v[j][1] + v[j][2] * v[j][2] + v[j][3] * v[j][3]; }
    const float rs = rsqrtf(wave_sum(ss) * (1.f / 1024.f) + 1e-6f);
#pragma unroll
    for (int j = 0; j < 4; ++j) { const f32x4 gg = *(const f32x4*)(g + 4 * lane + 256 * j); h16x4 o;
        o[0] = (h16)(v[j][0] * rs * gg[0]); o[1] = (h16)(v[j][1] * rs * gg[1]); o[2] = (h16)(v[j][2] * rs * gg[2]); o[3] = (h16)(v[j][3] * rs * gg[3]);
        *(h16x4*)(orow + 4 * lane + 256 * j) = o; }
}

__device__ __forceinline__ void phase0(const Params& p, LAS unsigned char* lds) {
    const int tid = threadIdx.x, lane = tid & 63, wave = tid >> 6;
    const int gw = blockIdx.x * 8 + wave, NGW = gridDim.x * 8;
    LAS float* scr = (LAS float*)(lds + wave * 8448);
    h16* W1T = (h16*)(p.ws + WS_W1T); h16* W2T = (h16*)(p.ws + WS_W2T); h16* W3T = (h16*)(p.ws + WS_W3T); h16* W4T = (h16*)(p.ws + WS_W4T);
    constexpr int I1 = 16 * 224, I2 = 32 * 32, I3 = 16 * 168, I4 = 24 * 32;
    for (int it = gw; it < I1 + I2 + I3 + I4; it += NGW) {
        int r = it;
        if (r < I1) { tr_item<1>(p.in[2], 1024, 7168, W1T, scr, r, 224, lane); continue; } r -= I1;
        if (r < I2) { tr_item<0>(p.in[8], 2048, 1024, W2T, scr, r, 32, lane); continue; } r -= I2;
        if (r < I3) { tr_item<2>(p.in[10], 1024, 5248, W3T, scr, r, 168, lane); continue; } r -= I3;
        tr_item<0>(p.in[22], 1536, 1024, W4T, scr, r, 32, lane);
    }
    h16* H0 = (h16*)p.out;
    for (int r = gw; r < NTOK; r += NGW) rms_row_f16(p.in[0] + (size_t)r * DM, nullptr, p.in[1], H0 + (size_t)r * DM, lane);
    const int gt = blockIdx.x * 512 + tid, NGT = gridDim.x * 512;
    h16* WSH = (h16*)(p.ws + WS_WSH);
    for (int i = gt; i < 8 * 128 * 128; i += NGT) WSH[i] = (h16)p.in[6][i];
    { float* STZ = (float*)(p.ws + WS_STATS); for (int i = gt; i < 2 * NTOK; i += NGT) STZ[i] = 0.f; }
    h16* CWT = (h16*)(p.ws + WS_CWT);
    const float* wf = p.in[21];
    for (int i = gt; i < 4 * 128 * 256; i += NGT) {
        const int k = i & 255, e = (i >> 8) & 127, g = i >> 15, d = k & 127; const bool sn = k >= 128;
        float s = 0.f;
        for (int dp = 0; dp < 128; ++dp) { const float fr = (float)((d * dp) & 127) * (1.f / 128.f);
            const float tw = sn ? __builtin_amdgcn_sinf(fr) : __builtin_amdgcn_cosf(fr);
            s += tw * wf[(g * 128 + dp) * 128 + e]; }
        CWT[i] = (h16)(s * 0.08838834764831845f);
    }
}

struct Epi1 {
    static constexpr bool PERM = false;
    h16 *XC, *G, *U, *V; float* st;
    __device__ __forceinline__ void operator()(const f32x4 (&acc)[2][2][4][2], const pg8::Unit& u, int wr, int wc, int fr, int fq) const {
        const int T = u.pn; const int row0 = u.pm * 256 + wr * 64 + fr;
        if (T < 16) {
            const int ch = 64 * T + 16 * wc + 4 * fq;
#pragma unroll
            for (int ai = 0; ai < 2; ++ai)
#pragma unroll
                for (int m = 0; m < 4; ++m) { const size_t r = (size_t)(row0 + ai * 128 + m * 16);
                    const f32x4 xa = acc[ai][0][m][0], ba = acc[ai][0][m][1], ca = acc[ai][1][m][0], za = acc[ai][1][m][1];
                    h16x4 xc, gg;
#pragma unroll
                    for (int e = 0; e < 4; ++e) { xc[e] = (h16)(ca[e] * xa[e]); gg[e] = (h16)(ba[e] * silu_f(za[e])); }
                    *(h16x4*)(XC + r * 1024 + ch) = xc; *(h16x4*)(G + r * 1024 + ch) = gg; }
        } else if (T < 24) {
#pragma unroll
            for (int ai = 0; ai < 2; ++ai)
#pragma unroll
                for (int m = 0; m < 4; ++m) { const size_t r = (size_t)(row0 + ai * 128 + m * 16);
#pragma unroll
                    for (int n = 0; n < 2; ++n) { const int ch = 128 * (T - 16) + 32 * wc + 16 * n + 4 * fq;
                        const f32x4 ub = acc[ai][0][m][n], zb = acc[ai][1][m][n]; h16x4 o;
#pragma unroll
                        for (int e = 0; e < 4; ++e) o[e] = (h16)(ub[e] * silu_f(zb[e]));
                        *(h16x4*)(U + r * 1024 + ch) = o; } }
        } else {
#pragma unroll
            for (int ai = 0; ai < 2; ++ai)
#pragma unroll
                for (int m = 0; m < 4; ++m) { const size_t r = (size_t)(row0 + ai * 128 + m * 16); float s1 = 0.f, s2 = 0.f;
#pragma unroll
                    for (int bj = 0; bj < 2; ++bj)
#pragma unroll
                        for (int n = 0; n < 2; ++n) { const int ch = 256 * (T - 24) + 128 * bj + 32 * wc + 16 * n + 4 * fq;
                            const f32x4 v = acc[ai][bj][m][n]; h16x4 o;
#pragma unroll
                            for (int e = 0; e < 4; ++e) { o[e] = (h16)v[e]; const float f = (float)o[e]; s1 += f; s2 += f * f; }
                            *(h16x4*)(V + r * 1024 + ch) = o; }
                    s1 += __shfl_xor(s1, 16); s2 += __shfl_xor(s2, 16); s1 += __shfl_xor(s1, 32); s2 += __shfl_xor(s2, 32);
                    if (fq == 0) { atomicAdd(st + 2 * r, s1); atomicAdd(st + 2 * r + 1, s2); } }
        }
    }
};
struct Epi2 {
    static constexpr bool PERM = true;
    h16* O1;
    __device__ __forceinline__ void operator()(const f32x4 (&acc)[2][2][4][2], const pg8::Unit& u, int wr, int wc, int fr, int fq) const {
        const int row0 = u.pm * 256 + wr * 64 + fr, col0 = u.pn * 256 + wc * 32 + 8 * fq;
#pragma unroll
        for (int ai = 0; ai < 2; ++ai)
#pragma unroll
            for (int m = 0; m < 4; ++m) { const size_t r = (size_t)(row0 + ai * 128 + m * 16);
#pragma unroll
                for (int bj = 0; bj < 2; ++bj) { const f32x4 v0 = acc[ai][bj][m][0], v1 = acc[ai][bj][m][1]; h16x8 o;
#pragma unroll
                    for (int e = 0; e < 4; ++e) { o[e] = (h16)v0[e]; o[4 + e] = (h16)v1[e]; }
                    *(h16x8*)(O1 + r * 1024 + col0 + bj * 128) = o; } }
    }
};
struct Epi3 {
    static constexpr bool PERM = true;
    h16 *PC, *ZCD, *FD;
    __device__ __forceinline__ void operator()(const f32x4 (&acc)[2][2][4][2], const pg8::Unit& u, int wr, int wc, int fr, int fq) const {
        const int row0 = u.pm * 256 + wr * 64 + fr, col0 = u.pn * 256 + wc * 32 + 8 * fq;
#pragma unroll
        for (int bj = 0; bj < 2; ++bj) { const int c = col0 + bj * 128;
            h16* base; size_t ld;
            if (c < 3200) { base = PC + c; ld = 3200; }
            else if (c < 4224) { base = ZCD + (c - 3200); ld = 1536; }
            else if (c < 4736) { base = FD + (c - 4224); ld = 512; }
            else if (c < 5248) { base = ZCD + 1024 + (c - 4736); ld = 1536; }
            else continue;
#pragma unroll
            for (int ai = 0; ai < 2; ++ai)
#pragma unroll
                for (int m = 0; m < 4; ++m) { const size_t r = (size_t)(row0 + ai * 128 + m * 16); const f32x4 v0 = acc[ai][bj][m][0], v1 = acc[ai][bj][m][1]; h16x8 o;
#pragma unroll
                    for (int e = 0; e < 4; ++e) { o[e] = (h16)v0[e]; o[4 + e] = (h16)v1[e]; }
                    *(h16x8*)(base + r * ld) = o; } }
    }
};
struct Epi4 {
    static constexpr bool PERM = true;
    h16* O2;
    __device__ __forceinline__ void operator()(const f32x4 (&acc)[2][2][4][2], const pg8::Unit& u, int wr, int wc, int fr, int fq) const {
        const int row0 = u.pm * 256 + wr * 64 + fr, col0 = u.pn * 256 + wc * 32 + 8 * fq;
#pragma unroll
        for (int ai = 0; ai < 2; ++ai)
#pragma unroll
            for (int m = 0; m < 4; ++m) { const size_t r = (size_t)(row0 + ai * 128 + m * 16);
#pragma unroll
                for (int bj = 0; bj < 2; ++bj) { const f32x4 v0 = acc[ai][bj][m][0], v1 = acc[ai][bj][m][1]; h16x8 o;
#pragma unroll
                    for (int e = 0; e < 4; ++e) { o[e] = (h16)v0[e]; o[4 + e] = (h16)v1[e]; }
                    *(h16x8*)(O2 + r * 1024 + col0 + bj * 128) = o; } }
    }
};

__device__ __forceinline__ void phase_stats(const Params& p) {
    const int tid = threadIdx.x, lane = tid & 63, wave = tid >> 6;
    const int gw = blockIdx.x * 8 + wave, NGW = gridDim.x * 8;
    const h16* V = (const h16*)(p.ws + WS_V); float* ST = (float*)(p.ws + WS_STATS);
    for (int r = gw; r < NTOK; r += NGW) {
        const h16x8 a = *(const h16x8*)(V + (size_t)r * 1024 + 8 * lane), b = *(const h16x8*)(V + (size_t)r * 1024 + 512 + 8 * lane);
        float s = 0.f;
#pragma unroll
        for (int e = 0; e < 8; ++e) s += (float)a[e] + (float)b[e];
        const float mu = wave_sum(s) * (1.f / 1024.f); float q = 0.f;
#pragma unroll
        for (int e = 0; e < 8; ++e) { const float x = (float)a[e] - mu, y = (float)b[e] - mu; q += x * x + y * y; }
        const float rs = rsqrtf(wave_sum(q) * (1.f / 1024.f) + 1e-5f);
        if (lane == 0) { ST[2 * r] = mu; ST[2 * r + 1] = rs; }
    }
}

__device__ __forceinline__ void phase_mix0(const Params& p, LAS unsigned char* lds) {
    const int tid = threadIdx.x, lane = tid & 63, wave = tid >> 6;
    const h16* XC = (const h16*)(p.ws + WS_XC); const h16* G = (const h16*)(p.ws + WS_G); const h16* U = (const h16*)(p.ws + WS_U); const h16* V = (const h16*)(p.ws + WS_V);
    h16* YC = (h16*)(p.ws + WS_YCAT);
    const float* cw = p.in[3];
    const int gt = blockIdx.x * 512 + tid, NGT = gridDim.x * 512;
    for (int idx = gt; idx < NTOK * 128; idx += NGT) {
        const int t = idx >> 7, c8 = (idx & 127) * 8, tp = t & (SEQ - 1);
        const h16x8 zero = {0, 0, 0, 0, 0, 0, 0, 0};
        const h16x8 x0 = *(const h16x8*)(XC + (size_t)t * 1024 + c8);
        const h16x8 xm = tp > 0 ? *(const h16x8*)(XC + (size_t)(t - 1) * 1024 + c8) : zero;
        const h16x8 xp = tp < SEQ - 1 ? *(const h16x8*)(XC + (size_t)(t + 1) * 1024 + c8) : zero;
        const h16x8 gg = *(const h16x8*)(G + (size_t)t * 1024 + c8);
        h16x8 o;
#pragma unroll
        for (int e = 0; e < 8; ++e) { const float y = cw[c8 + e] * (float)xm[e] + cw[1024 + c8 + e] * (float)x0[e] + cw[2048 + c8 + e] * (float)xp[e]; o[e] = (h16)(y * (float)gg[e]); }
        *(h16x8*)(YC + (size_t)t * 2048 + c8) = o;
    }
    const float* ST = (const float*)(p.ws + WS_STATS); const h16* WSH = (const h16*)(p.ws + WS_WSH);
    const float* lng = p.in[4]; const float* lnb = p.in[5]; const float* bs = p.in[7];
    LAS h16* vnT = (LAS h16*)lds;
    for (int it = blockIdx.x; it < 1024; it += gridDim.x) {
        const int g = it & 7, bn = it >> 3, t0 = bn * 128;
        __syncthreads();
#pragma unroll
        for (int q = 0; q < 4; ++q) { const int pc = tid + 512 * q, j = pc >> 4, d8 = (pc & 15) * 8;
            const h16x8 v = *(const h16x8*)(V + (size_t)(t0 + j) * 1024 + g * 128 + d8);
            const float mu = ST[2 * (t0 + j)] * (1.f / 1024.f), rs = rsqrtf(fmaxf(ST[2 * (t0 + j) + 1] * (1.f / 1024.f) - mu * mu, 0.f) + 1e-5f);
#pragma unroll
            for (int e = 0; e < 8; ++e) vnT[(d8 + e) * 136 + j] = (h16)(((float)v[e] - mu) * rs * lng[g * 128 + d8 + e] + lnb[g * 128 + d8 + e]); }
        __syncthreads();
        const int itile = wave >> 1, dt0 = (wave & 1) * 2;
        f32x16 acc0, acc1;
#pragma unroll
        for (int e = 0; e < 16; ++e) { acc0[e] = 0.f; acc1[e] = 0.f; }
        const h16* Arow = WSH + ((size_t)g * 128 + itile * 32 + (lane & 31)) * 128 + 8 * (lane >> 5);
        const LAS h16* B0p = vnT + (dt0 * 32 + (lane & 31)) * 136 + 8 * (lane >> 5);
        const LAS h16* B1p = B0p + 32 * 136;
#pragma unroll
        for (int ks = 0; ks < 8; ++ks) {
            const h16x8 a = *(const h16x8*)(Arow + 16 * ks);
            const h16x8 b0 = *(const LAS h16x8*)(B0p + 16 * ks), b1 = *(const LAS h16x8*)(B1p + 16 * ks);
            acc0 = __builtin_amdgcn_mfma_f32_32x32x16_f16(a, b0, acc0, 0, 0, 0);
            acc1 = __builtin_amdgcn_mfma_f32_32x32x16_f16(a, b1, acc1, 0, 0, 0);
        }
#pragma unroll
        for (int r = 0; r < 16; ++r) { const int i = itile * 32 + (r & 3) + 8 * (r >> 2) + 4 * (lane >> 5); const size_t t = (size_t)(t0 + i);
            const float bias = bs[g * 128 + i];
            const int d0 = g * 128 + dt0 * 32 + (lane & 31);
            YC[t * 2048 + 1024 + d0] = (h16)((acc0[r] + bias) * (float)U[t * 1024 + d0]);
            YC[t * 2048 + 1024 + d0 + 32] = (h16)((acc1[r] + bias) * (float)U[t * 1024 + d0 + 32]); }
    }
}

__device__ __forceinline__ void phase_norm1(const Params& p) {
    const int tid = threadIdx.x, lane = tid & 63, wave = tid >> 6;
    const int gw = blockIdx.x * 8 + wave, NGW = gridDim.x * 8;
    const h16* O1 = (const h16*)(p.ws + WS_O1); h16* H1 = (h16*)p.out;
    for (int r = gw; r < NTOK; r += NGW) rms_row_f16(p.in[0] + (size_t)r * DM, O1 + (size_t)r * DM, p.in[9], H1 + (size_t)r * DM, lane);
}

__device__ __forceinline__ void phase_fft(const Params& p, LAS unsigned char* lds) {
    const int tid = threadIdx.x;
    const h16* FD = (const h16*)(p.ws + WS_FD);
    h16* SPr = (h16*)(p.ws + WS_SPR); h16* SPi = (h16*)(p.ws + WS_SPI);
    LAS f32x2* X0 = (LAS f32x2*)lds; LAS f32x2* X1 = X0 + 8192;
    for (int it = blockIdx.x; it < 256; it += gridDim.x) {
        const int b = it >> 7, c0 = 4 * (it & 127);
        __syncthreads();
        for (int t = tid; t < SEQ; t += 512) { const h16x4 v = *(const h16x4*)(FD + (size_t)(b * SEQ + t) * 512 + c0);
            X0[t] = (f32x2){(float)v[0], (float)v[1]}; X1[t] = (f32x2){(float)v[2], (float)v[3]}; }
        __syncthreads();
        for (int s = 0; s < 13; ++s) {
            const int half = 4096 >> s;
#pragma unroll 2
            for (int j = tid; j < 4096; j += 512) {
                const int pos = j & (half - 1), grp = j >> (12 - s), i0 = (grp << (13 - s)) + pos, i1 = i0 + half;
                const float fr = (float)(pos << s) * (1.f / 8192.f);
                const float c = __builtin_amdgcn_cosf(fr), sn = __builtin_amdgcn_sinf(fr);
                { const f32x2 a = X0[i0], bb = X0[i1]; const f32x2 d = a - bb; X0[i0] = a + bb; X0[i1] = (f32x2){d[0] * c + d[1] * sn, d[1] * c - d[0] * sn}; }
                { const f32x2 a = X1[i0], bb = X1[i1]; const f32x2 d = a - bb; X1[i0] = a + bb; X1[i1] = (f32x2){d[0] * c + d[1] * sn, d[1] * c - d[0] * sn}; }
            }
            __syncthreads();
        }
        const float sc = 0.5f * 0.011048543456039806f;
        for (int k = tid; k < SEQ; k += 512) {
            const int ra = __brev((unsigned)k) >> 19, rb = __brev((unsigned)((SEQ - k) & (SEQ - 1))) >> 19;
            const f32x2 za = X0[ra], zb = X0[rb], ya = X1[ra], yb = X1[rb];
            h16x4 orr, oi;
            orr[0] = (h16)((za[0] + zb[0]) * sc); oi[0] = (h16)((za[1] - zb[1]) * sc);
            orr[1] = (h16)((za[1] + zb[1]) * sc); oi[1] = (h16)((zb[0] - za[0]) * sc);
            orr[2] = (h16)((ya[0] + yb[0]) * sc); oi[2] = (h16)((ya[1] - yb[1]) * sc);
            orr[3] = (h16)((ya[1] + yb[1]) * sc); oi[3] = (h16)((yb[0] - ya[0]) * sc);
            *(h16x4*)(SPr + (size_t)(b * SEQ + k) * 512 + c0) = orr; *(h16x4*)(SPi + (size_t)(b * SEQ + k) * 512 + c0) = oi;
        }
    }
}

__device__ __forceinline__ void phase_fnet_out(const Params& p) {
    const int tid = threadIdx.x, lane = tid & 63, wave = tid >> 6;
    const int gw = blockIdx.x * 8 + wave, NGW = gridDim.x * 8;
    const h16* SPr = (const h16*)(p.ws + WS_SPR); const h16* SPi = (const h16*)(p.ws + WS_SPI);
    const h16* CWT = (const h16*)(p.ws + WS_CWT); h16* ZCD = (h16*)(p.ws + WS_ZCD);
    for (int w = gw; w < 8192; w += NGW) {
        const int et = w & 3, g = (w >> 2) & 3, tt = w >> 4;
        const size_t trow = (size_t)(tt * 32 + (lane & 31));
        const h16* Ar = SPr + trow * 512 + g * 128 + 8 * (lane >> 5); const h16* Ai = SPi + trow * 512 + g * 128 + 8 * (lane >> 5);
        const h16* Bp = CWT + ((size_t)(g * 128 + et * 32 + (lane & 31))) * 256 + 8 * (lane >> 5);
        f32x16 acc;
#pragma unroll
        for (int e = 0; e < 16; ++e) acc[e] = 0.f;
#pragma unroll
        for (int ks = 0; ks < 8; ++ks) acc = __builtin_amdgcn_mfma_f32_32x32x16_f16(*(const h16x8*)(Ar + 16 * ks), *(const h16x8*)(Bp + 16 * ks), acc, 0, 0, 0);
#pragma unroll
        for (int ks = 0; ks < 8; ++ks) acc = __builtin_amdgcn_mfma_f32_32x32x16_f16(*(const h16x8*)(Ai + 16 * ks), *(const h16x8*)(Bp + 128 + 16 * ks), acc, 0, 0, 0);
#pragma unroll
        for (int r = 0; r < 16; ++r) { const size_t t = (size_t)(tt * 32 + (r & 3) + 8 * (r >> 2) + 4 * (lane >> 5));
            h16* zp = ZCD + t * 1536 + 1024 + g * 128 + et * 32 + (lane & 31);
            *zp = (h16)(acc[r] * silu_f((float)*zp)); }
    }
}

#define LDS_BAR() do { asm volatile("s_waitcnt lgkmcnt(0)" ::: "memory"); __builtin_amdgcn_s_barrier(); asm volatile("" ::: "memory"); } while (0)
#define LDS_WAIT() asm volatile("s_waitcnt lgkmcnt(0)" ::: "memory")
__device__ __forceinline__ void phase_scan(const Params& p, LAS unsigned char* lds) {
    const int tid = threadIdx.x, lane = tid & 63, wave = tid >> 6;
    const h16* PC = (const h16*)(p.ws + WS_PC);
    LAS h16* w2T = (LAS h16*)lds;
    LAS h16* a2T = w2T + 64 * 72;
    LAS unsigned char* priv = lds + 18432 + (wave & 3) * 4096;
    constexpr int SET_F = 5 * 2048 + 512;
    LAS float* OPS = (LAS float*)(lds + 18432 + 16384);
    LAS float* sYb = OPS + 2 * SET_F;
    for (int item = blockIdx.x; item < 256; item += gridDim.x) {
        const int xcd = item & 7, slot = item >> 3, gidx = xcd * 8 + (slot >> 2), q = slot & 3;
        const int dir = gidx >> 5, b = (gidx >> 4) & 1, h = gidx & 15;
        h16* Yd = (h16*)((unsigned char*)p.out + (size_t)dir * 32 * MiB);
        float* SB = (float*)(p.ws + WS_SBON) + (size_t)dir * NTOK * 16;
        const float* mu = p.in[11] + dir * 3200; const float* w0 = p.in[12] + dir * 1024 + 64 * h; const float* w2 = p.in[13] + (size_t)dir * 65536 + 64 * h;
        const float* a0 = p.in[14] + dir * 1024 + 64 * h; const float* a2 = p.in[15] + (size_t)dir * 65536 + 64 * h;
        const float* kkw = p.in[16] + 64 * h; const float* kaw = p.in[17] + 64 * h; const float* rkw = p.in[18] + 64 * h;
        __syncthreads();
        for (int i = tid; i < 4096; i += 512) { const int l = i >> 6, c = i & 63; w2T[c * 72 + l] = (h16)w2[l * 1024 + c]; a2T[c * 72 + l] = (h16)a2[l * 1024 + c]; }
        const int pw_ = wave & 3, s_sub = lane >> 3, c8 = (lane & 7) * 8, s_l = 8 * pw_ + s_sub;
        h16x8 mu_r8, mu_k8, mu_v8, mu_w8, mu_a8; f32x2 w0r[4], a0r[4], kkr[4], kar[4], omk[4], rkr[4];
#pragma unroll
        for (int e = 0; e < 8; ++e) { mu_r8[e] = (h16)mu[64 * h + c8 + e]; mu_k8[e] = (h16)mu[1024 + 64 * h + c8 + e]; mu_v8[e] = (h16)mu[2048 + 64 * h + c8 + e]; mu_w8[e] = (h16)mu[3072 + c8 + e]; mu_a8[e] = (h16)mu[3136 + c8 + e];
            w0r[e >> 1][e & 1] = w0[c8 + e]; a0r[e >> 1][e & 1] = a0[c8 + e]; kkr[e >> 1][e & 1] = kkw[c8 + e]; kar[e >> 1][e & 1] = kaw[c8 + e]; omk[e >> 1][e & 1] = 1.f - kaw[c8 + e]; rkr[e >> 1][e & 1] = rkw[c8 + e]; }
        f32x2 S01 = {0.f, 0.f}, S23 = {0.f, 0.f};
        const int srow = 4 * (wave & 3) + (lane >> 4), j0 = 4 * (lane & 15);
        const h16x8 z8 = {0, 0, 0, 0, 0, 0, 0, 0};
        h16x8 pr, pk, pv, pw, pa, qr_, qk_, qv_, qw_, qa_;
#define SCAN_LOAD(chn) do { const int sg_ = (chn) * 32 + s_l; const int t_ = dir ? (SEQ - 1 - sg_) : sg_; \
            const size_t rowc_ = (size_t)(b * SEQ + t_) * 3200; const size_t rowp_ = (size_t)(b * SEQ + (dir ? t_ + 1 : t_ - 1)) * 3200; const bool hp_ = sg_ > 0; \
            pr = *(const h16x8*)(PC + rowc_ + 64 * h + c8); pk = *(const h16x8*)(PC + rowc_ + 1024 + 64 * h + c8); pv = *(const h16x8*)(PC + rowc_ + 2048 + 64 * h + c8); \
            pw = *(const h16x8*)(PC + rowc_ + 3072 + c8); pa = *(const h16x8*)(PC + rowc_ + 3136 + c8); \
            qr_ = hp_ ? *(const h16x8*)(PC + rowp_ + 64 * h + c8) : z8; qk_ = hp_ ? *(const h16x8*)(PC + rowp_ + 1024 + 64 * h + c8) : z8; qv_ = hp_ ? *(const h16x8*)(PC + rowp_ + 2048 + 64 * h + c8) : z8; \
            qw_ = hp_ ? *(const h16x8*)(PC + rowp_ + 3072 + c8) : z8; qa_ = hp_ ? *(const h16x8*)(PC + rowp_ + 3136 + c8) : z8; } while (0)
#define SCAN_YSTORE(chn) do { const int sg_ = (chn) * 32 + s_l; const int t_ = dir ? (SEQ - 1 - sg_) : sg_; \
            const f32x2 y2_ = *(const LAS f32x2*)(sYb + ((chn) & 1) * 512 + s_l * 16 + 2 * (lane & 7)); \
            typedef _Float16 h16x2_ __attribute__((ext_vector_type(2))); h16x2_ o_; o_[0] = (h16)y2_[0]; o_[1] = (h16)y2_[1]; \
            *(h16x2_*)(Yd + (size_t)(b * SEQ + t_) * 1024 + 64 * h + 16 * q + 2 * (lane & 7)) = o_; } while (0)
        if (wave >= 4) SCAN_LOAD(0);
        __syncthreads();
        for (int n = -1; n < SEQ / 32; ++n) {
            if (wave < 4) {
                if (n >= 0) {
                    __builtin_amdgcn_s_setprio(3);
                    const LAS float* sR = OPS + (n & 1) * SET_F + j0; const LAS float* sW = sR + 2048; const LAS float* sK = sW + 2048; const LAS float* sA = sK + 2048; const LAS float* sB = sA + 2048; const LAS float* sV = OPS + (n & 1) * SET_F + 10240;
                    LAS float* sY = sYb + (n & 1) * 512;
                    f32x4 a_ = *(const LAS f32x4*)(sA), w_ = *(const LAS f32x4*)(sW), b_ = *(const LAS f32x4*)(sB);
                    f32x4 k_ = *(const LAS f32x4*)(sK), r_ = *(const LAS f32x4*)(sR);
                    f32x4 vq[4];
#pragma unroll
                    for (int u = 0; u < 4; ++u) vq[u] = *(const LAS f32x4*)(sV + srow * 32 + 4 * u);
                    f32x4 rp = r_;
#pragma unroll
                    for (int hb = 0; hb < 2; ++hb) {
                        f32x4 vn[4];
#pragma unroll
                        for (int u = 0; u < 4; ++u) vn[u] = *(const LAS f32x4*)(sV + srow * 32 + ((16 * (hb + 1)) & 31) + 4 * u);
#pragma unroll
                        for (int u16 = 0; u16 < 16; ++u16) {
                            const int s = 16 * hb + u16;
                            const int sn = (s + 1) & 31;
                            const f32x4 a_n = *(const LAS f32x4*)(sA + sn * 64), w_n = *(const LAS f32x4*)(sW + sn * 64), b_n = *(const LAS f32x4*)(sB + sn * 64);
                            const f32x4 k_n = *(const LAS f32x4*)(sK + sn * 64), r_n = *(const LAS f32x4*)(sR + sn * 64);
                            const float v = vq[u16 >> 2][u16 & 3];
                            const f32x2 vv = {v, v};
                            f32x2 pp = S01 * (f32x2){a_[0], a_[1]}; pp = S23 * (f32x2){a_[2], a_[3]} + pp;
                            f32x2 yy = S01 * (f32x2){rp[0], rp[1]}; yy = S23 * (f32x2){rp[2], rp[3]} + yy;
                            float sa = pp[0] + pp[1], y = yy[0] + yy[1];
                            sa += dpp_f<0xB1>(sa); y += dpp_f<0xB1>(y);
                            sa += dpp_f<0x4E>(sa); y += dpp_f<0x4E>(y);
                            sa += dpp_f<0x141>(sa); y += dpp_f<0x141>(y);
                            sa += dpp_f<0x140>(sa); y += dpp_f<0x140>(y);
                            sY[((s - 1) & 31) * 16 + srow] = y;
                            const f32x2 sv = {sa, sa};
                            S01 = S01 * (f32x2){w_[0], w_[1]} + vv * (f32x2){k_[0], k_[1]};
                            S23 = S23 * (f32x2){w_[2], w_[3]} + vv * (f32x2){k_[2], k_[3]};
                            S01 = sv * (f32x2){b_[0], b_[1]} + S01;
                            S23 = sv * (f32x2){b_[2], b_[3]} + S23;
                            rp = r_;
                            a_ = a_n; w_ = w_n; b_ = b_n; k_ = k_n; r_ = r_n;
                        }
#pragma unroll
                        for (int u = 0; u < 4; ++u) vq[u] = vn[u];
                    }
                    { f32x2 yy = S01 * (f32x2){rp[0], rp[1]}; yy = S23 * (f32x2){rp[2], rp[3]} + yy; sY[31 * 16 + srow] = red16(yy[0] + yy[1]); }
                    __builtin_amdgcn_s_setprio(0);
                }
            } else {
                if (n + 1 < SEQ / 32) {
                    const int cn = n + 1;
                    const int sg = cn * 32 + s_l; const int t = dir ? (SEQ - 1 - sg) : sg;
                    f32x2 qr[4], qk[4]; float qv[8];
                    LAS h16* TWp = (LAS h16*)priv; LAS h16* QAp = TWp + 8 * 72;
                    { const h16x8 r8 = pr + mu_r8 * (qr_ - pr), k8 = pk + mu_k8 * (qk_ - pk), v8 = pv + mu_v8 * (qv_ - pv);
                      const h16x8 w8 = pw + mu_w8 * (qw_ - pw), a8 = pa + mu_a8 * (qa_ - pa);
                      h16x8 tw8;
#pragma unroll
                      for (int pi = 0; pi < 4; ++pi) { qr[pi] = (f32x2){(float)r8[2 * pi], (float)r8[2 * pi + 1]}; qk[pi] = (f32x2){(float)k8[2 * pi], (float)k8[2 * pi + 1]};
                          qv[2 * pi] = (float)v8[2 * pi]; qv[2 * pi + 1] = (float)v8[2 * pi + 1];
                          const f32x2 tx = (f32x2){(float)w8[2 * pi], (float)w8[2 * pi + 1]} * 2.8853900817779268f;
                          const f32x2 dn = (f32x2){__builtin_amdgcn_exp2f(tx[0]), __builtin_amdgcn_exp2f(tx[1])} + 1.f;
                          const f32x2 th = (f32x2){__builtin_amdgcn_rcpf(dn[0]), __builtin_amdgcn_rcpf(dn[1])} * -2.f + 1.f;
                          tw8[2 * pi] = (h16)th[0]; tw8[2 * pi + 1] = (h16)th[1]; }
                      *(LAS h16x8*)(TWp + s_sub * 72 + c8) = tw8; *(LAS h16x8*)(QAp + s_sub * 72 + c8) = a8; }
                    if (cn + 1 < SEQ / 32) SCAN_LOAD(cn + 1);
                    LDS_WAIT();
                    f32x4 accw[4], acca[4];
#pragma unroll
                    for (int ct = 0; ct < 4; ++ct) { accw[ct] = (f32x4){0.f, 0.f, 0.f, 0.f}; acca[ct] = (f32x4){0.f, 0.f, 0.f, 0.f}; }
#pragma unroll
                    for (int ks = 0; ks < 2; ++ks) {
                        const h16x8 atw = *(const LAS h16x8*)(TWp + (lane & 7) * 72 + 32 * ks + 8 * (lane >> 4));
                        const h16x8 aqa = *(const LAS h16x8*)(QAp + (lane & 7) * 72 + 32 * ks + 8 * (lane >> 4));
#pragma unroll
                        for (int ct = 0; ct < 4; ++ct) {
                            const h16x8 bw = *(const LAS h16x8*)(w2T + (16 * ct + (lane & 15)) * 72 + 32 * ks + 8 * (lane >> 4));
                            const h16x8 ba = *(const LAS h16x8*)(a2T + (16 * ct + (lane & 15)) * 72 + 32 * ks + 8 * (lane >> 4));
                            accw[ct] = __builtin_amdgcn_mfma_f32_16x16x32_f16(atw, bw, accw[ct], 0, 0, 0);
                            acca[ct] = __builtin_amdgcn_mfma_f32_16x16x32_f16(aqa, ba, acca[ct], 0, 0, 0);
                        }
                    }
                    LDS_WAIT();
                    { LAS float* Zd = (LAS float*)priv + (lane >> 5) * 512 + (4 * ((lane >> 4) & 1)) * 64 + (lane & 15);
#pragma unroll
                      for (int ct = 0; ct < 4; ++ct)
#pragma unroll
                          for (int r = 0; r < 4; ++r) Zd[r * 64 + 16 * ct] = (lane < 32) ? accw[ct][r] : acca[ct][r]; }
                    LDS_WAIT();
                    const LAS float* Zw = (const LAS float*)priv + s_sub * 64 + c8; const LAS float* Za = Zw + 512;
                    const f32x4 zw0 = *(const LAS f32x4*)Zw, zw1 = *(const LAS f32x4*)(Zw + 4), za0 = *(const LAS f32x4*)Za, za1 = *(const LAS f32x4*)(Za + 4);
                    LDS_WAIT();
                    f32x2 kk[4], av_[4], kp[4], dec[4], kn2 = {0.f, 0.f}, sb2 = {0.f, 0.f};
#pragma unroll
                    for (int pi = 0; pi < 4; ++pi) {
                        const f32x2 zw = (pi < 2 ? (f32x2){zw0[2 * pi], zw0[2 * pi + 1]} : (f32x2){zw1[2 * pi - 4], zw1[2 * pi - 3]}) + w0r[pi];
                        const f32x2 za = (pi < 2 ? (f32x2){za0[2 * pi], za0[2 * pi + 1]} : (f32x2){za1[2 * pi - 4], za1[2 * pi - 3]}) + a0r[pi];
                        const f32x2 tw_ = zw * -1.4426950408889634f, ta_ = za * -1.4426950408889634f;
                        const f32x2 dw = (f32x2){__builtin_amdgcn_exp2f(tw_[0]), __builtin_amdgcn_exp2f(tw_[1])} + 1.f, da = (f32x2){__builtin_amdgcn_exp2f(ta_[0]), __builtin_amdgcn_exp2f(ta_[1])} + 1.f;
                        const f32x2 sw = (f32x2){__builtin_amdgcn_rcpf(dw[0]), __builtin_amdgcn_rcpf(dw[1])} * -0.8750387749225136f;
                        dec[pi] = (f32x2){__builtin_amdgcn_exp2f(sw[0]), __builtin_amdgcn_exp2f(sw[1])};
                        av_[pi] = (f32x2){__builtin_amdgcn_rcpf(da[0]), __builtin_amdgcn_rcpf(da[1])};
                        kk[pi] = qk[pi] * kkr[pi]; kn2 = kk[pi] * kk[pi] + kn2;
                        kp[pi] = qk[pi] * (av_[pi] * kar[pi] + omk[pi]);
                        sb2 = (qr[pi] * kp[pi]) * rkr[pi] + sb2; }
                    const float kn = red8(kn2[0] + kn2[1]), sbn = red8(sb2[0] + sb2[1]);
                    const float ninv = -rsqrtf(fmaxf(kn, 1e-12f));
                    LAS float* dR = OPS + (cn & 1) * SET_F + s_l * 64 + c8;
#pragma unroll
                    for (int hf = 0; hf < 2; ++hf) {
                        const f32x2 na0 = kk[2 * hf] * ninv, na1 = kk[2 * hf + 1] * ninv;
                        const f32x2 nb0 = na0 * av_[2 * hf], nb1 = na1 * av_[2 * hf + 1];
                        *(LAS f32x4*)(dR + 4 * hf) = (f32x4){qr[2 * hf][0], qr[2 * hf][1], qr[2 * hf + 1][0], qr[2 * hf + 1][1]};
                        *(LAS f32x4*)(dR + 2048 + 4 * hf) = (f32x4){dec[2 * hf][0], dec[2 * hf][1], dec[2 * hf + 1][0], dec[2 * hf + 1][1]};
                        *(LAS f32x4*)(dR + 4096 + 4 * hf) = (f32x4){kp[2 * hf][0], kp[2 * hf][1], kp[2 * hf + 1][0], kp[2 * hf + 1][1]};
                        *(LAS f32x4*)(dR + 6144 + 4 * hf) = (f32x4){na0[0], na0[1], na1[0], na1[1]};
                        *(LAS f32x4*)(dR + 8192 + 4 * hf) = (f32x4){-nb0[0], -nb0[1], -nb1[0], -nb1[1]}; }
                    if ((c8 >> 4) == q) { LAS float* dV = OPS + (cn & 1) * SET_F + 10240 + (c8 & 15) * 32 + s_l;
#pragma unroll
                        for (int e = 0; e < 8; ++e) dV[e * 32] = qv[e]; }
                    if (q == 0 && (lane & 7) == 0) SB[(size_t)(b * SEQ + t) * 16 + h] = sbn;
                }
                if (n >= 1) SCAN_YSTORE(n - 1);
            }
            LDS_BAR();
        }
        if (wave >= 4) SCAN_YSTORE(SEQ / 32 - 1);
#undef SCAN_LOAD
#undef SCAN_YSTORE
    }
}

__device__ __forceinline__ void phase_post(const Params& p) {
    const int tid = threadIdx.x;
    const h16* Y0 = (const h16*)p.out; const h16* Y1 = (const h16*)((const unsigned char*)p.out + 32 * MiB);
    const h16* PC = (const h16*)(p.ws + WS_PC); h16* ZCD = (h16*)(p.ws + WS_ZCD);
    const float* SB0 = (const float*)(p.ws + WS_SBON); const float* SB1 = SB0 + (size_t)NTOK * 16;
    const float* mu0 = p.in[11] + 2048; const float* mu1 = p.in[11] + 3200 + 2048;
    const float* lg = p.in[19]; const float* lb = p.in[20];
    const int gt = blockIdx.x * 512 + tid, NGT = gridDim.x * 512;
    for (int idx = gt; idx < NTOK * 128; idx += NGT) {
        const int t = idx >> 7, c = (idx & 127) * 8, hh = c >> 6, tp = t & (SEQ - 1);
        const h16x8 y0 = *(const h16x8*)(Y0 + (size_t)t * 1024 + c), y1 = *(const h16x8*)(Y1 + (size_t)t * 1024 + c);
        const h16x8 z8 = {0, 0, 0, 0, 0, 0, 0, 0};
        const h16x8 v0 = *(const h16x8*)(PC + (size_t)t * 3200 + 2048 + c);
        const h16x8 vm = tp > 0 ? *(const h16x8*)(PC + (size_t)(t - 1) * 3200 + 2048 + c) : z8;
        const h16x8 vp = tp < SEQ - 1 ? *(const h16x8*)(PC + (size_t)(t + 1) * 3200 + 2048 + c) : z8;
        const h16x8 zc = *(const h16x8*)(ZCD + (size_t)t * 1536 + c);
        const float s0 = SB0[(size_t)t * 16 + hh], s1 = SB1[(size_t)t * 16 + hh];
        float y[8], s = 0.f;
#pragma unroll
        for (int e = 0; e < 8; ++e) { y[e] = (float)y0[e] + (float)y1[e]; s += y[e]; }
        const float mean = red8(s) * (1.f / 64.f); float q = 0.f;
#pragma unroll
        for (int e = 0; e < 8; ++e) { y[e] -= mean; q += y[e] * y[e]; }
        const float rs = rsqrtf(red8(q) * (1.f / 64.f) + 64e-5f);
        const f32x4 lg0 = *(const f32x4*)(lg + c), lg1 = *(const f32x4*)(lg + c + 4), lb0 = *(const f32x4*)(lb + c), lb1 = *(const f32x4*)(lb + c + 4);
        const f32x4 ma0 = *(const f32x4*)(mu0 + c), ma1 = *(const f32x4*)(mu0 + c + 4), mb0 = *(const f32x4*)(mu1 + c), mb1 = *(const f32x4*)(mu1 + c + 4);
        h16x8 o;
#pragma unroll
        for (int e = 0; e < 8; ++e) { const float vv = (float)v0[e];
            const float m0 = e < 4 ? ma0[e & 3] : ma1[e & 3], m1 = e < 4 ? mb0[e & 3] : mb1[e & 3], gg = e < 4 ? lg0[e & 3] : lg1[e & 3], bb = e < 4 ? lb0[e & 3] : lb1[e & 3];
            const float vd0 = vv + m0 * ((float)vm[e] - vv), vd1 = vv + m1 * ((float)vp[e] - vv);
            const float val = y[e] * rs * gg + bb + s0 * vd0 + s1 * vd1;
            o[e] = (h16)(val * silu_f((float)zc[e])); }
        *(h16x8*)(ZCD + (size_t)t * 1536 + c) = o;
    }
}

__device__ __forceinline__ void phase_final(const Params& p) {
    const int tid = threadIdx.x, lane = tid & 63, wave = tid >> 6;
    const int gw = blockIdx.x * 8 + wave, NGW = gridDim.x * 8;
    const float* g = p.in[23]; const h16* O1 = (const h16*)(p.ws + WS_O1); const h16* O2 = (const h16*)(p.ws + WS_O2);
    for (int r = gw; r < NTOK; r += NGW) {
        const float* xr = p.in[0] + (size_t)r * DM; float* orow = p.out + (size_t)r * DM; f32x4 v[4]; float ss = 0.f;
#pragma unroll
        for (int j = 0; j < 4; ++j) { v[j] = *(const f32x4*)(xr + 4 * lane + 256 * j);
            const h16x4 a = *(const h16x4*)(O1 + (size_t)r * DM + 4 * lane + 256 * j), b = *(const h16x4*)(O2 + (size_t)r * DM + 4 * lane + 256 * j);
#pragma unroll
            for (int e = 0; e < 4; ++e) v[j][e] += (float)a[e] + (float)b[e];
            ss += v[j][0] * v[j][0] + v[j][1] * v[j][1] + v[j][2] * v[j][2] + v[j][3] * v[j][3]; }
        const float rs = rsqrtf(wave_sum(ss) * (1.f / 1024.f) + 1e-6f);
#pragma unroll
        for (int j = 0; j < 4; ++j) { const f32x4 gg = *(const f32x4*)(g + 4 * lane + 256 * j); f32x4 o = v[j] * rs; o = o * gg; *(f32x4*)(orow + 4 * lane + 256 * j) = o; }
    }
}

__global__ void __launch_bounds__(512, 2) mega(Params p) {
    extern __shared__ __attribute__((aligned(16))) unsigned char smem[];
    LAS unsigned char* lds = (LAS unsigned char*)smem;
    cg::grid_group grid = cg::this_grid();
    unsigned char* ws = p.ws;
    const int lo = p.ph_lo, hi = p.ph_hi;
#define IN(k) (lo <= (k) && (k) < hi)
    volatile LAS unsigned* bst = (volatile LAS unsigned*)(lds + LDS_MAIN);
    if (threadIdx.x < 4) bst[threadIdx.x] = 0u;
    __syncthreads();
    const XcdBarrier bar = xcd_barrier_post((unsigned*)(ws + WS_BAR), bst);
    if (hi > 1000) grid.sync();
#define SEAM(k) do { if (IN(k) && IN((k) + 1)) { xcd_barrier(bar); if ((REPMASK >> 13) & 1) xcd_barrier(bar); } } while (0)
    if (IN(0)) for (int rep_ = 0; rep_ <= ((REPMASK >> 0) & 1); ++rep_) { phase0(p, lds); } SEAM(0);
    if (IN(1)) for (int rep_ = 0; rep_ <= ((REPMASK >> 1) & 1); ++rep_) { pg8::Gemm g{(const h16*)p.out, (const h16*)(ws + WS_W1T), NTOK, 7168, 1024}; pg8::StaticOrder S; S.init(NTOK, 7168, gridDim.x, blockIdx.x);
                 Epi1 E{(h16*)(ws + WS_XC), (h16*)(ws + WS_G), (h16*)(ws + WS_U), (h16*)(ws + WS_V), (float*)(ws + WS_STATS)}; pg8::gemm_phase<Epi1>(lds, g, S, E); } SEAM(1);
    if (IN(3)) for (int rep_ = 0; rep_ <= ((REPMASK >> 3) & 1); ++rep_) { phase_mix0(p, lds); } SEAM(3);
    if (IN(4)) for (int rep_ = 0; rep_ <= ((REPMASK >> 4) & 1); ++rep_) { pg8::Gemm g{(const h16*)(ws + WS_YCAT), (const h16*)(ws + WS_W2T), NTOK, 1024, 2048}; pg8::StaticOrder S; S.init(NTOK, 1024, gridDim.x, blockIdx.x);
                 Epi2 E{(h16*)(ws + WS_O1)}; pg8::gemm_phase<Epi2>(lds, g, S, E); } SEAM(4);
    if (IN(5)) for (int rep_ = 0; rep_ <= ((REPMASK >> 5) & 1); ++rep_) { phase_norm1(p); } SEAM(5);
    if (IN(6)) for (int rep_ = 0; rep_ <= ((REPMASK >> 6) & 1); ++rep_) { pg8::Gemm g{(const h16*)p.out, (const h16*)(ws + WS_W3T), NTOK, 5376, 1024}; pg8::StaticOrder S; S.init(NTOK, 5376, gridDim.x, blockIdx.x);
                 Epi3 E{(h16*)(ws + WS_PC), (h16*)(ws + WS_ZCD), (h16*)(ws + WS_FD)}; pg8::gemm_phase<Epi3>(lds, g, S, E); } SEAM(6);
    if (IN(7)) for (int rep_ = 0; rep_ <= ((REPMASK >> 7) & 1); ++rep_) { phase_fft(p, lds); }
    if (IN(8)) for (int rep_ = 0; rep_ <= ((REPMASK >> 8) & 1); ++rep_) { phase_scan(p, lds); } SEAM(8);
    if (IN(9)) for (int rep_ = 0; rep_ <= ((REPMASK >> 9) & 1); ++rep_) { phase_fnet_out(p); }
    if (IN(10)) for (int rep_ = 0; rep_ <= ((REPMASK >> 10) & 1); ++rep_) { phase_post(p); } SEAM(10);
    if (IN(11)) for (int rep_ = 0; rep_ <= ((REPMASK >> 11) & 1); ++rep_) { pg8::Gemm g{(const h16*)(ws + WS_ZCD), (const h16*)(ws + WS_W4T), NTOK, 1024, 1536}; pg8::StaticOrder S; S.init(NTOK, 1024, gridDim.x, blockIdx.x);
                  Epi4 E{(h16*)(ws + WS_O2)}; pg8::gemm_phase<Epi4>(lds, g, S, E); } SEAM(11);
    if (IN(12)) for (int rep_ = 0; rep_ <= ((REPMASK >> 12) & 1); ++rep_) { phase_final(p); }
}

extern "C" void kernel_launch(void* const* d_in, const int* in_sizes, int n_in, void* d_out, int out_size, void* d_ws, size_t ws_size, hipStream_t stream) {
    static int grid = 0;
    if (grid == 0) {
        int dev = 0, cus = 0, per_cu = 0;
        hipGetDevice(&dev);
        hipDeviceGetAttribute(&cus, hipDeviceAttributeMultiprocessorCount, dev);
        if (hipFuncSetAttribute((const void*)mega, hipFuncAttributeMaxDynamicSharedMemorySize, LDS_BYTES) != hipSuccess) fprintf(stderr, "kernel_launch: hipFuncSetAttribute failed\n");
        hipOccupancyMaxActiveBlocksPerMultiprocessor(&per_cu, (const void*)mega, 512, LDS_BYTES);
        if (per_cu < 1) { fprintf(stderr, "kernel_launch: occupancy query says %d blocks per CU\n", per_cu); per_cu = 1; }
        (void)hipGetLastError();
        grid = cus;
        if (grid < 64) grid = 64;
    }
    if (hipMemsetAsync((unsigned char*)d_ws + WS_BAR, 0, XCD_BAR_WORDS * 4, stream) != hipSuccess) fprintf(stderr, "kernel_launch: memset of the barrier words failed\n");
    Params p{};
    for (int i = 0; i < 24; ++i) p.in[i] = (const float*)d_in[i];
    p.out = (float*)d_out; p.ws = (unsigned char*)d_ws;
#if N_LAUNCH_MODE == 1
    p.ph_lo = 0; p.ph_hi = NPHASE;
    void* args[] = {&p};
    hipError_t e = hipLaunchCooperativeKernel((const void*)mega, dim3(grid), dim3(512), args, LDS_BYTES, stream);
    if (e != hipSuccess) fprintf(stderr, "kernel_launch: cooperative launch failed: %s (grid %d)\n", hipGetErrorString(e), grid);
#else
    for (int ph = 0; ph < NPHASE; ++ph) { p.ph_lo = ph; p.ph_hi = ph + 1; hipLaunchKernelGGL(mega, dim3(grid), dim3(512), LDS_BYTES, stream, p); }
#endif
}
```

```cpp
#include <hip/hip_runtime.h>
#include <hip/hip_cooperative_groups.h>
#include <cstdio>
#include <cstdint>
namespace cg = cooperative_groups;

#ifndef N_LAUNCH_MODE
#define N_LAUNCH_MODE 1
#endif

#ifndef REPMASK
#define REPMASK 0
#endif
#define LAS __attribute__((address_space(3)))
typedef _Float16 h16;
typedef _Float16 h16x8 __attribute__((ext_vector_type(8)));
typedef _Float16 h16x4 __attribute__((ext_vector_type(4)));
typedef float f32x2 __attribute__((ext_vector_type(2)));
typedef float f32x4 __attribute__((ext_vector_type(4)));
typedef float f32x16 __attribute__((ext_vector_type(16)));

constexpr int NTOK = 16384, DM = 1024, SEQ = 8192;
constexpr int LDS_MAIN = 131072;
constexpr int LDS_BYTES = LDS_MAIN + 16;
constexpr int NPHASE = 13;
constexpr size_t MiB = 1024 * 1024;
constexpr size_t WS_W1T = 0;
constexpr size_t WS_W2T = WS_W1T + (size_t)7168 * 1024 * 2;
constexpr size_t WS_W3T = WS_W2T + (size_t)1024 * 2048 * 2;
constexpr size_t WS_W4T = WS_W3T + (size_t)5376 * 1024 * 2;
constexpr size_t WS_STATS = 32 * MiB;
constexpr size_t WS_WSH = WS_STATS + 131072;
constexpr size_t WS_CWT = WS_WSH + 262144;
constexpr size_t WS_SBON = WS_CWT + 262144;
constexpr size_t WS_BAR = 35 * MiB;
constexpr size_t WS_XC = 36 * MiB, WS_G = 68 * MiB, WS_U = 100 * MiB, WS_V = 132 * MiB, WS_YCAT = 164 * MiB;
constexpr size_t WS_SPR = 0, WS_SPI = 232 * MiB;
constexpr size_t WS_O2 = 68 * MiB;
constexpr size_t WS_O1 = 36 * MiB, WS_PC = 68 * MiB, WS_ZCD = 168 * MiB, WS_FD = 216 * MiB;

namespace pg8 {
constexpr int BM = 256, BK = 64, HALF = 128, HTB = HALF * BK * 2, STAGE_BYTES = 8 * HTB, NXCD = 8, WGM = 8;
__host__ __device__ __forceinline__ int lds_byte(int r, int c) { const int st = (r >> 4) * 2 + (c >> 5), rr = r & 15, cc = c & 31, ob = rr * 64 + cc * 2; return st * 1024 + (ob ^ (((ob >> 9) & 1) << 5)); }
__host__ __device__ __forceinline__ void stage_rc(int b, int& R, int& C) { const int st = b / 1024, sb = b % 1024, swz = sb ^ (((sb >> 9) & 1) << 5); R = (st >> 1) * 16 + swz / 64; C = (st & 1) * 32 + (swz % 64) / 2; }
__host__ __device__ __forceinline__ int perm32(int rho) { const int n = rho >> 4, i = rho & 15; return 8 * (i >> 2) + 4 * n + (i & 3); }
struct Unit { int pm, pn; };
struct Gemm { const h16* A; const h16* Bt; int M, N, K; };
struct StaticOrder {
    int nM, nN, nwg, G, c;
    __host__ __device__ void init(int M, int N, int G_, int c_) { nM = M / BM; nN = N / BM; nwg = nM * nN; G = G_; c = c_; }
    __host__ __device__ bool next(int i, Unit& u) const {
        const long L = (long)i * G + c; if (L >= nwg) return false;
        int wgid = (int)L; { const int q = nwg / NXCD, r = nwg % NXCD, xcd = wgid % NXCD, off = wgid / NXCD; wgid = (xcd < r ? xcd * (q + 1) : r * (q + 1) + (xcd - r) * q) + off; }
        const int nig = WGM * nN, gid = wgid / nig, fm = gid * WGM, gsz = (nM - fm) < WGM ? (nM - fm) : WGM;
        u.pm = fm + ((wgid % nig) % gsz); u.pn = (wgid % nig) / gsz; return true;
    }
};
template <class Epi>
__device__ __forceinline__ void gemm_phase(LAS unsigned char* lds, const Gemm g, const StaticOrder& S, const Epi& E) {
    const int tid = threadIdx.x, wid = __builtin_amdgcn_readfirstlane(tid >> 6), lane = tid & 63, wr = wid >> 2, wc = wid & 3, fr = lane & 15, fq = lane >> 4;
    const int K = g.K, nt = K / BK;
    unsigned voffA[2], voffB[2];
#pragma unroll
    for (int i = 0; i < 2; ++i) { int R, C; stage_rc(tid * 16 + i * 8192, R, C); const int Rb = Epi::PERM ? ((R & ~31) + perm32(R & 31)) : R; voffA[i] = (unsigned)(R * K + C) * 2u; voffB[i] = (unsigned)(Rb * K + C) * 2u; }
    const size_t kstep = (size_t)(BK * 2);
    const size_t hstep = (size_t)HALF * K * 2;
    const size_t tstep = 2 * hstep;
    const unsigned ldsw = (unsigned)wid * 1024u;
    const int aoff = lds_byte(wr * 64 + fr, fq * 8), boff = lds_byte(wc * 32 + fr, fq * 8);
#define PG8_SA(b, h) (((b) * 2 + (h)) * HTB)
#define PG8_SB(b, h) ((4 + (b) * 2 + (h)) * HTB)
#define PG8_STAGE(bufoff, gbase, voff) do { _Pragma("unroll") for (int _i = 0; _i < 2; ++_i) \
        __builtin_amdgcn_global_load_lds((const unsigned*)((const char*)(gbase) + (voff)[_i]), (LAS unsigned*)(lds + (bufoff) + ldsw + _i * 8192), 16, 0, 0); } while (0)
#define PG8_LDA(dst, b, h) do { _Pragma("unroll") for (int m = 0; m < 4; ++m) _Pragma("unroll") for (int k = 0; k < 2; ++k) dst[m][k] = *(const LAS h16x8*)(lds + PG8_SA(b, h) + aoff + m * 2048 + k * 1024); } while (0)
#define PG8_LDB(dst, b, h) do { _Pragma("unroll") for (int n = 0; n < 2; ++n) _Pragma("unroll") for (int k = 0; k < 2; ++k) dst[n][k] = *(const LAS h16x8*)(lds + PG8_SB(b, h) + boff + n * 2048 + k * 1024); } while (0)
#define PG8_MMA(ai, bj, At, Bt) do { __builtin_amdgcn_s_setprio(1); _Pragma("unroll") for (int m = 0; m < 4; ++m) _Pragma("unroll") for (int n = 0; n < 2; ++n) _Pragma("unroll") for (int k = 0; k < 2; ++k) \
        acc[ai][bj][m][n] = __builtin_amdgcn_mfma_f32_16x16x32_f16(Bt[n][k], At[m][k], acc[ai][bj][m][n], 0, 0, 0); __builtin_amdgcn_s_setprio(0); } while (0)
#define PG8_WAIT_V(n) asm volatile("s_waitcnt vmcnt(" #n ")" ::: "memory")
#define PG8_WAIT_L(n) asm volatile("s_waitcnt lgkmcnt(" #n ")" ::: "memory")
#define PG8_BAR __builtin_amdgcn_s_barrier()
#define PG8_SCHED __builtin_amdgcn_sched_barrier(0)
    Unit cur, nxt; int ui = 0;
    if (!S.next(0, cur)) return;
    f32x4 acc[2][2][4][2];
#pragma unroll
    for (int a = 0; a < 2; ++a)
#pragma unroll
        for (int b = 0; b < 2; ++b)
#pragma unroll
            for (int m = 0; m < 4; ++m)
#pragma unroll
                for (int n = 0; n < 2; ++n) acc[a][b][m][n] = (f32x4){0.f, 0.f, 0.f, 0.f};
    h16x8 At[4][2], B0[2][2], B1[2][2];
    const char* cA = (const char*)g.A + (size_t)cur.pm * tstep; const char* cB = (const char*)g.Bt + (size_t)cur.pn * tstep;
    PG8_STAGE(PG8_SB(0, 0), cB, voffB); PG8_STAGE(PG8_SA(0, 0), cA, voffA); PG8_STAGE(PG8_SB(0, 1), cB + hstep, voffB); PG8_STAGE(PG8_SA(0, 1), cA + hstep, voffA);
    if (wr == 1) PG8_BAR;
    PG8_WAIT_V(4); PG8_BAR;
    PG8_STAGE(PG8_SB(1, 0), cB + kstep, voffB); PG8_STAGE(PG8_SA(1, 0), cA + kstep, voffA); PG8_STAGE(PG8_SB(1, 1), cB + hstep + kstep, voffB);
    PG8_WAIT_V(6); PG8_BAR;
    for (;;) {
        const bool has_next = S.next(ui + 1, nxt);
        const char* nA = has_next ? (const char*)g.A + (size_t)nxt.pm * tstep : cA; const char* nB = has_next ? (const char*)g.Bt + (size_t)nxt.pn * tstep : cB;
        for (int t = 0; t < nt; t += 2) {
            const bool last = (t == nt - 2);
            const char* a1 = cA + (size_t)(t + 1) * kstep;
            const char* a2 = last ? nA : cA + (size_t)(t + 2) * kstep; const char* b2 = last ? nB : cB + (size_t)(t + 2) * kstep;
            const char* a3 = a2 + kstep; const char* b3 = b2 + kstep;
            PG8_LDB(B0, 0, 0); PG8_SCHED; PG8_LDA(At, 0, 0); PG8_STAGE(PG8_SA(1, 1), a1 + hstep, voffA);
            PG8_WAIT_L(8); PG8_BAR; PG8_WAIT_L(0); PG8_MMA(0, 0, At, B0); PG8_BAR; PG8_SCHED;
            PG8_LDB(B1, 0, 1); PG8_STAGE(PG8_SB(0, 0), b2, voffB);
            PG8_BAR; PG8_WAIT_L(0); PG8_MMA(0, 1, At, B1); PG8_BAR;
            PG8_LDA(At, 0, 1); PG8_STAGE(PG8_SA(0, 0), a2, voffA);
            PG8_BAR; PG8_WAIT_L(0); PG8_MMA(1, 0, At, B0); PG8_BAR; PG8_SCHED;
            PG8_STAGE(PG8_SB(0, 1), b2 + hstep, voffB);
            PG8_WAIT_V(6); PG8_BAR; PG8_MMA(1, 1, At, B1); PG8_BAR;
            PG8_LDB(B0, 1, 0); PG8_SCHED; PG8_LDA(At, 1, 0); PG8_STAGE(PG8_SA(0, 1), a2 + hstep, voffA);
            PG8_WAIT_L(8); PG8_BAR; PG8_WAIT_L(0); PG8_MMA(0, 0, At, B0); PG8_BAR; PG8_SCHED;
            PG8_LDB(B1, 1, 1); PG8_STAGE(PG8_SB(1, 0), b3, voffB);
            PG8_BAR; PG8_WAIT_L(0); PG8_MMA(0, 1, At, B1); PG8_BAR;
            PG8_LDA(At, 1, 1); PG8_STAGE(PG8_SA(1, 0), a3, voffA);
            PG8_BAR; PG8_WAIT_L(0); PG8_MMA(1, 0, At, B0); PG8_BAR; PG8_SCHED;
            PG8_STAGE(PG8_SB(1, 1), b3 + hstep, voffB);
            PG8_WAIT_V(6); PG8_BAR; PG8_MMA(1, 1, At, B1); PG8_BAR;
        }
        E(acc, cur, wr, wc, fr, fq);
        if (!has_next) break;
#pragma unroll
        for (int a = 0; a < 2; ++a)
#pragma unroll
            for (int b = 0; b < 2; ++b)
#pragma unroll
                for (int m = 0; m < 4; ++m)
#pragma unroll
                    for (int n = 0; n < 2; ++n) acc[a][b][m][n] = (f32x4){0.f, 0.f, 0.f, 0.f};
        cur = nxt; cA = nA; cB = nB; ++ui;
    }
    PG8_WAIT_V(0);
    if (wr == 0) PG8_BAR;
    PG8_BAR;
#undef PG8_SA
#undef PG8_SB
#undef PG8_STAGE
#undef PG8_LDA
#undef PG8_LDB
#undef PG8_MMA
#undef PG8_WAIT_V
#undef PG8_WAIT_L
#undef PG8_BAR
#undef PG8_SCHED
}
}


#define XB_TMO      128
#define XB_XCNT(j)  (256  + 64 * (j))
#define XB_XSUB(j)  (1280 + 64 * (j))
#define XB_XGEN(j)  (2304 + 64 * (j))
#define XB_TOP      3328
#define XB_TOPGEN   3392
#define XCD_BAR_WORDS 3456
#define XB_SPIN_CAP (1u << 18)
__device__ __forceinline__ unsigned xb_ld(unsigned* p)              { return __hip_atomic_load(p, __ATOMIC_RELAXED, __HIP_MEMORY_SCOPE_AGENT); }
__device__ __forceinline__ unsigned xb_add(unsigned* p, unsigned v) { return __hip_atomic_fetch_add(p, v, __ATOMIC_RELAXED, __HIP_MEMORY_SCOPE_AGENT); }
__device__ __forceinline__ unsigned xb_xcc_id() { return (unsigned)__builtin_amdgcn_s_getreg((3 << 11) | 20) & 0xFu; }
#define XB_SPIN(cond, bar) do { unsigned _sp = 0; while (cond) { __builtin_amdgcn_s_sleep(1); \
    if ((++_sp & 255u) == 0u) { if (xb_ld(&(bar)[XB_TMO])) break; if (_sp > XB_SPIN_CAP) { atomicAdd(&(bar)[XB_TMO], 1u); break; } } } } while (0)
struct XcdBarrier { unsigned* bar; unsigned x; volatile LAS unsigned* st; };
__device__ __forceinline__ XcdBarrier xcd_barrier_post(unsigned* bar, volatile LAS unsigned* st) {
    XcdBarrier b; b.bar = bar; b.x = xb_xcc_id(); b.st = st;
    if (threadIdx.x == 0) (void)xb_add(&bar[XB_XCNT(b.x)], 1u);
    return b;
}
__device__ __forceinline__ void xcd_barrier_complete(unsigned* bar, unsigned x, unsigned& nloc, unsigned& nx) {
    const unsigned G = gridDim.x * gridDim.y * gridDim.z;
    unsigned sum, cnt, mine, sp = 0u;
    for (;;) {
        sum = 0u; cnt = 0u; mine = 0u;
#pragma unroll
        for (unsigned j = 0; j < 16; ++j) { const unsigned c = xb_ld(&bar[XB_XCNT(j)]); sum += c; cnt += (c > 0u) ? 1u : 0u; mine = (j == x) ? c : mine; }
        if (sum == G) break;
        __builtin_amdgcn_s_sleep(1);
        if ((++sp & 255u) == 0u) { if (xb_ld(&bar[XB_TMO])) break; if (sp > XB_SPIN_CAP) { atomicAdd(&bar[XB_TMO], 1u); break; } }
    }
    nloc = mine > 0u ? mine : 1u; nx = cnt > 0u ? cnt : 1u;
}
__device__ __forceinline__ void xcd_barrier(const XcdBarrier& b) {
    asm volatile("s_waitcnt vmcnt(0)" ::: "memory");
    __syncthreads();
    if (threadIdx.x == 0) {
        unsigned* bar = b.bar;
        __builtin_amdgcn_s_waitcnt(0);
        unsigned nloc = b.st[0], nx = b.st[1];
        if (nloc == 0u) { xcd_barrier_complete(bar, b.x, nloc, nx); b.st[0] = nloc; b.st[1] = nx; }
        const unsigned old = xb_add(&bar[XB_XSUB(b.x)], 1u);
        const unsigned gen = old / nloc;
        if (old + 1u == (gen + 1u) * nloc) {
            __builtin_amdgcn_fence(__ATOMIC_RELEASE, "agent");
            asm volatile("s_waitcnt vmcnt(0)" ::: "memory");
            const unsigned og = xb_add(&bar[XB_TOP], 1u);
            const unsigned tg = og / nx;
            if (og + 1u == (tg + 1u) * nx) xb_add(&bar[XB_TOPGEN], 1u);
            else XB_SPIN(xb_ld(&bar[XB_TOPGEN]) == tg, bar);
            __builtin_amdgcn_fence(__ATOMIC_ACQUIRE, "agent");
            xb_add(&bar[XB_XGEN(b.x)], 1u);
            asm volatile("s_waitcnt vmcnt(0)" ::: "memory");
        } else {
            XB_SPIN(xb_ld(&bar[XB_XGEN(b.x)]) == gen, bar);
            __builtin_amdgcn_fence(__ATOMIC_ACQUIRE, "agent");
            asm volatile("s_waitcnt vmcnt(0)" ::: "memory");
        }
    }
    __syncthreads();
}

struct Params { const float* in[24]; float* out; unsigned char* ws; int ph_lo, ph_hi; };

__device__ __forceinline__ float silu_f(float x) { return x * __builtin_amdgcn_rcpf(1.f + __expf(-x)); }
__device__ __forceinline__ float sigmoid_f(float x) { return __builtin_amdgcn_rcpf(1.f + __expf(-x)); }
__device__ __forceinline__ float tanh_f(float x) { return 1.f - 2.f * __builtin_amdgcn_rcpf(__expf(2.f * x) + 1.f); }
__device__ __forceinline__ float wave_sum(float v) {
#pragma unroll
    for (int o = 1; o < 64; o <<= 1) v += __shfl_xor(v, o);
    return v;
}
template <int CTRL> __device__ __forceinline__ float dpp_f(float x) { return __int_as_float(__builtin_amdgcn_update_dpp(0, __float_as_int(x), CTRL, 0xf, 0xf, false)); }
__device__ __forceinline__ float red8(float x) {
    x += dpp_f<0xB1>(x); x += dpp_f<0x4E>(x); x += dpp_f<0x141>(x); return x;
}
__device__ __forceinline__ float red16(float x) {
    x += dpp_f<0xB1>(x); x += dpp_f<0x4E>(x); x += dpp_f<0x141>(x); x += dpp_f<0x140>(x); return x;
}

__device__ __forceinline__ int sigma1(int np) {
    const int T = np >> 8, c = np & 255;
    if (T < 16) { const int bj = c >> 7, wc = (c >> 5) & 3, n = (c >> 4) & 1, r = c & 15; return 1024 * (2 * bj + n) + 64 * T + 16 * wc + r; }
    if (T < 24) { return ((c >> 7) ? 6144 : 4096) + 128 * (T - 16) + (c & 127); }
    return 5120 + 256 * (T - 24) + c;
}

template <int MODE>
__device__ __forceinline__ void tr_item(const float* W, int K, int N, h16* WT, LAS float* scr, int item, int nblk, int lane) {
    const int kb = item / nblk, nb = item % nblk, k0 = 64 * kb, n0 = 32 * nb;
    const int np = n0 + (lane & 31);
    const int sc = (MODE == 1) ? sigma1(np) : np;
    const bool valid = (MODE != 2) || (np < 5248);
    float wv_[32];
#pragma unroll
    for (int i = 0; i < 32; ++i) { const int kk = 2 * i + (lane >> 5); wv_[i] = valid ? W[(size_t)(k0 + kk) * N + sc] : 0.f; }
#pragma unroll
    for (int i = 0; i < 32; ++i) { const int kk = 2 * i + (lane >> 5); scr[kk * 33 + (lane & 31)] = wv_[i]; }
    asm volatile("s_waitcnt lgkmcnt(0)" ::: "memory");
    const int c = lane & 7;
#pragma unroll
    for (int j = 0; j < 4; ++j) { const int n = (lane >> 3) + 8 * j; const LAS float* s = scr + (8 * c) * 33 + n;
        h16x8 o;
#pragma unroll
        for (int e = 0; e < 8; ++e) o[e] = (h16)s[e * 33];
        *(h16x8*)(WT + (size_t)(n0 + n) * K + k0 + 8 * c) = o; }
    asm volatile("s_waitcnt lgkmcnt(0)" ::: "memory");
}

__device__ __forceinline__ void rms_rows2_f16(const float* x0, const float* x1, const h16* ad0, const h16* ad1, const float* g, h16* or0, h16* or1, int lane) {
    f32x4 v[2][4]; h16x4 a[2][4]; float ss[2] = {0.f, 0.f};
#pragma unroll
    for (int j = 0; j < 4; ++j) { v[0][j] = *(const f32x4*)(x0 + 4 * lane + 256 * j); v[1][j] = *(const f32x4*)(x1 + 4 * lane + 256 * j);
        if (ad0) { a[0][j] = *(const h16x4*)(ad0 + 4 * lane + 256 * j); a[1][j] = *(const h16x4*)(ad1 + 4 * lane + 256 * j); } }
#pragma unroll
    for (int u = 0; u < 2; ++u)
#pragma unroll
        for (int j = 0; j < 4; ++j) {
            if (ad0) { v[u][j][0] += (float)a[u][j][0]; v[u][j][1] += (float)a[u][j][1]; v[u][j][2] += (float)a[u][j][2]; v[u][j][3] += (float)a[u][j][3]; }
            ss[u] += v[u][j][0] * v[u][j][0] + v[u][j][1] * v[u][j][1] + v[u][j][2] * v[u][j][2] + v[u][j][3] * v[u][j][3]; }
#pragma unroll
    for (int o = 1; o < 64; o <<= 1) { ss[0] += __shfl_xor(ss[0], o); ss[1] += __shfl_xor(ss[1], o); }
    const float rs0 = rsqrtf(ss[0] * (1.f / 1024.f) + 1e-6f), rs1 = rsqrtf(ss[1] * (1.f / 1024.f) + 1e-6f);
#pragma unroll
    for (int j = 0; j < 4; ++j) { const f32x4 gg = *(const f32x4*)(g + 4 * lane + 256 * j); h16x4 o0, o1;
#pragma unroll
        for (int e = 0; e < 4; ++e) { o0[e] = (h16)(v[0][j][e] * rs0 * gg[e]); o1[e] = (h16)(v[1][j][e] * rs1 * gg[e]); }
        *(h16x4*)(or0 + 4 * lane + 256 * j) = o0; *(h16x4*)(or1 + 4 * lane + 256 * j) = o1; }
}

__device__ __forceinline__ void phase0(const Params& p, LAS unsigned char* lds) {
    const int tid = threadIdx.x, lane = tid & 63, wave = tid >> 6;
    const int gw = blockIdx.x * 8 + wave, NGW = gridDim.x * 8;
    LAS float* scr = (LAS float*)(lds + wave * 8448);
    h16* W1T = (h16*)(p.ws + WS_W1T); h16* W2T = (h16*)(p.ws + WS_W2T); h16* W3T = (h16*)(p.ws + WS_W3T); h16* W4T = (h16*)(p.ws + WS_W4T);
    constexpr int I1 = 16 * 224, I2 = 32 * 32, I3 = 16 * 168, I4 = 24 * 32;
    for (int it = gw; it < I1 + I2 + I3 + I4; it += NGW) {
        int r = it;
        if (r < I1) { tr_item<1>(p.in[2], 1024, 7168, W1T, scr, r, 224, lane); continue; } r -= I1;
        if (r < I2) { tr_item<0>(p.in[8], 2048, 1024, W2T, scr, r, 32, lane); continue; } r -= I2;
        if (r < I3) { tr_item<2>(p.in[10], 1024, 5248, W3T, scr, r, 168, lane); continue; } r -= I3;
        tr_item<0>(p.in[22], 1536, 1024, W4T, scr, r, 32, lane);
    }
    h16* H0 = (h16*)p.out;
    for (int r = gw; r < NTOK; r += 2 * NGW) { const int r1 = (r + NGW < NTOK) ? r + NGW : r;
        rms_rows2_f16(p.in[0] + (size_t)r * DM, p.in[0] + (size_t)r1 * DM, nullptr, nullptr, p.in[1], H0 + (size_t)r * DM, H0 + (size_t)r1 * DM, lane); }
    const int gt = blockIdx.x * 512 + tid, NGT = gridDim.x * 512;
    h16* WSH = (h16*)(p.ws + WS_WSH);
    for (int i = gt; i < 8 * 128 * 128; i += NGT) WSH[i] = (h16)p.in[6][i];
    { float* STZ = (float*)(p.ws + WS_STATS); for (int i = gt; i < 2 * NTOK; i += NGT) STZ[i] = 0.f; }
    h16* CWT = (h16*)(p.ws + WS_CWT);
    const float* wf = p.in[21];
    for (int i = gt; i < 4 * 128 * 256; i += NGT) {
        const int k = i & 255, e = (i >> 8) & 127, g = i >> 15, d = k & 127; const bool sn = k >= 128;
        float s = 0.f;
        for (int dp = 0; dp < 128; ++dp) { const float fr = (float)((d * dp) & 127) * (1.f / 128.f);
            const float tw = sn ? __builtin_amdgcn_sinf(fr) : __builtin_amdgcn_cosf(fr);
            s += tw * wf[(g * 128 + dp) * 128 + e]; }
        CWT[i] = (h16)(s * 0.08838834764831845f);
    }
}

struct Epi1 {
    static constexpr bool PERM = false;
    h16 *XC, *G, *U, *V; float* st;
    __device__ __forceinline__ void operator()(const f32x4 (&acc)[2][2][4][2], const pg8::Unit& u, int wr, int wc, int fr, int fq) const {
        const int T = u.pn; const int row0 = u.pm * 256 + wr * 64 + fr;
        if (T < 16) {
            const int ch = 64 * T + 16 * wc + 4 * fq;
#pragma unroll
            for (int ai = 0; ai < 2; ++ai)
#pragma unroll
                for (int m = 0; m < 4; ++m) { const size_t r = (size_t)(row0 + ai * 128 + m * 16);
                    const f32x4 xa = acc[ai][0][m][0], ba = acc[ai][0][m][1], ca = acc[ai][1][m][0], za = acc[ai][1][m][1];
                    h16x4 xc, gg;
#pragma unroll
                    for (int e = 0; e < 4; ++e) { xc[e] = (h16)(ca[e] * xa[e]); gg[e] = (h16)(ba[e] * silu_f(za[e])); }
                    *(h16x4*)(XC + r * 1024 + ch) = xc; *(h16x4*)(G + r * 1024 + ch) = gg; }
        } else if (T < 24) {
#pragma unroll
            for (int ai = 0; ai < 2; ++ai)
#pragma unroll
                for (int m = 0; m < 4; ++m) { const size_t r = (size_t)(row0 + ai * 128 + m * 16);
#pragma unroll
                    for (int n = 0; n < 2; ++n) { const int ch = 128 * (T - 16) + 32 * wc + 16 * n + 4 * fq;
                        const f32x4 ub = acc[ai][0][m][n], zb = acc[ai][1][m][n]; h16x4 o;
#pragma unroll
                        for (int e = 0; e < 4; ++e) o[e] = (h16)(ub[e] * silu_f(zb[e]));
                        *(h16x4*)(U + r * 1024 + ch) = o; } }
        } else {
#pragma unroll
            for (int ai = 0; ai < 2; ++ai)
#pragma unroll
                for (int m = 0; m < 4; ++m) { const size_t r = (size_t)(row0 + ai * 128 + m * 16); float s1 = 0.f, s2 = 0.f;
#pragma unroll
                    for (int bj = 0; bj < 2; ++bj)
#pragma unroll
                        for (int n = 0; n < 2; ++n) { const int ch = 256 * (T - 24) + 128 * bj + 32 * wc + 16 * n + 4 * fq;
                            const f32x4 v = acc[ai][bj][m][n]; h16x4 o;
#pragma unroll
                            for (int e = 0; e < 4; ++e) { o[e] = (h16)v[e]; const float f = (float)o[e]; s1 += f; s2 += f * f; }
                            *(h16x4*)(V + r * 1024 + ch) = o; }
                    s1 += __shfl_xor(s1, 16); s2 += __shfl_xor(s2, 16); s1 += __shfl_xor(s1, 32); s2 += __shfl_xor(s2, 32);
                    if (fq == 0) { atomicAdd(st + 2 * r, s1); atomicAdd(st + 2 * r + 1, s2); } }
        }
    }
};
struct Epi2 {
    static constexpr bool PERM = true;
    h16* O1;
    __device__ __forceinline__ void operator()(const f32x4 (&acc)[2][2][4][2], const pg8::Unit& u, int wr, int wc, int fr, int fq) const {
        const int row0 = u.pm * 256 + wr * 64 + fr, col0 = u.pn * 256 + wc * 32 + 8 * fq;
#pragma unroll
        for (int ai = 0; ai < 2; ++ai)
#pragma unroll
            for (int m = 0; m < 4; ++m) { const size_t r = (size_t)(row0 + ai * 128 + m * 16);
#pragma unroll
                for (int bj = 0; bj < 2; ++bj) { const f32x4 v0 = acc[ai][bj][m][0], v1 = acc[ai][bj][m][1]; h16x8 o;
#pragma unroll
                    for (int e = 0; e < 4; ++e) { o[e] = (h16)v0[e]; o[4 + e] = (h16)v1[e]; }
                    *(h16x8*)(O1 + r * 1024 + col0 + bj * 128) = o; } }
    }
};
struct Epi3 {
    static constexpr bool PERM = true;
    h16 *PC, *ZCD, *FD;
    __device__ __forceinline__ void operator()(const f32x4 (&acc)[2][2][4][2], const pg8::Unit& u, int wr, int wc, int fr, int fq) const {
        const int row0 = u.pm * 256 + wr * 64 + fr, col0 = u.pn * 256 + wc * 32 + 8 * fq;
#pragma unroll
        for (int bj = 0; bj < 2; ++bj) { const int c = col0 + bj * 128;
            h16* base; size_t ld;
            if (c < 3200) { base = PC + c; ld = 3200; }
            else if (c < 4224) { base = ZCD + (c - 3200); ld = 1536; }
            else if (c < 4736) { base = FD + (c - 4224); ld = 512; }
            else if (c < 5248) { base = ZCD + 1024 + (c - 4736); ld = 1536; }
            else continue;
#pragma unroll
            for (int ai = 0; ai < 2; ++ai)
#pragma unroll
                for (int m = 0; m < 4; ++m) { const size_t r = (size_t)(row0 + ai * 128 + m * 16); const f32x4 v0 = acc[ai][bj][m][0], v1 = acc[ai][bj][m][1]; h16x8 o;
#pragma unroll
                    for (int e = 0; e < 4; ++e) { o[e] = (h16)v0[e]; o[4 + e] = (h16)v1[e]; }
                    *(h16x8*)(base + r * ld) = o; } }
    }
};
struct Epi4 {
    static constexpr bool PERM = true;
    h16* O2;
    __device__ __forceinline__ void operator()(const f32x4 (&acc)[2][2][4][2], const pg8::Unit& u, int wr, int wc, int fr, int fq) const {
        const int row0 = u.pm * 256 + wr * 64 + fr, col0 = u.pn * 256 + wc * 32 + 8 * fq;
#pragma unroll
        for (int ai = 0; ai < 2; ++ai)
#pragma unroll
            for (int m = 0; m < 4; ++m) { const size_t r = (size_t)(row0 + ai * 128 + m * 16);
#pragma unroll
                for (int bj = 0; bj < 2; ++bj) { const f32x4 v0 = acc[ai][bj][m][0], v1 = acc[ai][bj][m][1]; h16x8 o;
#pragma unroll
                    for (int e = 0; e < 4; ++e) { o[e] = (h16)v0[e]; o[4 + e] = (h16)v1[e]; }
                    *(h16x8*)(O2 + r * 1024 + col0 + bj * 128) = o; } }
    }
};

__device__ __forceinline__ void phase_stats(const Params& p) {
    const int tid = threadIdx.x, lane = tid & 63, wave = tid >> 6;
    const int gw = blockIdx.x * 8 + wave, NGW = gridDim.x * 8;
    const h16* V = (const h16*)(p.ws + WS_V); float* ST = (float*)(p.ws + WS_STATS);
    for (int r = gw; r < NTOK; r += NGW) {
        const h16x8 a = *(const h16x8*)(V + (size_t)r * 1024 + 8 * lane), b = *(const h16x8*)(V + (size_t)r * 1024 + 512 + 8 * lane);
        float s = 0.f;
#pragma unroll
        for (int e = 0; e < 8; ++e) s += (float)a[e] + (float)b[e];
        const float mu = wave_sum(s) * (1.f / 1024.f); float q = 0.f;
#pragma unroll
        for (int e = 0; e < 8; ++e) { const float x = (float)a[e] - mu, y = (float)b[e] - mu; q += x * x + y * y; }
        const float rs = rsqrtf(wave_sum(q) * (1.f / 1024.f) + 1e-5f);
        if (lane == 0) { ST[2 * r] = mu; ST[2 * r + 1] = rs; }
    }
}

__device__ __forceinline__ void phase_mix0(const Params& p, LAS unsigned char* lds) {
    const int tid = threadIdx.x, lane = tid & 63, wave = tid >> 6;
    const h16* XC = (const h16*)(p.ws + WS_XC); const h16* G = (const h16*)(p.ws + WS_G); const h16* U = (const h16*)(p.ws + WS_U); const h16* V = (const h16*)(p.ws + WS_V);
    h16* YC = (h16*)(p.ws + WS_YCAT);
    const float* cw = p.in[3];
    const int gt = blockIdx.x * 512 + tid, NGT = gridDim.x * 512;
    for (int idx0 = gt; idx0 < NTOK * 128; idx0 += 2 * NGT) {
        h16x8 x0[2], xm[2], xp[2], gg[2]; int tt[2], cc[2];
        const h16x8 zero = {0, 0, 0, 0, 0, 0, 0, 0};
#pragma unroll
        for (int u = 0; u < 2; ++u) { const int idx = (idx0 + u * NGT < NTOK * 128) ? idx0 + u * NGT : idx0; const int t = idx >> 7, c8 = (idx & 127) * 8, tp = t & (SEQ - 1); tt[u] = t; cc[u] = c8;
            x0[u] = *(const h16x8*)(XC + (size_t)t * 1024 + c8);
            xm[u] = tp > 0 ? *(const h16x8*)(XC + (size_t)(t - 1) * 1024 + c8) : zero;
            xp[u] = tp < SEQ - 1 ? *(const h16x8*)(XC + (size_t)(t + 1) * 1024 + c8) : zero;
            gg[u] = *(const h16x8*)(G + (size_t)t * 1024 + c8); }
#pragma unroll
        for (int u = 0; u < 2; ++u) { const int c8 = cc[u]; h16x8 o;
#pragma unroll
            for (int e = 0; e < 8; ++e) { const float y = cw[c8 + e] * (float)xm[u][e] + cw[1024 + c8 + e] * (float)x0[u][e] + cw[2048 + c8 + e] * (float)xp[u][e]; o[e] = (h16)(y * (float)gg[u][e]); }
            *(h16x8*)(YC + (size_t)tt[u] * 2048 + c8) = o; }
    }
    const float* ST = (const float*)(p.ws + WS_STATS); const h16* WSH = (const h16*)(p.ws + WS_WSH);
    const float* lng = p.in[4]; const float* lnb = p.in[5]; const float* bs = p.in[7];
    LAS h16* vnT = (LAS h16*)lds;
    for (int it = blockIdx.x; it < 1024; it += gridDim.x) {
        const int g = it & 7, bn = it >> 3, t0 = bn * 128;
        __syncthreads();
#pragma unroll
        for (int q = 0; q < 4; ++q) { const int pc = tid + 512 * q, j = pc >> 4, d8 = (pc & 15) * 8;
            const h16x8 v = *(const h16x8*)(V + (size_t)(t0 + j) * 1024 + g * 128 + d8);
            const float mu = ST[2 * (t0 + j)] * (1.f / 1024.f), rs = rsqrtf(fmaxf(ST[2 * (t0 + j) + 1] * (1.f / 1024.f) - mu * mu, 0.f) + 1e-5f);
#pragma unroll
            for (int e = 0; e < 8; ++e) vnT[(d8 + e) * 136 + ((((j >> 3) ^ (pc & 15)) << 3) | (j & 7))] = (h16)(((float)v[e] - mu) * rs * lng[g * 128 + d8 + e] + lnb[g * 128 + d8 + e]); }
        __syncthreads();
        const int itile = wave >> 1, dt0 = (wave & 1) * 2;
        f32x16 acc0, acc1;
#pragma unroll
        for (int e = 0; e < 16; ++e) { acc0[e] = 0.f; acc1[e] = 0.f; }
        const h16* Arow = WSH + ((size_t)g * 128 + itile * 32 + (lane & 31)) * 128 + 8 * (lane >> 5);
        const int d0_ = dt0 * 32 + (lane & 31), d1_ = d0_ + 32;
        const LAS h16* B0p = vnT + d0_ * 136; const LAS h16* B1p = vnT + d1_ * 136;
#pragma unroll
        for (int ks = 0; ks < 8; ++ks) {
            const h16x8 a = *(const h16x8*)(Arow + 16 * ks);
            const int jg = 2 * ks + (lane >> 5);
            const h16x8 b0 = *(const LAS h16x8*)(B0p + ((jg ^ ((d0_ >> 3) & 15)) << 3)), b1 = *(const LAS h16x8*)(B1p + ((jg ^ ((d1_ >> 3) & 15)) << 3));
            acc0 = __builtin_amdgcn_mfma_f32_32x32x16_f16(a, b0, acc0, 0, 0, 0);
            acc1 = __builtin_amdgcn_mfma_f32_32x32x16_f16(a, b1, acc1, 0, 0, 0);
        }
#pragma unroll
        for (int r = 0; r < 16; ++r) { const int i = itile * 32 + (r & 3) + 8 * (r >> 2) + 4 * (lane >> 5); const size_t t = (size_t)(t0 + i);
            const float bias = bs[g * 128 + i];
            const int d0 = g * 128 + dt0 * 32 + (lane & 31);
            YC[t * 2048 + 1024 + d0] = (h16)((acc0[r] + bias) * (float)U[t * 1024 + d0]);
            YC[t * 2048 + 1024 + d0 + 32] = (h16)((acc1[r] + bias) * (float)U[t * 1024 + d0 + 32]); }
    }
}

__device__ __forceinline__ void phase_norm1(const Params& p) {
    const int tid = threadIdx.x, lane = tid & 63, wave = tid >> 6;
    const int gw = blockIdx.x * 8 + wave, NGW = gridDim.x * 8;
    const h16* O1 = (const h16*)(p.ws + WS_O1); h16* H1 = (h16*)p.out;
    for (int r = gw; r < NTOK; r += 2 * NGW) { const int r1 = (r + NGW < NTOK) ? r + NGW : r;
        rms_rows2_f16(p.in[0] + (size_t)r * DM, p.in[0] + (size_t)r1 * DM, O1 + (size_t)r * DM, O1 + (size_t)r1 * DM, p.in[9], H1 + (size_t)r * DM, H1 + (size_t)r1 * DM, lane); }
}

__device__ __forceinline__ void phase_fft(const Params& p, LAS unsigned char* lds) {
    const int tid = threadIdx.x;
    const h16* FD = (const h16*)(p.ws + WS_FD);
    h16* SPr = (h16*)(p.ws + WS_SPR); h16* SPi = (h16*)(p.ws + WS_SPI);
    LAS f32x2* X0 = (LAS f32x2*)lds; LAS f32x2* X1 = X0 + 8192;
    for (int it = blockIdx.x; it < 256; it += gridDim.x) {
        const int b = it >> 7, c0 = 4 * (it & 127);
        __syncthreads();
        for (int t = tid; t < SEQ; t += 512) { const h16x4 v = *(const h16x4*)(FD + (size_t)(b * SEQ + t) * 512 + c0);
            X0[t] = (f32x2){(float)v[0], (float)v[1]}; X1[t] = (f32x2){(float)v[2], (float)v[3]}; }
        __syncthreads();
        for (int s = 0; s < 13; ++s) {
            const int half = 4096 >> s;
#pragma unroll 2
            for (int j = tid; j < 4096; j += 512) {
                const int pos = j & (half - 1), grp = j >> (12 - s), i0 = (grp << (13 - s)) + pos, i1 = i0 + half;
                const float fr = (float)(pos << s) * (1.f / 8192.f);
                const float c = __builtin_amdgcn_cosf(fr), sn = __builtin_amdgcn_sinf(fr);
                { const f32x2 a = X0[i0], bb = X0[i1]; const f32x2 d = a - bb; X0[i0] = a + bb; X0[i1] = (f32x2){d[0] * c + d[1] * sn, d[1] * c - d[0] * sn}; }
                { const f32x2 a = X1[i0], bb = X1[i1]; const f32x2 d = a - bb; X1[i0] = a + bb; X1[i1] = (f32x2){d[0] * c + d[1] * sn, d[1] * c - d[0] * sn}; }
            }
            __syncthreads();
        }
        const float sc = 0.5f * 0.011048543456039806f;
        for (int k = tid; k < SEQ; k += 512) {
            const int ra = __brev((unsigned)k) >> 19, rb = __brev((unsigned)((SEQ - k) & (SEQ - 1))) >> 19;
            const f32x2 za = X0[ra], zb = X0[rb], ya = X1[ra], yb = X1[rb];
            h16x4 orr, oi;
            orr[0] = (h16)((za[0] + zb[0]) * sc); oi[0] = (h16)((za[1] - zb[1]) * sc);
            orr[1] = (h16)((za[1] + zb[1]) * sc); oi[1] = (h16)((zb[0] - za[0]) * sc);
            orr[2] = (h16)((ya[0] + yb[0]) * sc); oi[2] = (h16)((ya[1] - yb[1]) * sc);
            orr[3] = (h16)((ya[1] + yb[1]) * sc); oi[3] = (h16)((yb[0] - ya[0]) * sc);
            *(h16x4*)(SPr + (size_t)(b * SEQ + k) * 512 + c0) = orr; *(h16x4*)(SPi + (size_t)(b * SEQ + k) * 512 + c0) = oi;
        }
    }
}

__device__ __forceinline__ void phase_fnet_out(const Params& p) {
    const int tid = threadIdx.x, lane = tid & 63, wave = tid >> 6;
    const int gw = blockIdx.x * 8 + wave, NGW = gridDim.x * 8;
    const h16* SPr = (const h16*)(p.ws + WS_SPR); const h16* SPi = (const h16*)(p.ws + WS_SPI);
    const h16* CWT = (const h16*)(p.ws + WS_CWT); h16* ZCD = (h16*)(p.ws + WS_ZCD);
    for (int w = gw; w < 8192; w += NGW) {
        const int et = w & 3, g = (w >> 2) & 3, tt = w >> 4;
        const size_t trow = (size_t)(tt * 32 + (lane & 31));
        const h16* Ar = SPr + trow * 512 + g * 128 + 8 * (lane >> 5); const h16* Ai = SPi + trow * 512 + g * 128 + 8 * (lane >> 5);
        const h16* Bp = CWT + ((size_t)(g * 128 + et * 32 + (lane & 31))) * 256 + 8 * (lane >> 5);
        f32x16 acc;
#pragma unroll
        for (int e = 0; e < 16; ++e) acc[e] = 0.f;
#pragma unroll
        for (int ks = 0; ks < 8; ++ks) acc = __builtin_amdgcn_mfma_f32_32x32x16_f16(*(const h16x8*)(Ar + 16 * ks), *(const h16x8*)(Bp + 16 * ks), acc, 0, 0, 0);
#pragma unroll
        for (int ks = 0; ks < 8; ++ks) acc = __builtin_amdgcn_mfma_f32_32x32x16_f16(*(const h16x8*)(Ai + 16 * ks), *(const h16x8*)(Bp + 128 + 16 * ks), acc, 0, 0, 0);
#pragma unroll
        for (int r = 0; r < 16; ++r) { const size_t t = (size_t)(tt * 32 + (r & 3) + 8 * (r >> 2) + 4 * (lane >> 5));
            h16* zp = ZCD + t * 1536 + 1024 + g * 128 + et * 32 + (lane & 31);
            *zp = (h16)(acc[r] * silu_f((float)*zp)); }
    }
}

#define LDS_BAR() do { asm volatile("s_waitcnt lgkmcnt(0)" ::: "memory"); __builtin_amdgcn_s_barrier(); asm volatile("" ::: "memory"); } while (0)
#define LDS_WAIT() asm volatile("s_waitcnt lgkmcnt(0)" ::: "memory")
__device__ __forceinline__ void phase_scan(const Params& p, LAS unsigned char* lds) {
    const int tid = threadIdx.x, lane = tid & 63, wave = tid >> 6;
    const h16* PC = (const h16*)(p.ws + WS_PC);
    LAS h16* w2T = (LAS h16*)lds;
    LAS h16* a2T = w2T + 64 * 72;
    LAS unsigned char* priv = lds + 18432 + (wave & 3) * 4096;
    constexpr int SET_F = 5 * 2048 + 512;
    LAS float* OPS = (LAS float*)(lds + 18432 + 16384);
    LAS float* sYb = OPS + 2 * SET_F;
    for (int item = blockIdx.x; item < 256; item += gridDim.x) {
        const int xcd = item & 7, slot = item >> 3, gidx = xcd * 8 + (slot >> 2), q = slot & 3;
        const int dir = gidx >> 5, b = (gidx >> 4) & 1, h = gidx & 15;
        h16* Yd = (h16*)((unsigned char*)p.out + (size_t)dir * 32 * MiB);
        float* SB = (float*)(p.ws + WS_SBON) + (size_t)dir * NTOK * 16;
        const float* mu = p.in[11] + dir * 3200; const float* w0 = p.in[12] + dir * 1024 + 64 * h; const float* w2 = p.in[13] + (size_t)dir * 65536 + 64 * h;
        const float* a0 = p.in[14] + dir * 1024 + 64 * h; const float* a2 = p.in[15] + (size_t)dir * 65536 + 64 * h;
        const float* kkw = p.in[16] + 64 * h; const float* kaw = p.in[17] + 64 * h; const float* rkw = p.in[18] + 64 * h;
        __syncthreads();
        for (int i = tid; i < 4096; i += 512) { const int l = i >> 6, c = i & 63; w2T[c * 72 + l] = (h16)w2[l * 1024 + c]; a2T[c * 72 + l] = (h16)a2[l * 1024 + c]; }
        const int pw_ = wave & 3, s_sub = lane >> 3, c8 = (lane & 7) * 8, s_l = 8 * pw_ + s_sub;
        h16x8 mu_r8, mu_k8, mu_v8, mu_w8, mu_a8; f32x2 w0r[4], a0r[4], kkr[4], kar[4], omk[4], rkr[4];
#pragma unroll
        for (int e = 0; e < 8; ++e) { mu_r8[e] = (h16)mu[64 * h + c8 + e]; mu_k8[e] = (h16)mu[1024 + 64 * h + c8 + e]; mu_v8[e] = (h16)mu[2048 + 64 * h + c8 + e]; mu_w8[e] = (h16)mu[3072 + c8 + e]; mu_a8[e] = (h16)mu[3136 + c8 + e];
            w0r[e >> 1][e & 1] = w0[c8 + e]; a0r[e >> 1][e & 1] = a0[c8 + e]; kkr[e >> 1][e & 1] = kkw[c8 + e]; kar[e >> 1][e & 1] = kaw[c8 + e]; omk[e >> 1][e & 1] = 1.f - kaw[c8 + e]; rkr[e >> 1][e & 1] = rkw[c8 + e]; }
        f32x2 S01 = {0.f, 0.f}, S23 = {0.f, 0.f};
        const int srow = 4 * (wave & 3) + (lane >> 4), j0 = 4 * (lane & 15);
        const h16x8 z8 = {0, 0, 0, 0, 0, 0, 0, 0};
        h16x8 pr, pk, pv, pw, pa, qr_, qk_, qv_, qw_, qa_;
#define SCAN_LOAD(chn) do { const int sg_ = (chn) * 32 + s_l; const int t_ = dir ? (SEQ - 1 - sg_) : sg_; \
            const size_t rowc_ = (size_t)(b * SEQ + t_) * 3200; const size_t rowp_ = (size_t)(b * SEQ + (dir ? t_ + 1 : t_ - 1)) * 3200; const bool hp_ = sg_ > 0; \
            pr = *(const h16x8*)(PC + rowc_ + 64 * h + c8); pk = *(const h16x8*)(PC + rowc_ + 1024 + 64 * h + c8); pv = *(const h16x8*)(PC + rowc_ + 2048 + 64 * h + c8); \
            pw = *(const h16x8*)(PC + rowc_ + 3072 + c8); pa = *(const h16x8*)(PC + rowc_ + 3136 + c8); \
            qr_ = hp_ ? *(const h16x8*)(PC + rowp_ + 64 * h + c8) : z8; qk_ = hp_ ? *(const h16x8*)(PC + rowp_ + 1024 + 64 * h + c8) : z8; qv_ = hp_ ? *(const h16x8*)(PC + rowp_ + 2048 + 64 * h + c8) : z8; \
            qw_ = hp_ ? *(const h16x8*)(PC + rowp_ + 3072 + c8) : z8; qa_ = hp_ ? *(const h16x8*)(PC + rowp_ + 3136 + c8) : z8; } while (0)
#define SCAN_YSTORE(chn) do { const int sg_ = (chn) * 32 + s_l; const int t_ = dir ? (SEQ - 1 - sg_) : sg_; \
            const f32x2 y2_ = *(const LAS f32x2*)(sYb + ((chn) & 1) * 512 + s_l * 16 + 2 * (lane & 7)); \
            typedef _Float16 h16x2_ __attribute__((ext_vector_type(2))); h16x2_ o_; o_[0] = (h16)y2_[0]; o_[1] = (h16)y2_[1]; \
            *(h16x2_*)(Yd + (size_t)(b * SEQ + t_) * 1024 + 64 * h + 16 * q + 2 * (lane & 7)) = o_; } while (0)
        if (wave >= 4) SCAN_LOAD(0);
        __syncthreads();
        for (int n = -1; n < SEQ / 32; ++n) {
            if (wave < 4) {
                if (n >= 0) {
                    __builtin_amdgcn_s_setprio(3);
                    const LAS float* sR = OPS + (n & 1) * SET_F + j0; const LAS float* sW = sR + 2048; const LAS float* sK = sW + 2048; const LAS float* sA = sK + 2048; const LAS float* sB = sA + 2048; const LAS float* sV = OPS + (n & 1) * SET_F + 10240;
                    LAS float* sY = sYb + (n & 1) * 512;
                    f32x4 a_ = *(const LAS f32x4*)(sA), w_ = *(const LAS f32x4*)(sW), b_ = *(const LAS f32x4*)(sB);
                    f32x4 k_ = *(const LAS f32x4*)(sK), r_ = *(const LAS f32x4*)(sR);
                    f32x4 vq[4];
#pragma unroll
                    for (int u = 0; u < 4; ++u) vq[u] = *(const LAS f32x4*)(sV + srow * 32 + 4 * u);
                    f32x4 rp = r_;
#pragma unroll
                    for (int hb = 0; hb < 2; ++hb) {
                        f32x4 vn[4];
#pragma unroll
                        for (int u = 0; u < 4; ++u) vn[u] = *(const LAS f32x4*)(sV + srow * 32 + ((16 * (hb + 1)) & 31) + 4 * u);
#pragma unroll
                        for (int u16 = 0; u16 < 16; ++u16) {
                            const int s = 16 * hb + u16;
                            const int sn = (s + 1) & 31;
                            const f32x4 a_n = *(const LAS f32x4*)(sA + sn * 64), w_n = *(const LAS f32x4*)(sW + sn * 64), b_n = *(const LAS f32x4*)(sB + sn * 64);
                            const f32x4 k_n = *(const LAS f32x4*)(sK + sn * 64), r_n = *(const LAS f32x4*)(sR + sn * 64);
                            const float v = vq[u16 >> 2][u16 & 3];
                            const f32x2 vv = {v, v};
                            f32x2 pp = S01 * (f32x2){a_[0], a_[1]}; pp = S23 * (f32x2){a_[2], a_[3]} + pp;
                            f32x2 yy = S01 * (f32x2){rp[0], rp[1]}; yy = S23 * (f32x2){rp[2], rp[3]} + yy;
                            float sa = pp[0] + pp[1], y = yy[0] + yy[1];
                            sa += dpp_f<0xB1>(sa); y += dpp_f<0xB1>(y);
                            sa += dpp_f<0x4E>(sa); y += dpp_f<0x4E>(y);
                            sa += dpp_f<0x141>(sa); y += dpp_f<0x141>(y);
                            sa += dpp_f<0x140>(sa); y += dpp_f<0x140>(y);
                            sY[((s - 1) & 31) * 16 + srow] = y;
                            const f32x2 sv = {sa, sa};
                            S01 = S01 * (f32x2){w_[0], w_[1]} + vv * (f32x2){k_[0], k_[1]};
                            S23 = S23 * (f32x2){w_[2], w_[3]} + vv * (f32x2){k_[2], k_[3]};
                            S01 = sv * (f32x2){b_[0], b_[1]} + S01;
                            S23 = sv * (f32x2){b_[2], b_[3]} + S23;
                            rp = r_;
                            a_ = a_n; w_ = w_n; b_ = b_n; k_ = k_n; r_ = r_n;
                        }
#pragma unroll
                        for (int u = 0; u < 4; ++u) vq[u] = vn[u];
                    }
                    { f32x2 yy = S01 * (f32x2){rp[0], rp[1]}; yy = S23 * (f32x2){rp[2], rp[3]} + yy; sY[31 * 16 + srow] = red16(yy[0] + yy[1]); }
                    __builtin_amdgcn_s_setprio(0);
                }
            } else {
                if (n + 1 < SEQ / 32) {
                    const int cn = n + 1;
                    const int sg = cn * 32 + s_l; const int t = dir ? (SEQ - 1 - sg) : sg;
                    f32x2 qr[4], qk[4]; float qv[8];
                    LAS h16* TWp = (LAS h16*)priv; LAS h16* QAp = TWp + 8 * 72;
                    { const h16x8 r8 = pr + mu_r8 * (qr_ - pr), k8 = pk + mu_k8 * (qk_ - pk), v8 = pv + mu_v8 * (qv_ - pv);
                      const h16x8 w8 = pw + mu_w8 * (qw_ - pw), a8 = pa + mu_a8 * (qa_ - pa);
                      h16x8 tw8;
#pragma unroll
                      for (int pi = 0; pi < 4; ++pi) { qr[pi] = (f32x2){(float)r8[2 * pi], (float)r8[2 * pi + 1]}; qk[pi] = (f32x2){(float)k8[2 * pi], (float)k8[2 * pi + 1]};
                          qv[2 * pi] = (float)v8[2 * pi]; qv[2 * pi + 1] = (float)v8[2 * pi + 1];
                          const f32x2 tx = (f32x2){(float)w8[2 * pi], (float)w8[2 * pi + 1]} * 2.8853900817779268f;
                          const f32x2 dn = (f32x2){__builtin_amdgcn_exp2f(tx[0]), __builtin_amdgcn_exp2f(tx[1])} + 1.f;
                          const f32x2 th = (f32x2){__builtin_amdgcn_rcpf(dn[0]), __builtin_amdgcn_rcpf(dn[1])} * -2.f + 1.f;
                          tw8[2 * pi] = (h16)th[0]; tw8[2 * pi + 1] = (h16)th[1]; }
                      *(LAS h16x8*)(TWp + s_sub * 72 + c8) = tw8; *(LAS h16x8*)(QAp + s_sub * 72 + c8) = a8; }
                    if (cn + 1 < SEQ / 32) SCAN_LOAD(cn + 1);
                    LDS_WAIT();
                    f32x4 accw[4], acca[4];
#pragma unroll
                    for (int ct = 0; ct < 4; ++ct) { accw[ct] = (f32x4){0.f, 0.f, 0.f, 0.f}; acca[ct] = (f32x4){0.f, 0.f, 0.f, 0.f}; }
#pragma unroll
                    for (int ks = 0; ks < 2; ++ks) {
                        const h16x8 atw = *(const LAS h16x8*)(TWp + (lane & 7) * 72 + 32 * ks + 8 * (lane >> 4));
                        const h16x8 aqa = *(const LAS h16x8*)(QAp + (lane & 7) * 72 + 32 * ks + 8 * (lane >> 4));
#pragma unroll
                        for (int ct = 0; ct < 4; ++ct) {
                            const h16x8 bw = *(const LAS h16x8*)(w2T + (16 * ct + (lane & 15)) * 72 + 32 * ks + 8 * (lane >> 4));
                            const h16x8 ba = *(const LAS h16x8*)(a2T + (16 * ct + (lane & 15)) * 72 + 32 * ks + 8 * (lane >> 4));
                            accw[ct] = __builtin_amdgcn_mfma_f32_16x16x32_f16(atw, bw, accw[ct], 0, 0, 0);
                            acca[ct] = __builtin_amdgcn_mfma_f32_16x16x32_f16(aqa, ba, acca[ct], 0, 0, 0);
                        }
                    }
                    LDS_WAIT();
                    { LAS float* Zd = (LAS float*)priv + (lane >> 5) * 512 + (4 * ((lane >> 4) & 1)) * 64 + (lane & 15);
#pragma unroll
                      for (int ct = 0; ct < 4; ++ct)
#pragma unroll
                          for (int r = 0; r < 4; ++r) Zd[r * 64 + 16 * ct] = (lane < 32) ? accw[ct][r] : acca[ct][r]; }
                    LDS_WAIT();
                    const LAS float* Zw = (const LAS float*)priv + s_sub * 64 + c8; const LAS float* Za = Zw + 512;
                    const f32x4 zw0 = *(const LAS f32x4*)Zw, zw1 = *(const LAS f32x4*)(Zw + 4), za0 = *(const LAS f32x4*)Za, za1 = *(const LAS f32x4*)(Za + 4);
                    LDS_WAIT();
                    f32x2 kk[4], av_[4], kp[4], dec[4], kn2 = {0.f, 0.f}, sb2 = {0.f, 0.f};
#pragma unroll
                    for (int pi = 0; pi < 4; ++pi) {
                        const f32x2 zw = (pi < 2 ? (f32x2){zw0[2 * pi], zw0[2 * pi + 1]} : (f32x2){zw1[2 * pi - 4], zw1[2 * pi - 3]}) + w0r[pi];
                        const f32x2 za = (pi < 2 ? (f32x2){za0[2 * pi], za0[2 * pi + 1]} : (f32x2){za1[2 * pi - 4], za1[2 * pi - 3]}) + a0r[pi];
                        const f32x2 tw_ = zw * -1.4426950408889634f, ta_ = za * -1.4426950408889634f;
                        const f32x2 dw = (f32x2){__builtin_amdgcn_exp2f(tw_[0]), __builtin_amdgcn_exp2f(tw_[1])} + 1.f, da = (f32x2){__builtin_amdgcn_exp2f(ta_[0]), __builtin_amdgcn_exp2f(ta_[1])} + 1.f;
                        const f32x2 sw = (f32x2){__builtin_amdgcn_rcpf(dw[0]), __builtin_amdgcn_rcpf(dw[1])} * -0.8750387749225136f;
                        dec[pi] = (f32x2){__builtin_amdgcn_exp2f(sw[0]), __builtin_amdgcn_exp2f(sw[1])};
                        av_[pi] = (f32x2){__builtin_amdgcn_rcpf(da[0]), __builtin_amdgcn_rcpf(da[1])};
                        kk[pi] = qk[pi] * kkr[pi]; kn2 = kk[pi] * kk[pi] + kn2;
                        kp[pi] = qk[pi] * (av_[pi] * kar[pi] + omk[pi]);
                        sb2 = (qr[pi] * kp[pi]) * rkr[pi] + sb2; }
                    const float kn = red8(kn2[0] + kn2[1]), sbn = red8(sb2[0] + sb2[1]);
                    const float ninv = -rsqrtf(fmaxf(kn, 1e-12f));
                    LAS float* dR = OPS + (cn & 1) * SET_F + s_l * 64 + c8;
#pragma unroll
                    for (int hf = 0; hf < 2; ++hf) {
                        const f32x2 na0 = kk[2 * hf] * ninv, na1 = kk[2 * hf + 1] * ninv;
                        const f32x2 nb0 = na0 * av_[2 * hf], nb1 = na1 * av_[2 * hf + 1];
                        *(LAS f32x4*)(dR + 4 * hf) = (f32x4){qr[2 * hf][0], qr[2 * hf][1], qr[2 * hf + 1][0], qr[2 * hf + 1][1]};
                        *(LAS f32x4*)(dR + 2048 + 4 * hf) = (f32x4){dec[2 * hf][0], dec[2 * hf][1], dec[2 * hf + 1][0], dec[2 * hf + 1][1]};
                        *(LAS f32x4*)(dR + 4096 + 4 * hf) = (f32x4){kp[2 * hf][0], kp[2 * hf][1], kp[2 * hf + 1][0], kp[2 * hf + 1][1]};
                        *(LAS f32x4*)(dR + 6144 + 4 * hf) = (f32x4){na0[0], na0[1], na1[0], na1[1]};
                        *(LAS f32x4*)(dR + 8192 + 4 * hf) = (f32x4){-nb0[0], -nb0[1], -nb1[0], -nb1[1]}; }
                    if ((c8 >> 4) == q) { LAS float* dV = OPS + (cn & 1) * SET_F + 10240 + (c8 & 15) * 32 + s_l;
#pragma unroll
                        for (int e = 0; e < 8; ++e) dV[e * 32] = qv[e]; }
                    if (q == 0 && (lane & 7) == 0) SB[(size_t)(b * SEQ + t) * 16 + h] = sbn;
                }
                if (n >= 1) SCAN_YSTORE(n - 1);
            }
            LDS_BAR();
        }
        if (wave >= 4) SCAN_YSTORE(SEQ / 32 - 1);
#undef SCAN_LOAD
#undef SCAN_YSTORE
    }
}

__device__ __forceinline__ void phase_post(const Params& p) {
    const int tid = threadIdx.x;
    const h16* Y0 = (const h16*)p.out; const h16* Y1 = (const h16*)((const unsigned char*)p.out + 32 * MiB);
    const h16* PC = (const h16*)(p.ws + WS_PC); h16* ZCD = (h16*)(p.ws + WS_ZCD);
    const float* SB0 = (const float*)(p.ws + WS_SBON); const float* SB1 = SB0 + (size_t)NTOK * 16;
    const float* mu0 = p.in[11] + 2048; const float* mu1 = p.in[11] + 3200 + 2048;
    const float* lg = p.in[19]; const float* lb = p.in[20];
    const int gt = blockIdx.x * 512 + tid, NGT = gridDim.x * 512;
    for (int idx = gt; idx < NTOK * 128; idx += NGT) {
        const int t = idx >> 7, c = (idx & 127) * 8, hh = c >> 6, tp = t & (SEQ - 1);
        const h16x8 y0 = *(const h16x8*)(Y0 + (size_t)t * 1024 + c), y1 = *(const h16x8*)(Y1 + (size_t)t * 1024 + c);
        const h16x8 z8 = {0, 0, 0, 0, 0, 0, 0, 0};
        const h16x8 v0 = *(const h16x8*)(PC + (size_t)t * 3200 + 2048 + c);
        const h16x8 vm = tp > 0 ? *(const h16x8*)(PC + (size_t)(t - 1) * 3200 + 2048 + c) : z8;
        const h16x8 vp = tp < SEQ - 1 ? *(const h16x8*)(PC + (size_t)(t + 1) * 3200 + 2048 + c) : z8;
        const h16x8 zc = *(const h16x8*)(ZCD + (size_t)t * 1536 + c);
        const float s0 = SB0[(size_t)t * 16 + hh], s1 = SB1[(size_t)t * 16 + hh];
        float y[8], s = 0.f;
#pragma unroll
        for (int e = 0; e < 8; ++e) { y[e] = (float)y0[e] + (float)y1[e]; s += y[e]; }
        const float mean = red8(s) * (1.f / 64.f); float q = 0.f;
#pragma unroll
        for (int e = 0; e < 8; ++e) { y[e] -= mean; q += y[e] * y[e]; }
        const float rs = rsqrtf(red8(q) * (1.f / 64.f) + 64e-5f);
        const f32x4 lg0 = *(const f32x4*)(lg + c), lg1 = *(const f32x4*)(lg + c + 4), lb0 = *(const f32x4*)(lb + c), lb1 = *(const f32x4*)(lb + c + 4);
        const f32x4 ma0 = *(const f32x4*)(mu0 + c), ma1 = *(const f32x4*)(mu0 + c + 4), mb0 = *(const f32x4*)(mu1 + c), mb1 = *(const f32x4*)(mu1 + c + 4);
        h16x8 o;
#pragma unroll
        for (int e = 0; e < 8; ++e) { const float vv = (float)v0[e];
            const float m0 = e < 4 ? ma0[e & 3] : ma1[e & 3], m1 = e < 4 ? mb0[e & 3] : mb1[e & 3], gg = e < 4 ? lg0[e & 3] : lg1[e & 3], bb = e < 4 ? lb0[e & 3] : lb1[e & 3];
            const float vd0 = vv + m0 * ((float)vm[e] - vv), vd1 = vv + m1 * ((float)vp[e] - vv);
            const float val = y[e] * rs * gg + bb + s0 * vd0 + s1 * vd1;
            o[e] = (h16)(val * silu_f((float)zc[e])); }
        *(h16x8*)(ZCD + (size_t)t * 1536 + c) = o;
    }
}

__device__ __forceinline__ void phase_final(const Params& p) {
    const int tid = threadIdx.x, lane = tid & 63, wave = tid >> 6;
    const int gw = blockIdx.x * 8 + wave, NGW = gridDim.x * 8;
    const float* g = p.in[23]; const h16* O1 = (const h16*)(p.ws + WS_O1); const h16* O2 = (const h16*)(p.ws + WS_O2);
    for (int r = gw; r < NTOK; r += 2 * NGW) {
        const int rr[2] = {r, (r + NGW < NTOK) ? r + NGW : r};
        f32x4 v[2][4]; h16x4 a[2][4], b[2][4]; float ss[2] = {0.f, 0.f};
#pragma unroll
        for (int u = 0; u < 2; ++u)
#pragma unroll
            for (int j = 0; j < 4; ++j) { const size_t o = (size_t)rr[u] * DM + 4 * lane + 256 * j; v[u][j] = *(const f32x4*)(p.in[0] + o); a[u][j] = *(const h16x4*)(O1 + o); b[u][j] = *(const h16x4*)(O2 + o); }
#pragma unroll
        for (int u = 0; u < 2; ++u)
#pragma unroll
            for (int j = 0; j < 4; ++j) {
#pragma unroll
                for (int e = 0; e < 4; ++e) v[u][j][e] += (float)a[u][j][e] + (float)b[u][j][e];
                ss[u] += v[u][j][0] * v[u][j][0] + v[u][j][1] * v[u][j][1] + v[u][j][2] * v[u][j][2] + v[u][j][3] * v[u][j][3]; }
#pragma unroll
        for (int o = 1; o < 64; o <<= 1) { ss[0] += __shfl_xor(ss[0], o); ss[1] += __shfl_xor(ss[1], o); }
        const float rs[2] = {rsqrtf(ss[0] * (1.f / 1024.f) + 1e-6f), rsqrtf(ss[1] * (1.f / 1024.f) + 1e-6f)};
#pragma unroll
        for (int j = 0; j < 4; ++j) { const f32x4 gg = *(const f32x4*)(g + 4 * lane + 256 * j);
#pragma unroll
            for (int u = 0; u < 2; ++u) { f32x4 o = v[u][j] * rs[u]; o = o * gg; *(f32x4*)(p.out + (size_t)rr[u] * DM + 4 * lane + 256 * j) = o; } }
    }
}

__global__ void __launch_bounds__(512, 2) mega(Params p) {
    extern __shared__ __attribute__((aligned(16))) unsigned char smem[];
    LAS unsigned char* lds = (LAS unsigned char*)smem;
    cg::grid_group grid = cg::this_grid();
    unsigned char* ws = p.ws;
    const int lo = p.ph_lo, hi = p.ph_hi;
#define IN(k) (lo <= (k) && (k) < hi)
    volatile LAS unsigned* bst = (volatile LAS unsigned*)(lds + LDS_MAIN);
    if (threadIdx.x < 4) bst[threadIdx.x] = 0u;
    __syncthreads();
    const XcdBarrier bar = xcd_barrier_post((unsigned*)(ws + WS_BAR), bst);
    if (hi > 1000) grid.sync();
#define SEAM(k) do { if (IN(k) && IN((k) + 1)) { xcd_barrier(bar); if ((REPMASK >> 13) & 1) xcd_barrier(bar); } } while (0)
    if (IN(0)) for (int rep_ = 0; rep_ <= ((REPMASK >> 0) & 1); ++rep_) { phase0(p, lds); } SEAM(0);
    if (IN(1)) for (int rep_ = 0; rep_ <= ((REPMASK >> 1) & 1); ++rep_) { pg8::Gemm g{(const h16*)p.out, (const h16*)(ws + WS_W1T), NTOK, 7168, 1024}; pg8::StaticOrder S; S.init(NTOK, 7168, gridDim.x, blockIdx.x);
                 Epi1 E{(h16*)(ws + WS_XC), (h16*)(ws + WS_G), (h16*)(ws + WS_U), (h16*)(ws + WS_V), (float*)(ws + WS_STATS)}; pg8::gemm_phase<Epi1>(lds, g, S, E); } SEAM(1);
    if (IN(3)) for (int rep_ = 0; rep_ <= ((REPMASK >> 3) & 1); ++rep_) { phase_mix0(p, lds); } SEAM(3);
    if (IN(4)) for (int rep_ = 0; rep_ <= ((REPMASK >> 4) & 1); ++rep_) { pg8::Gemm g{(const h16*)(ws + WS_YCAT), (const h16*)(ws + WS_W2T), NTOK, 1024, 2048}; pg8::StaticOrder S; S.init(NTOK, 1024, gridDim.x, blockIdx.x);
                 Epi2 E{(h16*)(ws + WS_O1)}; pg8::gemm_phase<Epi2>(lds, g, S, E); } SEAM(4);
    if (IN(5)) for (int rep_ = 0; rep_ <= ((REPMASK >> 5) & 1); ++rep_) { phase_norm1(p); } SEAM(5);
    if (IN(6)) for (int rep_ = 0; rep_ <= ((REPMASK >> 6) & 1); ++rep_) { pg8::Gemm g{(const h16*)p.out, (const h16*)(ws + WS_W3T), NTOK, 5376, 1024}; pg8::StaticOrder S; S.init(NTOK, 5376, gridDim.x, blockIdx.x);
                 Epi3 E{(h16*)(ws + WS_PC), (h16*)(ws + WS_ZCD), (h16*)(ws + WS_FD)}; pg8::gemm_phase<Epi3>(lds, g, S, E); } SEAM(6);
    if (IN(7)) for (int rep_ = 0; rep_ <= ((REPMASK >> 7) & 1); ++rep_) { phase_fft(p, lds); }
    if (IN(8)) for (int rep_ = 0; rep_ <= ((REPMASK >> 8) & 1); ++rep_) { phase_scan(p, lds); } SEAM(8);
    if (IN(9)) for (int rep_ = 0; rep_ <= ((REPMASK >> 9) & 1); ++rep_) { phase_fnet_out(p); }
    if (IN(10)) for (int rep_ = 0; rep_ <= ((REPMASK >> 10) & 1); ++rep_) { phase_post(p); } SEAM(10);
    if (IN(11)) for (int rep_ = 0; rep_ <= ((REPMASK >> 11) & 1); ++rep_) { pg8::Gemm g{(const h16*)(ws + WS_ZCD), (const h16*)(ws + WS_W4T), NTOK, 1024, 1536}; pg8::StaticOrder S; S.init(NTOK, 1024, gridDim.x, blockIdx.x);
                  Epi4 E{(h16*)(ws + WS_O2)}; pg8::gemm_phase<Epi4>(lds, g, S, E); } SEAM(11);
    if (IN(12)) for (int rep_ = 0; rep_ <= ((REPMASK >> 12) & 1); ++rep_) { phase_final(p); }
}

extern "C" void kernel_launch(void* const* d_in, const int* in_sizes, int n_in, void* d_out, int out_size, void* d_ws, size_t ws_size, hipStream_t stream) {
    static int grid = 0;
    if (grid == 0) {
        int dev = 0, cus = 0, per_cu = 0;
        hipGetDevice(&dev);
        hipDeviceGetAttribute(&cus, hipDeviceAttributeMultiprocessorCount, dev);
        if (hipFuncSetAttribute((const void*)mega, hipFuncAttributeMaxDynamicSharedMemorySize, LDS_BYTES) != hipSuccess) fprintf(stderr, "kernel_launch: hipFuncSetAttribute failed\n");
        hipOccupancyMaxActiveBlocksPerMultiprocessor(&per_cu, (const void*)mega, 512, LDS_BYTES);
        if (per_cu < 1) { fprintf(stderr, "kernel_launch: occupancy query says %d blocks per CU\n", per_cu); per_cu = 1; }
        (void)hipGetLastError();
        grid = cus;
        if (grid < 64) grid = 64;
    }
    if (hipMemsetAsync((unsigned char*)d_ws + WS_BAR, 0, XCD_BAR_WORDS * 4, stream) != hipSuccess) fprintf(stderr, "kernel_launch: memset of the barrier words failed\n");
    Params p{};
    for (int i = 0; i < 24; ++i) p.in[i] = (const float*)d_in[i];
    p.out = (float*)d_out; p.ws = (unsigned char*)d_ws;
#if N_LAUNCH_MODE == 1
    p.ph_lo = 0; p.ph_hi = NPHASE;
    void* args[] = {&p};
    hipError_t e = hipLaunchCooperativeKernel((const void*)mega, dim3(grid), dim3(512), args, LDS_BYTES, stream);
    if (e != hipSuccess) fprintf(stderr, "kernel_launch: cooperative launch failed: %s (grid %d)\n", hipGetErrorString(e), grid);
#else
    for (int ph = 0; ph < NPHASE; ++ph) { p.ph_lo = ph; p.ph_hi = ph + 1; hipLaunchKernelGGL(mega, dim3(grid), dim3(512), LDS_BYTES, stream, p); }
#endif
}
```

```cpp
#include <hip/hip_runtime.h>
#include <hip/hip_cooperative_groups.h>
#include <cstdio>
#include <cstdint>
namespace cg = cooperative_groups;

#ifndef N_LAUNCH_MODE
#define N_LAUNCH_MODE 1
#endif

#ifndef REPMASK
#define REPMASK 0
#endif
#define LAS __attribute__((address_space(3)))
typedef _Float16 h16;
typedef _Float16 h16x8 __attribute__((ext_vector_type(8)));
typedef _Float16 h16x4 __attribute__((ext_vector_type(4)));
typedef float f32x2 __attribute__((ext_vector_type(2)));
typedef float f32x4 __attribute__((ext_vector_type(4)));
typedef float f32x16 __attribute__((ext_vector_type(16)));

constexpr int NTOK = 16384, DM = 1024, SEQ = 8192;
constexpr int LDS_MAIN = 131072;
constexpr int LDS_BYTES = LDS_MAIN + 16;
constexpr int NPHASE = 13;
constexpr size_t MiB = 1024 * 1024;
constexpr size_t WS_W1T = 0;
constexpr size_t WS_W2T = WS_W1T + (size_t)7168 * 1024 * 2;
constexpr size_t WS_W3T = WS_W2T + (size_t)1024 * 2048 * 2;
constexpr size_t WS_W4T = WS_W3T + (size_t)5376 * 1024 * 2;
constexpr size_t WS_STATS = 32 * MiB;
constexpr size_t WS_WSH = WS_STATS + 131072;
constexpr size_t WS_CWT = WS_WSH + 262144;
constexpr size_t WS_SBON = WS_CWT + 262144;
constexpr size_t WS_BAR = 35 * MiB;
constexpr size_t WS_XC = 36 * MiB, WS_G = 68 * MiB, WS_U = 100 * MiB, WS_V = 132 * MiB, WS_YCAT = 164 * MiB;
constexpr size_t WS_SPR = 0, WS_SPI = 232 * MiB;
constexpr size_t WS_O2 = 68 * MiB;
constexpr size_t WS_O1 = 36 * MiB, WS_PC = 68 * MiB, WS_ZCD = 168 * MiB, WS_FD = 216 * MiB;

namespace pg8 {
constexpr int BM = 256, BK = 64, HALF = 128, HTB = HALF * BK * 2, STAGE_BYTES = 8 * HTB, NXCD = 8, WGM = 8;
__host__ __device__ __forceinline__ int lds_byte(int r, int c) { const int st = (r >> 4) * 2 + (c >> 5), rr = r & 15, cc = c & 31, ob = rr * 64 + cc * 2; return st * 1024 + (ob ^ (((ob >> 9) & 1) << 5)); }
__host__ __device__ __forceinline__ void stage_rc(int b, int& R, int& C) { const int st = b / 1024, sb = b % 1024, swz = sb ^ (((sb >> 9) & 1) << 5); R = (st >> 1) * 16 + swz / 64; C = (st & 1) * 32 + (swz % 64) / 2; }
__host__ __device__ __forceinline__ int perm32(int rho) { const int n = rho >> 4, i = rho & 15; return 8 * (i >> 2) + 4 * n + (i & 3); }
struct Unit { int pm, pn; };
struct Gemm { const h16* A; const h16* Bt; int M, N, K; };
struct StaticOrder {
    int nM, nN, nwg, G, c;
    __host__ __device__ void init(int M, int N, int G_, int c_) { nM = M / BM; nN = N / BM; nwg = nM * nN; G = G_; c = c_; }
    __host__ __device__ bool next(int i, Unit& u) const {
        const long L = (long)i * G + c; if (L >= nwg) return false;
        int wgid = (int)L; { const int q = nwg / NXCD, r = nwg % NXCD, xcd = wgid % NXCD, off = wgid / NXCD; wgid = (xcd < r ? xcd * (q + 1) : r * (q + 1) + (xcd - r) * q) + off; }
        const int nig = WGM * nN, gid = wgid / nig, fm = gid * WGM, gsz = (nM - fm) < WGM ? (nM - fm) : WGM;
        u.pm = fm + ((wgid % nig) % gsz); u.pn = (wgid % nig) / gsz; return true;
    }
};
template <class Epi>
__device__ __forceinline__ void gemm_phase(LAS unsigned char* lds, const Gemm g, const StaticOrder& S, const Epi& E) {
    const int tid = threadIdx.x, wid = __builtin_amdgcn_readfirstlane(tid >> 6), lane = tid & 63, wr = wid >> 2, wc = wid & 3, fr = lane & 15, fq = lane >> 4;
    const int K = g.K, nt = K / BK;
    unsigned voffA[2], voffB[2];
#pragma unroll
    for (int i = 0; i < 2; ++i) { int R, C; stage_rc(tid * 16 + i * 8192, R, C); const int Rb = Epi::PERM ? ((R & ~31) + perm32(R & 31)) : R; voffA[i] = (unsigned)(R * K + C) * 2u; voffB[i] = (unsigned)(Rb * K + C) * 2u; }
    const size_t kstep = (size_t)(BK * 2);
    const size_t hstep = (size_t)HALF * K * 2;
    const size_t tstep = 2 * hstep;
    const unsigned ldsw = (unsigned)wid * 1024u;
    const int aoff = lds_byte(wr * 64 + fr, fq * 8), boff = lds_byte(wc * 32 + fr, fq * 8);
#define PG8_SA(b, h) (((b) * 2 + (h)) * HTB)
#define PG8_SB(b, h) ((4 + (b) * 2 + (h)) * HTB)
#define PG8_STAGE(bufoff, gbase, voff) do { _Pragma("unroll") for (int _i = 0; _i < 2; ++_i) \
        __builtin_amdgcn_global_load_lds((const unsigned*)((const char*)(gbase) + (voff)[_i]), (LAS unsigned*)(lds + (bufoff) + ldsw + _i * 8192), 16, 0, 0); } while (0)
#define PG8_LDA(dst, b, h) do { _Pragma("unroll") for (int m = 0; m < 4; ++m) _Pragma("unroll") for (int k = 0; k < 2; ++k) dst[m][k] = *(const LAS h16x8*)(lds + PG8_SA(b, h) + aoff + m * 2048 + k * 1024); } while (0)
#define PG8_LDB(dst, b, h) do { _Pragma("unroll") for (int n = 0; n < 2; ++n) _Pragma("unroll") for (int k = 0; k < 2; ++k) dst[n][k] = *(const LAS h16x8*)(lds + PG8_SB(b, h) + boff + n * 2048 + k * 1024); } while (0)
#define PG8_MMA(ai, bj, At, Bt) do { __builtin_amdgcn_s_setprio(1); _Pragma("unroll") for (int m = 0; m < 4; ++m) _Pragma("unroll") for (int n = 0; n < 2; ++n) _Pragma("unroll") for (int k = 0; k < 2; ++k) \
        acc[ai][bj][m][n] = __builtin_amdgcn_mfma_f32_16x16x32_f16(Bt[n][k], At[m][k], acc[ai][bj][m][n], 0, 0, 0); __builtin_amdgcn_s_setprio(0); } while (0)
#define PG8_WAIT_V(n) asm volatile("s_waitcnt vmcnt(" #n ")" ::: "memory")
#define PG8_WAIT_L(n) asm volatile("s_waitcnt lgkmcnt(" #n ")" ::: "memory")
#define PG8_BAR __builtin_amdgcn_s_barrier()
#define PG8_SCHED __builtin_amdgcn_sched_barrier(0)
    Unit cur, nxt; int ui = 0;
    if (!S.next(0, cur)) return;
    f32x4 acc[2][2][4][2];
#pragma unroll
    for (int a = 0; a < 2; ++a)
#pragma unroll
        for (int b = 0; b < 2; ++b)
#pragma unroll
            for (int m = 0; m < 4; ++m)
#pragma unroll
                for (int n = 0; n < 2; ++n) acc[a][b][m][n] = (f32x4){0.f, 0.f, 0.f, 0.f};
    h16x8 At[4][2], B0[2][2], B1[2][2];
    const char* cA = (const char*)g.A + (size_t)cur.pm * tstep; const char* cB = (const char*)g.Bt + (size_t)cur.pn * tstep;
    PG8_STAGE(PG8_SB(0, 0), cB, voffB); PG8_STAGE(PG8_SA(0, 0), cA, voffA); PG8_STAGE(PG8_SB(0, 1), cB + hstep, voffB); PG8_STAGE(PG8_SA(0, 1), cA + hstep, voffA);
    if (wr == 1) PG8_BAR;
    PG8_WAIT_V(4); PG8_BAR;
    PG8_STAGE(PG8_SB(1, 0), cB + kstep, voffB); PG8_STAGE(PG8_SA(1, 0), cA + kstep, voffA); PG8_STAGE(PG8_SB(1, 1), cB + hstep + kstep, voffB);
    PG8_WAIT_V(6); PG8_BAR;
    for (;;) {
        const bool has_next = S.next(ui + 1, nxt);
        const char* nA = has_next ? (const char*)g.A + (size_t)nxt.pm * tstep : cA; const char* nB = has_next ? (const char*)g.Bt + (size_t)nxt.pn * tstep : cB;
        for (int t = 0; t < nt; t += 2) {
            const bool last = (t == nt - 2);
            const char* a1 = cA + (size_t)(t + 1) * kstep;
            const char* a2 = last ? nA : cA + (size_t)(t + 2) * kstep; const char* b2 = last ? nB : cB + (size_t)(t + 2) * kstep;
            const char* a3 = a2 + kstep; const char* b3 = b2 + kstep;
            PG8_LDB(B0, 0, 0); PG8_SCHED; PG8_LDA(At, 0, 0); PG8_STAGE(PG8_SA(1, 1), a1 + hstep, voffA);
            PG8_WAIT_L(8); PG8_BAR; PG8_WAIT_L(0); PG8_MMA(0, 0, At, B0); PG8_BAR; PG8_SCHED;
            PG8_LDB(B1, 0, 1); PG8_STAGE(PG8_SB(0, 0), b2, voffB);
            PG8_BAR; PG8_WAIT_L(0); PG8_MMA(0, 1, At, B1); PG8_BAR;
            PG8_LDA(At, 0, 1); PG8_STAGE(PG8_SA(0, 0), a2, voffA);
            PG8_BAR; PG8_WAIT_L(0); PG8_MMA(1, 0, At, B0); PG8_BAR; PG8_SCHED;
            PG8_STAGE(PG8_SB(0, 1), b2 + hstep, voffB);
            PG8_WAIT_V(6); PG8_BAR; PG8_MMA(1, 1, At, B1); PG8_BAR;
            PG8_LDB(B0, 1, 0); PG8_SCHED; PG8_LDA(At, 1, 0); PG8_STAGE(PG8_SA(0, 1), a2 + hstep, voffA);
            PG8_WAIT_L(8); PG8_BAR; PG8_WAIT_L(0); PG8_MMA(0, 0, At, B0); PG8_BAR; PG8_SCHED;
            PG8_LDB(B1, 1, 1); PG8_STAGE(PG8_SB(1, 0), b3, voffB);
            PG8_BAR; PG8_WAIT_L(0); PG8_MMA(0, 1, At, B1); PG8_BAR;
            PG8_LDA(At, 1, 1); PG8_STAGE(PG8_SA(1, 0), a3, voffA);
            PG8_BAR; PG8_WAIT_L(0); PG8_MMA(1, 0, At, B0); PG8_BAR; PG8_SCHED;
            PG8_STAGE(PG8_SB(1, 1), b3 + hstep, voffB);
            PG8_WAIT_V(6); PG8_BAR; PG8_MMA(1, 1, At, B1); PG8_BAR;
        }
        E(acc, cur, wr, wc, fr, fq);
        if (!has_next) break;
#pragma unroll
        for (int a = 0; a < 2; ++a)
#pragma unroll
            for (int b = 0; b < 2; ++b)
#pragma unroll
                for (int m = 0; m < 4; ++m)
#pragma unroll
                    for (int n = 0; n < 2; ++n) acc[a][b][m][n] = (f32x4){0.f, 0.f, 0.f, 0.f};
        cur = nxt; cA = nA; cB = nB; ++ui;
    }
    PG8_WAIT_V(0);
    if (wr == 0) PG8_BAR;
    PG8_BAR;
#undef PG8_SA
#undef PG8_SB
#undef PG8_STAGE
#undef PG8_LDA
#undef PG8_LDB
#undef PG8_MMA
#undef PG8_WAIT_V
#undef PG8_WAIT_L
#undef PG8_BAR
#undef PG8_SCHED
}
}


#define XB_TMO      128
#define XB_XCNT(j)  (256  + 64 * (j))
#define XB_XSUB(j)  (1280 + 64 * (j))
#define XB_XGEN(j)  (2304 + 64 * (j))
#define XB_TOP      3328
#define XB_TOPGEN   3392
#define XCD_BAR_WORDS 3456
#define XB_SPIN_CAP (1u << 18)
__device__ __forceinline__ unsigned xb_ld(unsigned* p)              { return __hip_atomic_load(p, __ATOMIC_RELAXED, __HIP_MEMORY_SCOPE_AGENT); }
__device__ __forceinline__ unsigned xb_add(unsigned* p, unsigned v) { return __hip_atomic_fetch_add(p, v, __ATOMIC_RELAXED, __HIP_MEMORY_SCOPE_AGENT); }
__device__ __forceinline__ unsigned xb_xcc_id() { return (unsigned)__builtin_amdgcn_s_getreg((3 << 11) | 20) & 0xFu; }
#define XB_SPIN(cond, bar) do { unsigned _sp = 0; while (cond) { __builtin_amdgcn_s_sleep(1); \
    if ((++_sp & 255u) == 0u) { if (xb_ld(&(bar)[XB_TMO])) break; if (_sp > XB_SPIN_CAP) { atomicAdd(&(bar)[XB_TMO], 1u); break; } } } } while (0)
struct XcdBarrier { unsigned* bar; unsigned x; volatile LAS unsigned* st; };
__device__ __forceinline__ XcdBarrier xcd_barrier_post(unsigned* bar, volatile LAS unsigned* st) {
    XcdBarrier b; b.bar = bar; b.x = xb_xcc_id(); b.st = st;
    if (threadIdx.x == 0) (void)xb_add(&bar[XB_XCNT(b.x)], 1u);
    return b;
}
__device__ __forceinline__ void xcd_barrier_complete(unsigned* bar, unsigned x, unsigned& nloc, unsigned& nx) {
    const unsigned G = gridDim.x * gridDim.y * gridDim.z;
    unsigned sum, cnt, mine, sp = 0u;
    for (;;) {
        sum = 0u; cnt = 0u; mine = 0u;
#pragma unroll
        for (unsigned j = 0; j < 16; ++j) { const unsigned c = xb_ld(&bar[XB_XCNT(j)]); sum += c; cnt += (c > 0u) ? 1u : 0u; mine = (j == x) ? c : mine; }
        if (sum == G) break;
        __builtin_amdgcn_s_sleep(1);
        if ((++sp & 255u) == 0u) { if (xb_ld(&bar[XB_TMO])) break; if (sp > XB_SPIN_CAP) { atomicAdd(&bar[XB_TMO], 1u); break; } }
    }
    nloc = mine > 0u ? mine : 1u; nx = cnt > 0u ? cnt : 1u;
}
__device__ __forceinline__ void xcd_barrier(const XcdBarrier& b) {
    asm volatile("s_waitcnt vmcnt(0)" ::: "memory");
    __syncthreads();
    if (threadIdx.x == 0) {
        unsigned* bar = b.bar;
        __builtin_amdgcn_s_waitcnt(0);
        unsigned nloc = b.st[0], nx = b.st[1];
        if (nloc == 0u) { xcd_barrier_complete(bar, b.x, nloc, nx); b.st[0] = nloc; b.st[1] = nx; }
        const unsigned old = xb_add(&bar[XB_XSUB(b.x)], 1u);
        const unsigned gen = old / nloc;
        if (old + 1u == (gen + 1u) * nloc) {
            __builtin_amdgcn_fence(__ATOMIC_RELEASE, "agent");
            asm volatile("s_waitcnt vmcnt(0)" ::: "memory");
            const unsigned og = xb_add(&bar[XB_TOP], 1u);
            const unsigned tg = og / nx;
            if (og + 1u == (tg + 1u) * nx) xb_add(&bar[XB_TOPGEN], 1u);
            else XB_SPIN(xb_ld(&bar[XB_TOPGEN]) == tg, bar);
            __builtin_amdgcn_fence(__ATOMIC_ACQUIRE, "agent");
            xb_add(&bar[XB_XGEN(b.x)], 1u);
            asm volatile("s_waitcnt vmcnt(0)" ::: "memory");
        } else {
            XB_SPIN(xb_ld(&bar[XB_XGEN(b.x)]) == gen, bar);
            __builtin_amdgcn_fence(__ATOMIC_ACQUIRE, "agent");
            asm volatile("s_waitcnt vmcnt(0)" ::: "memory");
        }
    }
    __syncthreads();
}

struct Params { const float* in[24]; float* out; unsigned char* ws; int ph_lo, ph_hi; };

__device__ __forceinline__ float silu_f(float x) { return x * __builtin_amdgcn_rcpf(1.f + __expf(-x)); }
__device__ __forceinline__ float sigmoid_f(float x) { return __builtin_amdgcn_rcpf(1.f + __expf(-x)); }
__device__ __forceinline__ float tanh_f(float x) { return 1.f - 2.f * __builtin_amdgcn_rcpf(__expf(2.f * x) + 1.f); }
__device__ __forceinline__ float wave_sum(float v) {
#pragma unroll
    for (int o = 1; o < 64; o <<= 1) v += __shfl_xor(v, o);
    return v;
}
template <int CTRL> __device__ __forceinline__ float dpp_f(float x) { return __int_as_float(__builtin_amdgcn_update_dpp(0, __float_as_int(x), CTRL, 0xf, 0xf, false)); }
__device__ __forceinline__ float red8(float x) {
    x += dpp_f<0xB1>(x); x += dpp_f<0x4E>(x); x += dpp_f<0x141>(x); return x;
}
__device__ __forceinline__ float red16(float x) {
    x += dpp_f<0xB1>(x); x += dpp_f<0x4E>(x); x += dpp_f<0x141>(x); x += dpp_f<0x140>(x); return x;
}

__device__ __forceinline__ int sigma1(int np) {
    const int T = np >> 8, c = np & 255;
    if (T < 16) { const int bj = c >> 7, wc = (c >> 5) & 3, n = (c >> 4) & 1, r = c & 15; return 1024 * (2 * bj + n) + 64 * T + 16 * wc + r; }
    if (T < 24) { return ((c >> 7) ? 6144 : 4096) + 128 * (T - 16) + (c & 127); }
    return 5120 + 256 * (T - 24) + c;
}

template <int MODE>
__device__ __forceinline__ void tr_item(const float* W, int K, int N, h16* WT, LAS float* scr, int item, int nblk, int lane) {
    const int kb = item / nblk, nb = item % nblk, k0 = 64 * kb, n0 = 32 * nb;
    const int np = n0 + (lane & 31);
    const int sc = (MODE == 1) ? sigma1(np) : np;
    const bool valid = (MODE != 2) || (np < 5248);
    float wv_[32];
#pragma unroll
    for (int i = 0; i < 32; ++i) { const int kk = 2 * i + (lane >> 5); wv_[i] = valid ? W[(size_t)(k0 + kk) * N + sc] : 0.f; }
#pragma unroll
    for (int i = 0; i < 32; ++i) { const int kk = 2 * i + (lane >> 5); scr[kk * 33 + (lane & 31)] = wv_[i]; }
    asm volatile("s_waitcnt lgkmcnt(0)" ::: "memory");
    const int c = lane & 7;
#pragma unroll
    for (int j = 0; j < 4; ++j) { const int n = (lane >> 3) + 8 * j; const LAS float* s = scr + (8 * c) * 33 + n;
        h16x8 o;
#pragma unroll
        for (int e = 0; e < 8; ++e) o[e] = (h16)s[e * 33];
        *(h16x8*)(WT + (size_t)(n0 + n) * K + k0 + 8 * c) = o; }
    asm volatile("s_waitcnt lgkmcnt(0)" ::: "memory");
}

__device__ __forceinline__ void rms_rows2_f16(const float* x0, const float* x1, const h16* ad0, const h16* ad1, const float* g, h16* or0, h16* or1, int lane) {
    f32x4 v[2][4]; h16x4 a[2][4]; float ss[2] = {0.f, 0.f};
#pragma unroll
    for (int j = 0; j < 4; ++j) { v[0][j] = *(const f32x4*)(x0 + 4 * lane + 256 * j); v[1][j] = *(const f32x4*)(x1 + 4 * lane + 256 * j);
        if (ad0) { a[0][j] = *(const h16x4*)(ad0 + 4 * lane + 256 * j); a[1][j] = *(const h16x4*)(ad1 + 4 * lane + 256 * j); } }
#pragma unroll
    for (int u = 0; u < 2; ++u)
#pragma unroll
        for (int j = 0; j < 4; ++j) {
            if (ad0) { v[u][j][0] += (float)a[u][j][0]; v[u][j][1] += (float)a[u][j][1]; v[u][j][2] += (float)a[u][j][2]; v[u][j][3] += (float)a[u][j][3]; }
            ss[u] += v[u][j][0] * v[u][j][0] + v[u][j][1] * v[u][j][1] + v[u][j][2] * v[u][j][2] + v[u][j][3] * v[u][j][3]; }
#pragma unroll
    for (int o = 1; o < 64; o <<= 1) { ss[0] += __shfl_xor(ss[0], o); ss[1] += __shfl_xor(ss[1], o); }
    const float rs0 = rsqrtf(ss[0] * (1.f / 1024.f) + 1e-6f), rs1 = rsqrtf(ss[1] * (1.f / 1024.f) + 1e-6f);
#pragma unroll
    for (int j = 0; j < 4; ++j) { const f32x4 gg = *(const f32x4*)(g + 4 * lane + 256 * j); h16x4 o0, o1;
#pragma unroll
        for (int e = 0; e < 4; ++e) { o0[e] = (h16)(v[0][j][e] * rs0 * gg[e]); o1[e] = (h16)(v[1][j][e] * rs1 * gg[e]); }
        *(h16x4*)(or0 + 4 * lane + 256 * j) = o0; *(h16x4*)(or1 + 4 * lane + 256 * j) = o1; }
}

__device__ __forceinline__ void phase0(const Params& p, LAS unsigned char* lds) {
    const int tid = threadIdx.x, lane = tid & 63, wave = tid >> 6;
    const int gw = blockIdx.x * 8 + wave, NGW = gridDim.x * 8;
    LAS float* scr = (LAS float*)(lds + wave * 8448);
    h16* W1T = (h16*)(p.ws + WS_W1T); h16* W2T = (h16*)(p.ws + WS_W2T); h16* W3T = (h16*)(p.ws + WS_W3T); h16* W4T = (h16*)(p.ws + WS_W4T);
    constexpr int I1 = 16 * 224, I2 = 32 * 32, I3 = 16 * 168, I4 = 24 * 32;
    for (int it = gw; it < I1 + I2 + I3 + I4; it += NGW) {
        int r = it;
        if (r < I1) { tr_item<1>(p.in[2], 1024, 7168, W1T, scr, r, 224, lane); continue; } r -= I1;
        if (r < I2) { tr_item<0>(p.in[8], 2048, 1024, W2T, scr, r, 32, lane); continue; } r -= I2;
        if (r < I3) { tr_item<2>(p.in[10], 1024, 5248, W3T, scr, r, 168, lane); continue; } r -= I3;
        tr_item<0>(p.in[22], 1536, 1024, W4T, scr, r, 32, lane);
    }
    h16* H0 = (h16*)p.out;
    for (int r = gw; r < NTOK; r += 2 * NGW) { const int r1 = (r + NGW < NTOK) ? r + NGW : r;
        rms_rows2_f16(p.in[0] + (size_t)r * DM, p.in[0] + (size_t)r1 * DM, nullptr, nullptr, p.in[1], H0 + (size_t)r * DM, H0 + (size_t)r1 * DM, lane); }
    const int gt = blockIdx.x * 512 + tid, NGT = gridDim.x * 512;
    h16* WSH = (h16*)(p.ws + WS_WSH);
    for (int i = gt; i < 8 * 128 * 128; i += NGT) WSH[i] = (h16)p.in[6][i];
    { float* STZ = (float*)(p.ws + WS_STATS); for (int i = gt; i < 2 * NTOK; i += NGT) STZ[i] = 0.f; }
    h16* CWT = (h16*)(p.ws + WS_CWT);
    const float* wf = p.in[21];
    for (int i = gt; i < 4 * 128 * 256; i += NGT) {
        const int k = i & 255, e = (i >> 8) & 127, g = i >> 15, d = k & 127; const bool sn = k >= 128;
        float s = 0.f;
        for (int dp = 0; dp < 128; ++dp) { const float fr = (float)((d * dp) & 127) * (1.f / 128.f);
            const float tw = sn ? __builtin_amdgcn_sinf(fr) : __builtin_amdgcn_cosf(fr);
            s += tw * wf[(g * 128 + dp) * 128 + e]; }
        CWT[i] = (h16)(s * 0.08838834764831845f);
    }
}

struct Epi1 {
    static constexpr bool PERM = false;
    h16 *XC, *G, *U, *V; float* st;
    __device__ __forceinline__ void operator()(const f32x4 (&acc)[2][2][4][2], const pg8::Unit& u, int wr, int wc, int fr, int fq) const {
        const int T = u.pn; const int row0 = u.pm * 256 + wr * 64 + fr;
        if (T < 16) {
            const int ch = 64 * T + 16 * wc + 4 * fq;
#pragma unroll
            for (int ai = 0; ai < 2; ++ai)
#pragma unroll
                for (int m = 0; m < 4; ++m) { const size_t r = (size_t)(row0 + ai * 128 + m * 16);
                    const f32x4 xa = acc[ai][0][m][0], ba = acc[ai][0][m][1], ca = acc[ai][1][m][0], za = acc[ai][1][m][1];
                    h16x4 xc, gg;
#pragma unroll
                    for (int e = 0; e < 4; ++e) { xc[e] = (h16)(ca[e] * xa[e]); gg[e] = (h16)(ba[e] * silu_f(za[e])); }
                    *(h16x4*)(XC + r * 1024 + ch) = xc; *(h16x4*)(G + r * 1024 + ch) = gg; }
        } else if (T < 24) {
#pragma unroll
            for (int ai = 0; ai < 2; ++ai)
#pragma unroll
                for (int m = 0; m < 4; ++m) { const size_t r = (size_t)(row0 + ai * 128 + m * 16);
#pragma unroll
                    for (int n = 0; n < 2; ++n) { const int ch = 128 * (T - 16) + 32 * wc + 16 * n + 4 * fq;
                        const f32x4 ub = acc[ai][0][m][n], zb = acc[ai][1][m][n]; h16x4 o;
#pragma unroll
                        for (int e = 0; e < 4; ++e) o[e] = (h16)(ub[e] * silu_f(zb[e]));
                        *(h16x4*)(U + r * 1024 + ch) = o; } }
        } else {
#pragma unroll
            for (int ai = 0; ai < 2; ++ai)
#pragma unroll
                for (int m = 0; m < 4; ++m) { const size_t r = (size_t)(row0 + ai * 128 + m * 16); float s1 = 0.f, s2 = 0.f;
#pragma unroll
                    for (int bj = 0; bj < 2; ++bj)
#pragma unroll
                        for (int n = 0; n < 2; ++n) { const int ch = 256 * (T - 24) + 128 * bj + 32 * wc + 16 * n + 4 * fq;
                            const f32x4 v = acc[ai][bj][m][n]; h16x4 o;
#pragma unroll
                            for (int e = 0; e < 4; ++e) { o[e] = (h16)v[e]; const float f = (float)o[e]; s1 += f; s2 += f * f; }
                            *(h16x4*)(V + r * 1024 + ch) = o; }
                    s1 += __shfl_xor(s1, 16); s2 += __shfl_xor(s2, 16); s1 += __shfl_xor(s1, 32); s2 += __shfl_xor(s2, 32);
                    if (fq == 0) { atomicAdd(st + 2 * r, s1); atomicAdd(st + 2 * r + 1, s2); } }
        }
    }
};
struct Epi2 {
    static constexpr bool PERM = true;
    h16* O1;
    __device__ __forceinline__ void operator()(const f32x4 (&acc)[2][2][4][2], const pg8::Unit& u, int wr, int wc, int fr, int fq) const {
        const int row0 = u.pm * 256 + wr * 64 + fr, col0 = u.pn * 256 + wc * 32 + 8 * fq;
#pragma unroll
        for (int ai = 0; ai < 2; ++ai)
#pragma unroll
            for (int m = 0; m < 4; ++m) { const size_t r = (size_t)(row0 + ai * 128 + m * 16);
#pragma unroll
                for (int bj = 0; bj < 2; ++bj) { const f32x4 v0 = acc[ai][bj][m][0], v1 = acc[ai][bj][m][1]; h16x8 o;
#pragma unroll
                    for (int e = 0; e < 4; ++e) { o[e] = (h16)v0[e]; o[4 + e] = (h16)v1[e]; }
                    *(h16x8*)(O1 + r * 1024 + col0 + bj * 128) = o; } }
    }
};
struct Epi3 {
    static constexpr bool PERM = true;
    h16 *PC, *ZCD, *FD;
    __device__ __forceinline__ void operator()(const f32x4 (&acc)[2][2][4][2], const pg8::Unit& u, int wr, int wc, int fr, int fq) const {
        const int row0 = u.pm * 256 + wr * 64 + fr, col0 = u.pn * 256 + wc * 32 + 8 * fq;
#pragma unroll
        for (int bj = 0; bj < 2; ++bj) { const int c = col0 + bj * 128;
            h16* base; size_t ld;
            if (c < 3200) { base = PC + c; ld = 3200; }
            else if (c < 4224) { base = ZCD + (c - 3200); ld = 1536; }
            else if (c < 4736) { base = FD + (c - 4224); ld = 512; }
            else if (c < 5248) { base = ZCD + 1024 + (c - 4736); ld = 1536; }
            else continue;
#pragma unroll
            for (int ai = 0; ai < 2; ++ai)
#pragma unroll
                for (int m = 0; m < 4; ++m) { const size_t r = (size_t)(row0 + ai * 128 + m * 16); const f32x4 v0 = acc[ai][bj][m][0], v1 = acc[ai][bj][m][1]; h16x8 o;
#pragma unroll
                    for (int e = 0; e < 4; ++e) { o[e] = (h16)v0[e]; o[4 + e] = (h16)v1[e]; }
                    *(h16x8*)(base + r * ld) = o; } }
    }
};
struct Epi4 {
    static constexpr bool PERM = true;
    h16* O2;
    __device__ __forceinline__ void operator()(const f32x4 (&acc)[2][2][4][2], const pg8::Unit& u, int wr, int wc, int fr, int fq) const {
        const int row0 = u.pm * 256 + wr * 64 + fr, col0 = u.pn * 256 + wc * 32 + 8 * fq;
#pragma unroll
        for (int ai = 0; ai < 2; ++ai)
#pragma unroll
            for (int m = 0; m < 4; ++m) { const size_t r = (size_t)(row0 + ai * 128 + m * 16);
#pragma unroll
                for (int bj = 0; bj < 2; ++bj) { const f32x4 v0 = acc[ai][bj][m][0], v1 = acc[ai][bj][m][1]; h16x8 o;
#pragma unroll
                    for (int e = 0; e < 4; ++e) { o[e] = (h16)v0[e]; o[4 + e] = (h16)v1[e]; }
                    *(h16x8*)(O2 + r * 1024 + col0 + bj * 128) = o; } }
    }
};

__device__ __forceinline__ void phase_stats(const Params& p) {
    const int tid = threadIdx.x, lane = tid & 63, wave = tid >> 6;
    const int gw = blockIdx.x * 8 + wave, NGW = gridDim.x * 8;
    const h16* V = (const h16*)(p.ws + WS_V); float* ST = (float*)(p.ws + WS_STATS);
    for (int r = gw; r < NTOK; r += NGW) {
        const h16x8 a = *(const h16x8*)(V + (size_t)r * 1024 + 8 * lane), b = *(const h16x8*)(V + (size_t)r * 1024 + 512 + 8 * lane);
        float s = 0.f;
#pragma unroll
        for (int e = 0; e < 8; ++e) s += (float)a[e] + (float)b[e];
        const float mu = wave_sum(s) * (1.f / 1024.f); float q = 0.f;
#pragma unroll
        for (int e = 0; e < 8; ++e) { const float x = (float)a[e] - mu, y = (float)b[e] - mu; q += x * x + y * y; }
        const float rs = rsqrtf(wave_sum(q) * (1.f / 1024.f) + 1e-5f);
        if (lane == 0) { ST[2 * r] = mu; ST[2 * r + 1] = rs; }
    }
}

__device__ __forceinline__ void phase_mix0(const Params& p, LAS unsigned char* lds) {
    const int tid = threadIdx.x, lane = tid & 63, wave = tid >> 6;
    const h16* XC = (const h16*)(p.ws + WS_XC); const h16* G = (const h16*)(p.ws + WS_G); const h16* U = (const h16*)(p.ws + WS_U); const h16* V = (const h16*)(p.ws + WS_V);
    h16* YC = (h16*)(p.ws + WS_YCAT);
    const float* cw = p.in[3];
    const int gt = blockIdx.x * 512 + tid, NGT = gridDim.x * 512;
    for (int idx0 = gt; idx0 < NTOK * 128; idx0 += 2 * NGT) {
        h16x8 x0[2], xm[2], xp[2], gg[2]; int tt[2], cc[2];
        const h16x8 zero = {0, 0, 0, 0, 0, 0, 0, 0};
#pragma unroll
        for (int u = 0; u < 2; ++u) { const int idx = (idx0 + u * NGT < NTOK * 128) ? idx0 + u * NGT : idx0; const int t = idx >> 7, c8 = (idx & 127) * 8, tp = t & (SEQ - 1); tt[u] = t; cc[u] = c8;
            x0[u] = *(const h16x8*)(XC + (size_t)t * 1024 + c8);
            xm[u] = tp > 0 ? *(const h16x8*)(XC + (size_t)(t - 1) * 1024 + c8) : zero;
            xp[u] = tp < SEQ - 1 ? *(const h16x8*)(XC + (size_t)(t + 1) * 1024 + c8) : zero;
            gg[u] = *(const h16x8*)(G + (size_t)t * 1024 + c8); }
#pragma unroll
        for (int u = 0; u < 2; ++u) { const int c8 = cc[u]; h16x8 o;
#pragma unroll
            for (int e = 0; e < 8; ++e) { const float y = cw[c8 + e] * (float)xm[u][e] + cw[1024 + c8 + e] * (float)x0[u][e] + cw[2048 + c8 + e] * (float)xp[u][e]; o[e] = (h16)(y * (float)gg[u][e]); }
            *(h16x8*)(YC + (size_t)tt[u] * 2048 + c8) = o; }
    }
    const float* ST = (const float*)(p.ws + WS_STATS); const h16* WSH = (const h16*)(p.ws + WS_WSH);
    const float* lng = p.in[4]; const float* lnb = p.in[5]; const float* bs = p.in[7];
    LAS h16* vnT = (LAS h16*)lds;
    for (int it = blockIdx.x; it < 1024; it += gridDim.x) {
        const int g = it & 7, bn = it >> 3, t0 = bn * 128;
        __syncthreads();
#pragma unroll
        for (int q = 0; q < 4; ++q) { const int pc = tid + 512 * q, j = pc >> 4, d8 = (pc & 15) * 8;
            const h16x8 v = *(const h16x8*)(V + (size_t)(t0 + j) * 1024 + g * 128 + d8);
            const float mu = ST[2 * (t0 + j)] * (1.f / 1024.f), rs = rsqrtf(fmaxf(ST[2 * (t0 + j) + 1] * (1.f / 1024.f) - mu * mu, 0.f) + 1e-5f);
#pragma unroll
            for (int e = 0; e < 8; ++e) vnT[(d8 + e) * 136 + ((((j >> 3) ^ (pc & 15)) << 3) | (j & 7))] = (h16)(((float)v[e] - mu) * rs * lng[g * 128 + d8 + e] + lnb[g * 128 + d8 + e]); }
        __syncthreads();
        const int itile = wave >> 1, dt0 = (wave & 1) * 2;
        f32x16 acc0, acc1;
#pragma unroll
        for (int e = 0; e < 16; ++e) { acc0[e] = 0.f; acc1[e] = 0.f; }
        const h16* Arow = WSH + ((size_t)g * 128 + itile * 32 + (lane & 31)) * 128 + 8 * (lane >> 5);
        const int d0_ = dt0 * 32 + (lane & 31), d1_ = d0_ + 32;
        const LAS h16* B0p = vnT + d0_ * 136; const LAS h16* B1p = vnT + d1_ * 136;
#pragma unroll
        for (int ks = 0; ks < 8; ++ks) {
            const h16x8 a = *(const h16x8*)(Arow + 16 * ks);
            const int jg = 2 * ks + (lane >> 5);
            const h16x8 b0 = *(const LAS h16x8*)(B0p + ((jg ^ ((d0_ >> 3) & 15)) << 3)), b1 = *(const LAS h16x8*)(B1p + ((jg ^ ((d1_ >> 3) & 15)) << 3));
            acc0 = __builtin_amdgcn_mfma_f32_32x32x16_f16(a, b0, acc0, 0, 0, 0);
            acc1 = __builtin_amdgcn_mfma_f32_32x32x16_f16(a, b1, acc1, 0, 0, 0);
        }
#pragma unroll
        for (int r = 0; r < 16; ++r) { const int i = itile * 32 + (r & 3) + 8 * (r >> 2) + 4 * (lane >> 5); const size_t t = (size_t)(t0 + i);
            const float bias = bs[g * 128 + i];
            const int d0 = g * 128 + dt0 * 32 + (lane & 31);
            YC[t * 2048 + 1024 + d0] = (h16)((acc0[r] + bias) * (float)U[t * 1024 + d0]);
            YC[t * 2048 + 1024 + d0 + 32] = (h16)((acc1[r] + bias) * (float)U[t * 1024 + d0 + 32]); }
    }
}

__device__ __forceinline__ void phase_norm1(const Params& p) {
    const int tid = threadIdx.x, lane = tid & 63, wave = tid >> 6;
    const int gw = blockIdx.x * 8 + wave, NGW = gridDim.x * 8;
    const h16* O1 = (const h16*)(p.ws + WS_O1); h16* H1 = (h16*)p.out;
    for (int r = gw; r < NTOK; r += 2 * NGW) { const int r1 = (r + NGW < NTOK) ? r + NGW : r;
        rms_rows2_f16(p.in[0] + (size_t)r * DM, p.in[0] + (size_t)r1 * DM, O1 + (size_t)r * DM, O1 + (size_t)r1 * DM, p.in[9], H1 + (size_t)r * DM, H1 + (size_t)r1 * DM, lane); }
}

__device__ __forceinline__ void phase_fft(const Params& p, LAS unsigned char* lds) {
    const int tid = threadIdx.x;
    const h16* FD = (const h16*)(p.ws + WS_FD);
    h16* SPr = (h16*)(p.ws + WS_SPR); h16* SPi = (h16*)(p.ws + WS_SPI);
    LAS f32x2* X0 = (LAS f32x2*)lds; LAS f32x2* X1 = X0 + 8192;
    for (int it = blockIdx.x; it < 256; it += gridDim.x) {
        const int b = it >> 7, c0 = 4 * (it & 127);
        __syncthreads();
        for (int t = tid; t < SEQ; t += 512) { const h16x4 v = *(const h16x4*)(FD + (size_t)(b * SEQ + t) * 512 + c0);
            X0[t] = (f32x2){(float)v[0], (float)v[1]}; X1[t] = (f32x2){(float)v[2], (float)v[3]}; }
        __syncthreads();
        for (int s = 0; s < 13; ++s) {
            const int half = 4096 >> s;
#pragma unroll 2
            for (int j = tid; j < 4096; j += 512) {
                const int pos = j & (half - 1), grp = j >> (12 - s), i0 = (grp << (13 - s)) + pos, i1 = i0 + half;
                const float fr = (float)(pos << s) * (1.f / 8192.f);
                const float c = __builtin_amdgcn_cosf(fr), sn = __builtin_amdgcn_sinf(fr);
                { const f32x2 a = X0[i0], bb = X0[i1]; const f32x2 d = a - bb; X0[i0] = a + bb; X0[i1] = (f32x2){d[0] * c + d[1] * sn, d[1] * c - d[0] * sn}; }
                { const f32x2 a = X1[i0], bb = X1[i1]; const f32x2 d = a - bb; X1[i0] = a + bb; X1[i1] = (f32x2){d[0] * c + d[1] * sn, d[1] * c - d[0] * sn}; }
            }
            __syncthreads();
        }
        const float sc = 0.5f * 0.011048543456039806f;
        for (int k = tid; k < SEQ; k += 512) {
            const int ra = __brev((unsigned)k) >> 19, rb = __brev((unsigned)((SEQ - k) & (SEQ - 1))) >> 19;
            const f32x2 za = X0[ra], zb = X0[rb], ya = X1[ra], yb = X1[rb];
            h16x4 orr, oi;
            orr[0] = (h16)((za[0] + zb[0]) * sc); oi[0] = (h16)((za[1] - zb[1]) * sc);
            orr[1] = (h16)((za[1] + zb[1]) * sc); oi[1] = (h16)((zb[0] - za[0]) * sc);
            orr[2] = (h16)((ya[0] + yb[0]) * sc); oi[2] = (h16)((ya[1] - yb[1]) * sc);
            orr[3] = (h16)((ya[1] + yb[1]) * sc); oi[3] = (h16)((yb[0] - ya[0]) * sc);
            *(h16x4*)(SPr + (size_t)(b * SEQ + k) * 512 + c0) = orr; *(h16x4*)(SPi + (size_t)(b * SEQ + k) * 512 + c0) = oi;
        }
    }
}

__device__ __forceinline__ void phase_fnet_out(const Params& p) {
    const int tid = threadIdx.x, lane = tid & 63, wave = tid >> 6;
    const int gw = blockIdx.x * 8 + wave, NGW = gridDim.x * 8;
    const h16* SPr = (const h16*)(p.ws + WS_SPR); const h16* SPi = (const h16*)(p.ws + WS_SPI);
    const h16* CWT = (const h16*)(p.ws + WS_CWT); h16* ZCD = (h16*)(p.ws + WS_ZCD);
    for (int w = gw; w < 8192; w += NGW) {
        const int et = w & 3, g = (w >> 2) & 3, tt = w >> 4;
        const size_t trow = (size_t)(tt * 32 + (lane & 31));
        const h16* Ar = SPr + trow * 512 + g * 128 + 8 * (lane >> 5); const h16* Ai = SPi + trow * 512 + g * 128 + 8 * (lane >> 5);
        const h16* Bp = CWT + ((size_t)(g * 128 + et * 32 + (lane & 31))) * 256 + 8 * (lane >> 5);
        f32x16 acc;
#pragma unroll
        for (int e = 0; e < 16; ++e) acc[e] = 0.f;
#pragma unroll
        for (int ks = 0; ks < 8; ++ks) acc = __builtin_amdgcn_mfma_f32_32x32x16_f16(*(const h16x8*)(Ar + 16 * ks), *(const h16x8*)(Bp + 16 * ks), acc, 0, 0, 0);
#pragma unroll
        for (int ks = 0; ks < 8; ++ks) acc = __builtin_amdgcn_mfma_f32_32x32x16_f16(*(const h16x8*)(Ai + 16 * ks), *(const h16x8*)(Bp + 128 + 16 * ks), acc, 0, 0, 0);
#pragma unroll
        for (int r = 0; r < 16; ++r) { const size_t t = (size_t)(tt * 32 + (r & 3) + 8 * (r >> 2) + 4 * (lane >> 5));
            h16* zp = ZCD + t * 1536 + 1024 + g * 128 + et * 32 + (lane & 31);
            *zp = (h16)(acc[r] * silu_f((float)*zp)); }
    }
}

#define LDS_BAR() do { asm volatile("s_waitcnt lgkmcnt(0)" ::: "memory"); __builtin_amdgcn_s_barrier(); asm volatile("" ::: "memory"); } while (0)
#define LDS_WAIT() asm volatile("s_waitcnt lgkmcnt(0)" ::: "memory")
__device__ __forceinline__ void phase_scan(const Params& p, LAS unsigned char* lds) {
    const int tid = threadIdx.x, lane = tid & 63, wave = tid >> 6;
    const h16* PC = (const h16*)(p.ws + WS_PC);
    LAS h16* w2T = (LAS h16*)lds;
    LAS h16* a2T = w2T + 64 * 72;
    LAS unsigned char* priv = lds + 18432 + (wave & 3) * 4096;
    constexpr int SET_F = 5 * 2048 + 512;
    LAS float* OPS = (LAS float*)(lds + 18432 + 16384);
    LAS float* sYb = OPS + 2 * SET_F;
    for (int item = blockIdx.x; item < 256; item += gridDim.x) {
        const int xcd = item & 7, slot = item >> 3, gidx = xcd * 8 + (slot >> 2), q = slot & 3;
        const int dir = gidx >> 5, b = (gidx >> 4) & 1, h = gidx & 15;
        h16* Yd = (h16*)((unsigned char*)p.out + (size_t)dir * 32 * MiB);
        float* SB = (float*)(p.ws + WS_SBON) + (size_t)dir * NTOK * 16;
        const float* mu = p.in[11] + dir * 3200; const float* w0 = p.in[12] + dir * 1024 + 64 * h; const float* w2 = p.in[13] + (size_t)dir * 65536 + 64 * h;
        const float* a0 = p.in[14] + dir * 1024 + 64 * h; const float* a2 = p.in[15] + (size_t)dir * 65536 + 64 * h;
        const float* kkw = p.in[16] + 64 * h; const float* kaw = p.in[17] + 64 * h; const float* rkw = p.in[18] + 64 * h;
        __syncthreads();
        for (int i = tid; i < 4096; i += 512) { const int l = i >> 6, c = i & 63; w2T[c * 72 + l] = (h16)w2[l * 1024 + c]; a2T[c * 72 + l] = (h16)a2[l * 1024 + c]; }
        const int pw_ = wave & 3, s_sub = lane >> 3, c8 = (lane & 7) * 8, s_l = 8 * pw_ + s_sub;
        h16x8 mu_r8, mu_k8, mu_v8, mu_w8, mu_a8; f32x2 w0r[4], a0r[4], kkr[4], kar[4], omk[4], rkr[4];
#pragma unroll
        for (int e = 0; e < 8; ++e) { mu_r8[e] = (h16)mu[64 * h + c8 + e]; mu_k8[e] = (h16)mu[1024 + 64 * h + c8 + e]; mu_v8[e] = (h16)mu[2048 + 64 * h + c8 + e]; mu_w8[e] = (h16)mu[3072 + c8 + e]; mu_a8[e] = (h16)mu[3136 + c8 + e];
            w0r[e >> 1][e & 1] = w0[c8 + e]; a0r[e >> 1][e & 1] = a0[c8 + e]; kkr[e >> 1][e & 1] = kkw[c8 + e]; kar[e >> 1][e & 1] = kaw[c8 + e]; omk[e >> 1][e & 1] = 1.f - kaw[c8 + e]; rkr[e >> 1][e & 1] = rkw[c8 + e]; }
        f32x2 S01 = {0.f, 0.f}, S23 = {0.f, 0.f};
        const int srow = 4 * (wave & 3) + (lane >> 4), j0 = 4 * (lane & 15);
        const h16x8 z8 = {0, 0, 0, 0, 0, 0, 0, 0};
        h16x8 pr, pk, pv, pw, pa, qr_, qk_, qv_, qw_, qa_;
        const h16 *pcA, *pcB, *ppA, *ppB;
        { const int t0_ = dir ? (SEQ - 1 - s_l) : s_l; pcA = PC + (size_t)(b * SEQ + t0_) * 3200 + c8 + 64 * h; pcB = pcA + 2048 - 64 * h;
          const long po_ = (s_l > 0) ? (dir ? 3200 : -3200) : 0; ppA = pcA + po_; ppB = pcB + po_; }
        const long cstride_ = dir ? -32 * 3200 : 32 * 3200;
#define SCAN_LOAD_RAW() do { \
            pr = *(const h16x8*)(pcA); pk = *(const h16x8*)(pcA + 1024); pv = *(const h16x8*)(pcB + 64 * h); pw = *(const h16x8*)(pcB + 1024); pa = *(const h16x8*)(pcB + 1088); \
            qr_ = *(const h16x8*)(ppA); qk_ = *(const h16x8*)(ppA + 1024); qv_ = *(const h16x8*)(ppB + 64 * h); qw_ = *(const h16x8*)(ppB + 1024); qa_ = *(const h16x8*)(ppB + 1088); \
            pcA += cstride_; pcB += cstride_; ppA = pcA + (dir ? 3200 : -3200); ppB = pcB + (dir ? 3200 : -3200); } while (0)
#define SCAN_LOAD(chn) SCAN_LOAD_RAW()
#define SCAN_YSTORE(chn) do { const int sg_ = (chn) * 32 + s_l; const int t_ = dir ? (SEQ - 1 - sg_) : sg_; \
            const f32x2 y2_ = *(const LAS f32x2*)(sYb + ((chn) & 1) * 512 + s_l * 16 + 2 * (lane & 7)); \
            typedef _Float16 h16x2_ __attribute__((ext_vector_type(2))); h16x2_ o_; o_[0] = (h16)y2_[0]; o_[1] = (h16)y2_[1]; \
            *(h16x2_*)(Yd + (size_t)(b * SEQ + t_) * 1024 + 64 * h + 16 * q + 2 * (lane & 7)) = o_; } while (0)
        if (wave >= 4) { SCAN_LOAD_RAW(); if (s_l == 0) { qr_ = z8; qk_ = z8; qv_ = z8; qw_ = z8; qa_ = z8; } }
        __syncthreads();
        for (int n = -1; n < SEQ / 32; ++n) {
            if (wave < 4) {
                if (n >= 0) {
                    __builtin_amdgcn_s_setprio(3);
                    const LAS float* sR = OPS + (n & 1) * SET_F + j0; const LAS float* sW = sR + 2048; const LAS float* sK = sW + 2048; const LAS float* sA = sK + 2048; const LAS float* sB = sA + 2048; const LAS float* sV = OPS + (n & 1) * SET_F + 10240;
                    LAS float* sY = sYb + (n & 1) * 512;
                    f32x4 a_ = *(const LAS f32x4*)(sA), w_ = *(const LAS f32x4*)(sW), b_ = *(const LAS f32x4*)(sB);
                    f32x4 k_ = *(const LAS f32x4*)(sK), r_ = *(const LAS f32x4*)(sR);
                    f32x4 vq[4];
#pragma unroll
                    for (int u = 0; u < 4; ++u) vq[u] = *(const LAS f32x4*)(sV + srow * 32 + 4 * u);
                    f32x4 rp = r_;
#pragma unroll
                    for (int hb = 0; hb < 2; ++hb) {
                        f32x4 vn[4];
#pragma unroll
                        for (int u = 0; u < 4; ++u) vn[u] = *(const LAS f32x4*)(sV + srow * 32 + ((16 * (hb + 1)) & 31) + 4 * u);
#pragma unroll
                        for (int u16 = 0; u16 < 16; ++u16) {
                            const int s = 16 * hb + u16;
                            const int sn = (s + 1) & 31;
                            const f32x4 a_n = *(const LAS f32x4*)(sA + sn * 64), w_n = *(const LAS f32x4*)(sW + sn * 64), b_n = *(const LAS f32x4*)(sB + sn * 64);
                            const f32x4 k_n = *(const LAS f32x4*)(sK + sn * 64), r_n = *(const LAS f32x4*)(sR + sn * 64);
                            const float v = vq[u16 >> 2][u16 & 3];
                            const f32x2 vv = {v, v};
                            f32x2 pp = S01 * (f32x2){a_[0], a_[1]}; pp = S23 * (f32x2){a_[2], a_[3]} + pp;
                            f32x2 yy = S01 * (f32x2){rp[0], rp[1]}; yy = S23 * (f32x2){rp[2], rp[3]} + yy;
                            float sa = pp[0] + pp[1], y = yy[0] + yy[1];
                            sa += dpp_f<0xB1>(sa); y += dpp_f<0xB1>(y);
                            sa += dpp_f<0x4E>(sa); y += dpp_f<0x4E>(y);
                            sa += dpp_f<0x141>(sa); y += dpp_f<0x141>(y);
                            sa += dpp_f<0x140>(sa); y += dpp_f<0x140>(y);
                            sY[((s - 1) & 31) * 16 + srow] = y;
                            const f32x2 sv = {sa, sa};
                            S01 = S01 * (f32x2){w_[0], w_[1]} + vv * (f32x2){k_[0], k_[1]};
                            S23 = S23 * (f32x2){w_[2], w_[3]} + vv * (f32x2){k_[2], k_[3]};
                            S01 = sv * (f32x2){b_[0], b_[1]} + S01;
                            S23 = sv * (f32x2){b_[2], b_[3]} + S23;
                            rp = r_;
                            a_ = a_n; w_ = w_n; b_ = b_n; k_ = k_n; r_ = r_n;
                        }
#pragma unroll
                        for (int u = 0; u < 4; ++u) vq[u] = vn[u];
                    }
                    { f32x2 yy = S01 * (f32x2){rp[0], rp[1]}; yy = S23 * (f32x2){rp[2], rp[3]} + yy; sY[31 * 16 + srow] = red16(yy[0] + yy[1]); }
                    __builtin_amdgcn_s_setprio(0);
                }
            } else {
                if (n + 1 < SEQ / 32) {
                    const int cn = n + 1;
                    const int sg = cn * 32 + s_l; const int t = dir ? (SEQ - 1 - sg) : sg;
                    f32x2 qr[4], qk[4]; float qv[8];
                    LAS h16* TWp = (LAS h16*)priv; LAS h16* QAp = TWp + 8 * 72;
                    { unsigned m1u_ = 0xBC00BC00u; asm volatile("" : "+s"(m1u_));
                      typedef unsigned u32x4_ __attribute__((ext_vector_type(4))); const u32x4_ m1v_ = {m1u_, m1u_, m1u_, m1u_}; const h16x8 m1_ = __builtin_bit_cast(h16x8, m1v_);
                      const h16x8 r8 = pr + mu_r8 * (pr * m1_ + qr_), k8 = pk + mu_k8 * (pk * m1_ + qk_), v8 = pv + mu_v8 * (pv * m1_ + qv_);
                      const h16x8 w8 = pw + mu_w8 * (pw * m1_ + qw_), a8 = pa + mu_a8 * (pa * m1_ + qa_);
                      h16x8 tw8;
#pragma unroll
                      for (int pi = 0; pi < 4; ++pi) { qr[pi] = (f32x2){(float)r8[2 * pi], (float)r8[2 * pi + 1]}; qk[pi] = (f32x2){(float)k8[2 * pi], (float)k8[2 * pi + 1]};
                          qv[2 * pi] = (float)v8[2 * pi]; qv[2 * pi + 1] = (float)v8[2 * pi + 1];
                          const f32x2 tx = (f32x2){(float)w8[2 * pi], (float)w8[2 * pi + 1]} * 2.8853900817779268f;
                          const f32x2 dn = (f32x2){__builtin_amdgcn_exp2f(tx[0]), __builtin_amdgcn_exp2f(tx[1])} + 1.f;
                          const f32x2 th = (f32x2){__builtin_amdgcn_rcpf(dn[0]), __builtin_amdgcn_rcpf(dn[1])} * -2.f + 1.f;
                          tw8[2 * pi] = (h16)th[0]; tw8[2 * pi + 1] = (h16)th[1]; }
                      *(LAS h16x8*)(TWp + s_sub * 72 + c8) = tw8; *(LAS h16x8*)(QAp + s_sub * 72 + c8) = a8; }
                    if (cn + 1 < SEQ / 32) SCAN_LOAD(cn + 1);
                    LDS_WAIT();
                    f32x4 accw[4], acca[4];
#pragma unroll
                    for (int ct = 0; ct < 4; ++ct) { accw[ct] = (f32x4){0.f, 0.f, 0.f, 0.f}; acca[ct] = (f32x4){0.f, 0.f, 0.f, 0.f}; }
#pragma unroll
                    for (int ks = 0; ks < 2; ++ks) {
                        const h16x8 atw = *(const LAS h16x8*)(TWp + (lane & 7) * 72 + 32 * ks + 8 * (lane >> 4));
                        const h16x8 aqa = *(const LAS h16x8*)(QAp + (lane & 7) * 72 + 32 * ks + 8 * (lane >> 4));
#pragma unroll
                        for (int ct = 0; ct < 4; ++ct) {
                            const h16x8 bw = *(const LAS h16x8*)(w2T + (16 * ct + (lane & 15)) * 72 + 32 * ks + 8 * (lane >> 4));
                            const h16x8 ba = *(const LAS h16x8*)(a2T + (16 * ct + (lane & 15)) * 72 + 32 * ks + 8 * (lane >> 4));
                            accw[ct] = __builtin_amdgcn_mfma_f32_16x16x32_f16(atw, bw, accw[ct], 0, 0, 0);
                            acca[ct] = __builtin_amdgcn_mfma_f32_16x16x32_f16(aqa, ba, acca[ct], 0, 0, 0);
                        }
                    }
                    LDS_WAIT();
                    { LAS float* Zd = (LAS float*)priv + (lane >> 5) * 512 + (4 * ((lane >> 4) & 1)) * 64 + (lane & 15);
#pragma unroll
                      for (int ct = 0; ct < 4; ++ct)
#pragma unroll
                          for (int r = 0; r < 4; ++r) Zd[r * 64 + 16 * ct] = (lane < 32) ? accw[ct][r] : acca[ct][r]; }
                    LDS_WAIT();
                    const LAS float* Zw = (const LAS float*)priv + s_sub * 64 + c8; const LAS float* Za = Zw + 512;
                    const f32x4 zw0 = *(const LAS f32x4*)Zw, zw1 = *(const LAS f32x4*)(Zw + 4), za0 = *(const LAS f32x4*)Za, za1 = *(const LAS f32x4*)(Za + 4);
                    LDS_WAIT();
                    f32x2 kk[4], av_[4], kp[4], dec[4], kn2 = {0.f, 0.f}, sb2 = {0.f, 0.f};
#pragma unroll
                    for (int pi = 0; pi < 4; ++pi) {
                        const f32x2 zw = (pi < 2 ? (f32x2){zw0[2 * pi], zw0[2 * pi + 1]} : (f32x2){zw1[2 * pi - 4], zw1[2 * pi - 3]}) + w0r[pi];
                        const f32x2 za = (pi < 2 ? (f32x2){za0[2 * pi], za0[2 * pi + 1]} : (f32x2){za1[2 * pi - 4], za1[2 * pi - 3]}) + a0r[pi];
                        const f32x2 tw_ = zw * -1.4426950408889634f, ta_ = za * -1.4426950408889634f;
                        const f32x2 dw = (f32x2){__builtin_amdgcn_exp2f(tw_[0]), __builtin_amdgcn_exp2f(tw_[1])} + 1.f, da = (f32x2){__builtin_amdgcn_exp2f(ta_[0]), __builtin_amdgcn_exp2f(ta_[1])} + 1.f;
                        const f32x2 sw = (f32x2){__builtin_amdgcn_rcpf(dw[0]), __builtin_amdgcn_rcpf(dw[1])} * -0.8750387749225136f;
                        dec[pi] = (f32x2){__builtin_amdgcn_exp2f(sw[0]), __builtin_amdgcn_exp2f(sw[1])};
                        av_[pi] = (f32x2){__builtin_amdgcn_rcpf(da[0]), __builtin_amdgcn_rcpf(da[1])};
                        kk[pi] = qk[pi] * kkr[pi]; kn2 = kk[pi] * kk[pi] + kn2;
                        kp[pi] = qk[pi] * (av_[pi] * kar[pi] + omk[pi]);
                        sb2 = (qr[pi] * kp[pi]) * rkr[pi] + sb2; }
                    const float kn = red8(kn2[0] + kn2[1]), sbn = red8(sb2[0] + sb2[1]);
                    const float ninv = -rsqrtf(fmaxf(kn, 1e-12f));
                    LAS float* dR = OPS + (cn & 1) * SET_F + s_l * 64 + c8;
#pragma unroll
                    for (int hf = 0; hf < 2; ++hf) {
                        const f32x2 na0 = kk[2 * hf] * ninv, na1 = kk[2 * hf + 1] * ninv;
                        const f32x2 nb0 = na0 * av_[2 * hf], nb1 = na1 * av_[2 * hf + 1];
                        *(LAS f32x4*)(dR + 4 * hf) = (f32x4){qr[2 * hf][0], qr[2 * hf][1], qr[2 * hf + 1][0], qr[2 * hf + 1][1]};
                        *(LAS f32x4*)(dR + 2048 + 4 * hf) = (f32x4){dec[2 * hf][0], dec[2 * hf][1], dec[2 * hf + 1][0], dec[2 * hf + 1][1]};
                        *(LAS f32x4*)(dR + 4096 + 4 * hf) = (f32x4){kp[2 * hf][0], kp[2 * hf][1], kp[2 * hf + 1][0], kp[2 * hf + 1][1]};
                        *(LAS f32x4*)(dR + 6144 + 4 * hf) = (f32x4){na0[0], na0[1], na1[0], na1[1]};
                        *(LAS f32x4*)(dR + 8192 + 4 * hf) = (f32x4){-nb0[0], -nb0[1], -nb1[0], -nb1[1]}; }
                    if ((c8 >> 4) == q) { LAS float* dV = OPS + (cn & 1) * SET_F + 10240 + (c8 & 15) * 32 + s_l;
#pragma unroll
                        for (int e = 0; e < 8; ++e) dV[e * 32] = qv[e]; }
                    if (q == 0 && (lane & 7) == 0) SB[(size_t)(b * SEQ + t) * 16 + h] = sbn;
                }
                if (n >= 1) SCAN_YSTORE(n - 1);
            }
            LDS_BAR();
        }
        if (wave >= 4) SCAN_YSTORE(SEQ / 32 - 1);
#undef SCAN_LOAD
#undef SCAN_LOAD_RAW
#undef SCAN_YSTORE
    }
}

__device__ __forceinline__ void phase_post(const Params& p) {
    const int tid = threadIdx.x;
    const h16* Y0 = (const h16*)p.out; const h16* Y1 = (const h16*)((const unsigned char*)p.out + 32 * MiB);
    const h16* PC = (const h16*)(p.ws + WS_PC); h16* ZCD = (h16*)(p.ws + WS_ZCD);
    const float* SB0 = (const float*)(p.ws + WS_SBON); const float* SB1 = SB0 + (size_t)NTOK * 16;
    const float* mu0 = p.in[11] + 2048; const float* mu1 = p.in[11] + 3200 + 2048;
    const float* lg = p.in[19]; const float* lb = p.in[20];
    const int gt = blockIdx.x * 512 + tid, NGT = gridDim.x * 512;
    for (int idx = gt; idx < NTOK * 128; idx += NGT) {
        const int t = idx >> 7, c = (idx & 127) * 8, hh = c >> 6, tp = t & (SEQ - 1);
        const h16x8 y0 = *(const h16x8*)(Y0 + (size_t)t * 1024 + c), y1 = *(const h16x8*)(Y1 + (size_t)t * 1024 + c);
        const h16x8 z8 = {0, 0, 0, 0, 0, 0, 0, 0};
        const h16x8 v0 = *(const h16x8*)(PC + (size_t)t * 3200 + 2048 + c);
        const h16x8 vm = tp > 0 ? *(const h16x8*)(PC + (size_t)(t - 1) * 3200 + 2048 + c) : z8;
        const h16x8 vp = tp < SEQ - 1 ? *(const h16x8*)(PC + (size_t)(t + 1) * 3200 + 2048 + c) : z8;
        const h16x8 zc = *(const h16x8*)(ZCD + (size_t)t * 1536 + c);
        const float s0 = SB0[(size_t)t * 16 + hh], s1 = SB1[(size_t)t * 16 + hh];
        float y[8], s = 0.f;
#pragma unroll
        for (int e = 0; e < 8; ++e) { y[e] = (float)y0[e] + (float)y1[e]; s += y[e]; }
        const float mean = red8(s) * (1.f / 64.f); float q = 0.f;
#pragma unroll
        for (int e = 0; e < 8; ++e) { y[e] -= mean; q += y[e] * y[e]; }
        const float rs = rsqrtf(red8(q) * (1.f / 64.f) + 64e-5f);
        const f32x4 lg0 = *(const f32x4*)(lg + c), lg1 = *(const f32x4*)(lg + c + 4), lb0 = *(const f32x4*)(lb + c), lb1 = *(const f32x4*)(lb + c + 4);
        const f32x4 ma0 = *(const f32x4*)(mu0 + c), ma1 = *(const f32x4*)(mu0 + c + 4), mb0 = *(const f32x4*)(mu1 + c), mb1 = *(const f32x4*)(mu1 + c + 4);
        h16x8 o;
#pragma unroll
        for (int e = 0; e < 8; ++e) { const float vv = (float)v0[e];
            const float m0 = e < 4 ? ma0[e & 3] : ma1[e & 3], m1 = e < 4 ? mb0[e & 3] : mb1[e & 3], gg = e < 4 ? lg0[e & 3] : lg1[e & 3], bb = e < 4 ? lb0[e & 3] : lb1[e & 3];
            const float vd0 = vv + m0 * ((float)vm[e] - vv), vd1 = vv + m1 * ((float)vp[e] - vv);
            const float val = y[e] * rs * gg + bb + s0 * vd0 + s1 * vd1;
            o[e] = (h16)(val * silu_f((float)zc[e])); }
        *(h16x8*)(ZCD + (size_t)t * 1536 + c) = o;
    }
}

__device__ __forceinline__ void phase_final(const Params& p) {
    const int tid = threadIdx.x, lane = tid & 63, wave = tid >> 6;
    const int gw = blockIdx.x * 8 + wave, NGW = gridDim.x * 8;
    const float* g = p.in[23]; const h16* O1 = (const h16*)(p.ws + WS_O1); const h16* O2 = (const h16*)(p.ws + WS_O2);
    for (int r = gw; r < NTOK; r += 2 * NGW) {
        const int rr[2] = {r, (r + NGW < NTOK) ? r + NGW : r};
        f32x4 v[2][4]; h16x4 a[2][4], b[2][4]; float ss[2] = {0.f, 0.f};
#pragma unroll
        for (int u = 0; u < 2; ++u)
#pragma unroll
            for (int j = 0; j < 4; ++j) { const size_t o = (size_t)rr[u] * DM + 4 * lane + 256 * j; v[u][j] = *(const f32x4*)(p.in[0] + o); a[u][j] = *(const h16x4*)(O1 + o); b[u][j] = *(const h16x4*)(O2 + o); }
#pragma unroll
        for (int u = 0; u < 2; ++u)
#pragma unroll
            for (int j = 0; j < 4; ++j) {
#pragma unroll
                for (int e = 0; e < 4; ++e) v[u][j][e] += (float)a[u][j][e] + (float)b[u][j][e];
                ss[u] += v[u][j][0] * v[u][j][0] + v[u][j][1] * v[u][j][1] + v[u][j][2] * v[u][j][2] + v[u][j][3] * v[u][j][3]; }
#pragma unroll
        for (int o = 1; o < 64; o <<= 1) { ss[0] += __shfl_xor(ss[0], o); ss[1] += __shfl_xor(ss[1], o); }
        const float rs[2] = {rsqrtf(ss[0] * (1.f / 1024.f) + 1e-6f), rsqrtf(ss[1] * (1.f / 1024.f) + 1e-6f)};
#pragma unroll
        for (int j = 0; j < 4; ++j) { const f32x4 gg = *(const f32x4*)(g + 4 * lane + 256 * j);
#pragma unroll
            for (int u = 0; u < 2; ++u) { f32x4 o = v[u][j] * rs[u]; o = o * gg; *(f32x4*)(p.out + (size_t)rr[u] * DM + 4 * lane + 256 * j) = o; } }
    }
}

__global__ void __launch_bounds__(512, 2) mega(Params p) {
    extern __shared__ __attribute__((aligned(16))) unsigned char smem[];
    LAS unsigned char* lds = (LAS unsigned char*)smem;
    cg::grid_group grid = cg::this_grid();
    unsigned char* ws = p.ws;
    const int lo = p.ph_lo, hi = p.ph_hi;
#define IN(k) (lo <= (k) && (k) < hi)
    volatile LAS unsigned* bst = (volatile LAS unsigned*)(lds + LDS_MAIN);
    if (threadIdx.x < 4) bst[threadIdx.x] = 0u;
    __syncthreads();
    const XcdBarrier bar = xcd_barrier_post((unsigned*)(ws + WS_BAR), bst);
    if (hi > 1000) grid.sync();
#define SEAM(k) do { if (IN(k) && IN((k) + 1)) { xcd_barrier(bar); if ((REPMASK >> 13) & 1) xcd_barrier(bar); } } while (0)
    if (IN(0)) for (int rep_ = 0; rep_ <= ((REPMASK >> 0) & 1); ++rep_) { phase0(p, lds); } SEAM(0);
    if (IN(1)) for (int rep_ = 0; rep_ <= ((REPMASK >> 1) & 1); ++rep_) { pg8::Gemm g{(const h16*)p.out, (const h16*)(ws + WS_W1T), NTOK, 7168, 1024}; pg8::StaticOrder S; S.init(NTOK, 7168, gridDim.x, blockIdx.x);
                 Epi1 E{(h16*)(ws + WS_XC), (h16*)(ws + WS_G), (h16*)(ws + WS_U), (h16*)(ws + WS_V), (float*)(ws + WS_STATS)}; pg8::gemm_phase<Epi1>(lds, g, S, E); } SEAM(1);
    if (IN(3)) for (int rep_ = 0; rep_ <= ((REPMASK >> 3) & 1); ++rep_) { phase_mix0(p, lds); } SEAM(3);
    if (IN(4)) for (int rep_ = 0; rep_ <= ((REPMASK >> 4) & 1); ++rep_) { pg8::Gemm g{(const h16*)(ws + WS_YCAT), (const h16*)(ws + WS_W2T), NTOK, 1024, 2048}; pg8::StaticOrder S; S.init(NTOK, 1024, gridDim.x, blockIdx.x);
                 Epi2 E{(h16*)(ws + WS_O1)}; pg8::gemm_phase<Epi2>(lds, g, S, E); } SEAM(4);
    if (IN(5)) for (int rep_ = 0; rep_ <= ((REPMASK >> 5) & 1); ++rep_) { phase_norm1(p); } SEAM(5);
    if (IN(6)) for (int rep_ = 0; rep_ <= ((REPMASK >> 6) & 1); ++rep_) { pg8::Gemm g{(const h16*)p.out, (const h16*)(ws + WS_W3T), NTOK, 5376, 1024}; pg8::StaticOrder S; S.init(NTOK, 5376, gridDim.x, blockIdx.x);
                 Epi3 E{(h16*)(ws + WS_PC), (h16*)(ws + WS_ZCD), (h16*)(ws + WS_FD)}; pg8::gemm_phase<Epi3>(lds, g, S, E); } SEAM(6);
    if (IN(7)) for (int rep_ = 0; rep_ <= ((REPMASK >> 7) & 1); ++rep_) { phase_fft(p, lds); }
    if (IN(8)) for (int rep_ = 0; rep_ <= ((REPMASK >> 8) & 1); ++rep_) { phase_scan(p, lds); } SEAM(8);
    if (IN(9)) for (int rep_ = 0; rep_ <= ((REPMASK >> 9) & 1); ++rep_) { phase_fnet_out(p); }
    if (IN(10)) for (int rep_ = 0; rep_ <= ((REPMASK >> 10) & 1); ++rep_) { phase_post(p); } SEAM(10);
    if (IN(11)) for (int rep_ = 0; rep_ <= ((REPMASK >> 11) & 1); ++rep_) { pg8::Gemm g{(const h16*)(ws + WS_ZCD), (const h16*)(ws + WS_W4T), NTOK, 1024, 1536}; pg8::StaticOrder S; S.init(NTOK, 1024, gridDim.x, blockIdx.x);
                  Epi4 E{(h16*)(ws + WS_O2)}; pg8::gemm_phase<Epi4>(lds, g, S, E); } SEAM(11);
    if (IN(12)) for (int rep_ = 0; rep_ <= ((REPMASK >> 12) & 1); ++rep_) { phase_final(p); }
}

extern "C" void kernel_launch(void* const* d_in, const int* in_sizes, int n_in, void* d_out, int out_size, void* d_ws, size_t ws_size, hipStream_t stream) {
    static int grid = 0;
    if (grid == 0) {
        int dev = 0, cus = 0, per_cu = 0;
        hipGetDevice(&dev);
        hipDeviceGetAttribute(&cus, hipDeviceAttributeMultiprocessorCount, dev);
        if (hipFuncSetAttribute((const void*)mega, hipFuncAttributeMaxDynamicSharedMemorySize, LDS_BYTES) != hipSuccess) fprintf(stderr, "kernel_launch: hipFuncSetAttribute failed\n");
        hipOccupancyMaxActiveBlocksPerMultiprocessor(&per_cu, (const void*)mega, 512, LDS_BYTES);
        if (per_cu < 1) { fprintf(stderr, "kernel_launch: occupancy query says %d blocks per CU\n", per_cu); per_cu = 1; }
        (void)hipGetLastError();
        grid = cus;
        if (grid < 64) grid = 64;
    }
    if (hipMemsetAsync((unsigned char*)d_ws + WS_BAR, 0, XCD_BAR_WORDS * 4, stream) != hipSuccess) fprintf(stderr, "kernel_launch: memset of the barrier words failed\n");
    Params p{};
    for (int i = 0; i < 24; ++i) p.in[i] = (const float*)d_in[i];
    p.out = (float*)d_out; p.ws = (unsigned char*)d_ws;
#if N_LAUNCH_MODE == 1
    p.ph_lo = 0; p.ph_hi = NPHASE;
    void* args[] = {&p};
    hipError_t e = hipLaunchCooperativeKernel((const void*)mega, dim3(grid), dim3(512), args, LDS_BYTES, stream);
    if (e != hipSuccess) fprintf(stderr, "kernel_launch: cooperative launch failed: %s (grid %d)\n", hipGetErrorString(e), grid);
#else
    for (int ph = 0; ph < NPHASE; ++ph) { p.ph_lo = ph; p.ph_hi = ph + 1; hipLaunchKernelGGL(mega, dim3(grid), dim3(512), LDS_BYTES, stream, p); }
#endif
}
```

```cpp
#include <hip/hip_runtime.h>
#include <hip/hip_cooperative_groups.h>
#include <cstdio>
#include <cstdint>
namespace cg = cooperative_groups;

#ifndef N_LAUNCH_MODE
#define N_LAUNCH_MODE 1
#endif

#ifndef REPMASK
#define REPMASK 0
#endif
#define LAS __attribute__((address_space(3)))
typedef _Float16 h16;
typedef _Float16 h16x8 __attribute__((ext_vector_type(8)));
typedef _Float16 h16x4 __attribute__((ext_vector_type(4)));
typedef float f32x2 __attribute__((ext_vector_type(2)));
typedef float f32x4 __attribute__((ext_vector_type(4)));
typedef float f32x16 __attribute__((ext_vector_type(16)));

constexpr int NTOK = 16384, DM = 1024, SEQ = 8192;
constexpr int LDS_MAIN = 131072;
constexpr int LDS_BYTES = LDS_MAIN + 16;
constexpr int NPHASE = 13;
constexpr size_t MiB = 1024 * 1024;
constexpr size_t WS_W1T = 0;
constexpr size_t WS_W2T = WS_W1T + (size_t)7168 * 1024 * 2;
constexpr size_t WS_W3T = WS_W2T + (size_t)1024 * 2048 * 2;
constexpr size_t WS_W4T = WS_W3T + (size_t)5376 * 1024 * 2;
constexpr size_t WS_STATS = 32 * MiB;
constexpr size_t WS_WSH = WS_STATS + 131072;
constexpr size_t WS_CWT = WS_WSH + 262144;
constexpr size_t WS_SBON = WS_CWT + 262144;
constexpr size_t WS_BAR = 35 * MiB;
constexpr size_t WS_XC = 36 * MiB, WS_G = 68 * MiB, WS_U = 100 * MiB, WS_V = 132 * MiB, WS_YCAT = 164 * MiB;
constexpr size_t WS_SPR = 0, WS_SPI = 232 * MiB;
constexpr size_t WS_O2 = 68 * MiB;
constexpr size_t WS_O1 = 36 * MiB, WS_PC = 68 * MiB, WS_ZCD = 168 * MiB, WS_FD = 216 * MiB;

namespace pg8 {
constexpr int BM = 256, BK = 64, HALF = 128, HTB = HALF * BK * 2, STAGE_BYTES = 8 * HTB, NXCD = 8, WGM = 8;
__host__ __device__ __forceinline__ int lds_byte(int r, int c) { const int st = (r >> 4) * 2 + (c >> 5), rr = r & 15, cc = c & 31, ob = rr * 64 + cc * 2; return st * 1024 + (ob ^ (((ob >> 9) & 1) << 5)); }
__host__ __device__ __forceinline__ void stage_rc(int b, int& R, int& C) { const int st = b / 1024, sb = b % 1024, swz = sb ^ (((sb >> 9) & 1) << 5); R = (st >> 1) * 16 + swz / 64; C = (st & 1) * 32 + (swz % 64) / 2; }
__host__ __device__ __forceinline__ int perm32(int rho) { const int n = rho >> 4, i = rho & 15; return 8 * (i >> 2) + 4 * n + (i & 3); }
struct Unit { int pm, pn; };
struct Gemm { const h16* A; const h16* Bt; int M, N, K; };
struct StaticOrder {
    int nM, nN, nwg, G, c;
    __host__ __device__ void init(int M, int N, int G_, int c_) { nM = M / BM; nN = N / BM; nwg = nM * nN; G = G_; c = c_; }
    __host__ __device__ bool next(int i, Unit& u) const {
        const long L = (long)i * G + c; if (L >= nwg) return false;
        int wgid = (int)L; { const int q = nwg / NXCD, r = nwg % NXCD, xcd = wgid % NXCD, off = wgid / NXCD; wgid = (xcd < r ? xcd * (q + 1) : r * (q + 1) + (xcd - r) * q) + off; }
        const int nig = WGM * nN, gid = wgid / nig, fm = gid * WGM, gsz = (nM - fm) < WGM ? (nM - fm) : WGM;
        u.pm = fm + ((wgid % nig) % gsz); u.pn = (wgid % nig) / gsz; return true;
    }
};
template <class Epi>
__device__ __forceinline__ void gemm_phase(LAS unsigned char* lds, const Gemm g, const StaticOrder& S, const Epi& E) {
    const int tid = threadIdx.x, wid = __builtin_amdgcn_readfirstlane(tid >> 6), lane = tid & 63, wr = wid >> 2, wc = wid & 3, fr = lane & 15, fq = lane >> 4;
    const int K = g.K, nt = K / BK;
    unsigned voffA[2], voffB[2];
#pragma unroll
    for (int i = 0; i < 2; ++i) { int R, C; stage_rc(tid * 16 + i * 8192, R, C); const int Rb = Epi::PERM ? ((R & ~31) + perm32(R & 31)) : R; voffA[i] = (unsigned)(R * K + C) * 2u; voffB[i] = (unsigned)(Rb * K + C) * 2u; }
    const size_t kstep = (size_t)(BK * 2);
    const size_t hstep = (size_t)HALF * K * 2;
    const size_t tstep = 2 * hstep;
    const unsigned ldsw = (unsigned)wid * 1024u;
    const int aoff = lds_byte(wr * 64 + fr, fq * 8), boff = lds_byte(wc * 32 + fr, fq * 8);
#define PG8_SA(b, h) (((b) * 2 + (h)) * HTB)
#define PG8_SB(b, h) ((4 + (b) * 2 + (h)) * HTB)
#define PG8_STAGE(bufoff, gbase, voff) do { _Pragma("unroll") for (int _i = 0; _i < 2; ++_i) \
        __builtin_amdgcn_global_load_lds((const unsigned*)((const char*)(gbase) + (voff)[_i]), (LAS unsigned*)(lds + (bufoff) + ldsw + _i * 8192), 16, 0, 0); } while (0)
#define PG8_LDA(dst, b, h) do { _Pragma("unroll") for (int m = 0; m < 4; ++m) _Pragma("unroll") for (int k = 0; k < 2; ++k) dst[m][k] = *(const LAS h16x8*)(lds + PG8_SA(b, h) + aoff + m * 2048 + k * 1024); } while (0)
#define PG8_LDB(dst, b, h) do { _Pragma("unroll") for (int n = 0; n < 2; ++n) _Pragma("unroll") for (int k = 0; k < 2; ++k) dst[n][k] = *(const LAS h16x8*)(lds + PG8_SB(b, h) + boff + n * 2048 + k * 1024); } while (0)
#define PG8_MMA(ai, bj, At, Bt) do { __builtin_amdgcn_s_setprio(1); _Pragma("unroll") for (int m = 0; m < 4; ++m) _Pragma("unroll") for (int n = 0; n < 2; ++n) _Pragma("unroll") for (int k = 0; k < 2; ++k) \
        acc[ai][bj][m][n] = __builtin_amdgcn_mfma_f32_16x16x32_f16(Bt[n][k], At[m][k], acc[ai][bj][m][n], 0, 0, 0); __builtin_amdgcn_s_setprio(0); } while (0)
#define PG8_WAIT_V(n) asm volatile("s_waitcnt vmcnt(" #n ")" ::: "memory")
#define PG8_WAIT_L(n) asm volatile("s_waitcnt lgkmcnt(" #n ")" ::: "memory")
#define PG8_BAR __builtin_amdgcn_s_barrier()
#define PG8_SCHED __builtin_amdgcn_sched_barrier(0)
    Unit cur, nxt; int ui = 0;
    if (!S.next(0, cur)) return;
    f32x4 acc[2][2][4][2];
#pragma unroll
    for (int a = 0; a < 2; ++a)
#pragma unroll
        for (int b = 0; b < 2; ++b)
#pragma unroll
            for (int m = 0; m < 4; ++m)
#pragma unroll
                for (int n = 0; n < 2; ++n) acc[a][b][m][n] = (f32x4){0.f, 0.f, 0.f, 0.f};
    h16x8 At[4][2], B0[2][2], B1[2][2];
    const char* cA = (const char*)g.A + (size_t)cur.pm * tstep; const char* cB = (const char*)g.Bt + (size_t)cur.pn * tstep;
    PG8_STAGE(PG8_SB(0, 0), cB, voffB); PG8_STAGE(PG8_SA(0, 0), cA, voffA); PG8_STAGE(PG8_SB(0, 1), cB + hstep, voffB); PG8_STAGE(PG8_SA(0, 1), cA + hstep, voffA);
    if (wr == 1) PG8_BAR;
    PG8_WAIT_V(4); PG8_BAR;
    PG8_STAGE(PG8_SB(1, 0), cB + kstep, voffB); PG8_STAGE(PG8_SA(1, 0), cA + kstep, voffA); PG8_STAGE(PG8_SB(1, 1), cB + hstep + kstep, voffB);
    PG8_WAIT_V(6); PG8_BAR;
    for (;;) {
        const bool has_next = S.next(ui + 1, nxt);
        const char* nA = has_next ? (const char*)g.A + (size_t)nxt.pm * tstep : cA; const char* nB = has_next ? (const char*)g.Bt + (size_t)nxt.pn * tstep : cB;
        for (int t = 0; t < nt; t += 2) {
            const bool last = (t == nt - 2);
            const char* a1 = cA + (size_t)(t + 1) * kstep;
            const char* a2 = last ? nA : cA + (size_t)(t + 2) * kstep; const char* b2 = last ? nB : cB + (size_t)(t + 2) * kstep;
            const char* a3 = a2 + kstep; const char* b3 = b2 + kstep;
            PG8_LDB(B0, 0, 0); PG8_SCHED; PG8_LDA(At, 0, 0); PG8_STAGE(PG8_SA(1, 1), a1 + hstep, voffA);
            PG8_WAIT_L(8); PG8_BAR; PG8_WAIT_L(0); PG8_MMA(0, 0, At, B0); PG8_BAR; PG8_SCHED;
            PG8_LDB(B1, 0, 1); PG8_STAGE(PG8_SB(0, 0), b2, voffB);
            PG8_BAR; PG8_WAIT_L(0); PG8_MMA(0, 1, At, B1); PG8_BAR;
            PG8_LDA(At, 0, 1); PG8_STAGE(PG8_SA(0, 0), a2, voffA);
            PG8_BAR; PG8_WAIT_L(0); PG8_MMA(1, 0, At, B0); PG8_BAR; PG8_SCHED;
            PG8_STAGE(PG8_SB(0, 1), b2 + hstep, voffB);
            PG8_WAIT_V(6); PG8_BAR; PG8_MMA(1, 1, At, B1); PG8_BAR;
            PG8_LDB(B0, 1, 0); PG8_SCHED; PG8_LDA(At, 1, 0); PG8_STAGE(PG8_SA(0, 1), a2 + hstep, voffA);
            PG8_WAIT_L(8); PG8_BAR; PG8_WAIT_L(0); PG8_MMA(0, 0, At, B0); PG8_BAR; PG8_SCHED;
            PG8_LDB(B1, 1, 1); PG8_STAGE(PG8_SB(1, 0), b3, voffB);
            PG8_BAR; PG8_WAIT_L(0); PG8_MMA(0, 1, At, B1); PG8_BAR;
            PG8_LDA(At, 1, 1); PG8_STAGE(PG8_SA(1, 0), a3, voffA);
            PG8_BAR; PG8_WAIT_L(0); PG8_MMA(1, 0, At, B0); PG8_BAR; PG8_SCHED;
            PG8_STAGE(PG8_SB(1, 1), b3 + hstep, voffB);
            PG8_WAIT_V(6); PG8_BAR; PG8_MMA(1, 1, At, B1); PG8_BAR;
        }
        E(acc, cur, wr, wc, fr, fq);
        if (!has_next) break;
#pragma unroll
        for (int a = 0; a < 2; ++a)
#pragma unroll
            for (int b = 0; b < 2; ++b)
#pragma unroll
                for (int m = 0; m < 4; ++m)
#pragma unroll
                    for (int n = 0; n < 2; ++n) acc[a][b][m][n] = (f32x4){0.f, 0.f, 0.f, 0.f};
        cur = nxt; cA = nA; cB = nB; ++ui;
    }
    PG8_WAIT_V(0);
    if (wr == 0) PG8_BAR;
    PG8_BAR;
#undef PG8_SA
#undef PG8_SB
#undef PG8_STAGE
#undef PG8_LDA
#undef PG8_LDB
#undef PG8_MMA
#undef PG8_WAIT_V
#undef PG8_WAIT_L
#undef PG8_BAR
#undef PG8_SCHED
}
}


#define XB_TMO      128
#define XB_XCNT(j)  (256  + 64 * (j))
#define XB_XSUB(j)  (1280 + 64 * (j))
#define XB_XGEN(j)  (2304 + 64 * (j))
#define XB_TOP      3328
#define XB_TOPGEN   3392
#define XCD_BAR_WORDS 3456
#define XB_SPIN_CAP (1u << 18)
__device__ __forceinline__ unsigned xb_ld(unsigned* p)              { return __hip_atomic_load(p, __ATOMIC_RELAXED, __HIP_MEMORY_SCOPE_AGENT); }
__device__ __forceinline__ unsigned xb_add(unsigned* p, unsigned v) { return __hip_atomic_fetch_add(p, v, __ATOMIC_RELAXED, __HIP_MEMORY_SCOPE_AGENT); }
__device__ __forceinline__ unsigned xb_xcc_id() { return (unsigned)__builtin_amdgcn_s_getreg((3 << 11) | 20) & 0xFu; }
#define XB_SPIN(cond, bar) do { unsigned _sp = 0; while (cond) { __builtin_amdgcn_s_sleep(1); \
    if ((++_sp & 255u) == 0u) { if (xb_ld(&(bar)[XB_TMO])) break; if (_sp > XB_SPIN_CAP) { atomicAdd(&(bar)[XB_TMO], 1u); break; } } } } while (0)
struct XcdBarrier { unsigned* bar; unsigned x; volatile LAS unsigned* st; };
__device__ __forceinline__ XcdBarrier xcd_barrier_post(unsigned* bar, volatile LAS unsigned* st) {
    XcdBarrier b; b.bar = bar; b.x = xb_xcc_id(); b.st = st;
    if (threadIdx.x == 0) (void)xb_add(&bar[XB_XCNT(b.x)], 1u);
    return b;
}
__device__ __forceinline__ void xcd_barrier_complete(unsigned* bar, unsigned x, unsigned& nloc, unsigned& nx) {
    const unsigned G = gridDim.x * gridDim.y * gridDim.z;
    unsigned sum, cnt, mine, sp = 0u;
    for (;;) {
        sum = 0u; cnt = 0u; mine = 0u;
#pragma unroll
        for (unsigned j = 0; j < 16; ++j) { const unsigned c = xb_ld(&bar[XB_XCNT(j)]); sum += c; cnt += (c > 0u) ? 1u : 0u; mine = (j == x) ? c : mine; }
        if (sum == G) break;
        __builtin_amdgcn_s_sleep(1);
        if ((++sp & 255u) == 0u) { if (xb_ld(&bar[XB_TMO])) break; if (sp > XB_SPIN_CAP) { atomicAdd(&bar[XB_TMO], 1u); break; } }
    }
    nloc = mine > 0u ? mine : 1u; nx = cnt > 0u ? cnt : 1u;
}
__device__ __forceinline__ void xcd_barrier(const XcdBarrier& b) {
    asm volatile("s_waitcnt vmcnt(0)" ::: "memory");
    __syncthreads();
    if (threadIdx.x == 0) {
        unsigned* bar = b.bar;
        __builtin_amdgcn_s_waitcnt(0);
        unsigned nloc = b.st[0], nx = b.st[1];
        if (nloc == 0u) { xcd_barrier_complete(bar, b.x, nloc, nx); b.st[0] = nloc; b.st[1] = nx; }
        const unsigned old = xb_add(&bar[XB_XSUB(b.x)], 1u);
        const unsigned gen = old / nloc;
        if (old + 1u == (gen + 1u) * nloc) {
            __builtin_amdgcn_fence(__ATOMIC_RELEASE, "agent");
            asm volatile("s_waitcnt vmcnt(0)" ::: "memory");
            const unsigned og = xb_add(&bar[XB_TOP], 1u);
            const unsigned tg = og / nx;
            if (og + 1u == (tg + 1u) * nx) xb_add(&bar[XB_TOPGEN], 1u);
            else XB_SPIN(xb_ld(&bar[XB_TOPGEN]) == tg, bar);
            __builtin_amdgcn_fence(__ATOMIC_ACQUIRE, "agent");
            xb_add(&bar[XB_XGEN(b.x)], 1u);
            asm volatile("s_waitcnt vmcnt(0)" ::: "memory");
        } else {
            XB_SPIN(xb_ld(&bar[XB_XGEN(b.x)]) == gen, bar);
            __builtin_amdgcn_fence(__ATOMIC_ACQUIRE, "agent");
            asm volatile("s_waitcnt vmcnt(0)" ::: "memory");
        }
    }
    __syncthreads();
}

struct Params { const float* in[24]; float* out; unsigned char* ws; int ph_lo, ph_hi; };

__device__ __forceinline__ float silu_f(float x) { return x * __builtin_amdgcn_rcpf(1.f + __expf(-x)); }
__device__ __forceinline__ float sigmoid_f(float x) { return __builtin_amdgcn_rcpf(1.f + __expf(-x)); }
__device__ __forceinline__ float tanh_f(float x) { return 1.f - 2.f * __builtin_amdgcn_rcpf(__expf(2.f * x) + 1.f); }
__device__ __forceinline__ float wave_sum(float v) {
#pragma unroll
    for (int o = 1; o < 64; o <<= 1) v += __shfl_xor(v, o);
    return v;
}
template <int CTRL> __device__ __forceinline__ float dpp_f(float x) { return __int_as_float(__builtin_amdgcn_update_dpp(0, __float_as_int(x), CTRL, 0xf, 0xf, false)); }
__device__ __forceinline__ float red8(float x) {
    x += dpp_f<0xB1>(x); x += dpp_f<0x4E>(x); x += dpp_f<0x141>(x); return x;
}
__device__ __forceinline__ float red16(float x) {
    x += dpp_f<0xB1>(x); x += dpp_f<0x4E>(x); x += dpp_f<0x141>(x); x += dpp_f<0x140>(x); return x;
}

__device__ __forceinline__ int sigma1(int np) {
    const int T = np >> 8, c = np & 255;
    if (T < 16) { const int bj = c >> 7, wc = (c >> 5) & 3, fq = (c >> 3) & 3, n = (c >> 2) & 1, e = c & 3; return 1024 * (2 * bj + n) + 64 * T + 16 * wc + 4 * fq + e; }
    if (T < 24) { return ((c >> 7) ? 6144 : 4096) + 128 * (T - 16) + (c & 127); }
    return 5120 + 256 * (T - 24) + c;
}

template <int MODE>
__device__ __forceinline__ void tr_item(const float* W, int K, int N, h16* WT, LAS float* scr, int item, int nblk, int lane) {
    const int kb = item / nblk, nb = item % nblk, k0 = 64 * kb, n0 = 32 * nb;
    const int np = n0 + (lane & 31);
    const int sc = (MODE == 1) ? sigma1(np) : np;
    const bool valid = (MODE != 2) || (np < 5248);
    float wv_[32];
#pragma unroll
    for (int i = 0; i < 32; ++i) { const int kk = 2 * i + (lane >> 5); wv_[i] = valid ? W[(size_t)(k0 + kk) * N + sc] : 0.f; }
#pragma unroll
    for (int i = 0; i < 32; ++i) { const int kk = 2 * i + (lane >> 5); scr[kk * 33 + (lane & 31)] = wv_[i]; }
    asm volatile("s_waitcnt lgkmcnt(0)" ::: "memory");
    const int c = lane & 7;
#pragma unroll
    for (int j = 0; j < 4; ++j) { const int n = (lane >> 3) + 8 * j; const LAS float* s = scr + (8 * c) * 33 + n;
        h16x8 o;
#pragma unroll
        for (int e = 0; e < 8; ++e) o[e] = (h16)s[e * 33];
        *(h16x8*)(WT + (size_t)(n0 + n) * K + k0 + 8 * c) = o; }
    asm volatile("s_waitcnt lgkmcnt(0)" ::: "memory");
}

__device__ __forceinline__ void rms_rows2_f16(const float* x0, const float* x1, const h16* ad0, const h16* ad1, const float* g, h16* or0, h16* or1, int lane) {
    f32x4 v[2][4]; h16x4 a[2][4]; float ss[2] = {0.f, 0.f};
#pragma unroll
    for (int j = 0; j < 4; ++j) { v[0][j] = *(const f32x4*)(x0 + 4 * lane + 256 * j); v[1][j] = *(const f32x4*)(x1 + 4 * lane + 256 * j);
        if (ad0) { a[0][j] = *(const h16x4*)(ad0 + 4 * lane + 256 * j); a[1][j] = *(const h16x4*)(ad1 + 4 * lane + 256 * j); } }
#pragma unroll
    for (int u = 0; u < 2; ++u)
#pragma unroll
        for (int j = 0; j < 4; ++j) {
            if (ad0) { v[u][j][0] += (float)a[u][j][0]; v[u][j][1] += (float)a[u][j][1]; v[u][j][2] += (float)a[u][j][2]; v[u][j][3] += (float)a[u][j][3]; }
            ss[u] += v[u][j][0] * v[u][j][0] + v[u][j][1] * v[u][j][1] + v[u][j][2] * v[u][j][2] + v[u][j][3] * v[u][j][3]; }
#pragma unroll
    for (int o = 1; o < 64; o <<= 1) { ss[0] += __shfl_xor(ss[0], o); ss[1] += __shfl_xor(ss[1], o); }
    const float rs0 = rsqrtf(ss[0] * (1.f / 1024.f) + 1e-6f), rs1 = rsqrtf(ss[1] * (1.f / 1024.f) + 1e-6f);
#pragma unroll
    for (int j = 0; j < 4; ++j) { const f32x4 gg = *(const f32x4*)(g + 4 * lane + 256 * j); h16x4 o0, o1;
#pragma unroll
        for (int e = 0; e < 4; ++e) { o0[e] = (h16)(v[0][j][e] * rs0 * gg[e]); o1[e] = (h16)(v[1][j][e] * rs1 * gg[e]); }
        *(h16x4*)(or0 + 4 * lane + 256 * j) = o0; *(h16x4*)(or1 + 4 * lane + 256 * j) = o1; }
}

__device__ __forceinline__ void phase0(const Params& p, LAS unsigned char* lds) {
    const int tid = threadIdx.x, lane = tid & 63, wave = tid >> 6;
    const int gw = blockIdx.x * 8 + wave, NGW = gridDim.x * 8;
    LAS float* scr = (LAS float*)(lds + wave * 8448);
    h16* W1T = (h16*)(p.ws + WS_W1T); h16* W2T = (h16*)(p.ws + WS_W2T); h16* W3T = (h16*)(p.ws + WS_W3T); h16* W4T = (h16*)(p.ws + WS_W4T);
    constexpr int I1 = 16 * 224, I2 = 32 * 32, I3 = 16 * 168, I4 = 24 * 32;
    for (int it = gw; it < I1 + I2 + I3 + I4; it += NGW) {
        int r = it;
        if (r < I1) { tr_item<1>(p.in[2], 1024, 7168, W1T, scr, r, 224, lane); continue; } r -= I1;
        if (r < I2) { tr_item<0>(p.in[8], 2048, 1024, W2T, scr, r, 32, lane); continue; } r -= I2;
        if (r < I3) { tr_item<2>(p.in[10], 1024, 5248, W3T, scr, r, 168, lane); continue; } r -= I3;
        tr_item<0>(p.in[22], 1536, 1024, W4T, scr, r, 32, lane);
    }
    h16* H0 = (h16*)p.out;
    for (int r = gw; r < NTOK; r += 2 * NGW) { const int r1 = (r + NGW < NTOK) ? r + NGW : r;
        rms_rows2_f16(p.in[0] + (size_t)r * DM, p.in[0] + (size_t)r1 * DM, nullptr, nullptr, p.in[1], H0 + (size_t)r * DM, H0 + (size_t)r1 * DM, lane); }
    const int gt = blockIdx.x * 512 + tid, NGT = gridDim.x * 512;
    h16* WSH = (h16*)(p.ws + WS_WSH);
    for (int i = gt; i < 8 * 128 * 128; i += NGT) WSH[i] = (h16)p.in[6][i];
    { float* STZ = (float*)(p.ws + WS_STATS); for (int i = gt; i < 2 * NTOK; i += NGT) STZ[i] = 0.f; }
    h16* CWT = (h16*)(p.ws + WS_CWT);
    const float* wf = p.in[21];
    for (int i = gt; i < 4 * 128 * 256; i += NGT) {
        const int k = i & 255, e = (i >> 8) & 127, g = i >> 15, d = k & 127; const bool sn = k >= 128;
        float s = 0.f;
        for (int dp = 0; dp < 128; ++dp) { const float fr = (float)((d * dp) & 127) * (1.f / 128.f);
            const float tw = sn ? __builtin_amdgcn_sinf(fr) : __builtin_amdgcn_cosf(fr);
            s += tw * wf[(g * 128 + dp) * 128 + e]; }
        CWT[i] = (h16)(s * 0.08838834764831845f);
    }
}

struct Epi1 {
    static constexpr bool PERM = true;
    h16 *XC, *G, *U, *V; float* st;
    __device__ __forceinline__ void operator()(const f32x4 (&acc)[2][2][4][2], const pg8::Unit& u, int wr, int wc, int fr, int fq) const {
        const int T = u.pn; const int row0 = u.pm * 256 + wr * 64 + fr;
        if (T < 16) {
            const int ch = 64 * T + 16 * wc + 4 * fq;
#pragma unroll
            for (int ai = 0; ai < 2; ++ai)
#pragma unroll
                for (int m = 0; m < 4; ++m) { const size_t r = (size_t)(row0 + ai * 128 + m * 16);
                    const f32x4 xa = acc[ai][0][m][0], ba = acc[ai][0][m][1], ca = acc[ai][1][m][0], za = acc[ai][1][m][1];
                    h16x4 xc, gg;
#pragma unroll
                    for (int e = 0; e < 4; ++e) { xc[e] = (h16)(ca[e] * xa[e]); gg[e] = (h16)(ba[e] * silu_f(za[e])); }
                    *(h16x4*)(XC + r * 1024 + ch) = xc; *(h16x4*)(G + r * 1024 + ch) = gg; }
        } else if (T < 24) {
            const int ch = 128 * (T - 16) + 32 * wc + 8 * fq;
#pragma unroll
            for (int ai = 0; ai < 2; ++ai)
#pragma unroll
                for (int m = 0; m < 4; ++m) { const size_t r = (size_t)(row0 + ai * 128 + m * 16); h16x8 o;
#pragma unroll
                    for (int n = 0; n < 2; ++n) { const f32x4 ub = acc[ai][0][m][n], zb = acc[ai][1][m][n];
#pragma unroll
                        for (int e = 0; e < 4; ++e) o[4 * n + e] = (h16)(ub[e] * silu_f(zb[e])); }
                    *(h16x8*)(U + r * 1024 + ch) = o; }
        } else {
#pragma unroll
            for (int ai = 0; ai < 2; ++ai)
#pragma unroll
                for (int m = 0; m < 4; ++m) { const size_t r = (size_t)(row0 + ai * 128 + m * 16); float s1 = 0.f, s2 = 0.f;
#pragma unroll
                    for (int bj = 0; bj < 2; ++bj) { const int ch = 256 * (T - 24) + 128 * bj + 32 * wc + 8 * fq; h16x8 o;
#pragma unroll
                        for (int n = 0; n < 2; ++n) { const f32x4 v = acc[ai][bj][m][n];
#pragma unroll
                            for (int e = 0; e < 4; ++e) { o[4 * n + e] = (h16)v[e]; const float f = (float)o[4 * n + e]; s1 += f; s2 += f * f; } }
                        *(h16x8*)(V + r * 1024 + ch) = o; }
                    s1 += __shfl_xor(s1, 16); s2 += __shfl_xor(s2, 16); s1 += __shfl_xor(s1, 32); s2 += __shfl_xor(s2, 32);
                    if (fq == 0) { atomicAdd(st + 2 * r, s1); atomicAdd(st + 2 * r + 1, s2); } }
        }
    }
};
struct Epi2 {
    static constexpr bool PERM = true;
    h16* O1;
    __device__ __forceinline__ void operator()(const f32x4 (&acc)[2][2][4][2], const pg8::Unit& u, int wr, int wc, int fr, int fq) const {
        const int row0 = u.pm * 256 + wr * 64 + fr, col0 = u.pn * 256 + wc * 32 + 8 * fq;
#pragma unroll
        for (int ai = 0; ai < 2; ++ai)
#pragma unroll
            for (int m = 0; m < 4; ++m) { const size_t r = (size_t)(row0 + ai * 128 + m * 16);
#pragma unroll
                for (int bj = 0; bj < 2; ++bj) { const f32x4 v0 = acc[ai][bj][m][0], v1 = acc[ai][bj][m][1]; h16x8 o;
#pragma unroll
                    for (int e = 0; e < 4; ++e) { o[e] = (h16)v0[e]; o[4 + e] = (h16)v1[e]; }
                    *(h16x8*)(O1 + r * 1024 + col0 + bj * 128) = o; } }
    }
};
struct Epi3 {
    static constexpr bool PERM = true;
    h16 *PC, *ZCD, *FD;
    __device__ __forceinline__ void operator()(const f32x4 (&acc)[2][2][4][2], const pg8::Unit& u, int wr, int wc, int fr, int fq) const {
        const int row0 = u.pm * 256 + wr * 64 + fr, col0 = u.pn * 256 + wc * 32 + 8 * fq;
#pragma unroll
        for (int bj = 0; bj < 2; ++bj) { const int c = col0 + bj * 128;
            h16* base; size_t ld;
            if (c < 3200) { base = PC + c; ld = 3200; }
            else if (c < 4224) { base = ZCD + (c - 3200); ld = 1536; }
            else if (c < 4736) { base = FD + (c - 4224); ld = 512; }
            else if (c < 5248) { base = ZCD + 1024 + (c - 4736); ld = 1536; }
            else continue;
#pragma unroll
            for (int ai = 0; ai < 2; ++ai)
#pragma unroll
                for (int m = 0; m < 4; ++m) { const size_t r = (size_t)(row0 + ai * 128 + m * 16); const f32x4 v0 = acc[ai][bj][m][0], v1 = acc[ai][bj][m][1]; h16x8 o;
#pragma unroll
                    for (int e = 0; e < 4; ++e) { o[e] = (h16)v0[e]; o[4 + e] = (h16)v1[e]; }
                    *(h16x8*)(base + r * ld) = o; } }
    }
};
struct Epi4 {
    static constexpr bool PERM = true;
    h16* O2;
    __device__ __forceinline__ void operator()(const f32x4 (&acc)[2][2][4][2], const pg8::Unit& u, int wr, int wc, int fr, int fq) const {
        const int row0 = u.pm * 256 + wr * 64 + fr, col0 = u.pn * 256 + wc * 32 + 8 * fq;
#pragma unroll
        for (int ai = 0; ai < 2; ++ai)
#pragma unroll
            for (int m = 0; m < 4; ++m) { const size_t r = (size_t)(row0 + ai * 128 + m * 16);
#pragma unroll
                for (int bj = 0; bj < 2; ++bj) { const f32x4 v0 = acc[ai][bj][m][0], v1 = acc[ai][bj][m][1]; h16x8 o;
#pragma unroll
                    for (int e = 0; e < 4; ++e) { o[e] = (h16)v0[e]; o[4 + e] = (h16)v1[e]; }
                    *(h16x8*)(O2 + r * 1024 + col0 + bj * 128) = o; } }
    }
};

__device__ __forceinline__ void phase_stats(const Params& p) {
    const int tid = threadIdx.x, lane = tid & 63, wave = tid >> 6;
    const int gw = blockIdx.x * 8 + wave, NGW = gridDim.x * 8;
    const h16* V = (const h16*)(p.ws + WS_V); float* ST = (float*)(p.ws + WS_STATS);
    for (int r = gw; r < NTOK; r += NGW) {
        const h16x8 a = *(const h16x8*)(V + (size_t)r * 1024 + 8 * lane), b = *(const h16x8*)(V + (size_t)r * 1024 + 512 + 8 * lane);
        float s = 0.f;
#pragma unroll
        for (int e = 0; e < 8; ++e) s += (float)a[e] + (float)b[e];
        const float mu = wave_sum(s) * (1.f / 1024.f); float q = 0.f;
#pragma unroll
        for (int e = 0; e < 8; ++e) { const float x = (float)a[e] - mu, y = (float)b[e] - mu; q += x * x + y * y; }
        const float rs = rsqrtf(wave_sum(q) * (1.f / 1024.f) + 1e-5f);
        if (lane == 0) { ST[2 * r] = mu; ST[2 * r + 1] = rs; }
    }
}

__device__ __forceinline__ void phase_mix0(const Params& p, LAS unsigned char* lds) {
    const int tid = threadIdx.x, lane = tid & 63, wave = tid >> 6;
    const h16* XC = (const h16*)(p.ws + WS_XC); const h16* G = (const h16*)(p.ws + WS_G); const h16* U = (const h16*)(p.ws + WS_U); const h16* V = (const h16*)(p.ws + WS_V);
    h16* YC = (h16*)(p.ws + WS_YCAT);
    const float* cw = p.in[3];
    const int gt = blockIdx.x * 512 + tid, NGT = gridDim.x * 512;
    for (int idx0 = gt; idx0 < NTOK * 128; idx0 += 2 * NGT) {
        h16x8 x0[2], xm[2], xp[2], gg[2]; int tt[2], cc[2];
        const h16x8 zero = {0, 0, 0, 0, 0, 0, 0, 0};
#pragma unroll
        for (int u = 0; u < 2; ++u) { const int idx = (idx0 + u * NGT < NTOK * 128) ? idx0 + u * NGT : idx0; const int t = idx >> 7, c8 = (idx & 127) * 8, tp = t & (SEQ - 1); tt[u] = t; cc[u] = c8;
            x0[u] = *(const h16x8*)(XC + (size_t)t * 1024 + c8);
            xm[u] = tp > 0 ? *(const h16x8*)(XC + (size_t)(t - 1) * 1024 + c8) : zero;
            xp[u] = tp < SEQ - 1 ? *(const h16x8*)(XC + (size_t)(t + 1) * 1024 + c8) : zero;
            gg[u] = *(const h16x8*)(G + (size_t)t * 1024 + c8); }
#pragma unroll
        for (int u = 0; u < 2; ++u) { const int c8 = cc[u]; h16x8 o;
#pragma unroll
            for (int e = 0; e < 8; ++e) { const float y = cw[c8 + e] * (float)xm[u][e] + cw[1024 + c8 + e] * (float)x0[u][e] + cw[2048 + c8 + e] * (float)xp[u][e]; o[e] = (h16)(y * (float)gg[u][e]); }
            *(h16x8*)(YC + (size_t)tt[u] * 2048 + c8) = o; }
    }
    const float* ST = (const float*)(p.ws + WS_STATS); const h16* WSH = (const h16*)(p.ws + WS_WSH);
    const float* lng = p.in[4]; const float* lnb = p.in[5]; const float* bs = p.in[7];
    LAS h16* vnT = (LAS h16*)lds;
    for (int it = blockIdx.x; it < 1024; it += gridDim.x) {
        const int g = it & 7, bn = it >> 3, t0 = bn * 128;
        __syncthreads();
#pragma unroll
        for (int q = 0; q < 4; ++q) { const int pc = tid + 512 * q, j = pc >> 4, d8 = (pc & 15) * 8;
            const h16x8 v = *(const h16x8*)(V + (size_t)(t0 + j) * 1024 + g * 128 + d8);
            const float mu = ST[2 * (t0 + j)] * (1.f / 1024.f), rs = rsqrtf(fmaxf(ST[2 * (t0 + j) + 1] * (1.f / 1024.f) - mu * mu, 0.f) + 1e-5f);
#pragma unroll
            for (int e = 0; e < 8; ++e) vnT[(d8 + e) * 136 + ((((j >> 3) ^ (pc & 15)) << 3) | (j & 7))] = (h16)(((float)v[e] - mu) * rs * lng[g * 128 + d8 + e] + lnb[g * 128 + d8 + e]); }
        __syncthreads();
        const int itile = wave >> 1, dt0 = (wave & 1) * 2;
        f32x16 acc0, acc1;
#pragma unroll
        for (int e = 0; e < 16; ++e) { acc0[e] = 0.f; acc1[e] = 0.f; }
        const h16* Arow = WSH + ((size_t)g * 128 + itile * 32 + (lane & 31)) * 128 + 8 * (lane >> 5);
        const int d0_ = dt0 * 32 + (lane & 31), d1_ = d0_ + 32;
        const LAS h16* B0p = vnT + d0_ * 136; const LAS h16* B1p = vnT + d1_ * 136;
#pragma unroll
        for (int ks = 0; ks < 8; ++ks) {
            const h16x8 a = *(const h16x8*)(Arow + 16 * ks);
            const int jg = 2 * ks + (lane >> 5);
            const h16x8 b0 = *(const LAS h16x8*)(B0p + ((jg ^ ((d0_ >> 3) & 15)) << 3)), b1 = *(const LAS h16x8*)(B1p + ((jg ^ ((d1_ >> 3) & 15)) << 3));
            acc0 = __builtin_amdgcn_mfma_f32_32x32x16_f16(a, b0, acc0, 0, 0, 0);
            acc1 = __builtin_amdgcn_mfma_f32_32x32x16_f16(a, b1, acc1, 0, 0, 0);
        }
#pragma unroll
        for (int r = 0; r < 16; ++r) { const int i = itile * 32 + (r & 3) + 8 * (r >> 2) + 4 * (lane >> 5); const size_t t = (size_t)(t0 + i);
            const float bias = bs[g * 128 + i];
            const int d0 = g * 128 + dt0 * 32 + (lane & 31);
            YC[t * 2048 + 1024 + d0] = (h16)((acc0[r] + bias) * (float)U[t * 1024 + d0]);
            YC[t * 2048 + 1024 + d0 + 32] = (h16)((acc1[r] + bias) * (float)U[t * 1024 + d0 + 32]); }
    }
}

__device__ __forceinline__ void phase_norm1(const Params& p) {
    const int tid = threadIdx.x, lane = tid & 63, wave = tid >> 6;
    const int gw = blockIdx.x * 8 + wave, NGW = gridDim.x * 8;
    const h16* O1 = (const h16*)(p.ws + WS_O1); h16* H1 = (h16*)p.out;
    for (int r = gw; r < NTOK; r += 2 * NGW) { const int r1 = (r + NGW < NTOK) ? r + NGW : r;
        rms_rows2_f16(p.in[0] + (size_t)r * DM, p.in[0] + (size_t)r1 * DM, O1 + (size_t)r * DM, O1 + (size_t)r1 * DM, p.in[9], H1 + (size_t)r * DM, H1 + (size_t)r1 * DM, lane); }
}

__device__ __forceinline__ void phase_fft(const Params& p, LAS unsigned char* lds) {
    const int tid = threadIdx.x;
    const h16* FD = (const h16*)(p.ws + WS_FD);
    h16* SPr = (h16*)(p.ws + WS_SPR); h16* SPi = (h16*)(p.ws + WS_SPI);
    LAS f32x2* X0 = (LAS f32x2*)lds; LAS f32x2* X1 = X0 + 8192;
    for (int it = blockIdx.x; it < 256; it += gridDim.x) {
        const int b = it >> 7, c0 = 4 * (it & 127);
        __syncthreads();
        for (int t = tid; t < SEQ; t += 512) { const h16x4 v = *(const h16x4*)(FD + (size_t)(b * SEQ + t) * 512 + c0);
            X0[t] = (f32x2){(float)v[0], (float)v[1]}; X1[t] = (f32x2){(float)v[2], (float)v[3]}; }
        __syncthreads();
        for (int s = 0; s < 13; ++s) {
            const int half = 4096 >> s;
#pragma unroll 2
            for (int j = tid; j < 4096; j += 512) {
                const int pos = j & (half - 1), grp = j >> (12 - s), i0 = (grp << (13 - s)) + pos, i1 = i0 + half;
                const float fr = (float)(pos << s) * (1.f / 8192.f);
                const float c = __builtin_amdgcn_cosf(fr), sn = __builtin_amdgcn_sinf(fr);
                { const f32x2 a = X0[i0], bb = X0[i1]; const f32x2 d = a - bb; X0[i0] = a + bb; X0[i1] = (f32x2){d[0] * c + d[1] * sn, d[1] * c - d[0] * sn}; }
                { const f32x2 a = X1[i0], bb = X1[i1]; const f32x2 d = a - bb; X1[i0] = a + bb; X1[i1] = (f32x2){d[0] * c + d[1] * sn, d[1] * c - d[0] * sn}; }
            }
            __syncthreads();
        }
        const float sc = 0.5f * 0.011048543456039806f;
        for (int k = tid; k < SEQ; k += 512) {
            const int ra = __brev((unsigned)k) >> 19, rb = __brev((unsigned)((SEQ - k) & (SEQ - 1))) >> 19;
            const f32x2 za = X0[ra], zb = X0[rb], ya = X1[ra], yb = X1[rb];
            h16x4 orr, oi;
            orr[0] = (h16)((za[0] + zb[0]) * sc); oi[0] = (h16)((za[1] - zb[1]) * sc);
            orr[1] = (h16)((za[1] + zb[1]) * sc); oi[1] = (h16)((zb[0] - za[0]) * sc);
            orr[2] = (h16)((ya[0] + yb[0]) * sc); oi[2] = (h16)((ya[1] - yb[1]) * sc);
            orr[3] = (h16)((ya[1] + yb[1]) * sc); oi[3] = (h16)((yb[0] - ya[0]) * sc);
            *(h16x4*)(SPr + (size_t)(b * SEQ + k) * 512 + c0) = orr; *(h16x4*)(SPi + (size_t)(b * SEQ + k) * 512 + c0) = oi;
        }
    }
}

__device__ __forceinline__ void phase_fnet_out(const Params& p) {
    const int tid = threadIdx.x, lane = tid & 63, wave = tid >> 6;
    const int gw = blockIdx.x * 8 + wave, NGW = gridDim.x * 8;
    const h16* SPr = (const h16*)(p.ws + WS_SPR); const h16* SPi = (const h16*)(p.ws + WS_SPI);
    const h16* CWT = (const h16*)(p.ws + WS_CWT); h16* ZCD = (h16*)(p.ws + WS_ZCD);
    for (int w = gw; w < 8192; w += NGW) {
        const int et = w & 3, g = (w >> 2) & 3, tt = w >> 4;
        const size_t trow = (size_t)(tt * 32 + (lane & 31));
        const h16* Ar = SPr + trow * 512 + g * 128 + 8 * (lane >> 5); const h16* Ai = SPi + trow * 512 + g * 128 + 8 * (lane >> 5);
        const h16* Bp = CWT + ((size_t)(g * 128 + et * 32 + (lane & 31))) * 256 + 8 * (lane >> 5);
        f32x16 acc;
#pragma unroll
        for (int e = 0; e < 16; ++e) acc[e] = 0.f;
#pragma unroll
        for (int ks = 0; ks < 8; ++ks) acc = __builtin_amdgcn_mfma_f32_32x32x16_f16(*(const h16x8*)(Ar + 16 * ks), *(const h16x8*)(Bp + 16 * ks), acc, 0, 0, 0);
#pragma unroll
        for (int ks = 0; ks < 8; ++ks) acc = __builtin_amdgcn_mfma_f32_32x32x16_f16(*(const h16x8*)(Ai + 16 * ks), *(const h16x8*)(Bp + 128 + 16 * ks), acc, 0, 0, 0);
#pragma unroll
        for (int r = 0; r < 16; ++r) { const size_t t = (size_t)(tt * 32 + (r & 3) + 8 * (r >> 2) + 4 * (lane >> 5));
            h16* zp = ZCD + t * 1536 + 1024 + g * 128 + et * 32 + (lane & 31);
            *zp = (h16)(acc[r] * silu_f((float)*zp)); }
    }
}

#define LDS_BAR() do { asm volatile("s_waitcnt lgkmcnt(0)" ::: "memory"); __builtin_amdgcn_s_barrier(); asm volatile("" ::: "memory"); } while (0)
#define LDS_WAIT() asm volatile("s_waitcnt lgkmcnt(0)" ::: "memory")
__device__ __forceinline__ void phase_scan(const Params& p, LAS unsigned char* lds) {
    const int tid = threadIdx.x, lane = tid & 63, wave = tid >> 6;
    const h16* PC = (const h16*)(p.ws + WS_PC);
    LAS h16* w2T = (LAS h16*)lds;
    LAS h16* a2T = w2T + 64 * 72;
    LAS unsigned char* priv = lds + 18432 + (wave & 3) * 4096;
    constexpr int SET_F = 5 * 2048 + 512;
    LAS float* OPS = (LAS float*)(lds + 18432 + 16384);
    LAS float* sYb = OPS + 2 * SET_F;
    for (int item = blockIdx.x; item < 256; item += gridDim.x) {
        const int xcd = item & 7, slot = item >> 3, gidx = xcd * 8 + (slot >> 2), q = slot & 3;
        const int dir = gidx >> 5, b = (gidx >> 4) & 1, h = gidx & 15;
        h16* Yd = (h16*)((unsigned char*)p.out + (size_t)dir * 32 * MiB);
        float* SB = (float*)(p.ws + WS_SBON) + (size_t)dir * NTOK * 16;
        const float* mu = p.in[11] + dir * 3200; const float* w0 = p.in[12] + dir * 1024 + 64 * h; const float* w2 = p.in[13] + (size_t)dir * 65536 + 64 * h;
        const float* a0 = p.in[14] + dir * 1024 + 64 * h; const float* a2 = p.in[15] + (size_t)dir * 65536 + 64 * h;
        const float* kkw = p.in[16] + 64 * h; const float* kaw = p.in[17] + 64 * h; const float* rkw = p.in[18] + 64 * h;
        __syncthreads();
        for (int i = tid; i < 4096; i += 512) { const int l = i >> 6, c = i & 63; w2T[c * 72 + l] = (h16)w2[l * 1024 + c]; a2T[c * 72 + l] = (h16)a2[l * 1024 + c]; }
        const int pw_ = wave & 3, s_sub = lane >> 3, c8 = (lane & 7) * 8, s_l = 8 * pw_ + s_sub;
        h16x8 mu_r8, mu_k8, mu_v8, mu_w8, mu_a8; f32x2 w0r[4], a0r[4], kkr[4], kar[4], omk[4], rkr[4];
#pragma unroll
        for (int e = 0; e < 8; ++e) { mu_r8[e] = (h16)mu[64 * h + c8 + e]; mu_k8[e] = (h16)mu[1024 + 64 * h + c8 + e]; mu_v8[e] = (h16)mu[2048 + 64 * h + c8 + e]; mu_w8[e] = (h16)mu[3072 + c8 + e]; mu_a8[e] = (h16)mu[3136 + c8 + e];
            w0r[e >> 1][e & 1] = w0[c8 + e]; a0r[e >> 1][e & 1] = a0[c8 + e]; kkr[e >> 1][e & 1] = kkw[c8 + e]; kar[e >> 1][e & 1] = kaw[c8 + e]; omk[e >> 1][e & 1] = 1.f - kaw[c8 + e]; rkr[e >> 1][e & 1] = rkw[c8 + e]; }
        f32x2 S01 = {0.f, 0.f}, S23 = {0.f, 0.f};
        const int srow = 4 * (wave & 3) + (lane >> 4), j0 = 4 * (lane & 15);
        const h16x8 z8 = {0, 0, 0, 0, 0, 0, 0, 0};
        h16x8 pr, pk, pv, pw, pa, qr_, qk_, qv_, qw_, qa_;
        const h16 *pcA, *pcB, *ppA, *ppB;
        { const int t0_ = dir ? (SEQ - 1 - s_l) : s_l; pcA = PC + (size_t)(b * SEQ + t0_) * 3200 + c8 + 64 * h; pcB = pcA + 2048 - 64 * h;
          const long po_ = (s_l > 0) ? (dir ? 3200 : -3200) : 0; ppA = pcA + po_; ppB = pcB + po_; }
        const long cstride_ = dir ? -32 * 3200 : 32 * 3200;
#define SCAN_LOAD_RAW() do { \
            pr = *(const h16x8*)(pcA); pk = *(const h16x8*)(pcA + 1024); pv = *(const h16x8*)(pcB + 64 * h); pw = *(const h16x8*)(pcB + 1024); pa = *(const h16x8*)(pcB + 1088); \
            qr_ = *(const h16x8*)(ppA); qk_ = *(const h16x8*)(ppA + 1024); qv_ = *(const h16x8*)(ppB + 64 * h); qw_ = *(const h16x8*)(ppB + 1024); qa_ = *(const h16x8*)(ppB + 1088); \
            pcA += cstride_; pcB += cstride_; ppA = pcA + (dir ? 3200 : -3200); ppB = pcB + (dir ? 3200 : -3200); } while (0)
#define SCAN_LOAD(chn) SCAN_LOAD_RAW()
#define SCAN_YSTORE(chn) do { const int sg_ = (chn) * 32 + s_l; const int t_ = dir ? (SEQ - 1 - sg_) : sg_; \
            const f32x2 y2_ = *(const LAS f32x2*)(sYb + ((chn) & 1) * 512 + s_l * 16 + 2 * (lane & 7)); \
            typedef _Float16 h16x2_ __attribute__((ext_vector_type(2))); h16x2_ o_; o_[0] = (h16)y2_[0]; o_[1] = (h16)y2_[1]; \
            *(h16x2_*)(Yd + (size_t)(b * SEQ + t_) * 1024 + 64 * h + 16 * q + 2 * (lane & 7)) = o_; } while (0)
        if (wave >= 4) { SCAN_LOAD_RAW(); if (s_l == 0) { qr_ = z8; qk_ = z8; qv_ = z8; qw_ = z8; qa_ = z8; } }
        __syncthreads();
        for (int n = -1; n < SEQ / 32; ++n) {
            if (wave < 4) {
                if (n >= 0) {
                    __builtin_amdgcn_s_setprio(3);
                    const LAS float* sR = OPS + (n & 1) * SET_F + j0; const LAS float* sW = sR + 2048; const LAS float* sK = sW + 2048; const LAS float* sA = sK + 2048; const LAS float* sB = sA + 2048; const LAS float* sV = OPS + (n & 1) * SET_F + 10240;
                    LAS float* sY = sYb + (n & 1) * 512;
                    f32x4 a_ = *(const LAS f32x4*)(sA), w_ = *(const LAS f32x4*)(sW), b_ = *(const LAS f32x4*)(sB);
                    f32x4 k_ = *(const LAS f32x4*)(sK), r_ = *(const LAS f32x4*)(sR);
                    f32x4 vq[4];
#pragma unroll
                    for (int u = 0; u < 4; ++u) vq[u] = *(const LAS f32x4*)(sV + srow * 32 + 4 * u);
                    f32x4 rp = r_;
#pragma unroll
                    for (int hb = 0; hb < 2; ++hb) {
                        f32x4 vn[4];
#pragma unroll
                        for (int u = 0; u < 4; ++u) vn[u] = *(const LAS f32x4*)(sV + srow * 32 + ((16 * (hb + 1)) & 31) + 4 * u);
#pragma unroll
                        for (int u16 = 0; u16 < 16; ++u16) {
                            const int s = 16 * hb + u16;
                            const int sn = (s + 1) & 31;
                            const f32x4 a_n = *(const LAS f32x4*)(sA + sn * 64), w_n = *(const LAS f32x4*)(sW + sn * 64), b_n = *(const LAS f32x4*)(sB + sn * 64);
                            const f32x4 k_n = *(const LAS f32x4*)(sK + sn * 64), r_n = *(const LAS f32x4*)(sR + sn * 64);
                            const float v = vq[u16 >> 2][u16 & 3];
                            const f32x2 vv = {v, v};
                            f32x2 pp = S01 * (f32x2){a_[0], a_[1]}; pp = S23 * (f32x2){a_[2], a_[3]} + pp;
                            f32x2 yy = S01 * (f32x2){rp[0], rp[1]}; yy = S23 * (f32x2){rp[2], rp[3]} + yy;
                            float sa = pp[0] + pp[1], y = yy[0] + yy[1];
                            sa += dpp_f<0xB1>(sa); y += dpp_f<0xB1>(y);
                            sa += dpp_f<0x4E>(sa); y += dpp_f<0x4E>(y);
                            sa += dpp_f<0x141>(sa); y += dpp_f<0x141>(y);
                            sa += dpp_f<0x140>(sa); y += dpp_f<0x140>(y);
                            sY[((s - 1) & 31) * 16 + srow] = y;
                            const f32x2 sv = {sa, sa};
                            S01 = S01 * (f32x2){w_[0], w_[1]} + vv * (f32x2){k_[0], k_[1]};
                            S23 = S23 * (f32x2){w_[2], w_[3]} + vv * (f32x2){k_[2], k_[3]};
                            S01 = sv * (f32x2){b_[0], b_[1]} + S01;
                            S23 = sv * (f32x2){b_[2], b_[3]} + S23;
                            rp = r_;
                            a_ = a_n; w_ = w_n; b_ = b_n; k_ = k_n; r_ = r_n;
                        }
#pragma unroll
                        for (int u = 0; u < 4; ++u) vq[u] = vn[u];
                    }
                    { f32x2 yy = S01 * (f32x2){rp[0], rp[1]}; yy = S23 * (f32x2){rp[2], rp[3]} + yy; sY[31 * 16 + srow] = red16(yy[0] + yy[1]); }
                    __builtin_amdgcn_s_setprio(0);
                }
            } else {
                if (n + 1 < SEQ / 32) {
                    const int cn = n + 1;
                    const int sg = cn * 32 + s_l; const int t = dir ? (SEQ - 1 - sg) : sg;
                    f32x2 qr[4], qk[4]; float qv[8];
                    LAS h16* TWp = (LAS h16*)priv; LAS h16* QAp = TWp + 8 * 72;
                    { unsigned m1u_ = 0xBC00BC00u; asm volatile("" : "+s"(m1u_));
                      typedef unsigned u32x4_ __attribute__((ext_vector_type(4))); const u32x4_ m1v_ = {m1u_, m1u_, m1u_, m1u_}; const h16x8 m1_ = __builtin_bit_cast(h16x8, m1v_);
                      const h16x8 r8 = pr + mu_r8 * (pr * m1_ + qr_), k8 = pk + mu_k8 * (pk * m1_ + qk_), v8 = pv + mu_v8 * (pv * m1_ + qv_);
                      const h16x8 w8 = pw + mu_w8 * (pw * m1_ + qw_), a8 = pa + mu_a8 * (pa * m1_ + qa_);
                      h16x8 tw8;
#pragma unroll
                      for (int pi = 0; pi < 4; ++pi) { qr[pi] = (f32x2){(float)r8[2 * pi], (float)r8[2 * pi + 1]}; qk[pi] = (f32x2){(float)k8[2 * pi], (float)k8[2 * pi + 1]};
                          qv[2 * pi] = (float)v8[2 * pi]; qv[2 * pi + 1] = (float)v8[2 * pi + 1];
                          const f32x2 tx = (f32x2){(float)w8[2 * pi], (float)w8[2 * pi + 1]} * 2.8853900817779268f;
                          const f32x2 dn = (f32x2){__builtin_amdgcn_exp2f(tx[0]), __builtin_amdgcn_exp2f(tx[1])} + 1.f;
                          const f32x2 th = (f32x2){__builtin_amdgcn_rcpf(dn[0]), __builtin_amdgcn_rcpf(dn[1])} * -2.f + 1.f;
                          tw8[2 * pi] = (h16)th[0]; tw8[2 * pi + 1] = (h16)th[1]; }
                      *(LAS h16x8*)(TWp + s_sub * 72 + c8) = tw8; *(LAS h16x8*)(QAp + s_sub * 72 + c8) = a8; }
                    if (cn + 1 < SEQ / 32) SCAN_LOAD(cn + 1);
                    LDS_WAIT();
                    f32x4 accw[4], acca[4];
#pragma unroll
                    for (int ct = 0; ct < 4; ++ct) { accw[ct] = (f32x4){0.f, 0.f, 0.f, 0.f}; acca[ct] = (f32x4){0.f, 0.f, 0.f, 0.f}; }
#pragma unroll
                    for (int ks = 0; ks < 2; ++ks) {
                        const h16x8 atw = *(const LAS h16x8*)(TWp + (lane & 7) * 72 + 32 * ks + 8 * (lane >> 4));
                        const h16x8 aqa = *(const LAS h16x8*)(QAp + (lane & 7) * 72 + 32 * ks + 8 * (lane >> 4));
#pragma unroll
                        for (int ct = 0; ct < 4; ++ct) {
                            const h16x8 bw = *(const LAS h16x8*)(w2T + (16 * ct + (lane & 15)) * 72 + 32 * ks + 8 * (lane >> 4));
                            const h16x8 ba = *(const LAS h16x8*)(a2T + (16 * ct + (lane & 15)) * 72 + 32 * ks + 8 * (lane >> 4));
                            accw[ct] = __builtin_amdgcn_mfma_f32_16x16x32_f16(atw, bw, accw[ct], 0, 0, 0);
                            acca[ct] = __builtin_amdgcn_mfma_f32_16x16x32_f16(aqa, ba, acca[ct], 0, 0, 0);
                        }
                    }
                    LDS_WAIT();
                    { LAS float* Zd = (LAS float*)priv + (lane >> 5) * 512 + (4 * ((lane >> 4) & 1)) * 64 + (lane & 15);
#pragma unroll
                      for (int ct = 0; ct < 4; ++ct)
#pragma unroll
                          for (int r = 0; r < 4; ++r) Zd[r * 64 + 16 * ct] = (lane < 32) ? accw[ct][r] : acca[ct][r]; }
                    LDS_WAIT();
                    const LAS float* Zw = (const LAS float*)priv + s_sub * 64 + c8; const LAS float* Za = Zw + 512;
                    const f32x4 zw0 = *(const LAS f32x4*)Zw, zw1 = *(const LAS f32x4*)(Zw + 4), za0 = *(const LAS f32x4*)Za, za1 = *(const LAS f32x4*)(Za + 4);
                    LDS_WAIT();
                    f32x2 kk[4], av_[4], kp[4], dec[4], kn2 = {0.f, 0.f}, sb2 = {0.f, 0.f};
#pragma unroll
                    for (int pi = 0; pi < 4; ++pi) {
                        const f32x2 zw = (pi < 2 ? (f32x2){zw0[2 * pi], zw0[2 * pi + 1]} : (f32x2){zw1[2 * pi - 4], zw1[2 * pi - 3]}) + w0r[pi];
                        const f32x2 za = (pi < 2 ? (f32x2){za0[2 * pi], za0[2 * pi + 1]} : (f32x2){za1[2 * pi - 4], za1[2 * pi - 3]}) + a0r[pi];
                        const f32x2 tw_ = zw * -1.4426950408889634f, ta_ = za * -1.4426950408889634f;
                        const f32x2 dw = (f32x2){__builtin_amdgcn_exp2f(tw_[0]), __builtin_amdgcn_exp2f(tw_[1])} + 1.f, da = (f32x2){__builtin_amdgcn_exp2f(ta_[0]), __builtin_amdgcn_exp2f(ta_[1])} + 1.f;
                        const f32x2 sw = (f32x2){__builtin_amdgcn_rcpf(dw[0]), __builtin_amdgcn_rcpf(dw[1])} * -0.8750387749225136f;
                        dec[pi] = (f32x2){__builtin_amdgcn_exp2f(sw[0]), __builtin_amdgcn_exp2f(sw[1])};
                        av_[pi] = (f32x2){__builtin_amdgcn_rcpf(da[0]), __builtin_amdgcn_rcpf(da[1])};
                        kk[pi] = qk[pi] * kkr[pi]; kn2 = kk[pi] * kk[pi] + kn2;
                        kp[pi] = qk[pi] * (av_[pi] * kar[pi] + omk[pi]);
                        sb2 = (qr[pi] * kp[pi]) * rkr[pi] + sb2; }
                    const float kn = red8(kn2[0] + kn2[1]), sbn = red8(sb2[0] + sb2[1]);
                    const float ninv = -rsqrtf(fmaxf(kn, 1e-12f));
                    LAS float* dR = OPS + (cn & 1) * SET_F + s_l * 64 + c8;
#pragma unroll
                    for (int hf = 0; hf < 2; ++hf) {
                        const f32x2 na0 = kk[2 * hf] * ninv, na1 = kk[2 * hf + 1] * ninv;
                        const f32x2 nb0 = na0 * av_[2 * hf], nb1 = na1 * av_[2 * hf + 1];
                        *(LAS f32x4*)(dR + 4 * hf) = (f32x4){qr[2 * hf][0], qr[2 * hf][1], qr[2 * hf + 1][0], qr[2 * hf + 1][1]};
                        *(LAS f32x4*)(dR + 2048 + 4 * hf) = (f32x4){dec[2 * hf][0], dec[2 * hf][1], dec[2 * hf + 1][0], dec[2 * hf + 1][1]};
                        *(LAS f32x4*)(dR + 4096 + 4 * hf) = (f32x4){kp[2 * hf][0], kp[2 * hf][1], kp[2 * hf + 1][0], kp[2 * hf + 1][1]};
                        *(LAS f32x4*)(dR + 6144 + 4 * hf) = (f32x4){na0[0], na0[1], na1[0], na1[1]};
                        *(LAS f32x4*)(dR + 8192 + 4 * hf) = (f32x4){-nb0[0], -nb0[1], -nb1[0], -nb1[1]}; }
                    if ((c8 >> 4) == q) { LAS float* dV = OPS + (cn & 1) * SET_F + 10240 + (c8 & 15) * 32 + s_l;
#pragma unroll
                        for (int e = 0; e < 8; ++e) dV[e * 32] = qv[e]; }
                    if (q == 0 && (lane & 7) == 0) SB[(size_t)(b * SEQ + t) * 16 + h] = sbn;
                }
                if (n >= 1) SCAN_YSTORE(n - 1);
            }
            LDS_BAR();
        }
        if (wave >= 4) SCAN_YSTORE(SEQ / 32 - 1);
#undef SCAN_LOAD
#undef SCAN_LOAD_RAW
#undef SCAN_YSTORE
    }
}

__device__ __forceinline__ void phase_post(const Params& p) {
    const int tid = threadIdx.x;
    const h16* Y0 = (const h16*)p.out; const h16* Y1 = (const h16*)((const unsigned char*)p.out + 32 * MiB);
    const h16* PC = (const h16*)(p.ws + WS_PC); h16* ZCD = (h16*)(p.ws + WS_ZCD);
    const float* SB0 = (const float*)(p.ws + WS_SBON); const float* SB1 = SB0 + (size_t)NTOK * 16;
    const float* mu0 = p.in[11] + 2048; const float* mu1 = p.in[11] + 3200 + 2048;
    const float* lg = p.in[19]; const float* lb = p.in[20];
    const int gt = blockIdx.x * 512 + tid, NGT = gridDim.x * 512;
    for (int idx = gt; idx < NTOK * 128; idx += NGT) {
        const int t = idx >> 7, c = (idx & 127) * 8, hh = c >> 6, tp = t & (SEQ - 1);
        const h16x8 y0 = *(const h16x8*)(Y0 + (size_t)t * 1024 + c), y1 = *(const h16x8*)(Y1 + (size_t)t * 1024 + c);
        const h16x8 z8 = {0, 0, 0, 0, 0, 0, 0, 0};
        const h16x8 v0 = *(const h16x8*)(PC + (size_t)t * 3200 + 2048 + c);
        const h16x8 vm = tp > 0 ? *(const h16x8*)(PC + (size_t)(t - 1) * 3200 + 2048 + c) : z8;
        const h16x8 vp = tp < SEQ - 1 ? *(const h16x8*)(PC + (size_t)(t + 1) * 3200 + 2048 + c) : z8;
        const h16x8 zc = *(const h16x8*)(ZCD + (size_t)t * 1536 + c);
        const float s0 = SB0[(size_t)t * 16 + hh], s1 = SB1[(size_t)t * 16 + hh];
        float y[8], s = 0.f;
#pragma unroll
        for (int e = 0; e < 8; ++e) { y[e] = (float)y0[e] + (float)y1[e]; s += y[e]; }
        const float mean = red8(s) * (1.f / 64.f); float q = 0.f;
#pragma unroll
        for (int e = 0; e < 8; ++e) { y[e] -= mean; q += y[e] * y[e]; }
        const float rs = rsqrtf(red8(q) * (1.f / 64.f) + 64e-5f);
        const f32x4 lg0 = *(const f32x4*)(lg + c), lg1 = *(const f32x4*)(lg + c + 4), lb0 = *(const f32x4*)(lb + c), lb1 = *(const f32x4*)(lb + c + 4);
        const f32x4 ma0 = *(const f32x4*)(mu0 + c), ma1 = *(const f32x4*)(mu0 + c + 4), mb0 = *(const f32x4*)(mu1 + c), mb1 = *(const f32x4*)(mu1 + c + 4);
        h16x8 o;
#pragma unroll
        for (int e = 0; e < 8; ++e) { const float vv = (float)v0[e];
            const float m0 = e < 4 ? ma0[e & 3] : ma1[e & 3], m1 = e < 4 ? mb0[e & 3] : mb1[e & 3], gg = e < 4 ? lg0[e & 3] : lg1[e & 3], bb = e < 4 ? lb0[e & 3] : lb1[e & 3];
            const float vd0 = vv + m0 * ((float)vm[e] - vv), vd1 = vv + m1 * ((float)vp[e] - vv);
            const float val = y[e] * rs * gg + bb + s0 * vd0 + s1 * vd1;
            o[e] = (h16)(val * silu_f((float)zc[e])); }
        *(h16x8*)(ZCD + (size_t)t * 1536 + c) = o;
    }
}

__device__ __forceinline__ void phase_final(const Params& p) {
    const int tid = threadIdx.x, lane = tid & 63, wave = tid >> 6;
    const int gw = blockIdx.x * 8 + wave, NGW = gridDim.x * 8;
    const float* g = p.in[23]; const h16* O1 = (const h16*)(p.ws + WS_O1); const h16* O2 = (const h16*)(p.ws + WS_O2);
    for (int r = gw; r < NTOK; r += 2 * NGW) {
        const int rr[2] = {r, (r + NGW < NTOK) ? r + NGW : r};
        f32x4 v[2][4]; h16x4 a[2][4], b[2][4]; float ss[2] = {0.f, 0.f};
#pragma unroll
        for (int u = 0; u < 2; ++u)
#pragma unroll
            for (int j = 0; j < 4; ++j) { const size_t o = (size_t)rr[u] * DM + 4 * lane + 256 * j; v[u][j] = *(const f32x4*)(p.in[0] + o); a[u][j] = *(const h16x4*)(O1 + o); b[u][j] = *(const h16x4*)(O2 + o); }
#pragma unroll
        for (int u = 0; u < 2; ++u)
#pragma unroll
            for (int j = 0; j < 4; ++j) {
#pragma unroll
                for (int e = 0; e < 4; ++e) v[u][j][e] += (float)a[u][j][e] + (float)b[u][j][e];
                ss[u] += v[u][j][0] * v[u][j][0] + v[u][j][1] * v[u][j][1] + v[u][j][2] * v[u][j][2] + v[u][j][3] * v[u][j][3]; }
#pragma unroll
        for (int o = 1; o < 64; o <<= 1) { ss[0] += __shfl_xor(ss[0], o); ss[1] += __shfl_xor(ss[1], o); }
        const float rs[2] = {rsqrtf(ss[0] * (1.f / 1024.f) + 1e-6f), rsqrtf(ss[1] * (1.f / 1024.f) + 1e-6f)};
#pragma unroll
        for (int j = 0; j < 4; ++j) { const f32x4 gg = *(const f32x4*)(g + 4 * lane + 256 * j);
#pragma unroll
            for (int u = 0; u < 2; ++u) { f32x4 o = v[u][j] * rs[u]; o = o * gg; *(f32x4*)(p.out + (size_t)rr[u] * DM + 4 * lane + 256 * j) = o; } }
    }
}

__global__ void __launch_bounds__(512, 2) mega(Params p) {
    extern __shared__ __attribute__((aligned(16))) unsigned char smem[];
    LAS unsigned char* lds = (LAS unsigned char*)smem;
    cg::grid_group grid = cg::this_grid();
    unsigned char* ws = p.ws;
    const int lo = p.ph_lo, hi = p.ph_hi;
#define IN(k) (lo <= (k) && (k) < hi)
    volatile LAS unsigned* bst = (volatile LAS unsigned*)(lds + LDS_MAIN);
    if (threadIdx.x < 4) bst[threadIdx.x] = 0u;
    __syncthreads();
    const XcdBarrier bar = xcd_barrier_post((unsigned*)(ws + WS_BAR), bst);
    if (hi > 1000) grid.sync();
#define SEAM(k) do { if (IN(k) && IN((k) + 1)) { xcd_barrier(bar); if ((REPMASK >> 13) & 1) xcd_barrier(bar); } } while (0)
    if (IN(0)) for (int rep_ = 0; rep_ <= ((REPMASK >> 0) & 1); ++rep_) { phase0(p, lds); } SEAM(0);
    if (IN(1)) for (int rep_ = 0; rep_ <= ((REPMASK >> 1) & 1); ++rep_) { pg8::Gemm g{(const h16*)p.out, (const h16*)(ws + WS_W1T), NTOK, 7168, 1024}; pg8::StaticOrder S; S.init(NTOK, 7168, gridDim.x, blockIdx.x);
                 Epi1 E{(h16*)(ws + WS_XC), (h16*)(ws + WS_G), (h16*)(ws + WS_U), (h16*)(ws + WS_V), (float*)(ws + WS_STATS)}; pg8::gemm_phase<Epi1>(lds, g, S, E); } SEAM(1);
    if (IN(3)) for (int rep_ = 0; rep_ <= ((REPMASK >> 3) & 1); ++rep_) { phase_mix0(p, lds); } SEAM(3);
    if (IN(4)) for (int rep_ = 0; rep_ <= ((REPMASK >> 4) & 1); ++rep_) { pg8::Gemm g{(const h16*)(ws + WS_YCAT), (const h16*)(ws + WS_W2T), NTOK, 1024, 2048}; pg8::StaticOrder S; S.init(NTOK, 1024, gridDim.x, blockIdx.x);
                 Epi2 E{(h16*)(ws + WS_O1)}; pg8::gemm_phase<Epi2>(lds, g, S, E); } SEAM(4);
    if (IN(5)) for (int rep_ = 0; rep_ <= ((REPMASK >> 5) & 1); ++rep_) { phase_norm1(p); } SEAM(5);
    if (IN(6)) for (int rep_ = 0; rep_ <= ((REPMASK >> 6) & 1); ++rep_) { pg8::Gemm g{(const h16*)p.out, (const h16*)(ws + WS_W3T), NTOK, 5376, 1024}; pg8::StaticOrder S; S.init(NTOK, 5376, gridDim.x, blockIdx.x);
                 Epi3 E{(h16*)(ws + WS_PC), (h16*)(ws + WS_ZCD), (h16*)(ws + WS_FD)}; pg8::gemm_phase<Epi3>(lds, g, S, E); } SEAM(6);
    if (IN(7)) for (int rep_ = 0; rep_ <= ((REPMASK >> 7) & 1); ++rep_) { phase_fft(p, lds); }
    if (IN(8)) for (int rep_ = 0; rep_ <= ((REPMASK >> 8) & 1); ++rep_) { phase_scan(p, lds); } SEAM(8);
    if (IN(9)) for (int rep_ = 0; rep_ <= ((REPMASK >> 9) & 1); ++rep_) { phase_fnet_out(p); }
    if (IN(10)) for (int rep_ = 0; rep_ <= ((REPMASK >> 10) & 1); ++rep_) { phase_post(p); } SEAM(10);
    if (IN(11)) for (int rep_ = 0; rep_ <= ((REPMASK >> 11) & 1); ++rep_) { pg8::Gemm g{(const h16*)(ws + WS_ZCD), (const h16*)(ws + WS_W4T), NTOK, 1024, 1536}; pg8::StaticOrder S; S.init(NTOK, 1024, gridDim.x, blockIdx.x);
                  Epi4 E{(h16*)(ws + WS_O2)}; pg8::gemm_phase<Epi4>(lds, g, S, E); } SEAM(11);
    if (IN(12)) for (int rep_ = 0; rep_ <= ((REPMASK >> 12) & 1); ++rep_) { phase_final(p); }
}

extern "C" void kernel_launch(void* const* d_in, const int* in_sizes, int n_in, void* d_out, int out_size, void* d_ws, size_t ws_size, hipStream_t stream) {
    static int grid = 0;
    if (grid == 0) {
        int dev = 0, cus = 0, per_cu = 0;
        hipGetDevice(&dev);
        hipDeviceGetAttribute(&cus, hipDeviceAttributeMultiprocessorCount, dev);
        if (hipFuncSetAttribute((const void*)mega, hipFuncAttributeMaxDynamicSharedMemorySize, LDS_BYTES) != hipSuccess) fprintf(stderr, "kernel_launch: hipFuncSetAttribute failed\n");
        hipOccupancyMaxActiveBlocksPerMultiprocessor(&per_cu, (const void*)mega, 512, LDS_BYTES);
        if (per_cu < 1) { fprintf(stderr, "kernel_launch: occupancy query says %d blocks per CU\n", per_cu); per_cu = 1; }
        (void)hipGetLastError();
        grid = cus;
        if (grid < 64) grid = 64;
    }
    if (hipMemsetAsync((unsigned char*)d_ws + WS_BAR, 0, XCD_BAR_WORDS * 4, stream) != hipSuccess) fprintf(stderr, "kernel_launch: memset of the barrier words failed\n");
    Params p{};
    for (int i = 0; i < 24; ++i) p.in[i] = (const float*)d_in[i];
    p.out = (float*)d_out; p.ws = (unsigned char*)d_ws;
#if N_LAUNCH_MODE == 1
    p.ph_lo = 0; p.ph_hi = NPHASE;
    void* args[] = {&p};
    hipError_t e = hipLaunchCooperativeKernel((const void*)mega, dim3(grid), dim3(512), args, LDS_BYTES, stream);
    if (e != hipSuccess) fprintf(stderr, "kernel_launch: cooperative launch failed: %s (grid %d)\n", hipGetErrorString(e), grid);
#else
    for (int ph = 0; ph < NPHASE; ++ph) { p.ph_lo = ph; p.ph_hi = ph + 1; hipLaunchKernelGGL(mega, dim3(grid), dim3(512), LDS_BYTES, stream, p); }
#endif
}
```

```cpp
#include <hip/hip_runtime.h>
#include <hip/hip_cooperative_groups.h>
#include <cstdio>
#include <cstdint>
namespace cg = cooperative_groups;

#ifndef N_LAUNCH_MODE
#define N_LAUNCH_MODE 1
#endif

#ifndef REPMASK
#define REPMASK 0
#endif
#define LAS __attribute__((address_space(3)))
typedef _Float16 h16;
typedef _Float16 h16x8 __attribute__((ext_vector_type(8)));
typedef _Float16 h16x4 __attribute__((ext_vector_type(4)));
typedef float f32x2 __attribute__((ext_vector_type(2)));
typedef float f32x4 __attribute__((ext_vector_type(4)));
typedef float f32x16 __attribute__((ext_vector_type(16)));

constexpr int NTOK = 16384, DM = 1024, SEQ = 8192;
constexpr int LDS_MAIN = 131072;
constexpr int LDS_BYTES = LDS_MAIN + 16;
constexpr int NPHASE = 13;
constexpr size_t MiB = 1024 * 1024;
constexpr size_t WS_W1T = 0;
constexpr size_t WS_W2T = WS_W1T + (size_t)7168 * 1024 * 2;
constexpr size_t WS_W3T = WS_W2T + (size_t)1024 * 2048 * 2;
constexpr size_t WS_W4T = WS_W3T + (size_t)5376 * 1024 * 2;
constexpr size_t WS_STATS = 32 * MiB;
constexpr size_t WS_WSH = WS_STATS + 131072;
constexpr size_t WS_CWT = WS_WSH + 262144;
constexpr size_t WS_SBON = WS_CWT + 262144;
constexpr size_t WS_BAR = 35 * MiB;
constexpr size_t WS_XC = 36 * MiB, WS_G = 68 * MiB, WS_U = 100 * MiB, WS_V = 132 * MiB, WS_YCAT = 164 * MiB;
constexpr size_t WS_SPR = 0, WS_SPI = 232 * MiB;
constexpr size_t WS_O2 = 68 * MiB;
constexpr size_t WS_O1 = 36 * MiB, WS_PC = 68 * MiB, WS_ZCD = 168 * MiB, WS_FD = 216 * MiB;

namespace pg8 {
constexpr int BM = 256, BK = 64, HALF = 128, HTB = HALF * BK * 2, STAGE_BYTES = 8 * HTB, NXCD = 8, WGM = 8;
__host__ __device__ __forceinline__ int lds_byte(int r, int c) { const int st = (r >> 4) * 2 + (c >> 5), rr = r & 15, cc = c & 31, ob = rr * 64 + cc * 2; return st * 1024 + (ob ^ (((ob >> 9) & 1) << 5)); }
__host__ __device__ __forceinline__ void stage_rc(int b, int& R, int& C) { const int st = b / 1024, sb = b % 1024, swz = sb ^ (((sb >> 9) & 1) << 5); R = (st >> 1) * 16 + swz / 64; C = (st & 1) * 32 + (swz % 64) / 2; }
__host__ __device__ __forceinline__ int perm32(int rho) { const int n = rho >> 4, i = rho & 15; return 8 * (i >> 2) + 4 * n + (i & 3); }
struct Unit { int pm, pn; };
struct Gemm { const h16* A; const h16* Bt; int M, N, K; };
struct StaticOrder {
    int nM, nN, nwg, G, c;
    __host__ __device__ void init(int M, int N, int G_, int c_) { nM = M / BM; nN = N / BM; nwg = nM * nN; G = G_; c = c_; }
    __host__ __device__ bool next(int i, Unit& u) const {
        const long L = (long)i * G + c; if (L >= nwg) return false;
        int wgid = (int)L; { const int q = nwg / NXCD, r = nwg % NXCD, xcd = wgid % NXCD, off = wgid / NXCD; wgid = (xcd < r ? xcd * (q + 1) : r * (q + 1) + (xcd - r) * q) + off; }
        const int nig = WGM * nN, gid = wgid / nig, fm = gid * WGM, gsz = (nM - fm) < WGM ? (nM - fm) : WGM;
        u.pm = fm + ((wgid % nig) % gsz); u.pn = (wgid % nig) / gsz; return true;
    }
};
template <class Epi>
__device__ __forceinline__ void gemm_phase(LAS unsigned char* lds, const Gemm g, const StaticOrder& S, const Epi& E) {
    const int tid = threadIdx.x, wid = __builtin_amdgcn_readfirstlane(tid >> 6), lane = tid & 63, wr = wid >> 2, wc = wid & 3, fr = lane & 15, fq = lane >> 4;
    const int K = g.K, nt = K / BK;
    unsigned voffA[2], voffB[2];
#pragma unroll
    for (int i = 0; i < 2; ++i) { int R, C; stage_rc(tid * 16 + i * 8192, R, C); const int Rb = Epi::PERM ? ((R & ~31) + perm32(R & 31)) : R; voffA[i] = (unsigned)(R * K + C) * 2u; voffB[i] = (unsigned)(Rb * K + C) * 2u; }
    const size_t kstep = (size_t)(BK * 2);
    const size_t hstep = (size_t)HALF * K * 2;
    const size_t tstep = 2 * hstep;
    const unsigned ldsw = (unsigned)wid * 1024u;
    const int aoff = lds_byte(wr * 64 + fr, fq * 8), boff = lds_byte(wc * 32 + fr, fq * 8);
#define PG8_SA(b, h) (((b) * 2 + (h)) * HTB)
#define PG8_SB(b, h) ((4 + (b) * 2 + (h)) * HTB)
#define PG8_STAGE(bufoff, gbase, voff) do { _Pragma("unroll") for (int _i = 0; _i < 2; ++_i) \
        __builtin_amdgcn_global_load_lds((const unsigned*)((const char*)(gbase) + (voff)[_i]), (LAS unsigned*)(lds + (bufoff) + ldsw + _i * 8192), 16, 0, 0); } while (0)
#define PG8_LDA(dst, b, h) do { _Pragma("unroll") for (int m = 0; m < 4; ++m) _Pragma("unroll") for (int k = 0; k < 2; ++k) dst[m][k] = *(const LAS h16x8*)(lds + PG8_SA(b, h) + aoff + m * 2048 + k * 1024); } while (0)
#define PG8_LDB(dst, b, h) do { _Pragma("unroll") for (int n = 0; n < 2; ++n) _Pragma("unroll") for (int k = 0; k < 2; ++k) dst[n][k] = *(const LAS h16x8*)(lds + PG8_SB(b, h) + boff + n * 2048 + k * 1024); } while (0)
#define PG8_MMA(ai, bj, At, Bt) do { __builtin_amdgcn_s_setprio(1); _Pragma("unroll") for (int m = 0; m < 4; ++m) _Pragma("unroll") for (int n = 0; n < 2; ++n) _Pragma("unroll") for (int k = 0; k < 2; ++k) \
        acc[ai][bj][m][n] = __builtin_amdgcn_mfma_f32_16x16x32_f16(Bt[n][k], At[m][k], acc[ai][bj][m][n], 0, 0, 0); __builtin_amdgcn_s_setprio(0); } while (0)
#define PG8_WAIT_V(n) asm volatile("s_waitcnt vmcnt(" #n ")" ::: "memory")
#define PG8_WAIT_L(n) asm volatile("s_waitcnt lgkmcnt(" #n ")" ::: "memory")
#define PG8_BAR __builtin_amdgcn_s_barrier()
#define PG8_SCHED __builtin_amdgcn_sched_barrier(0)
    Unit cur, nxt; int ui = 0;
    if (!S.next(0, cur)) return;
    f32x4 acc[2][2][4][2];
#pragma unroll
    for (int a = 0; a < 2; ++a)
#pragma unroll
        for (int b = 0; b < 2; ++b)
#pragma unroll
            for (int m = 0; m < 4; ++m)
#pragma unroll
                for (int n = 0; n < 2; ++n) acc[a][b][m][n] = (f32x4){0.f, 0.f, 0.f, 0.f};
    h16x8 At[4][2], B0[2][2], B1[2][2];
    const char* cA = (const char*)g.A + (size_t)cur.pm * tstep; const char* cB = (const char*)g.Bt + (size_t)cur.pn * tstep;
    PG8_STAGE(PG8_SB(0, 0), cB, voffB); PG8_STAGE(PG8_SA(0, 0), cA, voffA); PG8_STAGE(PG8_SB(0, 1), cB + hstep, voffB); PG8_STAGE(PG8_SA(0, 1), cA + hstep, voffA);
    if (wr == 1) PG8_BAR;
    PG8_WAIT_V(4); PG8_BAR;
    PG8_STAGE(PG8_SB(1, 0), cB + kstep, voffB); PG8_STAGE(PG8_SA(1, 0), cA + kstep, voffA); PG8_STAGE(PG8_SB(1, 1), cB + hstep + kstep, voffB);
    PG8_WAIT_V(6); PG8_BAR;
    for (;;) {
        const bool has_next = S.next(ui + 1, nxt);
        const char* nA = has_next ? (const char*)g.A + (size_t)nxt.pm * tstep : cA; const char* nB = has_next ? (const char*)g.Bt + (size_t)nxt.pn * tstep : cB;
        for (int t = 0; t < nt; t += 2) {
            const bool last = (t == nt - 2);
            const char* a1 = cA + (size_t)(t + 1) * kstep;
            const char* a2 = last ? nA : cA + (size_t)(t + 2) * kstep; const char* b2 = last ? nB : cB + (size_t)(t + 2) * kstep;
            const char* a3 = a2 + kstep; const char* b3 = b2 + kstep;
            PG8_LDB(B0, 0, 0); PG8_SCHED; PG8_LDA(At, 0, 0); PG8_STAGE(PG8_SA(1, 1), a1 + hstep, voffA);
            PG8_WAIT_L(8); PG8_BAR; PG8_WAIT_L(0); PG8_MMA(0, 0, At, B0); PG8_BAR; PG8_SCHED;
            PG8_LDB(B1, 0, 1); PG8_STAGE(PG8_SB(0, 0), b2, voffB);
            PG8_BAR; PG8_WAIT_L(0); PG8_MMA(0, 1, At, B1); PG8_BAR;
            PG8_LDA(At, 0, 1); PG8_STAGE(PG8_SA(0, 0), a2, voffA);
            PG8_BAR; PG8_WAIT_L(0); PG8_MMA(1, 0, At, B0); PG8_BAR; PG8_SCHED;
            PG8_STAGE(PG8_SB(0, 1), b2 + hstep, voffB);
            PG8_WAIT_V(6); PG8_BAR; PG8_MMA(1, 1, At, B1); PG8_BAR;
            PG8_LDB(B0, 1, 0); PG8_SCHED; PG8_LDA(At, 1, 0); PG8_STAGE(PG8_SA(0, 1), a2 + hstep, voffA);
            PG8_WAIT_L(8); PG8_BAR; PG8_WAIT_L(0); PG8_MMA(0, 0, At, B0); PG8_BAR; PG8_SCHED;
            PG8_LDB(B1, 1, 1); PG8_STAGE(PG8_SB(1, 0), b3, voffB);
            PG8_BAR; PG8_WAIT_L(0); PG8_MMA(0, 1, At, B1); PG8_BAR;
            PG8_LDA(At, 1, 1); PG8_STAGE(PG8_SA(1, 0), a3, voffA);
            PG8_BAR; PG8_WAIT_L(0); PG8_MMA(1, 0, At, B0); PG8_BAR; PG8_SCHED;
            PG8_STAGE(PG8_SB(1, 1), b3 + hstep, voffB);
            PG8_WAIT_V(6); PG8_BAR; PG8_MMA(1, 1, At, B1); PG8_BAR;
        }
        E(acc, cur, wr, wc, fr, fq);
        if (!has_next) break;
#pragma unroll
        for (int a = 0; a < 2; ++a)
#pragma unroll
            for (int b = 0; b < 2; ++b)
#pragma unroll
                for (int m = 0; m < 4; ++m)
#pragma unroll
                    for (int n = 0; n < 2; ++n) acc[a][b][m][n] = (f32x4){0.f, 0.f, 0.f, 0.f};
        cur = nxt; cA = nA; cB = nB; ++ui;
    }
    PG8_WAIT_V(0);
    if (wr == 0) PG8_BAR;
    PG8_BAR;
#undef PG8_SA
#undef PG8_SB
#undef PG8_STAGE
#undef PG8_LDA
#undef PG8_LDB
#undef PG8_MMA
#undef PG8_WAIT_V
#undef PG8_WAIT_L
#undef PG8_BAR
#undef PG8_SCHED
}
}


#define XB_TMO      128
#define XB_XCNT(j)  (256  + 64 * (j))
#define XB_XSUB(j)  (1280 + 64 * (j))
#define XB_XGEN(j)  (2304 + 64 * (j))
#define XB_TOP      3328
#define XB_TOPGEN   3392
#define XCD_BAR_WORDS 3456
#define XB_SPIN_CAP (1u << 18)
__device__ __forceinline__ unsigned xb_ld(unsigned* p)              { return __hip_atomic_load(p, __ATOMIC_RELAXED, __HIP_MEMORY_SCOPE_AGENT); }
__device__ __forceinline__ unsigned xb_add(unsigned* p, unsigned v) { return __hip_atomic_fetch_add(p, v, __ATOMIC_RELAXED, __HIP_MEMORY_SCOPE_AGENT); }
__device__ __forceinline__ unsigned xb_xcc_id() { return (unsigned)__builtin_amdgcn_s_getreg((3 << 11) | 20) & 0xFu; }
#define XB_SPIN(cond, bar) do { unsigned _sp = 0; while (cond) { __builtin_amdgcn_s_sleep(1); \
    if ((++_sp & 255u) == 0u) { if (xb_ld(&(bar)[XB_TMO])) break; if (_sp > XB_SPIN_CAP) { atomicAdd(&(bar)[XB_TMO], 1u); break; } } } } while (0)
struct XcdBarrier { unsigned* bar; unsigned x; volatile LAS unsigned* st; };
__device__ __forceinline__ XcdBarrier xcd_barrier_post(unsigned* bar, volatile LAS unsigned* st) {
    XcdBarrier b; b.bar = bar; b.x = xb_xcc_id(); b.st = st;
    if (threadIdx.x == 0) (void)xb_add(&bar[XB_XCNT(b.x)], 1u);
    return b;
}
__device__ __forceinline__ void xcd_barrier_complete(unsigned* bar, unsigned x, unsigned& nloc, unsigned& nx) {
    const unsigned G = gridDim.x * gridDim.y * gridDim.z;
    unsigned sum, cnt, mine, sp = 0u;
    for (;;) {
        sum = 0u; cnt = 0u; mine = 0u;
#pragma unroll
        for (unsigned j = 0; j < 16; ++j) { const unsigned c = xb_ld(&bar[XB_XCNT(j)]); sum += c; cnt += (c > 0u) ? 1u : 0u; mine = (j == x) ? c : mine; }
        if (sum == G) break;
        __builtin_amdgcn_s_sleep(1);
        if ((++sp & 255u) == 0u) { if (xb_ld(&bar[XB_TMO])) break; if (sp > XB_SPIN_CAP) { atomicAdd(&bar[XB_TMO], 1u); break; } }
    }
    nloc = mine > 0u ? mine : 1u; nx = cnt > 0u ? cnt : 1u;
}
__device__ __forceinline__ void xcd_barrier(const XcdBarrier& b) {
    asm volatile("s_waitcnt vmcnt(0)" ::: "memory");
    __syncthreads();
    if (threadIdx.x == 0) {
        unsigned* bar = b.bar;
        __builtin_amdgcn_s_waitcnt(0);
        unsigned nloc = b.st[0], nx = b.st[1];
        if (nloc == 0u) { xcd_barrier_complete(bar, b.x, nloc, nx); b.st[0] = nloc; b.st[1] = nx; }
        const unsigned old = xb_add(&bar[XB_XSUB(b.x)], 1u);
        const unsigned gen = old / nloc;
        if (old + 1u == (gen + 1u) * nloc) {
            __builtin_amdgcn_fence(__ATOMIC_RELEASE, "agent");
            asm volatile("s_waitcnt vmcnt(0)" ::: "memory");
            const unsigned og = xb_add(&bar[XB_TOP], 1u);
            const unsigned tg = og / nx;
            if (og + 1u == (tg + 1u) * nx) xb_add(&bar[XB_TOPGEN], 1u);
            else XB_SPIN(xb_ld(&bar[XB_TOPGEN]) == tg, bar);
            __builtin_amdgcn_fence(__ATOMIC_ACQUIRE, "agent");
            xb_add(&bar[XB_XGEN(b.x)], 1u);
            asm volatile("s_waitcnt vmcnt(0)" ::: "memory");
        } else {
            XB_SPIN(xb_ld(&bar[XB_XGEN(b.x)]) == gen, bar);
            __builtin_amdgcn_fence(__ATOMIC_ACQUIRE, "agent");
            asm volatile("s_waitcnt vmcnt(0)" ::: "memory");
        }
    }
    __syncthreads();
}

struct Params { const float* in[24]; float* out; unsigned char* ws; int ph_lo, ph_hi; };

__device__ __forceinline__ float silu_f(float x) { return x * __builtin_amdgcn_rcpf(1.f + __expf(-x)); }
__device__ __forceinline__ float sigmoid_f(float x) { return __builtin_amdgcn_rcpf(1.f + __expf(-x)); }
__device__ __forceinline__ float tanh_f(float x) { return 1.f - 2.f * __builtin_amdgcn_rcpf(__expf(2.f * x) + 1.f); }
__device__ __forceinline__ float wave_sum(float v) {
#pragma unroll
    for (int o = 1; o < 64; o <<= 1) v += __shfl_xor(v, o);
    return v;
}
template <int CTRL> __device__ __forceinline__ float dpp_f(float x) { return __int_as_float(__builtin_amdgcn_update_dpp(0, __float_as_int(x), CTRL, 0xf, 0xf, false)); }
__device__ __forceinline__ float red8(float x) {
    x += dpp_f<0xB1>(x); x += dpp_f<0x4E>(x); x += dpp_f<0x141>(x); return x;
}
__device__ __forceinline__ float red16(float x) {
    x += dpp_f<0xB1>(x); x += dpp_f<0x4E>(x); x += dpp_f<0x141>(x); x += dpp_f<0x140>(x); return x;
}

__device__ __forceinline__ int sigma1(int np) {
    const int T = np >> 8, c = np & 255;
    if (T < 16) { const int bj = c >> 7, wc = (c >> 5) & 3, fq = (c >> 3) & 3, n = (c >> 2) & 1, e = c & 3; return 1024 * (2 * bj + n) + 64 * T + 16 * wc + 4 * fq + e; }
    if (T < 24) { return ((c >> 7) ? 6144 : 4096) + 128 * (T - 16) + (c & 127); }
    return 5120 + 256 * (T - 24) + c;
}

template <int MODE>
__device__ __forceinline__ void tr_item(const float* W, int K, int N, h16* WT, LAS float* scr, int item, int nblk, int lane) {
    const int kb = item / nblk, nb = item % nblk, k0 = 64 * kb, n0 = 32 * nb;
    const int np = n0 + (lane & 31);
    const int sc = (MODE == 1) ? sigma1(np) : np;
    const bool valid = (MODE != 2) || (np < 5248);
    float wv_[32];
#pragma unroll
    for (int i = 0; i < 32; ++i) { const int kk = 2 * i + (lane >> 5); wv_[i] = valid ? W[(size_t)(k0 + kk) * N + sc] : 0.f; }
#pragma unroll
    for (int i = 0; i < 32; ++i) { const int kk = 2 * i + (lane >> 5); scr[kk * 33 + (lane & 31)] = wv_[i]; }
    asm volatile("s_waitcnt lgkmcnt(0)" ::: "memory");
    const int c = lane & 7;
#pragma unroll
    for (int j = 0; j < 4; ++j) { const int n = (lane >> 3) + 8 * j; const LAS float* s = scr + (8 * c) * 33 + n;
        h16x8 o;
#pragma unroll
        for (int e = 0; e < 8; ++e) o[e] = (h16)s[e * 33];
        *(h16x8*)(WT + (size_t)(n0 + n) * K + k0 + 8 * c) = o; }
    asm volatile("s_waitcnt lgkmcnt(0)" ::: "memory");
}

__device__ __forceinline__ void rms_rows2_f16(const float* x0, const float* x1, const h16* ad0, const h16* ad1, const float* g, h16* or0, h16* or1, int lane) {
    f32x4 v[2][4]; h16x4 a[2][4]; float ss[2] = {0.f, 0.f};
#pragma unroll
    for (int j = 0; j < 4; ++j) { v[0][j] = *(const f32x4*)(x0 + 4 * lane + 256 * j); v[1][j] = *(const f32x4*)(x1 + 4 * lane + 256 * j);
        if (ad0) { a[0][j] = *(const h16x4*)(ad0 + 4 * lane + 256 * j); a[1][j] = *(const h16x4*)(ad1 + 4 * lane + 256 * j); } }
#pragma unroll
    for (int u = 0; u < 2; ++u)
#pragma unroll
        for (int j = 0; j < 4; ++j) {
            if (ad0) { v[u][j][0] += (float)a[u][j][0]; v[u][j][1] += (float)a[u][j][1]; v[u][j][2] += (float)a[u][j][2]; v[u][j][3] += (float)a[u][j][3]; }
            ss[u] += v[u][j][0] * v[u][j][0] + v[u][j][1] * v[u][j][1] + v[u][j][2] * v[u][j][2] + v[u][j][3] * v[u][j][3]; }
#pragma unroll
    for (int o = 1; o < 64; o <<= 1) { ss[0] += __shfl_xor(ss[0], o); ss[1] += __shfl_xor(ss[1], o); }
    const float rs0 = rsqrtf(ss[0] * (1.f / 1024.f) + 1e-6f), rs1 = rsqrtf(ss[1] * (1.f / 1024.f) + 1e-6f);
#pragma unroll
    for (int j = 0; j < 4; ++j) { const f32x4 gg = *(const f32x4*)(g + 4 * lane + 256 * j); h16x4 o0, o1;
#pragma unroll
        for (int e = 0; e < 4; ++e) { o0[e] = (h16)(v[0][j][e] * rs0 * gg[e]); o1[e] = (h16)(v[1][j][e] * rs1 * gg[e]); }
        *(h16x4*)(or0 + 4 * lane + 256 * j) = o0; *(h16x4*)(or1 + 4 * lane + 256 * j) = o1; }
}

__device__ __forceinline__ void phase0(const Params& p, LAS unsigned char* lds) {
    const int tid = threadIdx.x, lane = tid & 63, wave = tid >> 6;
    const int gw = blockIdx.x * 8 + wave, NGW = gridDim.x * 8;
    LAS float* scr = (LAS float*)(lds + wave * 8448);
    h16* W1T = (h16*)(p.ws + WS_W1T); h16* W2T = (h16*)(p.ws + WS_W2T); h16* W3T = (h16*)(p.ws + WS_W3T); h16* W4T = (h16*)(p.ws + WS_W4T);
    constexpr int I1 = 16 * 224, I2 = 32 * 32, I3 = 16 * 168, I4 = 24 * 32;
    for (int it = gw; it < I1 + I2 + I3 + I4; it += NGW) {
        int r = it;
        if (r < I1) { tr_item<1>(p.in[2], 1024, 7168, W1T, scr, r, 224, lane); continue; } r -= I1;
        if (r < I2) { tr_item<0>(p.in[8], 2048, 1024, W2T, scr, r, 32, lane); continue; } r -= I2;
        if (r < I3) { tr_item<2>(p.in[10], 1024, 5248, W3T, scr, r, 168, lane); continue; } r -= I3;
        tr_item<0>(p.in[22], 1536, 1024, W4T, scr, r, 32, lane);
    }
    h16* H0 = (h16*)p.out;
    for (int r = gw; r < NTOK; r += 2 * NGW) { const int r1 = (r + NGW < NTOK) ? r + NGW : r;
        rms_rows2_f16(p.in[0] + (size_t)r * DM, p.in[0] + (size_t)r1 * DM, nullptr, nullptr, p.in[1], H0 + (size_t)r * DM, H0 + (size_t)r1 * DM, lane); }
    const int gt = blockIdx.x * 512 + tid, NGT = gridDim.x * 512;
    h16* WSH = (h16*)(p.ws + WS_WSH);
    for (int i = gt; i < 8 * 128 * 128; i += NGT) WSH[i] = (h16)p.in[6][i];
    { float* STZ = (float*)(p.ws + WS_STATS); for (int i = gt; i < 2 * NTOK; i += NGT) STZ[i] = 0.f; }
    h16* CWT = (h16*)(p.ws + WS_CWT);
    const float* wf = p.in[21];
    for (int i = gt; i < 4 * 128 * 256; i += NGT) {
        const int k = i & 255, e = (i >> 8) & 127, g = i >> 15, d = k & 127; const bool sn = k >= 128;
        float s = 0.f;
        for (int dp = 0; dp < 128; ++dp) { const float fr = (float)((d * dp) & 127) * (1.f / 128.f);
            const float tw = sn ? __builtin_amdgcn_sinf(fr) : __builtin_amdgcn_cosf(fr);
            s += tw * wf[(g * 128 + dp) * 128 + e]; }
        CWT[i] = (h16)(s * 0.08838834764831845f);
    }
}

struct Epi1 {
    static constexpr bool PERM = true;
    h16 *XC, *G, *U, *V; float* st;
    __device__ __forceinline__ void operator()(const f32x4 (&acc)[2][2][4][2], const pg8::Unit& u, int wr, int wc, int fr, int fq) const {
        const int T = u.pn; const int row0 = u.pm * 256 + wr * 64 + fr;
        if (T < 16) {
            const int ch = 64 * T + 16 * wc + 4 * fq;
#pragma unroll
            for (int ai = 0; ai < 2; ++ai)
#pragma unroll
                for (int m = 0; m < 4; ++m) { const size_t r = (size_t)(row0 + ai * 128 + m * 16);
                    const f32x4 xa = acc[ai][0][m][0], ba = acc[ai][0][m][1], ca = acc[ai][1][m][0], za = acc[ai][1][m][1];
                    h16x4 xc, gg;
#pragma unroll
                    for (int e = 0; e < 4; ++e) { xc[e] = (h16)(ca[e] * xa[e]); gg[e] = (h16)(ba[e] * silu_f(za[e])); }
                    *(h16x4*)(XC + r * 1024 + ch) = xc; *(h16x4*)(G + r * 1024 + ch) = gg; }
        } else if (T < 24) {
            const int ch = 128 * (T - 16) + 32 * wc + 8 * fq;
#pragma unroll
            for (int ai = 0; ai < 2; ++ai)
#pragma unroll
                for (int m = 0; m < 4; ++m) { const size_t r = (size_t)(row0 + ai * 128 + m * 16); h16x8 o;
#pragma unroll
                    for (int n = 0; n < 2; ++n) { const f32x4 ub = acc[ai][0][m][n], zb = acc[ai][1][m][n];
#pragma unroll
                        for (int e = 0; e < 4; ++e) o[4 * n + e] = (h16)(ub[e] * silu_f(zb[e])); }
                    *(h16x8*)(U + r * 1024 + ch) = o; }
        } else {
#pragma unroll
            for (int ai = 0; ai < 2; ++ai)
#pragma unroll
                for (int m = 0; m < 4; ++m) { const size_t r = (size_t)(row0 + ai * 128 + m * 16); float s1 = 0.f, s2 = 0.f;
#pragma unroll
                    for (int bj = 0; bj < 2; ++bj) { const int ch = 256 * (T - 24) + 128 * bj + 32 * wc + 8 * fq; h16x8 o;
#pragma unroll
                        for (int n = 0; n < 2; ++n) { const f32x4 v = acc[ai][bj][m][n];
#pragma unroll
                            for (int e = 0; e < 4; ++e) { o[4 * n + e] = (h16)v[e]; const float f = (float)o[4 * n + e]; s1 += f; s2 += f * f; } }
                        *(h16x8*)(V + r * 1024 + ch) = o; }
                    s1 += __shfl_xor(s1, 16); s2 += __shfl_xor(s2, 16); s1 += __shfl_xor(s1, 32); s2 += __shfl_xor(s2, 32);
                    if (fq == 0) { atomicAdd(st + 2 * r, s1); atomicAdd(st + 2 * r + 1, s2); } }
        }
    }
};
struct Epi2 {
    static constexpr bool PERM = true;
    h16* O1;
    __device__ __forceinline__ void operator()(const f32x4 (&acc)[2][2][4][2], const pg8::Unit& u, int wr, int wc, int fr, int fq) const {
        const int row0 = u.pm * 256 + wr * 64 + fr, col0 = u.pn * 256 + wc * 32 + 8 * fq;
#pragma unroll
        for (int ai = 0; ai < 2; ++ai)
#pragma unroll
            for (int m = 0; m < 4; ++m) { const size_t r = (size_t)(row0 + ai * 128 + m * 16);
#pragma unroll
                for (int bj = 0; bj < 2; ++bj) { const f32x4 v0 = acc[ai][bj][m][0], v1 = acc[ai][bj][m][1]; h16x8 o;
#pragma unroll
                    for (int e = 0; e < 4; ++e) { o[e] = (h16)v0[e]; o[4 + e] = (h16)v1[e]; }
                    *(h16x8*)(O1 + r * 1024 + col0 + bj * 128) = o; } }
    }
};
struct Epi3 {
    static constexpr bool PERM = true;
    h16 *PC, *ZCD, *FD;
    __device__ __forceinline__ void operator()(const f32x4 (&acc)[2][2][4][2], const pg8::Unit& u, int wr, int wc, int fr, int fq) const {
        const int row0 = u.pm * 256 + wr * 64 + fr, col0 = u.pn * 256 + wc * 32 + 8 * fq;
#pragma unroll
        for (int bj = 0; bj < 2; ++bj) { const int c = col0 + bj * 128;
            h16* base; size_t ld;
            if (c < 3200) { base = PC + c; ld = 3200; }
            else if (c < 4224) { base = ZCD + (c - 3200); ld = 1536; }
            else if (c < 4736) { base = FD + (c - 4224); ld = 512; }
            else if (c < 5248) { base = ZCD + 1024 + (c - 4736); ld = 1536; }
            else continue;
#pragma unroll
            for (int ai = 0; ai < 2; ++ai)
#pragma unroll
                for (int m = 0; m < 4; ++m) { const size_t r = (size_t)(row0 + ai * 128 + m * 16); const f32x4 v0 = acc[ai][bj][m][0], v1 = acc[ai][bj][m][1]; h16x8 o;
#pragma unroll
                    for (int e = 0; e < 4; ++e) { o[e] = (h16)v0[e]; o[4 + e] = (h16)v1[e]; }
                    *(h16x8*)(base + r * ld) = o; } }
    }
};
struct Epi4 {
    static constexpr bool PERM = true;
    h16* O2;
    __device__ __forceinline__ void operator()(const f32x4 (&acc)[2][2][4][2], const pg8::Unit& u, int wr, int wc, int fr, int fq) const {
        const int row0 = u.pm * 256 + wr * 64 + fr, col0 = u.pn * 256 + wc * 32 + 8 * fq;
#pragma unroll
        for (int ai = 0; ai < 2; ++ai)
#pragma unroll
            for (int m = 0; m < 4; ++m) { const size_t r = (size_t)(row0 + ai * 128 + m * 16);
#pragma unroll
                for (int bj = 0; bj < 2; ++bj) { const f32x4 v0 = acc[ai][bj][m][0], v1 = acc[ai][bj][m][1]; h16x8 o;
#pragma unroll
                    for (int e = 0; e < 4; ++e) { o[e] = (h16)v0[e]; o[4 + e] = (h16)v1[e]; }
                    *(h16x8*)(O2 + r * 1024 + col0 + bj * 128) = o; } }
    }
};

__device__ __forceinline__ void phase_stats(const Params& p) {
    const int tid = threadIdx.x, lane = tid & 63, wave = tid >> 6;
    const int gw = blockIdx.x * 8 + wave, NGW = gridDim.x * 8;
    const h16* V = (const h16*)(p.ws + WS_V); float* ST = (float*)(p.ws + WS_STATS);
    for (int r = gw; r < NTOK; r += NGW) {
        const h16x8 a = *(const h16x8*)(V + (size_t)r * 1024 + 8 * lane), b = *(const h16x8*)(V + (size_t)r * 1024 + 512 + 8 * lane);
        float s = 0.f;
#pragma unroll
        for (int e = 0; e < 8; ++e) s += (float)a[e] + (float)b[e];
        const float mu = wave_sum(s) * (1.f / 1024.f); float q = 0.f;
#pragma unroll
        for (int e = 0; e < 8; ++e) { const float x = (float)a[e] - mu, y = (float)b[e] - mu; q += x * x + y * y; }
        const float rs = rsqrtf(wave_sum(q) * (1.f / 1024.f) + 1e-5f);
        if (lane == 0) { ST[2 * r] = mu; ST[2 * r + 1] = rs; }
    }
}

__device__ __forceinline__ void phase_mix0(const Params& p, LAS unsigned char* lds) {
    const int tid = threadIdx.x, lane = tid & 63, wave = tid >> 6;
    const h16* XC = (const h16*)(p.ws + WS_XC); const h16* G = (const h16*)(p.ws + WS_G); const h16* U = (const h16*)(p.ws + WS_U); const h16* V = (const h16*)(p.ws + WS_V);
    h16* YC = (h16*)(p.ws + WS_YCAT);
    const float* cw = p.in[3];
    const int gt = blockIdx.x * 512 + tid, NGT = gridDim.x * 512;
    for (int idx0 = gt; idx0 < NTOK * 128; idx0 += 2 * NGT) {
        h16x8 x0[2], xm[2], xp[2], gg[2]; int tt[2], cc[2];
        const h16x8 zero = {0, 0, 0, 0, 0, 0, 0, 0};
#pragma unroll
        for (int u = 0; u < 2; ++u) { const int idx = (idx0 + u * NGT < NTOK * 128) ? idx0 + u * NGT : idx0; const int t = idx >> 7, c8 = (idx & 127) * 8, tp = t & (SEQ - 1); tt[u] = t; cc[u] = c8;
            x0[u] = *(const h16x8*)(XC + (size_t)t * 1024 + c8);
            xm[u] = tp > 0 ? *(const h16x8*)(XC + (size_t)(t - 1) * 1024 + c8) : zero;
            xp[u] = tp < SEQ - 1 ? *(const h16x8*)(XC + (size_t)(t + 1) * 1024 + c8) : zero;
            gg[u] = *(const h16x8*)(G + (size_t)t * 1024 + c8); }
#pragma unroll
        for (int u = 0; u < 2; ++u) { const int c8 = cc[u]; h16x8 o;
#pragma unroll
            for (int e = 0; e < 8; ++e) { const float y = cw[c8 + e] * (float)xm[u][e] + cw[1024 + c8 + e] * (float)x0[u][e] + cw[2048 + c8 + e] * (float)xp[u][e]; o[e] = (h16)(y * (float)gg[u][e]); }
            *(h16x8*)(YC + (size_t)tt[u] * 2048 + c8) = o; }
    }
    const float* ST = (const float*)(p.ws + WS_STATS); const h16* WSH = (const h16*)(p.ws + WS_WSH);
    const float* lng = p.in[4]; const float* lnb = p.in[5]; const float* bs = p.in[7];
    LAS h16* vnT = (LAS h16*)lds;
    for (int it = blockIdx.x; it < 1024; it += gridDim.x) {
        const int g = it & 7, bn = it >> 3, t0 = bn * 128;
        __syncthreads();
#pragma unroll
        for (int q = 0; q < 4; ++q) { const int pc = tid + 512 * q, j = pc >> 4, d8 = (pc & 15) * 8;
            const h16x8 v = *(const h16x8*)(V + (size_t)(t0 + j) * 1024 + g * 128 + d8);
            const float mu = ST[2 * (t0 + j)] * (1.f / 1024.f), rs = rsqrtf(fmaxf(ST[2 * (t0 + j) + 1] * (1.f / 1024.f) - mu * mu, 0.f) + 1e-5f);
#pragma unroll
            for (int e = 0; e < 8; ++e) vnT[(d8 + e) * 136 + ((((j >> 3) ^ (pc & 15)) << 3) | (j & 7))] = (h16)(((float)v[e] - mu) * rs * lng[g * 128 + d8 + e] + lnb[g * 128 + d8 + e]); }
        __syncthreads();
        const int itile = wave >> 1, dt0 = (wave & 1) * 2;
        f32x16 acc0, acc1;
#pragma unroll
        for (int e = 0; e < 16; ++e) { acc0[e] = 0.f; acc1[e] = 0.f; }
        const h16* Arow = WSH + ((size_t)g * 128 + itile * 32 + (lane & 31)) * 128 + 8 * (lane >> 5);
        const int d0_ = dt0 * 32 + (lane & 31), d1_ = d0_ + 32;
        const LAS h16* B0p = vnT + d0_ * 136; const LAS h16* B1p = vnT + d1_ * 136;
#pragma unroll
        for (int ks = 0; ks < 8; ++ks) {
            const h16x8 a = *(const h16x8*)(Arow + 16 * ks);
            const int jg = 2 * ks + (lane >> 5);
            const h16x8 b0 = *(const LAS h16x8*)(B0p + ((jg ^ ((d0_ >> 3) & 15)) << 3)), b1 = *(const LAS h16x8*)(B1p + ((jg ^ ((d1_ >> 3) & 15)) << 3));
            acc0 = __builtin_amdgcn_mfma_f32_32x32x16_f16(a, b0, acc0, 0, 0, 0);
            acc1 = __builtin_amdgcn_mfma_f32_32x32x16_f16(a, b1, acc1, 0, 0, 0);
        }
#pragma unroll
        for (int r = 0; r < 16; ++r) { const int i = itile * 32 + (r & 3) + 8 * (r >> 2) + 4 * (lane >> 5); const size_t t = (size_t)(t0 + i);
            const float bias = bs[g * 128 + i];
            const int d0 = g * 128 + dt0 * 32 + (lane & 31);
            YC[t * 2048 + 1024 + d0] = (h16)((acc0[r] + bias) * (float)U[t * 1024 + d0]);
            YC[t * 2048 + 1024 + d0 + 32] = (h16)((acc1[r] + bias) * (float)U[t * 1024 + d0 + 32]); }
    }
}

__device__ __forceinline__ void phase_norm1(const Params& p) {
    const int tid = threadIdx.x, lane = tid & 63, wave = tid >> 6;
    const int gw = blockIdx.x * 8 + wave, NGW = gridDim.x * 8;
    const h16* O1 = (const h16*)(p.ws + WS_O1); h16* H1 = (h16*)p.out;
    for (int r = gw; r < NTOK; r += 2 * NGW) { const int r1 = (r + NGW < NTOK) ? r + NGW : r;
        rms_rows2_f16(p.in[0] + (size_t)r * DM, p.in[0] + (size_t)r1 * DM, O1 + (size_t)r * DM, O1 + (size_t)r1 * DM, p.in[9], H1 + (size_t)r * DM, H1 + (size_t)r1 * DM, lane); }
}

__device__ __forceinline__ void phase_fft(const Params& p, LAS unsigned char* lds) {
    const int tid = threadIdx.x;
    const h16* FD = (const h16*)(p.ws + WS_FD);
    h16* SPr = (h16*)(p.ws + WS_SPR); h16* SPi = (h16*)(p.ws + WS_SPI);
    LAS f32x2* X0 = (LAS f32x2*)lds; LAS f32x2* X1 = X0 + 8192;
    for (int it = blockIdx.x; it < 256; it += gridDim.x) {
        const int b = it >> 7, c0 = 4 * (it & 127);
        __syncthreads();
        for (int t = tid; t < SEQ; t += 512) { const h16x4 v = *(const h16x4*)(FD + (size_t)(b * SEQ + t) * 512 + c0);
            X0[t] = (f32x2){(float)v[0], (float)v[1]}; X1[t] = (f32x2){(float)v[2], (float)v[3]}; }
        __syncthreads();
        for (int s = 0; s < 13; ++s) {
            const int half = 4096 >> s;
#pragma unroll 2
            for (int j = tid; j < 4096; j += 512) {
                const int pos = j & (half - 1), grp = j >> (12 - s), i0 = (grp << (13 - s)) + pos, i1 = i0 + half;
                const float fr = (float)(pos << s) * (1.f / 8192.f);
                const float c = __builtin_amdgcn_cosf(fr), sn = __builtin_amdgcn_sinf(fr);
                { const f32x2 a = X0[i0], bb = X0[i1]; const f32x2 d = a - bb; X0[i0] = a + bb; X0[i1] = (f32x2){d[0] * c + d[1] * sn, d[1] * c - d[0] * sn}; }
                { const f32x2 a = X1[i0], bb = X1[i1]; const f32x2 d = a - bb; X1[i0] = a + bb; X1[i1] = (f32x2){d[0] * c + d[1] * sn, d[1] * c - d[0] * sn}; }
            }
            __syncthreads();
        }
        const float sc = 0.5f * 0.011048543456039806f;
        for (int k = tid; k < SEQ; k += 512) {
            const int ra = __brev((unsigned)k) >> 19, rb = __brev((unsigned)((SEQ - k) & (SEQ - 1))) >> 19;
            const f32x2 za = X0[ra], zb = X0[rb], ya = X1[ra], yb = X1[rb];
            h16x4 orr, oi;
            orr[0] = (h16)((za[0] + zb[0]) * sc); oi[0] = (h16)((za[1] - zb[1]) * sc);
            orr[1] = (h16)((za[1] + zb[1]) * sc); oi[1] = (h16)((zb[0] - za[0]) * sc);
            orr[2] = (h16)((ya[0] + yb[0]) * sc); oi[2] = (h16)((ya[1] - yb[1]) * sc);
            orr[3] = (h16)((ya[1] + yb[1]) * sc); oi[3] = (h16)((yb[0] - ya[0]) * sc);
            *(h16x4*)(SPr + (size_t)(b * SEQ + k) * 512 + c0) = orr; *(h16x4*)(SPi + (size_t)(b * SEQ + k) * 512 + c0) = oi;
        }
    }
}

__device__ __forceinline__ void phase_fnet_out(const Params& p, LAS unsigned char* lds) {
    const int tid = threadIdx.x, lane = tid & 63, wave = tid >> 6;
    const h16* SPr = (const h16*)(p.ws + WS_SPR); const h16* SPi = (const h16*)(p.ws + WS_SPI);
    const h16* CWT = (const h16*)(p.ws + WS_CWT); h16* ZCD = (h16*)(p.ws + WS_ZCD);
    LAS h16* Lr = (LAS h16*)lds; LAS h16* Li = Lr + 32 * 520;
    const int g = wave >> 1, eh = wave & 1;
    for (int it = blockIdx.x; it < 512; it += gridDim.x) {
        const int t0 = it * 32;
        __syncthreads();
#pragma unroll
        for (int q = 0; q < 8; ++q) { const int idx = tid + 512 * q, arr = idx >> 11, rem = idx & 2047, row = rem >> 6, ch = rem & 63;
            const h16x8 v = *(const h16x8*)((arr ? SPi : SPr) + (size_t)(t0 + row) * 512 + ch * 8);
            *(LAS h16x8*)((arr ? Li : Lr) + row * 520 + ch * 8) = v; }
        __syncthreads();
        f32x16 acc0, acc1;
#pragma unroll
        for (int e = 0; e < 16; ++e) { acc0[e] = 0.f; acc1[e] = 0.f; }
        const LAS h16* Ar = Lr + (lane & 31) * 520 + g * 128 + 8 * (lane >> 5); const LAS h16* Ai = Li + (lane & 31) * 520 + g * 128 + 8 * (lane >> 5);
        const h16* B0 = CWT + ((size_t)(g * 128 + (2 * eh) * 32 + (lane & 31))) * 256 + 8 * (lane >> 5); const h16* B1 = B0 + 32 * 256;
#pragma unroll
        for (int ks = 0; ks < 8; ++ks) { const h16x8 a = *(const LAS h16x8*)(Ar + 16 * ks);
            acc0 = __builtin_amdgcn_mfma_f32_32x32x16_f16(a, *(const h16x8*)(B0 + 16 * ks), acc0, 0, 0, 0);
            acc1 = __builtin_amdgcn_mfma_f32_32x32x16_f16(a, *(const h16x8*)(B1 + 16 * ks), acc1, 0, 0, 0); }
#pragma unroll
        for (int ks = 0; ks < 8; ++ks) { const h16x8 a = *(const LAS h16x8*)(Ai + 16 * ks);
            acc0 = __builtin_amdgcn_mfma_f32_32x32x16_f16(a, *(const h16x8*)(B0 + 128 + 16 * ks), acc0, 0, 0, 0);
            acc1 = __builtin_amdgcn_mfma_f32_32x32x16_f16(a, *(const h16x8*)(B1 + 128 + 16 * ks), acc1, 0, 0, 0); }
#pragma unroll
        for (int r = 0; r < 16; ++r) { const size_t t = (size_t)(t0 + (r & 3) + 8 * (r >> 2) + 4 * (lane >> 5));
            h16* zp = ZCD + t * 1536 + 1024 + g * 128 + (2 * eh) * 32 + (lane & 31);
            zp[0] = (h16)(acc0[r] * silu_f((float)zp[0])); zp[32] = (h16)(acc1[r] * silu_f((float)zp[32])); }
    }
}

#define LDS_BAR() do { asm volatile("s_waitcnt lgkmcnt(0)" ::: "memory"); __builtin_amdgcn_s_barrier(); asm volatile("" ::: "memory"); } while (0)
#define LDS_WAIT() asm volatile("s_waitcnt lgkmcnt(0)" ::: "memory")
__device__ __forceinline__ void phase_scan(const Params& p, LAS unsigned char* lds) {
    const int tid = threadIdx.x, lane = tid & 63, wave = tid >> 6;
    const h16* PC = (const h16*)(p.ws + WS_PC);
    LAS h16* w2T = (LAS h16*)lds;
    LAS h16* a2T = w2T + 64 * 72;
    LAS unsigned char* priv = lds + 18432 + (wave & 3) * 4096;
    constexpr int SET_F = 5 * 2048 + 512;
    LAS float* OPS = (LAS float*)(lds + 18432 + 16384);
    LAS float* sYb = OPS + 2 * SET_F;
    for (int item = blockIdx.x; item < 256; item += gridDim.x) {
        const int xcd = item & 7, slot = item >> 3, gidx = xcd * 8 + (slot >> 2), q = slot & 3;
        const int dir = gidx >> 5, b = (gidx >> 4) & 1, h = gidx & 15;
        h16* Yd = (h16*)((unsigned char*)p.out + (size_t)dir * 32 * MiB);
        float* SB = (float*)(p.ws + WS_SBON) + (size_t)dir * NTOK * 16;
        const float* mu = p.in[11] + dir * 3200; const float* w0 = p.in[12] + dir * 1024 + 64 * h; const float* w2 = p.in[13] + (size_t)dir * 65536 + 64 * h;
        const float* a0 = p.in[14] + dir * 1024 + 64 * h; const float* a2 = p.in[15] + (size_t)dir * 65536 + 64 * h;
        const float* kkw = p.in[16] + 64 * h; const float* kaw = p.in[17] + 64 * h; const float* rkw = p.in[18] + 64 * h;
        __syncthreads();
        for (int i = tid; i < 4096; i += 512) { const int l = i >> 6, c = i & 63; w2T[c * 72 + l] = (h16)w2[l * 1024 + c]; a2T[c * 72 + l] = (h16)a2[l * 1024 + c]; }
        const int pw_ = wave & 3, s_sub = lane >> 3, c8 = (lane & 7) * 8, s_l = 8 * pw_ + s_sub;
        h16x8 mu_r8, mu_k8, mu_v8, mu_w8, mu_a8; f32x2 w0r[4], a0r[4], kkr[4], kar[4], omk[4], rkr[4];
#pragma unroll
        for (int e = 0; e < 8; ++e) { mu_r8[e] = (h16)mu[64 * h + c8 + e]; mu_k8[e] = (h16)mu[1024 + 64 * h + c8 + e]; mu_v8[e] = (h16)mu[2048 + 64 * h + c8 + e]; mu_w8[e] = (h16)mu[3072 + c8 + e]; mu_a8[e] = (h16)mu[3136 + c8 + e];
            w0r[e >> 1][e & 1] = w0[c8 + e]; a0r[e >> 1][e & 1] = a0[c8 + e]; kkr[e >> 1][e & 1] = kkw[c8 + e]; kar[e >> 1][e & 1] = kaw[c8 + e]; omk[e >> 1][e & 1] = 1.f - kaw[c8 + e]; rkr[e >> 1][e & 1] = rkw[c8 + e]; }
        f32x2 S01 = {0.f, 0.f}, S23 = {0.f, 0.f};
        const int srow = 4 * (wave & 3) + (lane >> 4), j0 = 4 * (lane & 15);
        const h16x8 z8 = {0, 0, 0, 0, 0, 0, 0, 0};
        h16x8 pr, pk, pv, pw, pa, qr_, qk_, qv_, qw_, qa_;
        const h16 *pcA, *pcB, *ppA, *ppB;
        { const int t0_ = dir ? (SEQ - 1 - s_l) : s_l; pcA = PC + (size_t)(b * SEQ + t0_) * 3200 + c8 + 64 * h; pcB = pcA + 2048 - 64 * h;
          const long po_ = (s_l > 0) ? (dir ? 3200 : -3200) : 0; ppA = pcA + po_; ppB = pcB + po_; }
        const long cstride_ = dir ? -32 * 3200 : 32 * 3200;
#define SCAN_LOAD_RAW() do { \
            pr = *(const h16x8*)(pcA); pk = *(const h16x8*)(pcA + 1024); pv = *(const h16x8*)(pcB + 64 * h); pw = *(const h16x8*)(pcB + 1024); pa = *(const h16x8*)(pcB + 1088); \
            qr_ = *(const h16x8*)(ppA); qk_ = *(const h16x8*)(ppA + 1024); qv_ = *(const h16x8*)(ppB + 64 * h); qw_ = *(const h16x8*)(ppB + 1024); qa_ = *(const h16x8*)(ppB + 1088); \
            pcA += cstride_; pcB += cstride_; ppA = pcA + (dir ? 3200 : -3200); ppB = pcB + (dir ? 3200 : -3200); } while (0)
#define SCAN_LOAD(chn) SCAN_LOAD_RAW()
#define SCAN_YSTORE(chn) do { const int sg_ = (chn) * 32 + s_l; const int t_ = dir ? (SEQ - 1 - sg_) : sg_; \
            const f32x2 y2_ = *(const LAS f32x2*)(sYb + ((chn) & 1) * 512 + s_l * 16 + 2 * (lane & 7)); \
            typedef _Float16 h16x2_ __attribute__((ext_vector_type(2))); h16x2_ o_; o_[0] = (h16)y2_[0]; o_[1] = (h16)y2_[1]; \
            *(h16x2_*)(Yd + (size_t)(b * SEQ + t_) * 1024 + 64 * h + 16 * q + 2 * (lane & 7)) = o_; } while (0)
        if (wave >= 4) { SCAN_LOAD_RAW(); if (s_l == 0) { qr_ = z8; qk_ = z8; qv_ = z8; qw_ = z8; qa_ = z8; } }
        __syncthreads();
        for (int n = -1; n < SEQ / 32; ++n) {
            if (wave < 4) {
                if (n >= 0) {
                    __builtin_amdgcn_s_setprio(3);
                    const LAS float* sR = OPS + (n & 1) * SET_F + j0; const LAS float* sW = sR + 2048; const LAS float* sK = sW + 2048; const LAS float* sA = sK + 2048; const LAS float* sB = sA + 2048; const LAS float* sV = OPS + (n & 1) * SET_F + 10240;
                    LAS float* sY = sYb + (n & 1) * 512;
                    f32x4 a_ = *(const LAS f32x4*)(sA), w_ = *(const LAS f32x4*)(sW), b_ = *(const LAS f32x4*)(sB);
                    f32x4 k_ = *(const LAS f32x4*)(sK), r_ = *(const LAS f32x4*)(sR);
                    f32x4 vq[4];
#pragma unroll
                    for (int u = 0; u < 4; ++u) vq[u] = *(const LAS f32x4*)(sV + srow * 32 + 4 * u);
                    f32x4 rp = r_;
#pragma unroll
                    for (int hb = 0; hb < 2; ++hb) {
                        f32x4 vn[4];
#pragma unroll
                        for (int u = 0; u < 4; ++u) vn[u] = *(const LAS f32x4*)(sV + srow * 32 + ((16 * (hb + 1)) & 31) + 4 * u);
#pragma unroll
                        for (int u16 = 0; u16 < 16; ++u16) {
                            const int s = 16 * hb + u16;
                            const int sn = (s + 1) & 31;
                            const f32x4 a_n = *(const LAS f32x4*)(sA + sn * 64), w_n = *(const LAS f32x4*)(sW + sn * 64), b_n = *(const LAS f32x4*)(sB + sn * 64);
                            const f32x4 k_n = *(const LAS f32x4*)(sK + sn * 64), r_n = *(const LAS f32x4*)(sR + sn * 64);
                            const float v = vq[u16 >> 2][u16 & 3];
                            const f32x2 vv = {v, v};
                            f32x2 pp = S01 * (f32x2){a_[0], a_[1]}; pp = S23 * (f32x2){a_[2], a_[3]} + pp;
                            f32x2 yy = S01 * (f32x2){rp[0], rp[1]}; yy = S23 * (f32x2){rp[2], rp[3]} + yy;
                            float sa = pp[0] + pp[1], y = yy[0] + yy[1];
                            sa += dpp_f<0xB1>(sa); y += dpp_f<0xB1>(y);
                            sa += dpp_f<0x4E>(sa); y += dpp_f<0x4E>(y);
                            sa += dpp_f<0x141>(sa); y += dpp_f<0x141>(y);
                            sa += dpp_f<0x140>(sa); y += dpp_f<0x140>(y);
                            sY[((s - 1) & 31) * 16 + srow] = y;
                            const f32x2 sv = {sa, sa};
                            S01 = S01 * (f32x2){w_[0], w_[1]} + vv * (f32x2){k_[0], k_[1]};
                            S23 = S23 * (f32x2){w_[2], w_[3]} + vv * (f32x2){k_[2], k_[3]};
                            S01 = sv * (f32x2){b_[0], b_[1]} + S01;
                            S23 = sv * (f32x2){b_[2], b_[3]} + S23;
                            rp = r_;
                            a_ = a_n; w_ = w_n; b_ = b_n; k_ = k_n; r_ = r_n;
                        }
#pragma unroll
                        for (int u = 0; u < 4; ++u) vq[u] = vn[u];
                    }
                    { f32x2 yy = S01 * (f32x2){rp[0], rp[1]}; yy = S23 * (f32x2){rp[2], rp[3]} + yy; sY[31 * 16 + srow] = red16(yy[0] + yy[1]); }
                    __builtin_amdgcn_s_setprio(0);
                }
            } else {
                if (n + 1 < SEQ / 32) {
                    const int cn = n + 1;
                    const int sg = cn * 32 + s_l; const int t = dir ? (SEQ - 1 - sg) : sg;
                    f32x2 qr[4], qk[4]; float qv[8];
                    LAS h16* TWp = (LAS h16*)priv; LAS h16* QAp = TWp + 8 * 72;
                    { unsigned m1u_ = 0xBC00BC00u; asm volatile("" : "+s"(m1u_));
                      typedef unsigned u32x4_ __attribute__((ext_vector_type(4))); const u32x4_ m1v_ = {m1u_, m1u_, m1u_, m1u_}; const h16x8 m1_ = __builtin_bit_cast(h16x8, m1v_);
                      const h16x8 r8 = pr + mu_r8 * (pr * m1_ + qr_), k8 = pk + mu_k8 * (pk * m1_ + qk_), v8 = pv + mu_v8 * (pv * m1_ + qv_);
                      const h16x8 w8 = pw + mu_w8 * (pw * m1_ + qw_), a8 = pa + mu_a8 * (pa * m1_ + qa_);
                      h16x8 tw8;
#pragma unroll
                      for (int pi = 0; pi < 4; ++pi) { qr[pi] = (f32x2){(float)r8[2 * pi], (float)r8[2 * pi + 1]}; qk[pi] = (f32x2){(float)k8[2 * pi], (float)k8[2 * pi + 1]};
                          qv[2 * pi] = (float)v8[2 * pi]; qv[2 * pi + 1] = (float)v8[2 * pi + 1];
                          const f32x2 tx = (f32x2){(float)w8[2 * pi], (float)w8[2 * pi + 1]} * 2.8853900817779268f;
                          const f32x2 dn = (f32x2){__builtin_amdgcn_exp2f(tx[0]), __builtin_amdgcn_exp2f(tx[1])} + 1.f;
                          const f32x2 th = (f32x2){__builtin_amdgcn_rcpf(dn[0]), __builtin_amdgcn_rcpf(dn[1])} * -2.f + 1.f;
                          tw8[2 * pi] = (h16)th[0]; tw8[2 * pi + 1] = (h16)th[1]; }
                      *(LAS h16x8*)(TWp + s_sub * 72 + c8) = tw8; *(LAS h16x8*)(QAp + s_sub * 72 + c8) = a8; }
                    if (cn + 1 < SEQ / 32) SCAN_LOAD(cn + 1);
                    LDS_WAIT();
                    f32x4 accw[4], acca[4];
#pragma unroll
                    for (int ct = 0; ct < 4; ++ct) { accw[ct] = (f32x4){0.f, 0.f, 0.f, 0.f}; acca[ct] = (f32x4){0.f, 0.f, 0.f, 0.f}; }
#pragma unroll
                    for (int ks = 0; ks < 2; ++ks) {
                        const h16x8 atw = *(const LAS h16x8*)(TWp + (lane & 7) * 72 + 32 * ks + 8 * (lane >> 4));
                        const h16x8 aqa = *(const LAS h16x8*)(QAp + (lane & 7) * 72 + 32 * ks + 8 * (lane >> 4));
#pragma unroll
                        for (int ct = 0; ct < 4; ++ct) {
                            const h16x8 bw = *(const LAS h16x8*)(w2T + (16 * ct + (lane & 15)) * 72 + 32 * ks + 8 * (lane >> 4));
                            const h16x8 ba = *(const LAS h16x8*)(a2T + (16 * ct + (lane & 15)) * 72 + 32 * ks + 8 * (lane >> 4));
                            accw[ct] = __builtin_amdgcn_mfma_f32_16x16x32_f16(atw, bw, accw[ct], 0, 0, 0);
                            acca[ct] = __builtin_amdgcn_mfma_f32_16x16x32_f16(aqa, ba, acca[ct], 0, 0, 0);
                        }
                    }
                    LDS_WAIT();
                    { LAS float* Zd = (LAS float*)priv + (lane >> 5) * 512 + (4 * ((lane >> 4) & 1)) * 64 + (lane & 15);
#pragma unroll
                      for (int ct = 0; ct < 4; ++ct)
#pragma unroll
                          for (int r = 0; r < 4; ++r) Zd[r * 64 + 16 * ct] = (lane < 32) ? accw[ct][r] : acca[ct][r]; }
                    LDS_WAIT();
                    const LAS float* Zw = (const LAS float*)priv + s_sub * 64 + c8; const LAS float* Za = Zw + 512;
                    const f32x4 zw0 = *(const LAS f32x4*)Zw, zw1 = *(const LAS f32x4*)(Zw + 4), za0 = *(const LAS f32x4*)Za, za1 = *(const LAS f32x4*)(Za + 4);
                    LDS_WAIT();
                    f32x2 kk[4], av_[4], kp[4], dec[4], kn2 = {0.f, 0.f}, sb2 = {0.f, 0.f};
#pragma unroll
                    for (int pi = 0; pi < 4; ++pi) {
                        const f32x2 zw = (pi < 2 ? (f32x2){zw0[2 * pi], zw0[2 * pi + 1]} : (f32x2){zw1[2 * pi - 4], zw1[2 * pi - 3]}) + w0r[pi];
                        const f32x2 za = (pi < 2 ? (f32x2){za0[2 * pi], za0[2 * pi + 1]} : (f32x2){za1[2 * pi - 4], za1[2 * pi - 3]}) + a0r[pi];
                        const f32x2 tw_ = zw * -1.4426950408889634f, ta_ = za * -1.4426950408889634f;
                        const f32x2 dw = (f32x2){__builtin_amdgcn_exp2f(tw_[0]), __builtin_amdgcn_exp2f(tw_[1])} + 1.f, da = (f32x2){__builtin_amdgcn_exp2f(ta_[0]), __builtin_amdgcn_exp2f(ta_[1])} + 1.f;
                        const f32x2 sw = (f32x2){__builtin_amdgcn_rcpf(dw[0]), __builtin_amdgcn_rcpf(dw[1])} * -0.8750387749225136f;
                        dec[pi] = (f32x2){__builtin_amdgcn_exp2f(sw[0]), __builtin_amdgcn_exp2f(sw[1])};
                        av_[pi] = (f32x2){__builtin_amdgcn_rcpf(da[0]), __builtin_amdgcn_rcpf(da[1])};
                        kk[pi] = qk[pi] * kkr[pi]; kn2 = kk[pi] * kk[pi] + kn2;
                        kp[pi] = qk[pi] * (av_[pi] * kar[pi] + omk[pi]);
                        sb2 = (qr[pi] * kp[pi]) * rkr[pi] + sb2; }
                    const float kn = red8(kn2[0] + kn2[1]), sbn = red8(sb2[0] + sb2[1]);
                    const float ninv = -rsqrtf(fmaxf(kn, 1e-12f));
                    LAS float* dR = OPS + (cn & 1) * SET_F + s_l * 64 + c8;
#pragma unroll
                    for (int hf = 0; hf < 2; ++hf) {
                        const f32x2 na0 = kk[2 * hf] * ninv, na1 = kk[2 * hf + 1] * ninv;
                        const f32x2 nb0 = na0 * av_[2 * hf], nb1 = na1 * av_[2 * hf + 1];
                        *(LAS f32x4*)(dR + 4 * hf) = (f32x4){qr[2 * hf][0], qr[2 * hf][1], qr[2 * hf + 1][0], qr[2 * hf + 1][1]};
                        *(LAS f32x4*)(dR + 2048 + 4 * hf) = (f32x4){dec[2 * hf][0], dec[2 * hf][1], dec[2 * hf + 1][0], dec[2 * hf + 1][1]};
                        *(LAS f32x4*)(dR + 4096 + 4 * hf) = (f32x4){kp[2 * hf][0], kp[2 * hf][1], kp[2 * hf + 1][0], kp[2 * hf + 1][1]};
                        *(LAS f32x4*)(dR + 6144 + 4 * hf) = (f32x4){na0[0], na0[1], na1[0], na1[1]};
                        *(LAS f32x4*)(dR + 8192 + 4 * hf) = (f32x4){-nb0[0], -nb0[1], -nb1[0], -nb1[1]}; }
                    if ((c8 >> 4) == q) { LAS float* dV = OPS + (cn & 1) * SET_F + 10240 + (c8 & 15) * 32 + s_l;
#pragma unroll
                        for (int e = 0; e < 8; ++e) dV[e * 32] = qv[e]; }
                    if (q == 0 && (lane & 7) == 0) SB[(size_t)(b * SEQ + t) * 16 + h] = sbn;
                }
                if (n >= 1) SCAN_YSTORE(n - 1);
            }
            LDS_BAR();
        }
        if (wave >= 4) SCAN_YSTORE(SEQ / 32 - 1);
#undef SCAN_LOAD
#undef SCAN_LOAD_RAW
#undef SCAN_YSTORE
    }
}

__device__ __forceinline__ void phase_post(const Params& p) {
    const int tid = threadIdx.x;
    const h16* Y0 = (const h16*)p.out; const h16* Y1 = (const h16*)((const unsigned char*)p.out + 32 * MiB);
    const h16* PC = (const h16*)(p.ws + WS_PC); h16* ZCD = (h16*)(p.ws + WS_ZCD);
    const float* SB0 = (const float*)(p.ws + WS_SBON); const float* SB1 = SB0 + (size_t)NTOK * 16;
    const float* mu0 = p.in[11] + 2048; const float* mu1 = p.in[11] + 3200 + 2048;
    const float* lg = p.in[19]; const float* lb = p.in[20];
    const int gt = blockIdx.x * 512 + tid, NGT = gridDim.x * 512;
    for (int idx = gt; idx < NTOK * 128; idx += NGT) {
        const int t = idx >> 7, c = (idx & 127) * 8, hh = c >> 6, tp = t & (SEQ - 1);
        const h16x8 y0 = *(const h16x8*)(Y0 + (size_t)t * 1024 + c), y1 = *(const h16x8*)(Y1 + (size_t)t * 1024 + c);
        const h16x8 z8 = {0, 0, 0, 0, 0, 0, 0, 0};
        const h16x8 v0 = *(const h16x8*)(PC + (size_t)t * 3200 + 2048 + c);
        const h16x8 vm = tp > 0 ? *(const h16x8*)(PC + (size_t)(t - 1) * 3200 + 2048 + c) : z8;
        const h16x8 vp = tp < SEQ - 1 ? *(const h16x8*)(PC + (size_t)(t + 1) * 3200 + 2048 + c) : z8;
        const h16x8 zc = *(const h16x8*)(ZCD + (size_t)t * 1536 + c);
        const float s0 = SB0[(size_t)t * 16 + hh], s1 = SB1[(size_t)t * 16 + hh];
        float y[8], s = 0.f;
#pragma unroll
        for (int e = 0; e < 8; ++e) { y[e] = (float)y0[e] + (float)y1[e]; s += y[e]; }
        const float mean = red8(s) * (1.f / 64.f); float q = 0.f;
#pragma unroll
        for (int e = 0; e < 8; ++e) { y[e] -= mean; q += y[e] * y[e]; }
        const float rs = rsqrtf(red8(q) * (1.f / 64.f) + 64e-5f);
        const f32x4 lg0 = *(const f32x4*)(lg + c), lg1 = *(const f32x4*)(lg + c + 4), lb0 = *(const f32x4*)(lb + c), lb1 = *(const f32x4*)(lb + c + 4);
        const f32x4 ma0 = *(const f32x4*)(mu0 + c), ma1 = *(const f32x4*)(mu0 + c + 4), mb0 = *(const f32x4*)(mu1 + c), mb1 = *(const f32x4*)(mu1 + c + 4);
        h16x8 o;
#pragma unroll
        for (int e = 0; e < 8; ++e) { const float vv = (float)v0[e];
            const float m0 = e < 4 ? ma0[e & 3] : ma1[e & 3], m1 = e < 4 ? mb0[e & 3] : mb1[e & 3], gg = e < 4 ? lg0[e & 3] : lg1[e & 3], bb = e < 4 ? lb0[e & 3] : lb1[e & 3];
            const float vd0 = vv + m0 * ((float)vm[e] - vv), vd1 = vv + m1 * ((float)vp[e] - vv);
            const float val = y[e] * rs * gg + bb + s0 * vd0 + s1 * vd1;
            o[e] = (h16)(val * silu_f((float)zc[e])); }
        *(h16x8*)(ZCD + (size_t)t * 1536 + c) = o;
    }
}

__device__ __forceinline__ void phase_final(const Params& p) {
    const int tid = threadIdx.x, lane = tid & 63, wave = tid >> 6;
    const int gw = blockIdx.x * 8 + wave, NGW = gridDim.x * 8;
    const float* g = p.in[23]; const h16* O1 = (const h16*)(p.ws + WS_O1); const h16* O2 = (const h16*)(p.ws + WS_O2);
    for (int r = gw; r < NTOK; r += 2 * NGW) {
        const int rr[2] = {r, (r + NGW < NTOK) ? r + NGW : r};
        f32x4 v[2][4]; h16x4 a[2][4], b[2][4]; float ss[2] = {0.f, 0.f};
#pragma unroll
        for (int u = 0; u < 2; ++u)
#pragma unroll
            for (int j = 0; j < 4; ++j) { const size_t o = (size_t)rr[u] * DM + 4 * lane + 256 * j; v[u][j] = *(const f32x4*)(p.in[0] + o); a[u][j] = *(const h16x4*)(O1 + o); b[u][j] = *(const h16x4*)(O2 + o); }
#pragma unroll
        for (int u = 0; u < 2; ++u)
#pragma unroll
            for (int j = 0; j < 4; ++j) {
#pragma unroll
                for (int e = 0; e < 4; ++e) v[u][j][e] += (float)a[u][j][e] + (float)b[u][j][e];
                ss[u] += v[u][j][0] * v[u][j][0] + v[u][j][1] * v[u][j][1] + v[u][j][2] * v[u][j][2] + v[u][j][3] * v[u][j][3]; }
#pragma unroll
        for (int o = 1; o < 64; o <<= 1) { ss[0] += __shfl_xor(ss[0], o); ss[1] += __shfl_xor(ss[1], o); }
        const float rs[2] = {rsqrtf(ss[0] * (1.f / 1024.f) + 1e-6f), rsqrtf(ss[1] * (1.f / 1024.f) + 1e-6f)};
#pragma unroll
        for (int j = 0; j < 4; ++j) { const f32x4 gg = *(const f32x4*)(g + 4 * lane + 256 * j);
#pragma unroll
            for (int u = 0; u < 2; ++u) { f32x4 o = v[u][j] * rs[u]; o = o * gg; *(f32x4*)(p.out + (size_t)rr[u] * DM + 4 * lane + 256 * j) = o; } }
    }
}

__global__ void __launch_bounds__(512, 2) mega(Params p) {
    extern __shared__ __attribute__((aligned(16))) unsigned char smem[];
    LAS unsigned char* lds = (LAS unsigned char*)smem;
    cg::grid_group grid = cg::this_grid();
    unsigned char* ws = p.ws;
    const int lo = p.ph_lo, hi = p.ph_hi;
#define IN(k) (lo <= (k) && (k) < hi)
    volatile LAS unsigned* bst = (volatile LAS unsigned*)(lds + LDS_MAIN);
    if (threadIdx.x < 4) bst[threadIdx.x] = 0u;
    __syncthreads();
    const XcdBarrier bar = xcd_barrier_post((unsigned*)(ws + WS_BAR), bst);
    if (hi > 1000) grid.sync();
#define SEAM(k) do { if (IN(k) && IN((k) + 1)) { xcd_barrier(bar); if ((REPMASK >> 13) & 1) xcd_barrier(bar); } } while (0)
    if (IN(0)) for (int rep_ = 0; rep_ <= ((REPMASK >> 0) & 1); ++rep_) { phase0(p, lds); } SEAM(0);
    if (IN(1)) for (int rep_ = 0; rep_ <= ((REPMASK >> 1) & 1); ++rep_) { pg8::Gemm g{(const h16*)p.out, (const h16*)(ws + WS_W1T), NTOK, 7168, 1024}; pg8::StaticOrder S; S.init(NTOK, 7168, gridDim.x, blockIdx.x);
                 Epi1 E{(h16*)(ws + WS_XC), (h16*)(ws + WS_G), (h16*)(ws + WS_U), (h16*)(ws + WS_V), (float*)(ws + WS_STATS)}; pg8::gemm_phase<Epi1>(lds, g, S, E); } SEAM(1);
    if (IN(3)) for (int rep_ = 0; rep_ <= ((REPMASK >> 3) & 1); ++rep_) { phase_mix0(p, lds); } SEAM(3);
    if (IN(4)) for (int rep_ = 0; rep_ <= ((REPMASK >> 4) & 1); ++rep_) { pg8::Gemm g{(const h16*)(ws + WS_YCAT), (const h16*)(ws + WS_W2T), NTOK, 1024, 2048}; pg8::StaticOrder S; S.init(NTOK, 1024, gridDim.x, blockIdx.x);
                 Epi2 E{(h16*)(ws + WS_O1)}; pg8::gemm_phase<Epi2>(lds, g, S, E); } SEAM(4);
    if (IN(5)) for (int rep_ = 0; rep_ <= ((REPMASK >> 5) & 1); ++rep_) { phase_norm1(p); } SEAM(5);
    if (IN(6)) for (int rep_ = 0; rep_ <= ((REPMASK >> 6) & 1); ++rep_) { pg8::Gemm g{(const h16*)p.out, (const h16*)(ws + WS_W3T), NTOK, 5376, 1024}; pg8::StaticOrder S; S.init(NTOK, 5376, gridDim.x, blockIdx.x);
                 Epi3 E{(h16*)(ws + WS_PC), (h16*)(ws + WS_ZCD), (h16*)(ws + WS_FD)}; pg8::gemm_phase<Epi3>(lds, g, S, E); } SEAM(6);
    if (IN(7)) for (int rep_ = 0; rep_ <= ((REPMASK >> 7) & 1); ++rep_) { phase_fft(p, lds); }
    if (IN(8)) for (int rep_ = 0; rep_ <= ((REPMASK >> 8) & 1); ++rep_) { phase_scan(p, lds); } SEAM(8);
    if (IN(9)) for (int rep_ = 0; rep_ <= ((REPMASK >> 9) & 1); ++rep_) { phase_fnet_out(p, lds); }
    if (IN(10)) for (int rep_ = 0; rep_ <= ((REPMASK >> 10) & 1); ++rep_) { phase_post(p); } SEAM(10);
    if (IN(11)) for (int rep_ = 0; rep_ <= ((REPMASK >> 11) & 1); ++rep_) { pg8::Gemm g{(const h16*)(ws + WS_ZCD), (const h16*)(ws + WS_W4T), NTOK, 1024, 1536}; pg8::StaticOrder S; S.init(NTOK, 1024, gridDim.x, blockIdx.x);
                  Epi4 E{(h16*)(ws + WS_O2)}; pg8::gemm_phase<Epi4>(lds, g, S, E); } SEAM(11);
    if (IN(12)) for (int rep_ = 0; rep_ <= ((REPMASK >> 12) & 1); ++rep_) { phase_final(p); }
}

extern "C" void kernel_launch(void* const* d_in, const int* in_sizes, int n_in, void* d_out, int out_size, void* d_ws, size_t ws_size, hipStream_t stream) {
    static int grid = 0;
    if (grid == 0) {
        int dev = 0, cus = 0, per_cu = 0;
        hipGetDevice(&dev);
        hipDeviceGetAttribute(&cus, hipDeviceAttributeMultiprocessorCount, dev);
        if (hipFuncSetAttribute((const void*)mega, hipFuncAttributeMaxDynamicSharedMemorySize, LDS_BYTES) != hipSuccess) fprintf(stderr, "kernel_launch: hipFuncSetAttribute failed\n");
        hipOccupancyMaxActiveBlocksPerMultiprocessor(&per_cu, (const void*)mega, 512, LDS_BYTES);
        if (per_cu < 1) { fprintf(stderr, "kernel_launch: occupancy query says %d blocks per CU\n", per_cu); per_cu = 1; }
        (void)hipGetLastError();
        grid = cus;
        if (grid < 64) grid = 64;
    }
    if (hipMemsetAsync((unsigned char*)d_ws + WS_BAR, 0, XCD_BAR_WORDS * 4, stream) != hipSuccess) fprintf(stderr, "kernel_launch: memset of the barrier words failed\n");
    Params p{};
    for (int i = 0; i < 24; ++i) p.in[i] = (const float*)d_in[i];
    p.out = (float*)d_out; p.ws = (unsigned char*)d_ws;
#if N_LAUNCH_MODE == 1
    p.ph_lo = 0; p.ph_hi = NPHASE;
    void* args[] = {&p};
    hipError_t e = hipLaunchCooperativeKernel((const void*)mega, dim3(grid), dim3(512), args, LDS_BYTES, stream);
    if (e != hipSuccess) fprintf(stderr, "kernel_launch: cooperative launch failed: %s (grid %d)\n", hipGetErrorString(e), grid);
#else
    for (int ph = 0; ph < NPHASE; ++ph) { p.ph_lo = ph; p.ph_hi = ph + 1; hipLaunchKernelGGL(mega, dim3(grid), dim3(512), LDS_BYTES, stream, p); }
#endif
}
```

```cpp
#include <hip/hip_runtime.h>
#include <hip/hip_cooperative_groups.h>
#include <cstdio>
#include <cstdint>
namespace cg = cooperative_groups;

#ifndef N_LAUNCH_MODE
#define N_LAUNCH_MODE 1
#endif

#ifndef REPMASK
#define REPMASK 0
#endif
#define LAS __attribute__((address_space(3)))
typedef _Float16 h16;
typedef _Float16 h16x8 __attribute__((ext_vector_type(8)));
typedef _Float16 h16x4 __attribute__((ext_vector_type(4)));
typedef float f32x2 __attribute__((ext_vector_type(2)));
typedef float f32x4 __attribute__((ext_vector_type(4)));
typedef float f32x16 __attribute__((ext_vector_type(16)));

constexpr int NTOK = 16384, DM = 1024, SEQ = 8192;
constexpr int LDS_MAIN = 131072;
constexpr int LDS_BYTES = LDS_MAIN + 16;
constexpr int NPHASE = 13;
constexpr size_t MiB = 1024 * 1024;
constexpr size_t WS_W1T = 0;
constexpr size_t WS_W2T = WS_W1T + (size_t)7168 * 1024 * 2;
constexpr size_t WS_W3T = WS_W2T + (size_t)1024 * 2048 * 2;
constexpr size_t WS_W4T = WS_W3T + (size_t)5376 * 1024 * 2;
constexpr size_t WS_STATS = 32 * MiB;
constexpr size_t WS_WSH = WS_STATS + 131072;
constexpr size_t WS_CWT = WS_WSH + 262144;
constexpr size_t WS_SBON = WS_CWT + 262144;
constexpr size_t WS_BAR = 35 * MiB;
constexpr size_t WS_XC = 36 * MiB, WS_G = 68 * MiB, WS_U = 100 * MiB, WS_V = 132 * MiB, WS_YCAT = 164 * MiB;
constexpr size_t WS_SPR = 0, WS_SPI = 232 * MiB;
constexpr size_t WS_O2 = 68 * MiB;
constexpr size_t WS_O1 = 36 * MiB, WS_PC = 68 * MiB, WS_ZCD = 168 * MiB, WS_FD = 216 * MiB;

namespace pg8 {
constexpr int BM = 256, BK = 64, HALF = 128, HTB = HALF * BK * 2, STAGE_BYTES = 8 * HTB, NXCD = 8, WGM = 8;
__host__ __device__ __forceinline__ int lds_byte(int r, int c) { const int st = (r >> 4) * 2 + (c >> 5), rr = r & 15, cc = c & 31, ob = rr * 64 + cc * 2; return st * 1024 + (ob ^ (((ob >> 9) & 1) << 5)); }
__host__ __device__ __forceinline__ void stage_rc(int b, int& R, int& C) { const int st = b / 1024, sb = b % 1024, swz = sb ^ (((sb >> 9) & 1) << 5); R = (st >> 1) * 16 + swz / 64; C = (st & 1) * 32 + (swz % 64) / 2; }
__host__ __device__ __forceinline__ int perm32(int rho) { const int n = rho >> 4, i = rho & 15; return 8 * (i >> 2) + 4 * n + (i & 3); }
struct Unit { int pm, pn; };
struct Gemm { const h16* A; const h16* Bt; int M, N, K; };
struct StaticOrder {
    int nM, nN, nwg, G, c;
    __host__ __device__ void init(int M, int N, int G_, int c_) { nM = M / BM; nN = N / BM; nwg = nM * nN; G = G_; c = c_; }
    __host__ __device__ bool next(int i, Unit& u) const {
        const long L = (long)i * G + c; if (L >= nwg) return false;
        int wgid = (int)L; { const int q = nwg / NXCD, r = nwg % NXCD, xcd = wgid % NXCD, off = wgid / NXCD; wgid = (xcd < r ? xcd * (q + 1) : r * (q + 1) + (xcd - r) * q) + off; }
        const int nig = WGM * nN, gid = wgid / nig, fm = gid * WGM, gsz = (nM - fm) < WGM ? (nM - fm) : WGM;
        u.pm = fm + ((wgid % nig) % gsz); u.pn = (wgid % nig) / gsz; return true;
    }
};
template <class Epi>
__device__ __forceinline__ void gemm_phase(LAS unsigned char* lds, const Gemm g, const StaticOrder& S, const Epi& E) {
    const int tid = threadIdx.x, wid = __builtin_amdgcn_readfirstlane(tid >> 6), lane = tid & 63, wr = wid >> 2, wc = wid & 3, fr = lane & 15, fq = lane >> 4;
    const int K = g.K, nt = K / BK;
    unsigned voffA[2], voffB[2];
#pragma unroll
    for (int i = 0; i < 2; ++i) { int R, C; stage_rc(tid * 16 + i * 8192, R, C); const int Rb = Epi::PERM ? ((R & ~31) + perm32(R & 31)) : R; voffA[i] = (unsigned)(R * K + C) * 2u; voffB[i] = (unsigned)(Rb * K + C) * 2u; }
    const size_t kstep = (size_t)(BK * 2);
    const size_t hstep = (size_t)HALF * K * 2;
    const size_t tstep = 2 * hstep;
    const unsigned ldsw = (unsigned)wid * 1024u;
    const int aoff = lds_byte(wr * 64 + fr, fq * 8), boff = lds_byte(wc * 32 + fr, fq * 8);
#define PG8_SA(b, h) (((b) * 2 + (h)) * HTB)
#define PG8_SB(b, h) ((4 + (b) * 2 + (h)) * HTB)
#define PG8_STAGE(bufoff, gbase, voff) do { _Pragma("unroll") for (int _i = 0; _i < 2; ++_i) \
        __builtin_amdgcn_global_load_lds((const unsigned*)((const char*)(gbase) + (voff)[_i]), (LAS unsigned*)(lds + (bufoff) + ldsw + _i * 8192), 16, 0, 0); } while (0)
#define PG8_LDA(dst, b, h) do { _Pragma("unroll") for (int m = 0; m < 4; ++m) _Pragma("unroll") for (int k = 0; k < 2; ++k) dst[m][k] = *(const LAS h16x8*)(lds + PG8_SA(b, h) + aoff + m * 2048 + k * 1024); } while (0)
#define PG8_LDB(dst, b, h) do { _Pragma("unroll") for (int n = 0; n < 2; ++n) _Pragma("unroll") for (int k = 0; k < 2; ++k) dst[n][k] = *(const LAS h16x8*)(lds + PG8_SB(b, h) + boff + n * 2048 + k * 1024); } while (0)
#define PG8_MMA(ai, bj, At, Bt) do { __builtin_amdgcn_s_setprio(1); _Pragma("unroll") for (int m = 0; m < 4; ++m) _Pragma("unroll") for (int n = 0; n < 2; ++n) _Pragma("unroll") for (int k = 0; k < 2; ++k) \
        acc[ai][bj][m][n] = __builtin_amdgcn_mfma_f32_16x16x32_f16(Bt[n][k], At[m][k], acc[ai][bj][m][n], 0, 0, 0); __builtin_amdgcn_s_setprio(0); } while (0)
#define PG8_WAIT_V(n) asm volatile("s_waitcnt vmcnt(" #n ")" ::: "memory")
#define PG8_WAIT_L(n) asm volatile("s_waitcnt lgkmcnt(" #n ")" ::: "memory")
#define PG8_BAR __builtin_amdgcn_s_barrier()
#define PG8_SCHED __builtin_amdgcn_sched_barrier(0)
    Unit cur, nxt; int ui = 0;
    if (!S.next(0, cur)) return;
    f32x4 acc[2][2][4][2];
#pragma unroll
    for (int a = 0; a < 2; ++a)
#pragma unroll
        for (int b = 0; b < 2; ++b)
#pragma unroll
            for (int m = 0; m < 4; ++m)
#pragma unroll
                for (int n = 0; n < 2; ++n) acc[a][b][m][n] = (f32x4){0.f, 0.f, 0.f, 0.f};
    h16x8 At[4][2], B0[2][2], B1[2][2];
    const char* cA = (const char*)g.A + (size_t)cur.pm * tstep; const char* cB = (const char*)g.Bt + (size_t)cur.pn * tstep;
    PG8_STAGE(PG8_SB(0, 0), cB, voffB); PG8_STAGE(PG8_SA(0, 0), cA, voffA); PG8_STAGE(PG8_SB(0, 1), cB + hstep, voffB); PG8_STAGE(PG8_SA(0, 1), cA + hstep, voffA);
    if (wr == 1) PG8_BAR;
    PG8_WAIT_V(4); PG8_BAR;
    PG8_STAGE(PG8_SB(1, 0), cB + kstep, voffB); PG8_STAGE(PG8_SA(1, 0), cA + kstep, voffA); PG8_STAGE(PG8_SB(1, 1), cB + hstep + kstep, voffB);
    PG8_WAIT_V(6); PG8_BAR;
    for (;;) {
        const bool has_next = S.next(ui + 1, nxt);
        const char* nA = has_next ? (const char*)g.A + (size_t)nxt.pm * tstep : cA; const char* nB = has_next ? (const char*)g.Bt + (size_t)nxt.pn * tstep : cB;
        for (int t = 0; t < nt; t += 2) {
            const bool last = (t == nt - 2);
            const char* a1 = cA + (size_t)(t + 1) * kstep;
            const char* a2 = last ? nA : cA + (size_t)(t + 2) * kstep; const char* b2 = last ? nB : cB + (size_t)(t + 2) * kstep;
            const char* a3 = a2 + kstep; const char* b3 = b2 + kstep;
            PG8_LDB(B0, 0, 0); PG8_SCHED; PG8_LDA(At, 0, 0); PG8_STAGE(PG8_SA(1, 1), a1 + hstep, voffA);
            PG8_WAIT_L(8); PG8_BAR; PG8_WAIT_L(0); PG8_MMA(0, 0, At, B0); PG8_BAR; PG8_SCHED;
            PG8_LDB(B1, 0, 1); PG8_STAGE(PG8_SB(0, 0), b2, voffB);
            PG8_BAR; PG8_WAIT_L(0); PG8_MMA(0, 1, At, B1); PG8_BAR;
            PG8_LDA(At, 0, 1); PG8_STAGE(PG8_SA(0, 0), a2, voffA);
            PG8_BAR; PG8_WAIT_L(0); PG8_MMA(1, 0, At, B0); PG8_BAR; PG8_SCHED;
            PG8_STAGE(PG8_SB(0, 1), b2 + hstep, voffB);
            PG8_WAIT_V(6); PG8_BAR; PG8_MMA(1, 1, At, B1); PG8_BAR;
            PG8_LDB(B0, 1, 0); PG8_SCHED; PG8_LDA(At, 1, 0); PG8_STAGE(PG8_SA(0, 1), a2 + hstep, voffA);
            PG8_WAIT_L(8); PG8_BAR; PG8_WAIT_L(0); PG8_MMA(0, 0, At, B0); PG8_BAR; PG8_SCHED;
            PG8_LDB(B1, 1, 1); PG8_STAGE(PG8_SB(1, 0), b3, voffB);
            PG8_BAR; PG8_WAIT_L(0); PG8_MMA(0, 1, At, B1); PG8_BAR;
            PG8_LDA(At, 1, 1); PG8_STAGE(PG8_SA(1, 0), a3, voffA);
            PG8_BAR; PG8_WAIT_L(0); PG8_MMA(1, 0, At, B0); PG8_BAR; PG8_SCHED;
            PG8_STAGE(PG8_SB(1, 1), b3 + hstep, voffB);
            PG8_WAIT_V(6); PG8_BAR; PG8_MMA(1, 1, At, B1); PG8_BAR;
        }
        E(acc, cur, wr, wc, fr, fq);
        if (!has_next) break;
#pragma unroll
        for (int a = 0; a < 2; ++a)
#pragma unroll
            for (int b = 0; b < 2; ++b)
#pragma unroll
                for (int m = 0; m < 4; ++m)
#pragma unroll
                    for (int n = 0; n < 2; ++n) acc[a][b][m][n] = (f32x4){0.f, 0.f, 0.f, 0.f};
        cur = nxt; cA = nA; cB = nB; ++ui;
    }
    PG8_WAIT_V(0);
    if (wr == 0) PG8_BAR;
    PG8_BAR;
#undef PG8_SA
#undef PG8_SB
#undef PG8_STAGE
#undef PG8_LDA
#undef PG8_LDB
#undef PG8_MMA
#undef PG8_WAIT_V
#undef PG8_WAIT_L
#undef PG8_BAR
#undef PG8_SCHED
}
}


#define XB_TMO      128
#define XB_XCNT(j)  (256  + 64 * (j))
#define XB_XSUB(j)  (1280 + 64 * (j))
#define XB_XGEN(j)  (2304 + 64 * (j))
#define XB_TOP      3328
#define XB_TOPGEN   3392
#define XCD_BAR_WORDS 3456
#define XB_SPIN_CAP (1u << 18)
__device__ __forceinline__ unsigned xb_ld(unsigned* p)              { return __hip_atomic_load(p, __ATOMIC_RELAXED, __HIP_MEMORY_SCOPE_AGENT); }
__device__ __forceinline__ unsigned xb_add(unsigned* p, unsigned v) { return __hip_atomic_fetch_add(p, v, __ATOMIC_RELAXED, __HIP_MEMORY_SCOPE_AGENT); }
__device__ __forceinline__ unsigned xb_xcc_id() { return (unsigned)__builtin_amdgcn_s_getreg((3 << 11) | 20) & 0xFu; }
#define XB_SPIN(cond, bar) do { unsigned _sp = 0; while (cond) { __builtin_amdgcn_s_sleep(1); \
    if ((++_sp & 255u) == 0u) { if (xb_ld(&(bar)[XB_TMO])) break; if (_sp > XB_SPIN_CAP) { atomicAdd(&(bar)[XB_TMO], 1u); break; } } } } while (0)
struct XcdBarrier { unsigned* bar; unsigned x; volatile LAS unsigned* st; };
__device__ __forceinline__ XcdBarrier xcd_barrier_post(unsigned* bar, volatile LAS unsigned* st) {
    XcdBarrier b; b.bar = bar; b.x = xb_xcc_id(); b.st = st;
    if (threadIdx.x == 0) (void)xb_add(&bar[XB_XCNT(b.x)], 1u);
    return b;
}
__device__ __forceinline__ void xcd_barrier_complete(unsigned* bar, unsigned x, unsigned& nloc, unsigned& nx) {
    const unsigned G = gridDim.x * gridDim.y * gridDim.z;
    unsigned sum, cnt, mine, sp = 0u;
    for (;;) {
        sum = 0u; cnt = 0u; mine = 0u;
#pragma unroll
        for (unsigned j = 0; j < 16; ++j) { const unsigned c = xb_ld(&bar[XB_XCNT(j)]); sum += c; cnt += (c > 0u) ? 1u : 0u; mine = (j == x) ? c : mine; }
        if (sum == G) break;
        __builtin_amdgcn_s_sleep(1);
        if ((++sp & 255u) == 0u) { if (xb_ld(&bar[XB_TMO])) break; if (sp > XB_SPIN_CAP) { atomicAdd(&bar[XB_TMO], 1u); break; } }
    }
    nloc = mine > 0u ? mine : 1u; nx = cnt > 0u ? cnt : 1u;
}
__device__ __forceinline__ void xcd_barrier(const XcdBarrier& b) {
    asm volatile("s_waitcnt vmcnt(0)" ::: "memory");
    __syncthreads();
    if (threadIdx.x == 0) {
        unsigned* bar = b.bar;
        __builtin_amdgcn_s_waitcnt(0);
        unsigned nloc = b.st[0], nx = b.st[1];
        if (nloc == 0u) { xcd_barrier_complete(bar, b.x, nloc, nx); b.st[0] = nloc; b.st[1] = nx; }
        const unsigned old = xb_add(&bar[XB_XSUB(b.x)], 1u);
        const unsigned gen = old / nloc;
        if (old + 1u == (gen + 1u) * nloc) {
            __builtin_amdgcn_fence(__ATOMIC_RELEASE, "agent");
            asm volatile("s_waitcnt vmcnt(0)" ::: "memory");
            const unsigned og = xb_add(&bar[XB_TOP], 1u);
            const unsigned tg = og / nx;
            if (og + 1u == (tg + 1u) * nx) xb_add(&bar[XB_TOPGEN], 1u);
            else XB_SPIN(xb_ld(&bar[XB_TOPGEN]) == tg, bar);
            __builtin_amdgcn_fence(__ATOMIC_ACQUIRE, "agent");
            xb_add(&bar[XB_XGEN(b.x)], 1u);
            asm volatile("s_waitcnt vmcnt(0)" ::: "memory");
        } else {
            XB_SPIN(xb_ld(&bar[XB_XGEN(b.x)]) == gen, bar);
            __builtin_amdgcn_fence(__ATOMIC_ACQUIRE, "agent");
            asm volatile("s_waitcnt vmcnt(0)" ::: "memory");
        }
    }
    __syncthreads();
}

struct Params { const float* in[24]; float* out; unsigned char* ws; int ph_lo, ph_hi; };

__device__ __forceinline__ float silu_f(float x) { return x * __builtin_amdgcn_rcpf(1.f + __expf(-x)); }
__device__ __forceinline__ float sigmoid_f(float x) { return __builtin_amdgcn_rcpf(1.f + __expf(-x)); }
__device__ __forceinline__ float tanh_f(float x) { return 1.f - 2.f * __builtin_amdgcn_rcpf(__expf(2.f * x) + 1.f); }
__device__ __forceinline__ float wave_sum(float v) {
#pragma unroll
    for (int o = 1; o < 64; o <<= 1) v += __shfl_xor(v, o);
    return v;
}
template <int CTRL> __device__ __forceinline__ float dpp_f(float x) { return __int_as_float(__builtin_amdgcn_update_dpp(0, __float_as_int(x), CTRL, 0xf, 0xf, false)); }
__device__ __forceinline__ float red8(float x) {
    x += dpp_f<0xB1>(x); x += dpp_f<0x4E>(x); x += dpp_f<0x141>(x); return x;
}
__device__ __forceinline__ float red16(float x) {
    x += dpp_f<0xB1>(x); x += dpp_f<0x4E>(x); x += dpp_f<0x141>(x); x += dpp_f<0x140>(x); return x;
}

__device__ __forceinline__ int sigma1(int np) {
    const int T = np >> 8, c = np & 255;
    if (T < 16) { const int bj = c >> 7, wc = (c >> 5) & 3, fq = (c >> 3) & 3, n = (c >> 2) & 1, e = c & 3; return 1024 * (2 * bj + n) + 64 * T + 16 * wc + 4 * fq + e; }
    if (T < 24) { return ((c >> 7) ? 6144 : 4096) + 128 * (T - 16) + (c & 127); }
    return 5120 + 256 * (T - 24) + c;
}

template <int MODE>
__device__ __forceinline__ void tr_item(const float* W, int K, int N, h16* WT, LAS float* scr, int item, int nblk, int lane) {
    const int kb = item / nblk, nb = item % nblk, k0 = 64 * kb, n0 = 32 * nb;
    const int np = n0 + (lane & 31);
    const int sc = (MODE == 1) ? sigma1(np) : np;
    const bool valid = (MODE != 2) || (np < 5248);
    float wv_[32];
#pragma unroll
    for (int i = 0; i < 32; ++i) { const int kk = 2 * i + (lane >> 5); wv_[i] = valid ? W[(size_t)(k0 + kk) * N + sc] : 0.f; }
#pragma unroll
    for (int i = 0; i < 32; ++i) { const int kk = 2 * i + (lane >> 5); scr[kk * 33 + (lane & 31)] = wv_[i]; }
    asm volatile("s_waitcnt lgkmcnt(0)" ::: "memory");
    const int c = lane & 7;
#pragma unroll
    for (int j = 0; j < 4; ++j) { const int n = (lane >> 3) + 8 * j; const LAS float* s = scr + (8 * c) * 33 + n;
        h16x8 o;
#pragma unroll
        for (int e = 0; e < 8; ++e) o[e] = (h16)s[e * 33];
        *(h16x8*)(WT + (size_t)(n0 + n) * K + k0 + 8 * c) = o; }
    asm volatile("s_waitcnt lgkmcnt(0)" ::: "memory");
}

__device__ __forceinline__ void rms_rows2_f16(const float* x0, const float* x1, const h16* ad0, const h16* ad1, const float* g, h16* or0, h16* or1, int lane) {
    f32x4 v[2][4]; h16x4 a[2][4]; float ss[2] = {0.f, 0.f};
#pragma unroll
    for (int j = 0; j < 4; ++j) { v[0][j] = *(const f32x4*)(x0 + 4 * lane + 256 * j); v[1][j] = *(const f32x4*)(x1 + 4 * lane + 256 * j);
        if (ad0) { a[0][j] = *(const h16x4*)(ad0 + 4 * lane + 256 * j); a[1][j] = *(const h16x4*)(ad1 + 4 * lane + 256 * j); } }
#pragma unroll
    for (int u = 0; u < 2; ++u)
#pragma unroll
        for (int j = 0; j < 4; ++j) {
            if (ad0) { v[u][j][0] += (float)a[u][j][0]; v[u][j][1] += (float)a[u][j][1]; v[u][j][2] += (float)a[u][j][2]; v[u][j][3] += (float)a[u][j][3]; }
            ss[u] += v[u][j][0] * v[u][j][0] + v[u][j][1] * v[u][j][1] + v[u][j][2] * v[u][j][2] + v[u][j][3] * v[u][j][3]; }
#pragma unroll
    for (int o = 1; o < 64; o <<= 1) { ss[0] += __shfl_xor(ss[0], o); ss[1] += __shfl_xor(ss[1], o); }
    const float rs0 = rsqrtf(ss[0] * (1.f / 1024.f) + 1e-6f), rs1 = rsqrtf(ss[1] * (1.f / 1024.f) + 1e-6f);
#pragma unroll
    for (int j = 0; j < 4; ++j) { const f32x4 gg = *(const f32x4*)(g + 4 * lane + 256 * j); h16x4 o0, o1;
#pragma unroll
        for (int e = 0; e < 4; ++e) { o0[e] = (h16)(v[0][j][e] * rs0 * gg[e]); o1[e] = (h16)(v[1][j][e] * rs1 * gg[e]); }
        *(h16x4*)(or0 + 4 * lane + 256 * j) = o0; *(h16x4*)(or1 + 4 * lane + 256 * j) = o1; }
}

__device__ __forceinline__ void phase0(const Params& p, LAS unsigned char* lds) {
    const int tid = threadIdx.x, lane = tid & 63, wave = tid >> 6;
    const int gw = blockIdx.x * 8 + wave, NGW = gridDim.x * 8;
    LAS float* scr = (LAS float*)(lds + wave * 8448);
    h16* W1T = (h16*)(p.ws + WS_W1T); h16* W2T = (h16*)(p.ws + WS_W2T); h16* W3T = (h16*)(p.ws + WS_W3T); h16* W4T = (h16*)(p.ws + WS_W4T);
    constexpr int I1 = 16 * 224, I2 = 32 * 32, I3 = 16 * 168, I4 = 24 * 32;
    for (int it = gw; it < I1 + I2 + I3 + I4; it += NGW) {
        int r = it;
        if (r < I1) { tr_item<1>(p.in[2], 1024, 7168, W1T, scr, r, 224, lane); continue; } r -= I1;
        if (r < I2) { tr_item<0>(p.in[8], 2048, 1024, W2T, scr, r, 32, lane); continue; } r -= I2;
        if (r < I3) { tr_item<2>(p.in[10], 1024, 5248, W3T, scr, r, 168, lane); continue; } r -= I3;
        tr_item<0>(p.in[22], 1536, 1024, W4T, scr, r, 32, lane);
    }
    h16* H0 = (h16*)p.out;
    for (int r = gw; r < NTOK; r += 2 * NGW) { const int r1 = (r + NGW < NTOK) ? r + NGW : r;
        rms_rows2_f16(p.in[0] + (size_t)r * DM, p.in[0] + (size_t)r1 * DM, nullptr, nullptr, p.in[1], H0 + (size_t)r * DM, H0 + (size_t)r1 * DM, lane); }
    const int gt = blockIdx.x * 512 + tid, NGT = gridDim.x * 512;
    h16* WSH = (h16*)(p.ws + WS_WSH);
    for (int i = gt; i < 8 * 128 * 128; i += NGT) WSH[i] = (h16)p.in[6][i];
    { float* STZ = (float*)(p.ws + WS_STATS); for (int i = gt; i < 2 * NTOK; i += NGT) STZ[i] = 0.f; }
    h16* CWT = (h16*)(p.ws + WS_CWT);
    const float* wf = p.in[21];
    for (int i = gt; i < 4 * 128 * 256; i += NGT) {
        const int k = i & 255, e = (i >> 8) & 127, g = i >> 15, d = k & 127; const bool sn = k >= 128;
        float s = 0.f;
        for (int dp = 0; dp < 128; ++dp) { const float fr = (float)((d * dp) & 127) * (1.f / 128.f);
            const float tw = sn ? __builtin_amdgcn_sinf(fr) : __builtin_amdgcn_cosf(fr);
            s += tw * wf[(g * 128 + dp) * 128 + e]; }
        CWT[i] = (h16)(s * 0.08838834764831845f);
    }
}

struct Epi1 {
    static constexpr bool PERM = true;
    h16 *XC, *G, *U, *V; float* st;
    __device__ __forceinline__ void operator()(const f32x4 (&acc)[2][2][4][2], const pg8::Unit& u, int wr, int wc, int fr, int fq) const {
        const int T = u.pn; const int row0 = u.pm * 256 + wr * 64 + fr;
        if (T < 16) {
            const int ch = 64 * T + 16 * wc + 4 * fq;
#pragma unroll
            for (int ai = 0; ai < 2; ++ai)
#pragma unroll
                for (int m = 0; m < 4; ++m) { const size_t r = (size_t)(row0 + ai * 128 + m * 16);
                    const f32x4 xa = acc[ai][0][m][0], ba = acc[ai][0][m][1], ca = acc[ai][1][m][0], za = acc[ai][1][m][1];
                    h16x4 xc, gg;
#pragma unroll
                    for (int e = 0; e < 4; ++e) { xc[e] = (h16)(ca[e] * xa[e]); gg[e] = (h16)(ba[e] * silu_f(za[e])); }
                    *(h16x4*)(XC + r * 1024 + ch) = xc; *(h16x4*)(G + r * 1024 + ch) = gg; }
        } else if (T < 24) {
            const int ch = 128 * (T - 16) + 32 * wc + 8 * fq;
#pragma unroll
            for (int ai = 0; ai < 2; ++ai)
#pragma unroll
                for (int m = 0; m < 4; ++m) { const size_t r = (size_t)(row0 + ai * 128 + m * 16); h16x8 o;
#pragma unroll
                    for (int n = 0; n < 2; ++n) { const f32x4 ub = acc[ai][0][m][n], zb = acc[ai][1][m][n];
#pragma unroll
                        for (int e = 0; e < 4; ++e) o[4 * n + e] = (h16)(ub[e] * silu_f(zb[e])); }
                    *(h16x8*)(U + r * 1024 + ch) = o; }
        } else {
#pragma unroll
            for (int ai = 0; ai < 2; ++ai)
#pragma unroll
                for (int m = 0; m < 4; ++m) { const size_t r = (size_t)(row0 + ai * 128 + m * 16); float s1 = 0.f, s2 = 0.f;
#pragma unroll
                    for (int bj = 0; bj < 2; ++bj) { const int ch = 256 * (T - 24) + 128 * bj + 32 * wc + 8 * fq; h16x8 o;
#pragma unroll
                        for (int n = 0; n < 2; ++n) { const f32x4 v = acc[ai][bj][m][n];
#pragma unroll
                            for (int e = 0; e < 4; ++e) { o[4 * n + e] = (h16)v[e]; const float f = (float)o[4 * n + e]; s1 += f; s2 += f * f; } }
                        *(h16x8*)(V + r * 1024 + ch) = o; }
                    s1 += __shfl_xor(s1, 16); s2 += __shfl_xor(s2, 16); s1 += __shfl_xor(s1, 32); s2 += __shfl_xor(s2, 32);
                    if (fq == 0) { atomicAdd(st + 2 * r, s1); atomicAdd(st + 2 * r + 1, s2); } }
        }
    }
};
struct Epi2 {
    static constexpr bool PERM = true;
    h16* O1;
    __device__ __forceinline__ void operator()(const f32x4 (&acc)[2][2][4][2], const pg8::Unit& u, int wr, int wc, int fr, int fq) const {
        const int row0 = u.pm * 256 + wr * 64 + fr, col0 = u.pn * 256 + wc * 32 + 8 * fq;
#pragma unroll
        for (int ai = 0; ai < 2; ++ai)
#pragma unroll
            for (int m = 0; m < 4; ++m) { const size_t r = (size_t)(row0 + ai * 128 + m * 16);
#pragma unroll
                for (int bj = 0; bj < 2; ++bj) { const f32x4 v0 = acc[ai][bj][m][0], v1 = acc[ai][bj][m][1]; h16x8 o;
#pragma unroll
                    for (int e = 0; e < 4; ++e) { o[e] = (h16)v0[e]; o[4 + e] = (h16)v1[e]; }
                    *(h16x8*)(O1 + r * 1024 + col0 + bj * 128) = o; } }
    }
};
struct Epi3 {
    static constexpr bool PERM = true;
    h16 *PC, *ZCD, *FD;
    __device__ __forceinline__ void operator()(const f32x4 (&acc)[2][2][4][2], const pg8::Unit& u, int wr, int wc, int fr, int fq) const {
        const int row0 = u.pm * 256 + wr * 64 + fr, col0 = u.pn * 256 + wc * 32 + 8 * fq;
#pragma unroll
        for (int bj = 0; bj < 2; ++bj) { const int c = col0 + bj * 128;
            h16* base; size_t ld;
            if (c < 3200) { base = PC + c; ld = 3200; }
            else if (c < 4224) { base = ZCD + (c - 3200); ld = 1536; }
            else if (c < 4736) {
                const int cg = (c - 4224) >> 2;
#pragma unroll
                for (int ai = 0; ai < 2; ++ai)
#pragma unroll
                    for (int m = 0; m < 4; ++m) { const size_t r = (size_t)(row0 + ai * 128 + m * 16); const f32x4 v0 = acc[ai][bj][m][0], v1 = acc[ai][bj][m][1]; h16x4 o0, o1;
#pragma unroll
                        for (int e = 0; e < 4; ++e) { o0[e] = (h16)v0[e]; o1[e] = (h16)v1[e]; }
                        *(h16x4*)(FD + ((size_t)cg * NTOK + r) * 4) = o0; *(h16x4*)(FD + ((size_t)(cg + 1) * NTOK + r) * 4) = o1; }
                continue; }
            else if (c < 5248) { base = ZCD + 1024 + (c - 4736); ld = 1536; }
            else continue;
#pragma unroll
            for (int ai = 0; ai < 2; ++ai)
#pragma unroll
                for (int m = 0; m < 4; ++m) { const size_t r = (size_t)(row0 + ai * 128 + m * 16); const f32x4 v0 = acc[ai][bj][m][0], v1 = acc[ai][bj][m][1]; h16x8 o;
#pragma unroll
                    for (int e = 0; e < 4; ++e) { o[e] = (h16)v0[e]; o[4 + e] = (h16)v1[e]; }
                    *(h16x8*)(base + r * ld) = o; } }
    }
};
struct Epi4 {
    static constexpr bool PERM = true;
    h16* O2;
    __device__ __forceinline__ void operator()(const f32x4 (&acc)[2][2][4][2], const pg8::Unit& u, int wr, int wc, int fr, int fq) const {
        const int row0 = u.pm * 256 + wr * 64 + fr, col0 = u.pn * 256 + wc * 32 + 8 * fq;
#pragma unroll
        for (int ai = 0; ai < 2; ++ai)
#pragma unroll
            for (int m = 0; m < 4; ++m) { const size_t r = (size_t)(row0 + ai * 128 + m * 16);
#pragma unroll
                for (int bj = 0; bj < 2; ++bj) { const f32x4 v0 = acc[ai][bj][m][0], v1 = acc[ai][bj][m][1]; h16x8 o;
#pragma unroll
                    for (int e = 0; e < 4; ++e) { o[e] = (h16)v0[e]; o[4 + e] = (h16)v1[e]; }
                    *(h16x8*)(O2 + r * 1024 + col0 + bj * 128) = o; } }
    }
};

__device__ __forceinline__ void phase_stats(const Params& p) {
    const int tid = threadIdx.x, lane = tid & 63, wave = tid >> 6;
    const int gw = blockIdx.x * 8 + wave, NGW = gridDim.x * 8;
    const h16* V = (const h16*)(p.ws + WS_V); float* ST = (float*)(p.ws + WS_STATS);
    for (int r = gw; r < NTOK; r += NGW) {
        const h16x8 a = *(const h16x8*)(V + (size_t)r * 1024 + 8 * lane), b = *(const h16x8*)(V + (size_t)r * 1024 + 512 + 8 * lane);
        float s = 0.f;
#pragma unroll
        for (int e = 0; e < 8; ++e) s += (float)a[e] + (float)b[e];
        const float mu = wave_sum(s) * (1.f / 1024.f); float q = 0.f;
#pragma unroll
        for (int e = 0; e < 8; ++e) { const float x = (float)a[e] - mu, y = (float)b[e] - mu; q += x * x + y * y; }
        const float rs = rsqrtf(wave_sum(q) * (1.f / 1024.f) + 1e-5f);
        if (lane == 0) { ST[2 * r] = mu; ST[2 * r + 1] = rs; }
    }
}

__device__ __forceinline__ void phase_mix0(const Params& p, LAS unsigned char* lds) {
    const int tid = threadIdx.x, lane = tid & 63, wave = tid >> 6;
    const h16* XC = (const h16*)(p.ws + WS_XC); const h16* G = (const h16*)(p.ws + WS_G); const h16* U = (const h16*)(p.ws + WS_U); const h16* V = (const h16*)(p.ws + WS_V);
    h16* YC = (h16*)(p.ws + WS_YCAT);
    const float* cw = p.in[3];
    const int gt = blockIdx.x * 512 + tid, NGT = gridDim.x * 512;
    for (int idx0 = gt; idx0 < NTOK * 128; idx0 += 2 * NGT) {
        h16x8 x0[2], xm[2], xp[2], gg[2]; int tt[2], cc[2];
        const h16x8 zero = {0, 0, 0, 0, 0, 0, 0, 0};
#pragma unroll
        for (int u = 0; u < 2; ++u) { const int idx = (idx0 + u * NGT < NTOK * 128) ? idx0 + u * NGT : idx0; const int t = idx >> 7, c8 = (idx & 127) * 8, tp = t & (SEQ - 1); tt[u] = t; cc[u] = c8;
            x0[u] = *(const h16x8*)(XC + (size_t)t * 1024 + c8);
            xm[u] = tp > 0 ? *(const h16x8*)(XC + (size_t)(t - 1) * 1024 + c8) : zero;
            xp[u] = tp < SEQ - 1 ? *(const h16x8*)(XC + (size_t)(t + 1) * 1024 + c8) : zero;
            gg[u] = *(const h16x8*)(G + (size_t)t * 1024 + c8); }
#pragma unroll
        for (int u = 0; u < 2; ++u) { const int c8 = cc[u]; h16x8 o;
#pragma unroll
            for (int e = 0; e < 8; ++e) { const float y = cw[c8 + e] * (float)xm[u][e] + cw[1024 + c8 + e] * (float)x0[u][e] + cw[2048 + c8 + e] * (float)xp[u][e]; o[e] = (h16)(y * (float)gg[u][e]); }
            *(h16x8*)(YC + (size_t)tt[u] * 2048 + c8) = o; }
    }
    const float* ST = (const float*)(p.ws + WS_STATS); const h16* WSH = (const h16*)(p.ws + WS_WSH);
    const float* lng = p.in[4]; const float* lnb = p.in[5]; const float* bs = p.in[7];
    LAS h16* vnT = (LAS h16*)lds;
    for (int it = blockIdx.x; it < 1024; it += gridDim.x) {
        const int g = it & 7, bn = it >> 3, t0 = bn * 128;
        __syncthreads();
#pragma unroll
        for (int q = 0; q < 4; ++q) { const int pc = tid + 512 * q, j = pc >> 4, d8 = (pc & 15) * 8;
            const h16x8 v = *(const h16x8*)(V + (size_t)(t0 + j) * 1024 + g * 128 + d8);
            const float mu = ST[2 * (t0 + j)] * (1.f / 1024.f), rs = rsqrtf(fmaxf(ST[2 * (t0 + j) + 1] * (1.f / 1024.f) - mu * mu, 0.f) + 1e-5f);
#pragma unroll
            for (int e = 0; e < 8; ++e) vnT[(d8 + e) * 136 + ((((j >> 3) ^ (pc & 15)) << 3) | (j & 7))] = (h16)(((float)v[e] - mu) * rs * lng[g * 128 + d8 + e] + lnb[g * 128 + d8 + e]); }
        __syncthreads();
        const int itile = wave >> 1, dt0 = (wave & 1) * 2;
        f32x16 acc0, acc1;
#pragma unroll
        for (int e = 0; e < 16; ++e) { acc0[e] = 0.f; acc1[e] = 0.f; }
        const h16* Arow = WSH + ((size_t)g * 128 + itile * 32 + (lane & 31)) * 128 + 8 * (lane >> 5);
        const int d0_ = dt0 * 32 + (lane & 31), d1_ = d0_ + 32;
        const LAS h16* B0p = vnT + d0_ * 136; const LAS h16* B1p = vnT + d1_ * 136;
#pragma unroll
        for (int ks = 0; ks < 8; ++ks) {
            const h16x8 a = *(const h16x8*)(Arow + 16 * ks);
            const int jg = 2 * ks + (lane >> 5);
            const h16x8 b0 = *(const LAS h16x8*)(B0p + ((jg ^ ((d0_ >> 3) & 15)) << 3)), b1 = *(const LAS h16x8*)(B1p + ((jg ^ ((d1_ >> 3) & 15)) << 3));
            acc0 = __builtin_amdgcn_mfma_f32_32x32x16_f16(a, b0, acc0, 0, 0, 0);
            acc1 = __builtin_amdgcn_mfma_f32_32x32x16_f16(a, b1, acc1, 0, 0, 0);
        }
#pragma unroll
        for (int r = 0; r < 16; ++r) { const int i = itile * 32 + (r & 3) + 8 * (r >> 2) + 4 * (lane >> 5); const size_t t = (size_t)(t0 + i);
            const float bias = bs[g * 128 + i];
            const int d0 = g * 128 + dt0 * 32 + (lane & 31);
            YC[t * 2048 + 1024 + d0] = (h16)((acc0[r] + bias) * (float)U[t * 1024 + d0]);
            YC[t * 2048 + 1024 + d0 + 32] = (h16)((acc1[r] + bias) * (float)U[t * 1024 + d0 + 32]); }
    }
}

__device__ __forceinline__ void phase_norm1(const Params& p) {
    const int tid = threadIdx.x, lane = tid & 63, wave = tid >> 6;
    const int gw = blockIdx.x * 8 + wave, NGW = gridDim.x * 8;
    const h16* O1 = (const h16*)(p.ws + WS_O1); h16* H1 = (h16*)p.out;
    for (int r = gw; r < NTOK; r += 2 * NGW) { const int r1 = (r + NGW < NTOK) ? r + NGW : r;
        rms_rows2_f16(p.in[0] + (size_t)r * DM, p.in[0] + (size_t)r1 * DM, O1 + (size_t)r * DM, O1 + (size_t)r1 * DM, p.in[9], H1 + (size_t)r * DM, H1 + (size_t)r1 * DM, lane); }
}

__device__ __forceinline__ void phase_fft(const Params& p, LAS unsigned char* lds) {
    const int tid = threadIdx.x;
    const h16* FD = (const h16*)(p.ws + WS_FD);
    h16* SPr = (h16*)(p.ws + WS_SPR); h16* SPi = (h16*)(p.ws + WS_SPI);
    LAS f32x2* X0 = (LAS f32x2*)lds; LAS f32x2* X1 = X0 + 8192;
    for (int it = blockIdx.x; it < 256; it += gridDim.x) {
        const int b = it >> 7, c0 = 4 * (it & 127);
        __syncthreads();
        for (int t = tid; t < SEQ; t += 512) { const h16x4 v = *(const h16x4*)(FD + ((size_t)(it & 127) * NTOK + b * SEQ + t) * 4);
            X0[t] = (f32x2){(float)v[0], (float)v[1]}; X1[t] = (f32x2){(float)v[2], (float)v[3]}; }
        __syncthreads();
        for (int s = 0; s < 13; ++s) {
            const int half = 4096 >> s;
#pragma unroll 2
            for (int j = tid; j < 4096; j += 512) {
                const int pos = j & (half - 1), grp = j >> (12 - s), i0 = (grp << (13 - s)) + pos, i1 = i0 + half;
                const float fr = (float)(pos << s) * (1.f / 8192.f);
                const float c = __builtin_amdgcn_cosf(fr), sn = __builtin_amdgcn_sinf(fr);
                { const f32x2 a = X0[i0], bb = X0[i1]; const f32x2 d = a - bb; X0[i0] = a + bb; X0[i1] = (f32x2){d[0] * c + d[1] * sn, d[1] * c - d[0] * sn}; }
                { const f32x2 a = X1[i0], bb = X1[i1]; const f32x2 d = a - bb; X1[i0] = a + bb; X1[i1] = (f32x2){d[0] * c + d[1] * sn, d[1] * c - d[0] * sn}; }
            }
            __syncthreads();
        }
        const float sc = 0.5f * 0.011048543456039806f;
        for (int k = tid; k < SEQ; k += 512) {
            const int ra = __brev((unsigned)k) >> 19, rb = __brev((unsigned)((SEQ - k) & (SEQ - 1))) >> 19;
            const f32x2 za = X0[ra], zb = X0[rb], ya = X1[ra], yb = X1[rb];
            h16x4 orr, oi;
            orr[0] = (h16)((za[0] + zb[0]) * sc); oi[0] = (h16)((za[1] - zb[1]) * sc);
            orr[1] = (h16)((za[1] + zb[1]) * sc); oi[1] = (h16)((zb[0] - za[0]) * sc);
            orr[2] = (h16)((ya[0] + yb[0]) * sc); oi[2] = (h16)((ya[1] - yb[1]) * sc);
            orr[3] = (h16)((ya[1] + yb[1]) * sc); oi[3] = (h16)((yb[0] - ya[0]) * sc);
            *(h16x4*)(SPr + ((size_t)(it & 127) * NTOK + b * SEQ + k) * 4) = orr; *(h16x4*)(SPi + ((size_t)(it & 127) * NTOK + b * SEQ + k) * 4) = oi;
        }
    }
}

__device__ __forceinline__ void phase_fnet_out(const Params& p, LAS unsigned char* lds) {
    const int tid = threadIdx.x, lane = tid & 63, wave = tid >> 6;
    const h16* SPr = (const h16*)(p.ws + WS_SPR); const h16* SPi = (const h16*)(p.ws + WS_SPI);
    const h16* CWT = (const h16*)(p.ws + WS_CWT); h16* ZCD = (h16*)(p.ws + WS_ZCD);
    LAS h16* Lr = (LAS h16*)lds; LAS h16* Li = Lr + 32 * 520;
    const int g = wave >> 1, eh = wave & 1;
    for (int it = blockIdx.x; it < 512; it += gridDim.x) {
        const int t0 = it * 32;
        __syncthreads();
#pragma unroll
        for (int q = 0; q < 8; ++q) { const int idx = tid + 512 * q, arr = idx >> 11, rem = idx & 2047, cg = rem >> 4, tp = rem & 15;
            const h16x8 v = *(const h16x8*)((arr ? SPi : SPr) + ((size_t)cg * NTOK + t0 + 2 * tp) * 4);
            LAS h16* d_ = (arr ? Li : Lr) + (2 * tp) * 520 + 4 * cg;
            *(LAS h16x4*)d_ = (h16x4){v[0], v[1], v[2], v[3]}; *(LAS h16x4*)(d_ + 520) = (h16x4){v[4], v[5], v[6], v[7]}; }
        __syncthreads();
        f32x16 acc0, acc1;
#pragma unroll
        for (int e = 0; e < 16; ++e) { acc0[e] = 0.f; acc1[e] = 0.f; }
        const LAS h16* Ar = Lr + (lane & 31) * 520 + g * 128 + 8 * (lane >> 5); const LAS h16* Ai = Li + (lane & 31) * 520 + g * 128 + 8 * (lane >> 5);
        const h16* B0 = CWT + ((size_t)(g * 128 + (2 * eh) * 32 + (lane & 31))) * 256 + 8 * (lane >> 5); const h16* B1 = B0 + 32 * 256;
#pragma unroll
        for (int ks = 0; ks < 8; ++ks) { const h16x8 a = *(const LAS h16x8*)(Ar + 16 * ks);
            acc0 = __builtin_amdgcn_mfma_f32_32x32x16_f16(a, *(const h16x8*)(B0 + 16 * ks), acc0, 0, 0, 0);
            acc1 = __builtin_amdgcn_mfma_f32_32x32x16_f16(a, *(const h16x8*)(B1 + 16 * ks), acc1, 0, 0, 0); }
#pragma unroll
        for (int ks = 0; ks < 8; ++ks) { const h16x8 a = *(const LAS h16x8*)(Ai + 16 * ks);
            acc0 = __builtin_amdgcn_mfma_f32_32x32x16_f16(a, *(const h16x8*)(B0 + 128 + 16 * ks), acc0, 0, 0, 0);
            acc1 = __builtin_amdgcn_mfma_f32_32x32x16_f16(a, *(const h16x8*)(B1 + 128 + 16 * ks), acc1, 0, 0, 0); }
#pragma unroll
        for (int r = 0; r < 16; ++r) { const size_t t = (size_t)(t0 + (r & 3) + 8 * (r >> 2) + 4 * (lane >> 5));
            h16* zp = ZCD + t * 1536 + 1024 + g * 128 + (2 * eh) * 32 + (lane & 31);
            zp[0] = (h16)(acc0[r] * silu_f((float)zp[0])); zp[32] = (h16)(acc1[r] * silu_f((float)zp[32])); }
    }
}

#define LDS_BAR() do { asm volatile("s_waitcnt lgkmcnt(0)" ::: "memory"); __builtin_amdgcn_s_barrier(); asm volatile("" ::: "memory"); } while (0)
#define LDS_WAIT() asm volatile("s_waitcnt lgkmcnt(0)" ::: "memory")
__device__ __forceinline__ void phase_scan(const Params& p, LAS unsigned char* lds) {
    const int tid = threadIdx.x, lane = tid & 63, wave = tid >> 6;
    const h16* PC = (const h16*)(p.ws + WS_PC);
    LAS h16* w2T = (LAS h16*)lds;
    LAS h16* a2T = w2T + 64 * 72;
    LAS unsigned char* priv = lds + 18432 + (wave & 3) * 4096;
    constexpr int SET_F = 5 * 2048 + 512;
    LAS float* OPS = (LAS float*)(lds + 18432 + 16384);
    LAS float* sYb = OPS + 2 * SET_F;
    for (int item = blockIdx.x; item < 256; item += gridDim.x) {
        const int xcd = item & 7, slot = item >> 3, gidx = xcd * 8 + (slot >> 2), q = slot & 3;
        const int dir = gidx >> 5, b = (gidx >> 4) & 1, h = gidx & 15;
        h16* Yd = (h16*)((unsigned char*)p.out + (size_t)dir * 32 * MiB);
        float* SB = (float*)(p.ws + WS_SBON) + (size_t)dir * NTOK * 16;
        const float* mu = p.in[11] + dir * 3200; const float* w0 = p.in[12] + dir * 1024 + 64 * h; const float* w2 = p.in[13] + (size_t)dir * 65536 + 64 * h;
        const float* a0 = p.in[14] + dir * 1024 + 64 * h; const float* a2 = p.in[15] + (size_t)dir * 65536 + 64 * h;
        const float* kkw = p.in[16] + 64 * h; const float* kaw = p.in[17] + 64 * h; const float* rkw = p.in[18] + 64 * h;
        __syncthreads();
        for (int i = tid; i < 4096; i += 512) { const int l = i >> 6, c = i & 63; w2T[c * 72 + l] = (h16)w2[l * 1024 + c]; a2T[c * 72 + l] = (h16)a2[l * 1024 + c]; }
        const int pw_ = wave & 3, s_sub = lane >> 3, c8 = (lane & 7) * 8, s_l = 8 * pw_ + s_sub;
        h16x8 mu_r8, mu_k8, mu_v8, mu_w8, mu_a8; f32x2 w0r[4], a0r[4], kkr[4], kar[4], omk[4], rkr[4];
#pragma unroll
        for (int e = 0; e < 8; ++e) { mu_r8[e] = (h16)mu[64 * h + c8 + e]; mu_k8[e] = (h16)mu[1024 + 64 * h + c8 + e]; mu_v8[e] = (h16)mu[2048 + 64 * h + c8 + e]; mu_w8[e] = (h16)mu[3072 + c8 + e]; mu_a8[e] = (h16)mu[3136 + c8 + e];
            w0r[e >> 1][e & 1] = w0[c8 + e]; a0r[e >> 1][e & 1] = a0[c8 + e]; kkr[e >> 1][e & 1] = kkw[c8 + e]; kar[e >> 1][e & 1] = kaw[c8 + e]; omk[e >> 1][e & 1] = 1.f - kaw[c8 + e]; rkr[e >> 1][e & 1] = rkw[c8 + e]; }
        f32x2 S01 = {0.f, 0.f}, S23 = {0.f, 0.f};
        const int srow = 4 * (wave & 3) + (lane >> 4), j0 = 4 * (lane & 15);
        const h16x8 z8 = {0, 0, 0, 0, 0, 0, 0, 0};
        h16x8 pr, pk, pv, pw, pa, qr_, qk_, qv_, qw_, qa_;
        const h16 *pcA, *pcB, *ppA, *ppB;
        { const int t0_ = dir ? (SEQ - 1 - s_l) : s_l; pcA = PC + (size_t)(b * SEQ + t0_) * 3200 + c8 + 64 * h; pcB = pcA + 2048 - 64 * h;
          const long po_ = (s_l > 0) ? (dir ? 3200 : -3200) : 0; ppA = pcA + po_; ppB = pcB + po_; }
        const long cstride_ = dir ? -32 * 3200 : 32 * 3200;
#define SCAN_LOAD_RAW() do { \
            pr = *(const h16x8*)(pcA); pk = *(const h16x8*)(pcA + 1024); pv = *(const h16x8*)(pcB + 64 * h); pw = *(const h16x8*)(pcB + 1024); pa = *(const h16x8*)(pcB + 1088); \
            qr_ = *(const h16x8*)(ppA); qk_ = *(const h16x8*)(ppA + 1024); qv_ = *(const h16x8*)(ppB + 64 * h); qw_ = *(const h16x8*)(ppB + 1024); qa_ = *(const h16x8*)(ppB + 1088); \
            pcA += cstride_; pcB += cstride_; ppA = pcA + (dir ? 3200 : -3200); ppB = pcB + (dir ? 3200 : -3200); } while (0)
#define SCAN_LOAD(chn) SCAN_LOAD_RAW()
#define SCAN_YSTORE(chn) do { const int sg_ = (chn) * 32 + s_l; const int t_ = dir ? (SEQ - 1 - sg_) : sg_; \
            const f32x2 y2_ = *(const LAS f32x2*)(sYb + ((chn) & 1) * 512 + s_l * 16 + 2 * (lane & 7)); \
            typedef _Float16 h16x2_ __attribute__((ext_vector_type(2))); h16x2_ o_; o_[0] = (h16)y2_[0]; o_[1] = (h16)y2_[1]; \
            *(h16x2_*)(Yd + (size_t)(b * SEQ + t_) * 1024 + 64 * h + 16 * q + 2 * (lane & 7)) = o_; } while (0)
        if (wave >= 4) { SCAN_LOAD_RAW(); if (s_l == 0) { qr_ = z8; qk_ = z8; qv_ = z8; qw_ = z8; qa_ = z8; } }
        __syncthreads();
        for (int n = -1; n < SEQ / 32; ++n) {
            if (wave < 4) {
                if (n >= 0) {
                    __builtin_amdgcn_s_setprio(3);
                    const LAS float* sR = OPS + (n & 1) * SET_F + j0; const LAS float* sW = sR + 2048; const LAS float* sK = sW + 2048; const LAS float* sA = sK + 2048; const LAS float* sB = sA + 2048; const LAS float* sV = OPS + (n & 1) * SET_F + 10240;
                    LAS float* sY = sYb + (n & 1) * 512;
                    f32x4 a_ = *(const LAS f32x4*)(sA), w_ = *(const LAS f32x4*)(sW), b_ = *(const LAS f32x4*)(sB);
                    f32x4 k_ = *(const LAS f32x4*)(sK), r_ = *(const LAS f32x4*)(sR);
                    f32x4 vq[4];
#pragma unroll
                    for (int u = 0; u < 4; ++u) vq[u] = *(const LAS f32x4*)(sV + srow * 32 + 4 * u);
                    f32x4 rp = r_;
#pragma unroll
                    for (int hb = 0; hb < 2; ++hb) {
                        f32x4 vn[4];
#pragma unroll
                        for (int u = 0; u < 4; ++u) vn[u] = *(const LAS f32x4*)(sV + srow * 32 + ((16 * (hb + 1)) & 31) + 4 * u);
#pragma unroll
                        for (int u16 = 0; u16 < 16; ++u16) {
                            const int s = 16 * hb + u16;
                            const int sn = (s + 1) & 31;
                            const f32x4 a_n = *(const LAS f32x4*)(sA + sn * 64), w_n = *(const LAS f32x4*)(sW + sn * 64), b_n = *(const LAS f32x4*)(sB + sn * 64);
                            const f32x4 k_n = *(const LAS f32x4*)(sK + sn * 64), r_n = *(const LAS f32x4*)(sR + sn * 64);
                            const float v = vq[u16 >> 2][u16 & 3];
                            const f32x2 vv = {v, v};
                            f32x2 pp = S01 * (f32x2){a_[0], a_[1]}; pp = S23 * (f32x2){a_[2], a_[3]} + pp;
                            f32x2 yy = S01 * (f32x2){rp[0], rp[1]}; yy = S23 * (f32x2){rp[2], rp[3]} + yy;
                            float sa = pp[0] + pp[1], y = yy[0] + yy[1];
                            sa += dpp_f<0xB1>(sa); y += dpp_f<0xB1>(y);
                            sa += dpp_f<0x4E>(sa); y += dpp_f<0x4E>(y);
                            sa += dpp_f<0x141>(sa); y += dpp_f<0x141>(y);
                            sa += dpp_f<0x140>(sa); y += dpp_f<0x140>(y);
                            sY[((s - 1) & 31) * 16 + srow] = y;
                            const f32x2 sv = {sa, sa};
                            S01 = S01 * (f32x2){w_[0], w_[1]} + vv * (f32x2){k_[0], k_[1]};
                            S23 = S23 * (f32x2){w_[2], w_[3]} + vv * (f32x2){k_[2], k_[3]};
                            S01 = sv * (f32x2){b_[0], b_[1]} + S01;
                            S23 = sv * (f32x2){b_[2], b_[3]} + S23;
                            rp = r_;
                            a_ = a_n; w_ = w_n; b_ = b_n; k_ = k_n; r_ = r_n;
                        }
#pragma unroll
                        for (int u = 0; u < 4; ++u) vq[u] = vn[u];
                    }
                    { f32x2 yy = S01 * (f32x2){rp[0], rp[1]}; yy = S23 * (f32x2){rp[2], rp[3]} + yy; sY[31 * 16 + srow] = red16(yy[0] + yy[1]); }
                    __builtin_amdgcn_s_setprio(0);
                }
            } else {
                if (n + 1 < SEQ / 32) {
                    const int cn = n + 1;
                    const int sg = cn * 32 + s_l; const int t = dir ? (SEQ - 1 - sg) : sg;
                    f32x2 qr[4], qk[4]; float qv[8];
                    LAS h16* TWp = (LAS h16*)priv; LAS h16* QAp = TWp + 8 * 72;
                    { unsigned m1u_ = 0xBC00BC00u; asm volatile("" : "+s"(m1u_));
                      typedef unsigned u32x4_ __attribute__((ext_vector_type(4))); const u32x4_ m1v_ = {m1u_, m1u_, m1u_, m1u_}; const h16x8 m1_ = __builtin_bit_cast(h16x8, m1v_);
                      const h16x8 r8 = pr + mu_r8 * (pr * m1_ + qr_), k8 = pk + mu_k8 * (pk * m1_ + qk_), v8 = pv + mu_v8 * (pv * m1_ + qv_);
                      const h16x8 w8 = pw + mu_w8 * (pw * m1_ + qw_), a8 = pa + mu_a8 * (pa * m1_ + qa_);
                      h16x8 tw8;
#pragma unroll
                      for (int pi = 0; pi < 4; ++pi) { qr[pi] = (f32x2){(float)r8[2 * pi], (float)r8[2 * pi + 1]}; qk[pi] = (f32x2){(float)k8[2 * pi], (float)k8[2 * pi + 1]};
                          qv[2 * pi] = (float)v8[2 * pi]; qv[2 * pi + 1] = (float)v8[2 * pi + 1];
                          const f32x2 tx = (f32x2){(float)w8[2 * pi], (float)w8[2 * pi + 1]} * 2.8853900817779268f;
                          const f32x2 dn = (f32x2){__builtin_amdgcn_exp2f(tx[0]), __builtin_amdgcn_exp2f(tx[1])} + 1.f;
                          const f32x2 th = (f32x2){__builtin_amdgcn_rcpf(dn[0]), __builtin_amdgcn_rcpf(dn[1])} * -2.f + 1.f;
                          tw8[2 * pi] = (h16)th[0]; tw8[2 * pi + 1] = (h16)th[1]; }
                      *(LAS h16x8*)(TWp + s_sub * 72 + c8) = tw8; *(LAS h16x8*)(QAp + s_sub * 72 + c8) = a8; }
                    if (cn + 1 < SEQ / 32) SCAN_LOAD(cn + 1);
                    LDS_WAIT();
                    f32x4 accw[4], acca[4];
#pragma unroll
                    for (int ct = 0; ct < 4; ++ct) { accw[ct] = (f32x4){0.f, 0.f, 0.f, 0.f}; acca[ct] = (f32x4){0.f, 0.f, 0.f, 0.f}; }
#pragma unroll
                    for (int ks = 0; ks < 2; ++ks) {
                        const h16x8 atw = *(const LAS h16x8*)(TWp + (lane & 7) * 72 + 32 * ks + 8 * (lane >> 4));
                        const h16x8 aqa = *(const LAS h16x8*)(QAp + (lane & 7) * 72 + 32 * ks + 8 * (lane >> 4));
#pragma unroll
                        for (int ct = 0; ct < 4; ++ct) {
                            const h16x8 bw = *(const LAS h16x8*)(w2T + (16 * ct + (lane & 15)) * 72 + 32 * ks + 8 * (lane >> 4));
                            const h16x8 ba = *(const LAS h16x8*)(a2T + (16 * ct + (lane & 15)) * 72 + 32 * ks + 8 * (lane >> 4));
                            accw[ct] = __builtin_amdgcn_mfma_f32_16x16x32_f16(atw, bw, accw[ct], 0, 0, 0);
                            acca[ct] = __builtin_amdgcn_mfma_f32_16x16x32_f16(aqa, ba, acca[ct], 0, 0, 0);
                        }
                    }
                    LDS_WAIT();
                    { LAS float* Zd = (LAS float*)priv + (lane >> 5) * 512 + (4 * ((lane >> 4) & 1)) * 64 + (lane & 15);
#pragma unroll
                      for (int ct = 0; ct < 4; ++ct)
#pragma unroll
                          for (int r = 0; r < 4; ++r) Zd[r * 64 + 16 * ct] = (lane < 32) ? accw[ct][r] : acca[ct][r]; }
                    LDS_WAIT();
                    const LAS float* Zw = (const LAS float*)priv + s_sub * 64 + c8; const LAS float* Za = Zw + 512;
                    const f32x4 zw0 = *(const LAS f32x4*)Zw, zw1 = *(const LAS f32x4*)(Zw + 4), za0 = *(const LAS f32x4*)Za, za1 = *(const LAS f32x4*)(Za + 4);
                    LDS_WAIT();
                    f32x2 kk[4], av_[4], kp[4], dec[4], kn2 = {0.f, 0.f}, sb2 = {0.f, 0.f};
#pragma unroll
                    for (int pi = 0; pi < 4; ++pi) {
                        const f32x2 zw = (pi < 2 ? (f32x2){zw0[2 * pi], zw0[2 * pi + 1]} : (f32x2){zw1[2 * pi - 4], zw1[2 * pi - 3]}) + w0r[pi];
                        const f32x2 za = (pi < 2 ? (f32x2){za0[2 * pi], za0[2 * pi + 1]} : (f32x2){za1[2 * pi - 4], za1[2 * pi - 3]}) + a0r[pi];
                        const f32x2 tw_ = zw * -1.4426950408889634f, ta_ = za * -1.4426950408889634f;
                        const f32x2 dw = (f32x2){__builtin_amdgcn_exp2f(tw_[0]), __builtin_amdgcn_exp2f(tw_[1])} + 1.f, da = (f32x2){__builtin_amdgcn_exp2f(ta_[0]), __builtin_amdgcn_exp2f(ta_[1])} + 1.f;
                        const f32x2 sw = (f32x2){__builtin_amdgcn_rcpf(dw[0]), __builtin_amdgcn_rcpf(dw[1])} * -0.8750387749225136f;
                        dec[pi] = (f32x2){__builtin_amdgcn_exp2f(sw[0]), __builtin_amdgcn_exp2f(sw[1])};
                        av_[pi] = (f32x2){__builtin_amdgcn_rcpf(da[0]), __builtin_amdgcn_rcpf(da[1])};
                        kk[pi] = qk[pi] * kkr[pi]; kn2 = kk[pi] * kk[pi] + kn2;
                        kp[pi] = qk[pi] * (av_[pi] * kar[pi] + omk[pi]);
                        sb2 = (qr[pi] * kp[pi]) * rkr[pi] + sb2; }
                    const float kn = red8(kn2[0] + kn2[1]), sbn = red8(sb2[0] + sb2[1]);
                    const float ninv = -rsqrtf(fmaxf(kn, 1e-12f));
                    LAS float* dR = OPS + (cn & 1) * SET_F + s_l * 64 + c8;
#pragma unroll
                    for (int hf = 0; hf < 2; ++hf) {
                        const f32x2 na0 = kk[2 * hf] * ninv, na1 = kk[2 * hf + 1] * ninv;
                        const f32x2 nb0 = na0 * av_[2 * hf], nb1 = na1 * av_[2 * hf + 1];
                        *(LAS f32x4*)(dR + 4 * hf) = (f32x4){qr[2 * hf][0], qr[2 * hf][1], qr[2 * hf + 1][0], qr[2 * hf + 1][1]};
                        *(LAS f32x4*)(dR + 2048 + 4 * hf) = (f32x4){dec[2 * hf][0], dec[2 * hf][1], dec[2 * hf + 1][0], dec[2 * hf + 1][1]};
                        *(LAS f32x4*)(dR + 4096 + 4 * hf) = (f32x4){kp[2 * hf][0], kp[2 * hf][1], kp[2 * hf + 1][0], kp[2 * hf + 1][1]};
                        *(LAS f32x4*)(dR + 6144 + 4 * hf) = (f32x4){na0[0], na0[1], na1[0], na1[1]};
                        *(LAS f32x4*)(dR + 8192 + 4 * hf) = (f32x4){-nb0[0], -nb0[1], -nb1[0], -nb1[1]}; }
                    if ((c8 >> 4) == q) { LAS float* dV = OPS + (cn & 1) * SET_F + 10240 + (c8 & 15) * 32 + s_l;
#pragma unroll
                        for (int e = 0; e < 8; ++e) dV[e * 32] = qv[e]; }
                    if (q == 0 && (lane & 7) == 0) SB[(size_t)(b * SEQ + t) * 16 + h] = sbn;
                }
                if (n >= 1) SCAN_YSTORE(n - 1);
            }
            LDS_BAR();
        }
        if (wave >= 4) SCAN_YSTORE(SEQ / 32 - 1);
#undef SCAN_LOAD
#undef SCAN_LOAD_RAW
#undef SCAN_YSTORE
    }
}

__device__ __forceinline__ void phase_post(const Params& p) {
    const int tid = threadIdx.x;
    const h16* Y0 = (const h16*)p.out; const h16* Y1 = (const h16*)((const unsigned char*)p.out + 32 * MiB);
    const h16* PC = (const h16*)(p.ws + WS_PC); h16* ZCD = (h16*)(p.ws + WS_ZCD);
    const float* SB0 = (const float*)(p.ws + WS_SBON); const float* SB1 = SB0 + (size_t)NTOK * 16;
    const float* mu0 = p.in[11] + 2048; const float* mu1 = p.in[11] + 3200 + 2048;
    const float* lg = p.in[19]; const float* lb = p.in[20];
    const int gt = blockIdx.x * 512 + tid, NGT = gridDim.x * 512;
    for (int idx = gt; idx < NTOK * 128; idx += NGT) {
        const int t = idx >> 7, c = (idx & 127) * 8, hh = c >> 6, tp = t & (SEQ - 1);
        const h16x8 y0 = *(const h16x8*)(Y0 + (size_t)t * 1024 + c), y1 = *(const h16x8*)(Y1 + (size_t)t * 1024 + c);
        const h16x8 z8 = {0, 0, 0, 0, 0, 0, 0, 0};
        const h16x8 v0 = *(const h16x8*)(PC + (size_t)t * 3200 + 2048 + c);
        const h16x8 vm = tp > 0 ? *(const h16x8*)(PC + (size_t)(t - 1) * 3200 + 2048 + c) : z8;
        const h16x8 vp = tp < SEQ - 1 ? *(const h16x8*)(PC + (size_t)(t + 1) * 3200 + 2048 + c) : z8;
        const h16x8 zc = *(const h16x8*)(ZCD + (size_t)t * 1536 + c);
        const float s0 = SB0[(size_t)t * 16 + hh], s1 = SB1[(size_t)t * 16 + hh];
        float y[8], s = 0.f;
#pragma unroll
        for (int e = 0; e < 8; ++e) { y[e] = (float)y0[e] + (float)y1[e]; s += y[e]; }
        const float mean = red8(s) * (1.f / 64.f); float q = 0.f;
#pragma unroll
        for (int e = 0; e < 8; ++e) { y[e] -= mean; q += y[e] * y[e]; }
        const float rs = rsqrtf(red8(q) * (1.f / 64.f) + 64e-5f);
        const f32x4 lg0 = *(const f32x4*)(lg + c), lg1 = *(const f32x4*)(lg + c + 4), lb0 = *(const f32x4*)(lb + c), lb1 = *(const f32x4*)(lb + c + 4);
        const f32x4 ma0 = *(const f32x4*)(mu0 + c), ma1 = *(const f32x4*)(mu0 + c + 4), mb0 = *(const f32x4*)(mu1 + c), mb1 = *(const f32x4*)(mu1 + c + 4);
        h16x8 o;
#pragma unroll
        for (int e = 0; e < 8; ++e) { const float vv = (float)v0[e];
            const float m0 = e < 4 ? ma0[e & 3] : ma1[e & 3], m1 = e < 4 ? mb0[e & 3] : mb1[e & 3], gg = e < 4 ? lg0[e & 3] : lg1[e & 3], bb = e < 4 ? lb0[e & 3] : lb1[e & 3];
            const float vd0 = vv + m0 * ((float)vm[e] - vv), vd1 = vv + m1 * ((float)vp[e] - vv);
            const float val = y[e] * rs * gg + bb + s0 * vd0 + s1 * vd1;
            o[e] = (h16)(val * silu_f((float)zc[e])); }
        *(h16x8*)(ZCD + (size_t)t * 1536 + c) = o;
    }
}

__device__ __forceinline__ void phase_final(const Params& p) {
    const int tid = threadIdx.x, lane = tid & 63, wave = tid >> 6;
    const int gw = blockIdx.x * 8 + wave, NGW = gridDim.x * 8;
    const float* g = p.in[23]; const h16* O1 = (const h16*)(p.ws + WS_O1); const h16* O2 = (const h16*)(p.ws + WS_O2);
    for (int r = gw; r < NTOK; r += 2 * NGW) {
        const int rr[2] = {r, (r + NGW < NTOK) ? r + NGW : r};
        f32x4 v[2][4]; h16x4 a[2][4], b[2][4]; float ss[2] = {0.f, 0.f};
#pragma unroll
        for (int u = 0; u < 2; ++u)
#pragma unroll
            for (int j = 0; j < 4; ++j) { const size_t o = (size_t)rr[u] * DM + 4 * lane + 256 * j; v[u][j] = *(const f32x4*)(p.in[0] + o); a[u][j] = *(const h16x4*)(O1 + o); b[u][j] = *(const h16x4*)(O2 + o); }
#pragma unroll
        for (int u = 0; u < 2; ++u)
#pragma unroll
            for (int j = 0; j < 4; ++j) {
#pragma unroll
                for (int e = 0; e < 4; ++e) v[u][j][e] += (float)a[u][j][e] + (float)b[u][j][e];
                ss[u] += v[u][j][0] * v[u][j][0] + v[u][j][1] * v[u][j][1] + v[u][j][2] * v[u][j][2] + v[u][j][3] * v[u][j][3]; }
#pragma unroll
        for (int o = 1; o < 64; o <<= 1) { ss[0] += __shfl_xor(ss[0], o); ss[1] += __shfl_xor(ss[1], o); }
        const float rs[2] = {rsqrtf(ss[0] * (1.f / 1024.f) + 1e-6f), rsqrtf(ss[1] * (1.f / 1024.f) + 1e-6f)};
#pragma unroll
        for (int j = 0; j < 4; ++j) { const f32x4 gg = *(const f32x4*)(g + 4 * lane + 256 * j);
#pragma unroll
            for (int u = 0; u < 2; ++u) { f32x4 o = v[u][j] * rs[u]; o = o * gg; *(f32x4*)(p.out + (size_t)rr[u] * DM + 4 * lane + 256 * j) = o; } }
    }
}

__global__ void __launch_bounds__(512, 2) mega(Params p) {
    extern __shared__ __attribute__((aligned(16))) unsigned char smem[];
    LAS unsigned char* lds = (LAS unsigned char*)smem;
    cg::grid_group grid = cg::this_grid();
    unsigned char* ws = p.ws;
    const int lo = p.ph_lo, hi = p.ph_hi;
#define IN(k) (lo <= (k) && (k) < hi)
    volatile LAS unsigned* bst = (volatile LAS unsigned*)(lds + LDS_MAIN);
    if (threadIdx.x < 4) bst[threadIdx.x] = 0u;
    __syncthreads();
    const XcdBarrier bar = xcd_barrier_post((unsigned*)(ws + WS_BAR), bst);
    if (hi > 1000) grid.sync();
#define SEAM(k) do { if (IN(k) && IN((k) + 1)) { xcd_barrier(bar); if ((REPMASK >> 13) & 1) xcd_barrier(bar); } } while (0)
    if (IN(0)) for (int rep_ = 0; rep_ <= ((REPMASK >> 0) & 1); ++rep_) { phase0(p, lds); } SEAM(0);
    if (IN(1)) for (int rep_ = 0; rep_ <= ((REPMASK >> 1) & 1); ++rep_) { pg8::Gemm g{(const h16*)p.out, (const h16*)(ws + WS_W1T), NTOK, 7168, 1024}; pg8::StaticOrder S; S.init(NTOK, 7168, gridDim.x, blockIdx.x);
                 Epi1 E{(h16*)(ws + WS_XC), (h16*)(ws + WS_G), (h16*)(ws + WS_U), (h16*)(ws + WS_V), (float*)(ws + WS_STATS)}; pg8::gemm_phase<Epi1>(lds, g, S, E); } SEAM(1);
    if (IN(3)) for (int rep_ = 0; rep_ <= ((REPMASK >> 3) & 1); ++rep_) { phase_mix0(p, lds); } SEAM(3);
    if (IN(4)) for (int rep_ = 0; rep_ <= ((REPMASK >> 4) & 1); ++rep_) { pg8::Gemm g{(const h16*)(ws + WS_YCAT), (const h16*)(ws + WS_W2T), NTOK, 1024, 2048}; pg8::StaticOrder S; S.init(NTOK, 1024, gridDim.x, blockIdx.x);
                 Epi2 E{(h16*)(ws + WS_O1)}; pg8::gemm_phase<Epi2>(lds, g, S, E); } SEAM(4);
    if (IN(5)) for (int rep_ = 0; rep_ <= ((REPMASK >> 5) & 1); ++rep_) { phase_norm1(p); } SEAM(5);
    if (IN(6)) for (int rep_ = 0; rep_ <= ((REPMASK >> 6) & 1); ++rep_) { pg8::Gemm g{(const h16*)p.out, (const h16*)(ws + WS_W3T), NTOK, 5376, 1024}; pg8::StaticOrder S; S.init(NTOK, 5376, gridDim.x, blockIdx.x);
                 Epi3 E{(h16*)(ws + WS_PC), (h16*)(ws + WS_ZCD), (h16*)(ws + WS_FD)}; pg8::gemm_phase<Epi3>(lds, g, S, E); } SEAM(6);
    if (IN(7)) for (int rep_ = 0; rep_ <= ((REPMASK >> 7) & 1); ++rep_) { phase_fft(p, lds); }
    if (IN(8)) for (int rep_ = 0; rep_ <= ((REPMASK >> 8) & 1); ++rep_) { phase_scan(p, lds); } SEAM(8);
    if (IN(9)) for (int rep_ = 0; rep_ <= ((REPMASK >> 9) & 1); ++rep_) { phase_fnet_out(p, lds); }
    if (IN(10)) for (int rep_ = 0; rep_ <= ((REPMASK >> 10) & 1); ++rep_) { phase_post(p); } SEAM(10);
    if (IN(11)) for (int rep_ = 0; rep_ <= ((REPMASK >> 11) & 1); ++rep_) { pg8::Gemm g{(const h16*)(ws + WS_ZCD), (const h16*)(ws + WS_W4T), NTOK, 1024, 1536}; pg8::StaticOrder S; S.init(NTOK, 1024, gridDim.x, blockIdx.x);
                  Epi4 E{(h16*)(ws + WS_O2)}; pg8::gemm_phase<Epi4>(lds, g, S, E); } SEAM(11);
    if (IN(12)) for (int rep_ = 0; rep_ <= ((REPMASK >> 12) & 1); ++rep_) { phase_final(p); }
}

extern "C" void kernel_launch(void* const* d_in, const int* in_sizes, int n_in, void* d_out, int out_size, void* d_ws, size_t ws_size, hipStream_t stream) {
    static int grid = 0;
    if (grid == 0) {
        int dev = 0, cus = 0, per_cu = 0;
        hipGetDevice(&dev);
        hipDeviceGetAttribute(&cus, hipDeviceAttributeMultiprocessorCount, dev);
        if (hipFuncSetAttribute((const void*)mega, hipFuncAttributeMaxDynamicSharedMemorySize, LDS_BYTES) != hipSuccess) fprintf(stderr, "kernel_launch: hipFuncSetAttribute failed\n");
        hipOccupancyMaxActiveBlocksPerMultiprocessor(&per_cu, (const void*)mega, 512, LDS_BYTES);
        if (per_cu < 1) { fprintf(stderr, "kernel_launch: occupancy query says %d blocks per CU\n", per_cu); per_cu = 1; }
        (void)hipGetLastError();
        grid = cus;
        if (grid < 64) grid = 64;
    }
    if (hipMemsetAsync((unsigned char*)d_ws + WS_BAR, 0, XCD_BAR_WORDS * 4, stream) != hipSuccess) fprintf(stderr, "kernel_launch: memset of the barrier words failed\n");
    Params p{};
    for (int i = 0; i < 24; ++i) p.in[i] = (const float*)d_in[i];
    p.out = (float*)d_out; p.ws = (unsigned char*)d_ws;
#if N_LAUNCH_MODE == 1
    p.ph_lo = 0; p.ph_hi = NPHASE;
    void* args[] = {&p};
    hipError_t e = hipLaunchCooperativeKernel((const void*)mega, dim3(grid), dim3(512), args, LDS_BYTES, stream);
    if (e != hipSuccess) fprintf(stderr, "kernel_launch: cooperative launch failed: %s (grid %d)\n", hipGetErrorString(e), grid);
#else
    for (int ph = 0; ph < NPHASE; ++ph) { p.ph_lo = ph; p.ph_hi = ph + 1; hipLaunchKernelGGL(mega, dim3(grid), dim3(512), LDS_BYTES, stream, p); }
#endif
}
```

```cpp
#include <hip/hip_runtime.h>
#include <hip/hip_cooperative_groups.h>
#include <cstdio>
#include <cstdint>
namespace cg = cooperative_groups;

#ifndef N_LAUNCH_MODE
#define N_LAUNCH_MODE 1
#endif

#ifndef REPMASK
#define REPMASK 0
#endif
#define LAS __attribute__((address_space(3)))
typedef _Float16 h16;
typedef _Float16 h16x8 __attribute__((ext_vector_type(8)));
typedef _Float16 h16x4 __attribute__((ext_vector_type(4)));
typedef float f32x2 __attribute__((ext_vector_type(2)));
typedef float f32x4 __attribute__((ext_vector_type(4)));
typedef float f32x16 __attribute__((ext_vector_type(16)));

constexpr int NTOK = 16384, DM = 1024, SEQ = 8192;
constexpr int LDS_MAIN = 131072;
constexpr int LDS_BYTES = LDS_MAIN + 16;
constexpr int NPHASE = 13;
constexpr size_t MiB = 1024 * 1024;
constexpr size_t WS_W1T = 0;
constexpr size_t WS_W2T = WS_W1T + (size_t)7168 * 1024 * 2;
constexpr size_t WS_W3T = WS_W2T + (size_t)1024 * 2048 * 2;
constexpr size_t WS_W4T = WS_W3T + (size_t)5376 * 1024 * 2;
constexpr size_t WS_STATS = 32 * MiB;
constexpr size_t WS_WSH = WS_STATS + 131072;
constexpr size_t WS_CWT = WS_WSH + 262144;
constexpr size_t WS_SBON = WS_CWT + 262144;
constexpr size_t WS_BAR = 35 * MiB;
constexpr size_t WS_XC = 36 * MiB, WS_G = 68 * MiB, WS_U = 100 * MiB, WS_V = 132 * MiB, WS_YCAT = 164 * MiB;
constexpr size_t WS_SPR = 0, WS_SPI = 232 * MiB;
constexpr size_t WS_O2 = 68 * MiB;
constexpr size_t WS_O1 = 36 * MiB, WS_PC = 68 * MiB, WS_ZCD = 168 * MiB, WS_FD = 216 * MiB;

namespace pg8 {
constexpr int BM = 256, BK = 64, HALF = 128, HTB = HALF * BK * 2, STAGE_BYTES = 8 * HTB, NXCD = 8, WGM = 8;
__host__ __device__ __forceinline__ int lds_byte(int r, int c) { const int st = (r >> 4) * 2 + (c >> 5), rr = r & 15, cc = c & 31, ob = rr * 64 + cc * 2; return st * 1024 + (ob ^ (((ob >> 9) & 1) << 5)); }
__host__ __device__ __forceinline__ void stage_rc(int b, int& R, int& C) { const int st = b / 1024, sb = b % 1024, swz = sb ^ (((sb >> 9) & 1) << 5); R = (st >> 1) * 16 + swz / 64; C = (st & 1) * 32 + (swz % 64) / 2; }
__host__ __device__ __forceinline__ int perm32(int rho) { const int n = rho >> 4, i = rho & 15; return 8 * (i >> 2) + 4 * n + (i & 3); }
struct Unit { int pm, pn; };
struct Gemm { const h16* A; const h16* Bt; int M, N, K; };
struct StaticOrder {
    int nM, nN, nwg, G, c;
    __host__ __device__ void init(int M, int N, int G_, int c_) { nM = M / BM; nN = N / BM; nwg = nM * nN; G = G_; c = c_; }
    __host__ __device__ bool next(int i, Unit& u) const {
        const long L = (long)i * G + c; if (L >= nwg) return false;
        int wgid = (int)L; { const int q = nwg / NXCD, r = nwg % NXCD, xcd = wgid % NXCD, off = wgid / NXCD; wgid = (xcd < r ? xcd * (q + 1) : r * (q + 1) + (xcd - r) * q) + off; }
        const int nig = WGM * nN, gid = wgid / nig, fm = gid * WGM, gsz = (nM - fm) < WGM ? (nM - fm) : WGM;
        u.pm = fm + ((wgid % nig) % gsz); u.pn = (wgid % nig) / gsz; return true;
    }
};
template <class Epi>
__device__ __forceinline__ void gemm_phase(LAS unsigned char* lds, const Gemm g, const StaticOrder& S, const Epi& E) {
    const int tid = threadIdx.x, wid = __builtin_amdgcn_readfirstlane(tid >> 6), lane = tid & 63, wr = wid >> 2, wc = wid & 3, fr = lane & 15, fq = lane >> 4;
    const int K = g.K, nt = K / BK;
    unsigned voffA[2], voffB[2];
#pragma unroll
    for (int i = 0; i < 2; ++i) { int R, C; stage_rc(tid * 16 + i * 8192, R, C); const int Rb = Epi::PERM ? ((R & ~31) + perm32(R & 31)) : R; voffA[i] = (unsigned)(R * K + C) * 2u; voffB[i] = (unsigned)(Rb * K + C) * 2u; }
    const size_t kstep = (size_t)(BK * 2);
    const size_t hstep = (size_t)HALF * K * 2;
    const size_t tstep = 2 * hstep;
    const unsigned ldsw = (unsigned)wid * 1024u;
    const int aoff = lds_byte(wr * 64 + fr, fq * 8), boff = lds_byte(wc * 32 + fr, fq * 8);
#define PG8_SA(b, h) (((b) * 2 + (h)) * HTB)
#define PG8_SB(b, h) ((4 + (b) * 2 + (h)) * HTB)
#define PG8_STAGE(bufoff, gbase, voff) do { _Pragma("unroll") for (int _i = 0; _i < 2; ++_i) \
        __builtin_amdgcn_global_load_lds((const unsigned*)((const char*)(gbase) + (voff)[_i]), (LAS unsigned*)(lds + (bufoff) + ldsw + _i * 8192), 16, 0, 0); } while (0)
#define PG8_LDA(dst, b, h) do { _Pragma("unroll") for (int m = 0; m < 4; ++m) _Pragma("unroll") for (int k = 0; k < 2; ++k) dst[m][k] = *(const LAS h16x8*)(lds + PG8_SA(b, h) + aoff + m * 2048 + k * 1024); } while (0)
#define PG8_LDB(dst, b, h) do { _Pragma("unroll") for (int n = 0; n < 2; ++n) _Pragma("unroll") for (int k = 0; k < 2; ++k) dst[n][k] = *(const LAS h16x8*)(lds + PG8_SB(b, h) + boff + n * 2048 + k * 1024); } while (0)
#define PG8_MMA(ai, bj, At, Bt) do { __builtin_amdgcn_s_setprio(1); _Pragma("unroll") for (int m = 0; m < 4; ++m) _Pragma("unroll") for (int n = 0; n < 2; ++n) _Pragma("unroll") for (int k = 0; k < 2; ++k) \
        acc[ai][bj][m][n] = __builtin_amdgcn_mfma_f32_16x16x32_f16(Bt[n][k], At[m][k], acc[ai][bj][m][n], 0, 0, 0); __builtin_amdgcn_s_setprio(0); } while (0)
#define PG8_WAIT_V(n) asm volatile("s_waitcnt vmcnt(" #n ")" ::: "memory")
#define PG8_WAIT_L(n) asm volatile("s_waitcnt lgkmcnt(" #n ")" ::: "memory")
#define PG8_BAR __builtin_amdgcn_s_barrier()
#define PG8_SCHED __builtin_amdgcn_sched_barrier(0)
    Unit cur, nxt; int ui = 0;
    if (!S.next(0, cur)) return;
    f32x4 acc[2][2][4][2];
#pragma unroll
    for (int a = 0; a < 2; ++a)
#pragma unroll
        for (int b = 0; b < 2; ++b)
#pragma unroll
            for (int m = 0; m < 4; ++m)
#pragma unroll
                for (int n = 0; n < 2; ++n) acc[a][b][m][n] = (f32x4){0.f, 0.f, 0.f, 0.f};
    h16x8 At[4][2], B0[2][2], B1[2][2];
    const char* cA = (const char*)g.A + (size_t)cur.pm * tstep; const char* cB = (const char*)g.Bt + (size_t)cur.pn * tstep;
    PG8_STAGE(PG8_SB(0, 0), cB, voffB); PG8_STAGE(PG8_SA(0, 0), cA, voffA); PG8_STAGE(PG8_SB(0, 1), cB + hstep, voffB); PG8_STAGE(PG8_SA(0, 1), cA + hstep, voffA);
    if (wr == 1) PG8_BAR;
    PG8_WAIT_V(4); PG8_BAR;
    PG8_STAGE(PG8_SB(1, 0), cB + kstep, voffB); PG8_STAGE(PG8_SA(1, 0), cA + kstep, voffA); PG8_STAGE(PG8_SB(1, 1), cB + hstep + kstep, voffB);
    PG8_WAIT_V(6); PG8_BAR;
    for (;;) {
        const bool has_next = S.next(ui + 1, nxt);
        const char* nA = has_next ? (const char*)g.A + (size_t)nxt.pm * tstep : cA; const char* nB = has_next ? (const char*)g.Bt + (size_t)nxt.pn * tstep : cB;
        for (int t = 0; t < nt; t += 2) {
            const bool last = (t == nt - 2);
            const char* a1 = cA + (size_t)(t + 1) * kstep;
            const char* a2 = last ? nA : cA + (size_t)(t + 2) * kstep; const char* b2 = last ? nB : cB + (size_t)(t + 2) * kstep;
            const char* a3 = a2 + kstep; const char* b3 = b2 + kstep;
            PG8_LDB(B0, 0, 0); PG8_SCHED; PG8_LDA(At, 0, 0); PG8_STAGE(PG8_SA(1, 1), a1 + hstep, voffA);
            PG8_WAIT_L(8); PG8_BAR; PG8_WAIT_L(0); PG8_MMA(0, 0, At, B0); PG8_BAR; PG8_SCHED;
            PG8_LDB(B1, 0, 1); PG8_STAGE(PG8_SB(0, 0), b2, voffB);
            PG8_BAR; PG8_WAIT_L(0); PG8_MMA(0, 1, At, B1); PG8_BAR;
            PG8_LDA(At, 0, 1); PG8_STAGE(PG8_SA(0, 0), a2, voffA);
            PG8_BAR; PG8_WAIT_L(0); PG8_MMA(1, 0, At, B0); PG8_BAR; PG8_SCHED;
            PG8_STAGE(PG8_SB(0, 1), b2 + hstep, voffB);
            PG8_WAIT_V(6); PG8_BAR; PG8_MMA(1, 1, At, B1); PG8_BAR;
            PG8_LDB(B0, 1, 0); PG8_SCHED; PG8_LDA(At, 1, 0); PG8_STAGE(PG8_SA(0, 1), a2 + hstep, voffA);
            PG8_WAIT_L(8); PG8_BAR; PG8_WAIT_L(0); PG8_MMA(0, 0, At, B0); PG8_BAR; PG8_SCHED;
            PG8_LDB(B1, 1, 1); PG8_STAGE(PG8_SB(1, 0), b3, voffB);
            PG8_BAR; PG8_WAIT_L(0); PG8_MMA(0, 1, At, B1); PG8_BAR;
            PG8_LDA(At, 1, 1); PG8_STAGE(PG8_SA(1, 0), a3, voffA);
            PG8_BAR; PG8_WAIT_L(0); PG8_MMA(1, 0, At, B0); PG8_BAR; PG8_SCHED;
            PG8_STAGE(PG8_SB(1, 1), b3 + hstep, voffB);
            PG8_WAIT_V(6); PG8_BAR; PG8_MMA(1, 1, At, B1); PG8_BAR;
        }
        E(acc, cur, wr, wc, fr, fq);
        if (!has_next) break;
#pragma unroll
        for (int a = 0; a < 2; ++a)
#pragma unroll
            for (int b = 0; b < 2; ++b)
#pragma unroll
                for (int m = 0; m < 4; ++m)
#pragma unroll
                    for (int n = 0; n < 2; ++n) acc[a][b][m][n] = (f32x4){0.f, 0.f, 0.f, 0.f};
        cur = nxt; cA = nA; cB = nB; ++ui;
    }
    PG8_WAIT_V(0);
    if (wr == 0) PG8_BAR;
    PG8_BAR;
#undef PG8_SA
#undef PG8_SB
#undef PG8_STAGE
#undef PG8_LDA
#undef PG8_LDB
#undef PG8_MMA
#undef PG8_WAIT_V
#undef PG8_WAIT_L
#undef PG8_BAR
#undef PG8_SCHED
}
}


#define XB_TMO      128
#define XB_XCNT(j)  (256  + 64 * (j))
#define XB_XSUB(j)  (1280 + 64 * (j))
#define XB_XGEN(j)  (2304 + 64 * (j))
#define XB_TOP      3328
#define XB_TOPGEN   3392
#define XCD_BAR_WORDS 3456
#define XB_SPIN_CAP (1u << 18)
__device__ __forceinline__ unsigned xb_ld(unsigned* p)              { return __hip_atomic_load(p, __ATOMIC_RELAXED, __HIP_MEMORY_SCOPE_AGENT); }
__device__ __forceinline__ unsigned xb_add(unsigned* p, unsigned v) { return __hip_atomic_fetch_add(p, v, __ATOMIC_RELAXED, __HIP_MEMORY_SCOPE_AGENT); }
__device__ __forceinline__ unsigned xb_xcc_id() { return (unsigned)__builtin_amdgcn_s_getreg((3 << 11) | 20) & 0xFu; }
#define XB_SPIN(cond, bar) do { unsigned _sp = 0; while (cond) { __builtin_amdgcn_s_sleep(1); \
    if ((++_sp & 255u) == 0u) { if (xb_ld(&(bar)[XB_TMO])) break; if (_sp > XB_SPIN_CAP) { atomicAdd(&(bar)[XB_TMO], 1u); break; } } } } while (0)
struct XcdBarrier { unsigned* bar; unsigned x; volatile LAS unsigned* st; };
__device__ __forceinline__ XcdBarrier xcd_barrier_post(unsigned* bar, volatile LAS unsigned* st) {
    XcdBarrier b; b.bar = bar; b.x = xb_xcc_id(); b.st = st;
    if (threadIdx.x == 0) (void)xb_add(&bar[XB_XCNT(b.x)], 1u);
    return b;
}
__device__ __forceinline__ void xcd_barrier_complete(unsigned* bar, unsigned x, unsigned& nloc, unsigned& nx) {
    const unsigned G = gridDim.x * gridDim.y * gridDim.z;
    unsigned sum, cnt, mine, sp = 0u;
    for (;;) {
        sum = 0u; cnt = 0u; mine = 0u;
#pragma unroll
        for (unsigned j = 0; j < 16; ++j) { const unsigned c = xb_ld(&bar[XB_XCNT(j)]); sum += c; cnt += (c > 0u) ? 1u : 0u; mine = (j == x) ? c : mine; }
        if (sum == G) break;
        __builtin_amdgcn_s_sleep(1);
        if ((++sp & 255u) == 0u) { if (xb_ld(&bar[XB_TMO])) break; if (sp > XB_SPIN_CAP) { atomicAdd(&bar[XB_TMO], 1u); break; } }
    }
    nloc = mine > 0u ? mine : 1u; nx = cnt > 0u ? cnt : 1u;
}
__device__ __forceinline__ void xcd_barrier(const XcdBarrier& b) {
    asm volatile("s_waitcnt vmcnt(0)" ::: "memory");
    __syncthreads();
    if (threadIdx.x == 0) {
        unsigned* bar = b.bar;
        __builtin_amdgcn_s_waitcnt(0);
        unsigned nloc = b.st[0], nx = b.st[1];
        if (nloc == 0u) { xcd_barrier_complete(bar, b.x, nloc, nx); b.st[0] = nloc; b.st[1] = nx; }
        const unsigned old = xb_add(&bar[XB_XSUB(b.x)], 1u);
        const unsigned gen = old / nloc;
        if (old + 1u == (gen + 1u) * nloc) {
            __builtin_amdgcn_fence(__ATOMIC_RELEASE, "agent");
            asm volatile("s_waitcnt vmcnt(0)" ::: "memory");
            const unsigned og = xb_add(&bar[XB_TOP], 1u);
            const unsigned tg = og / nx;
            if (og + 1u == (tg + 1u) * nx) xb_add(&bar[XB_TOPGEN], 1u);
            else XB_SPIN(xb_ld(&bar[XB_TOPGEN]) == tg, bar);
            __builtin_amdgcn_fence(__ATOMIC_ACQUIRE, "agent");
            xb_add(&bar[XB_XGEN(b.x)], 1u);
            asm volatile("s_waitcnt vmcnt(0)" ::: "memory");
        } else {
            XB_SPIN(xb_ld(&bar[XB_XGEN(b.x)]) == gen, bar);
            __builtin_amdgcn_fence(__ATOMIC_ACQUIRE, "agent");
            asm volatile("s_waitcnt vmcnt(0)" ::: "memory");
        }
    }
    __syncthreads();
}

struct Params { const float* in[24]; float* out; unsigned char* ws; int ph_lo, ph_hi; };

__device__ __forceinline__ float silu_f(float x) { return x * __builtin_amdgcn_rcpf(1.f + __expf(-x)); }
__device__ __forceinline__ float sigmoid_f(float x) { return __builtin_amdgcn_rcpf(1.f + __expf(-x)); }
__device__ __forceinline__ float tanh_f(float x) { return 1.f - 2.f * __builtin_amdgcn_rcpf(__expf(2.f * x) + 1.f); }
__device__ __forceinline__ float wave_sum(float v) {
#pragma unroll
    for (int o = 1; o < 64; o <<= 1) v += __shfl_xor(v, o);
    return v;
}
template <int CTRL> __device__ __forceinline__ float dpp_f(float x) { return __int_as_float(__builtin_amdgcn_update_dpp(0, __float_as_int(x), CTRL, 0xf, 0xf, false)); }
__device__ __forceinline__ float red8(float x) {
    x += dpp_f<0xB1>(x); x += dpp_f<0x4E>(x); x += dpp_f<0x141>(x); return x;
}
__device__ __forceinline__ float red16(float x) {
    x += dpp_f<0xB1>(x); x += dpp_f<0x4E>(x); x += dpp_f<0x141>(x); x += dpp_f<0x140>(x); return x;
}

__device__ __forceinline__ int sigma1(int np) {
    const int T = np >> 8, c = np & 255;
    if (T < 16) { const int bj = c >> 7, wc = (c >> 5) & 3, fq = (c >> 3) & 3, n = (c >> 2) & 1, e = c & 3; return 1024 * (2 * bj + n) + 64 * T + 16 * wc + 4 * fq + e; }
    if (T < 24) { return ((c >> 7) ? 6144 : 4096) + 128 * (T - 16) + (c & 127); }
    return 5120 + 256 * (T - 24) + c;
}

template <int MODE>
__device__ __forceinline__ void tr_item(const float* W, int K, int N, h16* WT, LAS float* scr, int item, int nblk, int lane) {
    const int kb = item / nblk, nb = item % nblk, k0 = 64 * kb, n0 = 32 * nb;
    const int np = n0 + (lane & 31);
    const int sc = (MODE == 1) ? sigma1(np) : np;
    const bool valid = (MODE != 2) || (np < 5248);
    float wv_[32];
#pragma unroll
    for (int i = 0; i < 32; ++i) { const int kk = 2 * i + (lane >> 5); wv_[i] = valid ? W[(size_t)(k0 + kk) * N + sc] : 0.f; }
#pragma unroll
    for (int i = 0; i < 32; ++i) { const int kk = 2 * i + (lane >> 5); scr[kk * 33 + (lane & 31)] = wv_[i]; }
    asm volatile("s_waitcnt lgkmcnt(0)" ::: "memory");
    const int c = lane & 7;
#pragma unroll
    for (int j = 0; j < 4; ++j) { const int n = (lane >> 3) + 8 * j; const LAS float* s = scr + (8 * c) * 33 + n;
        h16x8 o;
#pragma unroll
        for (int e = 0; e < 8; ++e) o[e] = (h16)s[e * 33];
        *(h16x8*)(WT + (size_t)(n0 + n) * K + k0 + 8 * c) = o; }
    asm volatile("s_waitcnt lgkmcnt(0)" ::: "memory");
}

__device__ __forceinline__ void rms_rows2_f16(const float* x0, const float* x1, const h16* ad0, const h16* ad1, const float* g, h16* or0, h16* or1, int lane) {
    f32x4 v[2][4]; h16x4 a[2][4]; float ss[2] = {0.f, 0.f};
#pragma unroll
    for (int j = 0; j < 4; ++j) { v[0][j] = *(const f32x4*)(x0 + 4 * lane + 256 * j); v[1][j] = *(const f32x4*)(x1 + 4 * lane + 256 * j);
        if (ad0) { a[0][j] = *(const h16x4*)(ad0 + 4 * lane + 256 * j); a[1][j] = *(const h16x4*)(ad1 + 4 * lane + 256 * j); } }
#pragma unroll
    for (int u = 0; u < 2; ++u)
#pragma unroll
        for (int j = 0; j < 4; ++j) {
            if (ad0) { v[u][j][0] += (float)a[u][j][0]; v[u][j][1] += (float)a[u][j][1]; v[u][j][2] += (float)a[u][j][2]; v[u][j][3] += (float)a[u][j][3]; }
            ss[u] += v[u][j][0] * v[u][j][0] + v[u][j][1] * v[u][j][1] + v[u][j][2] * v[u][j][2] + v[u][j][3] * v[u][j][3]; }
#pragma unroll
    for (int o = 1; o < 64; o <<= 1) { ss[0] += __shfl_xor(ss[0], o); ss[1] += __shfl_xor(ss[1], o); }
    const float rs0 = rsqrtf(ss[0] * (1.f / 1024.f) + 1e-6f), rs1 = rsqrtf(ss[1] * (1.f / 1024.f) + 1e-6f);
#pragma unroll
    for (int j = 0; j < 4; ++j) { const f32x4 gg = *(const f32x4*)(g + 4 * lane + 256 * j); h16x4 o0, o1;
#pragma unroll
        for (int e = 0; e < 4; ++e) { o0[e] = (h16)(v[0][j][e] * rs0 * gg[e]); o1[e] = (h16)(v[1][j][e] * rs1 * gg[e]); }
        *(h16x4*)(or0 + 4 * lane + 256 * j) = o0; *(h16x4*)(or1 + 4 * lane + 256 * j) = o1; }
}

__device__ __forceinline__ void phase0(const Params& p, LAS unsigned char* lds) {
    const int tid = threadIdx.x, lane = tid & 63, wave = tid >> 6;
    const int gw = blockIdx.x * 8 + wave, NGW = gridDim.x * 8;
    LAS float* scr = (LAS float*)(lds + wave * 8448);
    h16* W1T = (h16*)(p.ws + WS_W1T); h16* W2T = (h16*)(p.ws + WS_W2T); h16* W3T = (h16*)(p.ws + WS_W3T); h16* W4T = (h16*)(p.ws + WS_W4T);
    constexpr int I1 = 16 * 224, I2 = 32 * 32, I3 = 16 * 168, I4 = 24 * 32;
    for (int it = gw; it < I1 + I2 + I3 + I4; it += NGW) {
        int r = it;
        if (r < I1) { tr_item<1>(p.in[2], 1024, 7168, W1T, scr, r, 224, lane); continue; } r -= I1;
        if (r < I2) { tr_item<0>(p.in[8], 2048, 1024, W2T, scr, r, 32, lane); continue; } r -= I2;
        if (r < I3) { tr_item<2>(p.in[10], 1024, 5248, W3T, scr, r, 168, lane); continue; } r -= I3;
        tr_item<0>(p.in[22], 1536, 1024, W4T, scr, r, 32, lane);
    }
    h16* H0 = (h16*)p.out;
    for (int r = gw; r < NTOK; r += 2 * NGW) { const int r1 = (r + NGW < NTOK) ? r + NGW : r;
        rms_rows2_f16(p.in[0] + (size_t)r * DM, p.in[0] + (size_t)r1 * DM, nullptr, nullptr, p.in[1], H0 + (size_t)r * DM, H0 + (size_t)r1 * DM, lane); }
    const int gt = blockIdx.x * 512 + tid, NGT = gridDim.x * 512;
    h16* WSH = (h16*)(p.ws + WS_WSH);
    for (int i = gt; i < 8 * 128 * 128; i += NGT) WSH[i] = (h16)p.in[6][i];
    { float* STZ = (float*)(p.ws + WS_STATS); for (int i = gt; i < 2 * NTOK; i += NGT) STZ[i] = 0.f; }
    h16* CWT = (h16*)(p.ws + WS_CWT);
    const float* wf = p.in[21];
    for (int i = gt; i < 4 * 128 * 256; i += NGT) {
        const int k = i & 255, e = (i >> 8) & 127, g = i >> 15, d = k & 127; const bool sn = k >= 128;
        float s = 0.f;
        for (int dp = 0; dp < 128; ++dp) { const float fr = (float)((d * dp) & 127) * (1.f / 128.f);
            const float tw = sn ? __builtin_amdgcn_sinf(fr) : __builtin_amdgcn_cosf(fr);
            s += tw * wf[(g * 128 + dp) * 128 + e]; }
        CWT[i] = (h16)(s * 0.08838834764831845f);
    }
}

struct Epi1 {
    static constexpr bool PERM = true;
    h16 *XC, *G, *U, *V; float* st;
    __device__ __forceinline__ void operator()(const f32x4 (&acc)[2][2][4][2], const pg8::Unit& u, int wr, int wc, int fr, int fq) const {
        const int T = u.pn; const int row0 = u.pm * 256 + wr * 64 + fr;
        if (T < 16) {
            const int ch = 64 * T + 16 * wc + 4 * fq;
#pragma unroll
            for (int ai = 0; ai < 2; ++ai)
#pragma unroll
                for (int m = 0; m < 4; ++m) { const size_t r = (size_t)(row0 + ai * 128 + m * 16);
                    const f32x4 xa = acc[ai][0][m][0], ba = acc[ai][0][m][1], ca = acc[ai][1][m][0], za = acc[ai][1][m][1];
                    h16x4 xc, gg;
#pragma unroll
                    for (int e = 0; e < 4; ++e) { xc[e] = (h16)(ca[e] * xa[e]); gg[e] = (h16)(ba[e] * silu_f(za[e])); }
                    *(h16x4*)(XC + r * 1024 + ch) = xc; *(h16x4*)(G + r * 1024 + ch) = gg; }
        } else if (T < 24) {
            const int ch = 128 * (T - 16) + 32 * wc + 8 * fq;
#pragma unroll
            for (int ai = 0; ai < 2; ++ai)
#pragma unroll
                for (int m = 0; m < 4; ++m) { const size_t r = (size_t)(row0 + ai * 128 + m * 16); h16x8 o;
#pragma unroll
                    for (int n = 0; n < 2; ++n) { const f32x4 ub = acc[ai][0][m][n], zb = acc[ai][1][m][n];
#pragma unroll
                        for (int e = 0; e < 4; ++e) o[4 * n + e] = (h16)(ub[e] * silu_f(zb[e])); }
                    *(h16x8*)(U + r * 1024 + ch) = o; }
        } else {
#pragma unroll
            for (int ai = 0; ai < 2; ++ai)
#pragma unroll
                for (int m = 0; m < 4; ++m) { const size_t r = (size_t)(row0 + ai * 128 + m * 16); float s1 = 0.f, s2 = 0.f;
#pragma unroll
                    for (int bj = 0; bj < 2; ++bj) { const int ch = 256 * (T - 24) + 128 * bj + 32 * wc + 8 * fq; h16x8 o;
#pragma unroll
                        for (int n = 0; n < 2; ++n) { const f32x4 v = acc[ai][bj][m][n];
#pragma unroll
                            for (int e = 0; e < 4; ++e) { o[4 * n + e] = (h16)v[e]; const float f = (float)o[4 * n + e]; s1 += f; s2 += f * f; } }
                        *(h16x8*)(V + r * 1024 + ch) = o; }
                    s1 += __shfl_xor(s1, 16); s2 += __shfl_xor(s2, 16); s1 += __shfl_xor(s1, 32); s2 += __shfl_xor(s2, 32);
                    if (fq == 0) { atomicAdd(st + 2 * r, s1); atomicAdd(st + 2 * r + 1, s2); } }
        }
    }
};
struct Epi2 {
    static constexpr bool PERM = true;
    h16* O1;
    __device__ __forceinline__ void operator()(const f32x4 (&acc)[2][2][4][2], const pg8::Unit& u, int wr, int wc, int fr, int fq) const {
        const int row0 = u.pm * 256 + wr * 64 + fr, col0 = u.pn * 256 + wc * 32 + 8 * fq;
#pragma unroll
        for (int ai = 0; ai < 2; ++ai)
#pragma unroll
            for (int m = 0; m < 4; ++m) { const size_t r = (size_t)(row0 + ai * 128 + m * 16);
#pragma unroll
                for (int bj = 0; bj < 2; ++bj) { const f32x4 v0 = acc[ai][bj][m][0], v1 = acc[ai][bj][m][1]; h16x8 o;
#pragma unroll
                    for (int e = 0; e < 4; ++e) { o[e] = (h16)v0[e]; o[4 + e] = (h16)v1[e]; }
                    *(h16x8*)(O1 + r * 1024 + col0 + bj * 128) = o; } }
    }
};
struct Epi3 {
    static constexpr bool PERM = true;
    h16 *PC, *ZCD, *FD;
    __device__ __forceinline__ void operator()(const f32x4 (&acc)[2][2][4][2], const pg8::Unit& u, int wr, int wc, int fr, int fq) const {
        const int row0 = u.pm * 256 + wr * 64 + fr, col0 = u.pn * 256 + wc * 32 + 8 * fq;
#pragma unroll
        for (int bj = 0; bj < 2; ++bj) { const int c = col0 + bj * 128;
            h16* base; size_t ld;
            if (c < 3200) { base = PC + c; ld = 3200; }
            else if (c < 4224) { base = ZCD + (c - 3200); ld = 1536; }
            else if (c < 4736) {
                const int cg = (c - 4224) >> 2;
#pragma unroll
                for (int ai = 0; ai < 2; ++ai)
#pragma unroll
                    for (int m = 0; m < 4; ++m) { const size_t r = (size_t)(row0 + ai * 128 + m * 16); const f32x4 v0 = acc[ai][bj][m][0], v1 = acc[ai][bj][m][1]; h16x4 o0, o1;
#pragma unroll
                        for (int e = 0; e < 4; ++e) { o0[e] = (h16)v0[e]; o1[e] = (h16)v1[e]; }
                        *(h16x4*)(FD + ((size_t)cg * NTOK + r) * 4) = o0; *(h16x4*)(FD + ((size_t)(cg + 1) * NTOK + r) * 4) = o1; }
                continue; }
            else if (c < 5248) { base = ZCD + 1024 + (c - 4736); ld = 1536; }
            else continue;
#pragma unroll
            for (int ai = 0; ai < 2; ++ai)
#pragma unroll
                for (int m = 0; m < 4; ++m) { const size_t r = (size_t)(row0 + ai * 128 + m * 16); const f32x4 v0 = acc[ai][bj][m][0], v1 = acc[ai][bj][m][1]; h16x8 o;
#pragma unroll
                    for (int e = 0; e < 4; ++e) { o[e] = (h16)v0[e]; o[4 + e] = (h16)v1[e]; }
                    *(h16x8*)(base + r * ld) = o; } }
    }
};
struct Epi4 {
    static constexpr bool PERM = true;
    h16* O2;
    __device__ __forceinline__ void operator()(const f32x4 (&acc)[2][2][4][2], const pg8::Unit& u, int wr, int wc, int fr, int fq) const {
        const int row0 = u.pm * 256 + wr * 64 + fr, col0 = u.pn * 256 + wc * 32 + 8 * fq;
#pragma unroll
        for (int ai = 0; ai < 2; ++ai)
#pragma unroll
            for (int m = 0; m < 4; ++m) { const size_t r = (size_t)(row0 + ai * 128 + m * 16);
#pragma unroll
                for (int bj = 0; bj < 2; ++bj) { const f32x4 v0 = acc[ai][bj][m][0], v1 = acc[ai][bj][m][1]; h16x8 o;
#pragma unroll
                    for (int e = 0; e < 4; ++e) { o[e] = (h16)v0[e]; o[4 + e] = (h16)v1[e]; }
                    *(h16x8*)(O2 + r * 1024 + col0 + bj * 128) = o; } }
    }
};

__device__ __forceinline__ void phase_stats(const Params& p) {
    const int tid = threadIdx.x, lane = tid & 63, wave = tid >> 6;
    const int gw = blockIdx.x * 8 + wave, NGW = gridDim.x * 8;
    const h16* V = (const h16*)(p.ws + WS_V); float* ST = (float*)(p.ws + WS_STATS);
    for (int r = gw; r < NTOK; r += NGW) {
        const h16x8 a = *(const h16x8*)(V + (size_t)r * 1024 + 8 * lane), b = *(const h16x8*)(V + (size_t)r * 1024 + 512 + 8 * lane);
        float s = 0.f;
#pragma unroll
        for (int e = 0; e < 8; ++e) s += (float)a[e] + (float)b[e];
        const float mu = wave_sum(s) * (1.f / 1024.f); float q = 0.f;
#pragma unroll
        for (int e = 0; e < 8; ++e) { const float x = (float)a[e] - mu, y = (float)b[e] - mu; q += x * x + y * y; }
        const float rs = rsqrtf(wave_sum(q) * (1.f / 1024.f) + 1e-5f);
        if (lane == 0) { ST[2 * r] = mu; ST[2 * r + 1] = rs; }
    }
}

__device__ __forceinline__ void phase_mix0(const Params& p, LAS unsigned char* lds) {
    const int tid = threadIdx.x, lane = tid & 63, wave = tid >> 6;
    const h16* XC = (const h16*)(p.ws + WS_XC); const h16* G = (const h16*)(p.ws + WS_G); const h16* U = (const h16*)(p.ws + WS_U); const h16* V = (const h16*)(p.ws + WS_V);
    h16* YC = (h16*)(p.ws + WS_YCAT);
    const float* cw = p.in[3];
    const int gt = blockIdx.x * 512 + tid, NGT = gridDim.x * 512;
    for (int idx0 = gt; idx0 < NTOK * 128; idx0 += 2 * NGT) {
        h16x8 x0[2], xm[2], xp[2], gg[2]; int tt[2], cc[2];
        const h16x8 zero = {0, 0, 0, 0, 0, 0, 0, 0};
#pragma unroll
        for (int u = 0; u < 2; ++u) { const int idx = (idx0 + u * NGT < NTOK * 128) ? idx0 + u * NGT : idx0; const int t = idx >> 7, c8 = (idx & 127) * 8, tp = t & (SEQ - 1); tt[u] = t; cc[u] = c8;
            x0[u] = *(const h16x8*)(XC + (size_t)t * 1024 + c8);
            xm[u] = tp > 0 ? *(const h16x8*)(XC + (size_t)(t - 1) * 1024 + c8) : zero;
            xp[u] = tp < SEQ - 1 ? *(const h16x8*)(XC + (size_t)(t + 1) * 1024 + c8) : zero;
            gg[u] = *(const h16x8*)(G + (size_t)t * 1024 + c8); }
#pragma unroll
        for (int u = 0; u < 2; ++u) { const int c8 = cc[u]; h16x8 o;
#pragma unroll
            for (int e = 0; e < 8; ++e) { const float y = cw[c8 + e] * (float)xm[u][e] + cw[1024 + c8 + e] * (float)x0[u][e] + cw[2048 + c8 + e] * (float)xp[u][e]; o[e] = (h16)(y * (float)gg[u][e]); }
            *(h16x8*)(YC + (size_t)tt[u] * 2048 + c8) = o; }
    }
    const float* ST = (const float*)(p.ws + WS_STATS); const h16* WSH = (const h16*)(p.ws + WS_WSH);
    const float* lng = p.in[4]; const float* lnb = p.in[5]; const float* bs = p.in[7];
    LAS h16* vnT = (LAS h16*)lds;
    for (int it = blockIdx.x; it < 1024; it += gridDim.x) {
        const int g = it & 7, bn = it >> 3, t0 = bn * 128;
        __syncthreads();
#pragma unroll
        for (int q = 0; q < 4; ++q) { const int pc = tid + 512 * q, j = pc >> 4, d8 = (pc & 15) * 8;
            const h16x8 v = *(const h16x8*)(V + (size_t)(t0 + j) * 1024 + g * 128 + d8);
            const float mu = ST[2 * (t0 + j)] * (1.f / 1024.f), rs = rsqrtf(fmaxf(ST[2 * (t0 + j) + 1] * (1.f / 1024.f) - mu * mu, 0.f) + 1e-5f);
#pragma unroll
            for (int e = 0; e < 8; ++e) vnT[(d8 + e) * 136 + ((((j >> 3) ^ (pc & 15)) << 3) | (j & 7))] = (h16)(((float)v[e] - mu) * rs * lng[g * 128 + d8 + e] + lnb[g * 128 + d8 + e]); }
        __syncthreads();
        const int itile = wave >> 1, dt0 = (wave & 1) * 2;
        f32x16 acc0, acc1;
#pragma unroll
        for (int e = 0; e < 16; ++e) { acc0[e] = 0.f; acc1[e] = 0.f; }
        const h16* Arow = WSH + ((size_t)g * 128 + itile * 32 + (lane & 31)) * 128 + 8 * (lane >> 5);
        const int d0_ = dt0 * 32 + (lane & 31), d1_ = d0_ + 32;
        const LAS h16* B0p = vnT + d0_ * 136; const LAS h16* B1p = vnT + d1_ * 136;
#pragma unroll
        for (int ks = 0; ks < 8; ++ks) {
            const h16x8 a = *(const h16x8*)(Arow + 16 * ks);
            const int jg = 2 * ks + (lane >> 5);
            const h16x8 b0 = *(const LAS h16x8*)(B0p + ((jg ^ ((d0_ >> 3) & 15)) << 3)), b1 = *(const LAS h16x8*)(B1p + ((jg ^ ((d1_ >> 3) & 15)) << 3));
            acc0 = __builtin_amdgcn_mfma_f32_32x32x16_f16(a, b0, acc0, 0, 0, 0);
            acc1 = __builtin_amdgcn_mfma_f32_32x32x16_f16(a, b1, acc1, 0, 0, 0);
        }
#pragma unroll
        for (int r = 0; r < 16; ++r) { const int i = itile * 32 + (r & 3) + 8 * (r >> 2) + 4 * (lane >> 5); const size_t t = (size_t)(t0 + i);
            const float bias = bs[g * 128 + i];
            const int d0 = g * 128 + dt0 * 32 + (lane & 31);
            YC[t * 2048 + 1024 + d0] = (h16)((acc0[r] + bias) * (float)U[t * 1024 + d0]);
            YC[t * 2048 + 1024 + d0 + 32] = (h16)((acc1[r] + bias) * (float)U[t * 1024 + d0 + 32]); }
    }
}

__device__ __forceinline__ void phase_norm1(const Params& p) {
    const int tid = threadIdx.x, lane = tid & 63, wave = tid >> 6;
    const int gw = blockIdx.x * 8 + wave, NGW = gridDim.x * 8;
    const h16* O1 = (const h16*)(p.ws + WS_O1); h16* H1 = (h16*)p.out;
    for (int r = gw; r < NTOK; r += 2 * NGW) { const int r1 = (r + NGW < NTOK) ? r + NGW : r;
        rms_rows2_f16(p.in[0] + (size_t)r * DM, p.in[0] + (size_t)r1 * DM, O1 + (size_t)r * DM, O1 + (size_t)r1 * DM, p.in[9], H1 + (size_t)r * DM, H1 + (size_t)r1 * DM, lane); }
}

__device__ __forceinline__ void phase_fft(const Params& p, LAS unsigned char* lds) {
    const int tid = threadIdx.x;
    const h16* FD = (const h16*)(p.ws + WS_FD);
    h16* SPr = (h16*)(p.ws + WS_SPR); h16* SPi = (h16*)(p.ws + WS_SPI);
    LAS f32x2* X0 = (LAS f32x2*)lds; LAS f32x2* X1 = X0 + 8192;
    for (int it = blockIdx.x; it < 256; it += gridDim.x) {
        const int b = it >> 7, c0 = 4 * (it & 127);
        __syncthreads();
        for (int t = tid; t < SEQ; t += 512) { const h16x4 v = *(const h16x4*)(FD + ((size_t)(it & 127) * NTOK + b * SEQ + t) * 4);
            X0[t] = (f32x2){(float)v[0], (float)v[1]}; X1[t] = (f32x2){(float)v[2], (float)v[3]}; }
        __syncthreads();
        for (int s = 0; s < 6; ++s) {
            const int lq = 11 - 2 * s, q = 1 << lq;
            const float rn = 1.f / (float)(4 << lq);
#pragma unroll 2
            for (int j = tid; j < 2048; j += 512) {
                const int pp = j & (q - 1), i0 = ((j >> lq) << (lq + 2)) + pp;
                const float fr = (float)pp * rn;
                const float c1 = __builtin_amdgcn_cosf(fr), s1 = __builtin_amdgcn_sinf(fr), c2 = __builtin_amdgcn_cosf(2.f * fr), s2 = __builtin_amdgcn_sinf(2.f * fr), c3 = __builtin_amdgcn_cosf(3.f * fr), s3 = __builtin_amdgcn_sinf(3.f * fr);
#pragma unroll
                for (int f = 0; f < 2; ++f) { LAS f32x2* X = f ? X1 : X0;
                    const f32x2 a = X[i0], b_ = X[i0 + q], c_ = X[i0 + 2 * q], d_ = X[i0 + 3 * q];
                    const f32x2 t0 = a + c_, t1 = a - c_, t2 = b_ + d_, t3 = b_ - d_;
                    const f32x2 y0 = t0 + t2, y2 = t0 - t2;
                    const f32x2 y1 = {t1[0] + t3[1], t1[1] - t3[0]}, y3 = {t1[0] - t3[1], t1[1] + t3[0]};
                    X[i0] = y0;
                    X[i0 + q] = (f32x2){y1[0] * c1 + y1[1] * s1, y1[1] * c1 - y1[0] * s1};
                    X[i0 + 2 * q] = (f32x2){y2[0] * c2 + y2[1] * s2, y2[1] * c2 - y2[0] * s2};
                    X[i0 + 3 * q] = (f32x2){y3[0] * c3 + y3[1] * s3, y3[1] * c3 - y3[0] * s3}; }
            }
            __syncthreads();
        }
        for (int j = tid; j < 4096; j += 512) {
            { const f32x2 a = X0[2 * j], bb = X0[2 * j + 1]; X0[2 * j] = a + bb; X0[2 * j + 1] = a - bb; }
            { const f32x2 a = X1[2 * j], bb = X1[2 * j + 1]; X1[2 * j] = a + bb; X1[2 * j + 1] = a - bb; }
        }
        __syncthreads();
        const float sc = 0.5f * 0.011048543456039806f;
        for (int k = tid; k < SEQ; k += 512) {
            const unsigned kb = (unsigned)((SEQ - k) & (SEQ - 1));
            const unsigned ya_ = __brev((unsigned)k & 0xFFFu) >> 20, yb_ = __brev(kb & 0xFFFu) >> 20;
            const int ra = (int)(((((ya_ & 0xAAAu) >> 1) | ((ya_ & 0x555u) << 1)) << 1) | ((unsigned)k >> 12));
            const int rb = (int)(((((yb_ & 0xAAAu) >> 1) | ((yb_ & 0x555u) << 1)) << 1) | (kb >> 12));
            const f32x2 za = X0[ra], zb = X0[rb], ya = X1[ra], yb = X1[rb];
            h16x4 orr, oi;
            orr[0] = (h16)((za[0] + zb[0]) * sc); oi[0] = (h16)((za[1] - zb[1]) * sc);
            orr[1] = (h16)((za[1] + zb[1]) * sc); oi[1] = (h16)((zb[0] - za[0]) * sc);
            orr[2] = (h16)((ya[0] + yb[0]) * sc); oi[2] = (h16)((ya[1] - yb[1]) * sc);
            orr[3] = (h16)((ya[1] + yb[1]) * sc); oi[3] = (h16)((yb[0] - ya[0]) * sc);
            *(h16x4*)(SPr + ((size_t)(it & 127) * NTOK + b * SEQ + k) * 4) = orr; *(h16x4*)(SPi + ((size_t)(it & 127) * NTOK + b * SEQ + k) * 4) = oi;
        }
    }
}

__device__ __forceinline__ void phase_fnet_out(const Params& p, LAS unsigned char* lds) {
    const int tid = threadIdx.x, lane = tid & 63, wave = tid >> 6;
    const h16* SPr = (const h16*)(p.ws + WS_SPR); const h16* SPi = (const h16*)(p.ws + WS_SPI);
    const h16* CWT = (const h16*)(p.ws + WS_CWT); h16* ZCD = (h16*)(p.ws + WS_ZCD);
    LAS h16* Lr = (LAS h16*)lds; LAS h16* Li = Lr + 32 * 520;
    const int g = wave >> 1, eh = wave & 1;
    for (int it = blockIdx.x; it < 512; it += gridDim.x) {
        const int t0 = it * 32;
        __syncthreads();
#pragma unroll
        for (int q = 0; q < 8; ++q) { const int idx = tid + 512 * q, arr = idx >> 11, rem = idx & 2047, cg = rem >> 4, tp = rem & 15;
            const h16x8 v = *(const h16x8*)((arr ? SPi : SPr) + ((size_t)cg * NTOK + t0 + 2 * tp) * 4);
            LAS h16* d_ = (arr ? Li : Lr) + (2 * tp) * 520 + 4 * cg;
            *(LAS h16x4*)d_ = (h16x4){v[0], v[1], v[2], v[3]}; *(LAS h16x4*)(d_ + 520) = (h16x4){v[4], v[5], v[6], v[7]}; }
        __syncthreads();
        f32x16 acc0, acc1;
#pragma unroll
        for (int e = 0; e < 16; ++e) { acc0[e] = 0.f; acc1[e] = 0.f; }
        const LAS h16* Ar = Lr + (lane & 31) * 520 + g * 128 + 8 * (lane >> 5); const LAS h16* Ai = Li + (lane & 31) * 520 + g * 128 + 8 * (lane >> 5);
        const h16* B0 = CWT + ((size_t)(g * 128 + (2 * eh) * 32 + (lane & 31))) * 256 + 8 * (lane >> 5); const h16* B1 = B0 + 32 * 256;
#pragma unroll
        for (int ks = 0; ks < 8; ++ks) { const h16x8 a = *(const LAS h16x8*)(Ar + 16 * ks);
            acc0 = __builtin_amdgcn_mfma_f32_32x32x16_f16(a, *(const h16x8*)(B0 + 16 * ks), acc0, 0, 0, 0);
            acc1 = __builtin_amdgcn_mfma_f32_32x32x16_f16(a, *(const h16x8*)(B1 + 16 * ks), acc1, 0, 0, 0); }
#pragma unroll
        for (int ks = 0; ks < 8; ++ks) { const h16x8 a = *(const LAS h16x8*)(Ai + 16 * ks);
            acc0 = __builtin_amdgcn_mfma_f32_32x32x16_f16(a, *(const h16x8*)(B0 + 128 + 16 * ks), acc0, 0, 0, 0);
            acc1 = __builtin_amdgcn_mfma_f32_32x32x16_f16(a, *(const h16x8*)(B1 + 128 + 16 * ks), acc1, 0, 0, 0); }
#pragma unroll
        for (int r = 0; r < 16; ++r) { const size_t t = (size_t)(t0 + (r & 3) + 8 * (r >> 2) + 4 * (lane >> 5));
            h16* zp = ZCD + t * 1536 + 1024 + g * 128 + (2 * eh) * 32 + (lane & 31);
            zp[0] = (h16)(acc0[r] * silu_f((float)zp[0])); zp[32] = (h16)(acc1[r] * silu_f((float)zp[32])); }
    }
}

#define LDS_BAR() do { asm volatile("s_waitcnt lgkmcnt(0)" ::: "memory"); __builtin_amdgcn_s_barrier(); asm volatile("" ::: "memory"); } while (0)
#define LDS_WAIT() asm volatile("s_waitcnt lgkmcnt(0)" ::: "memory")
__device__ __forceinline__ void phase_scan(const Params& p, LAS unsigned char* lds) {
    const int tid = threadIdx.x, lane = tid & 63, wave = tid >> 6;
    const h16* PC = (const h16*)(p.ws + WS_PC);
    LAS h16* w2T = (LAS h16*)lds;
    LAS h16* a2T = w2T + 64 * 72;
    LAS unsigned char* priv = lds + 18432 + (wave & 3) * 4096;
    constexpr int SET_F = 5 * 2048 + 512;
    LAS float* OPS = (LAS float*)(lds + 18432 + 16384);
    LAS float* sYb = OPS + 2 * SET_F;
    for (int item = blockIdx.x; item < 256; item += gridDim.x) {
        const int xcd = item & 7, slot = item >> 3, gidx = xcd * 8 + (slot >> 2), q = slot & 3;
        const int dir = gidx >> 5, b = (gidx >> 4) & 1, h = gidx & 15;
        h16* Yd = (h16*)((unsigned char*)p.out + (size_t)dir * 32 * MiB);
        float* SB = (float*)(p.ws + WS_SBON) + (size_t)dir * NTOK * 16;
        const float* mu = p.in[11] + dir * 3200; const float* w0 = p.in[12] + dir * 1024 + 64 * h; const float* w2 = p.in[13] + (size_t)dir * 65536 + 64 * h;
        const float* a0 = p.in[14] + dir * 1024 + 64 * h; const float* a2 = p.in[15] + (size_t)dir * 65536 + 64 * h;
        const float* kkw = p.in[16] + 64 * h; const float* kaw = p.in[17] + 64 * h; const float* rkw = p.in[18] + 64 * h;
        __syncthreads();
        for (int i = tid; i < 4096; i += 512) { const int l = i >> 6, c = i & 63; w2T[c * 72 + l] = (h16)w2[l * 1024 + c]; a2T[c * 72 + l] = (h16)a2[l * 1024 + c]; }
        const int pw_ = wave & 3, s_sub = lane >> 3, c8 = (lane & 7) * 8, s_l = 8 * pw_ + s_sub;
        h16x8 mu_r8, mu_k8, mu_v8, mu_w8, mu_a8; f32x2 w0r[4], a0r[4], kkr[4], kar[4], omk[4], rkr[4];
#pragma unroll
        for (int e = 0; e < 8; ++e) { mu_r8[e] = (h16)mu[64 * h + c8 + e]; mu_k8[e] = (h16)mu[1024 + 64 * h + c8 + e]; mu_v8[e] = (h16)mu[2048 + 64 * h + c8 + e]; mu_w8[e] = (h16)mu[3072 + c8 + e]; mu_a8[e] = (h16)mu[3136 + c8 + e];
            w0r[e >> 1][e & 1] = w0[c8 + e]; a0r[e >> 1][e & 1] = a0[c8 + e]; kkr[e >> 1][e & 1] = kkw[c8 + e]; kar[e >> 1][e & 1] = kaw[c8 + e]; omk[e >> 1][e & 1] = 1.f - kaw[c8 + e]; rkr[e >> 1][e & 1] = rkw[c8 + e]; }
        f32x2 S01 = {0.f, 0.f}, S23 = {0.f, 0.f};
        const int srow = 4 * (wave & 3) + (lane >> 4), j0 = 4 * (lane & 15);
        const h16x8 z8 = {0, 0, 0, 0, 0, 0, 0, 0};
        h16x8 pr, pk, pv, pw, pa, qr_, qk_, qv_, qw_, qa_;
        const h16 *pcA, *pcB, *ppA, *ppB;
        { const int t0_ = dir ? (SEQ - 1 - s_l) : s_l; pcA = PC + (size_t)(b * SEQ + t0_) * 3200 + c8 + 64 * h; pcB = pcA + 2048 - 64 * h;
          const long po_ = (s_l > 0) ? (dir ? 3200 : -3200) : 0; ppA = pcA + po_; ppB = pcB + po_; }
        const long cstride_ = dir ? -32 * 3200 : 32 * 3200;
#define SCAN_LOAD_RAW() do { \
            pr = *(const h16x8*)(pcA); pk = *(const h16x8*)(pcA + 1024); pv = *(const h16x8*)(pcB + 64 * h); pw = *(const h16x8*)(pcB + 1024); pa = *(const h16x8*)(pcB + 1088); \
            qr_ = *(const h16x8*)(ppA); qk_ = *(const h16x8*)(ppA + 1024); qv_ = *(const h16x8*)(ppB + 64 * h); qw_ = *(const h16x8*)(ppB + 1024); qa_ = *(const h16x8*)(ppB + 1088); \
            pcA += cstride_; pcB += cstride_; ppA = pcA + (dir ? 3200 : -3200); ppB = pcB + (dir ? 3200 : -3200); } while (0)
#define SCAN_LOAD(chn) SCAN_LOAD_RAW()
#define SCAN_YSTORE(chn) do { const int sg_ = (chn) * 32 + s_l; const int t_ = dir ? (SEQ - 1 - sg_) : sg_; \
            const f32x2 y2_ = *(const LAS f32x2*)(sYb + ((chn) & 1) * 512 + s_l * 16 + 2 * (lane & 7)); \
            typedef _Float16 h16x2_ __attribute__((ext_vector_type(2))); h16x2_ o_; o_[0] = (h16)y2_[0]; o_[1] = (h16)y2_[1]; \
            *(h16x2_*)(Yd + (size_t)(b * SEQ + t_) * 1024 + 64 * h + 16 * q + 2 * (lane & 7)) = o_; } while (0)
        if (wave >= 4) { SCAN_LOAD_RAW(); if (s_l == 0) { qr_ = z8; qk_ = z8; qv_ = z8; qw_ = z8; qa_ = z8; } }
        __syncthreads();
        for (int n = -1; n < SEQ / 32; ++n) {
            if (wave < 4) {
                if (n >= 0) {
                    __builtin_amdgcn_s_setprio(3);
                    const LAS float* sR = OPS + (n & 1) * SET_F + j0; const LAS float* sW = sR + 2048; const LAS float* sK = sW + 2048; const LAS float* sA = sK + 2048; const LAS float* sB = sA + 2048; const LAS float* sV = OPS + (n & 1) * SET_F + 10240;
                    LAS float* sY = sYb + (n & 1) * 512;
                    f32x4 a_ = *(const LAS f32x4*)(sA), w_ = *(const LAS f32x4*)(sW), b_ = *(const LAS f32x4*)(sB);
                    f32x4 k_ = *(const LAS f32x4*)(sK), r_ = *(const LAS f32x4*)(sR);
                    f32x4 vq[4];
#pragma unroll
                    for (int u = 0; u < 4; ++u) vq[u] = *(const LAS f32x4*)(sV + srow * 32 + 4 * u);
                    f32x4 rp = r_;
#pragma unroll
                    for (int hb = 0; hb < 2; ++hb) {
                        f32x4 vn[4];
#pragma unroll
                        for (int u = 0; u < 4; ++u) vn[u] = *(const LAS f32x4*)(sV + srow * 32 + ((16 * (hb + 1)) & 31) + 4 * u);
#pragma unroll
                        for (int u16 = 0; u16 < 16; ++u16) {
                            const int s = 16 * hb + u16;
                            const int sn = (s + 1) & 31;
                            const f32x4 a_n = *(const LAS f32x4*)(sA + sn * 64), w_n = *(const LAS f32x4*)(sW + sn * 64), b_n = *(const LAS f32x4*)(sB + sn * 64);
                            const f32x4 k_n = *(const LAS f32x4*)(sK + sn * 64), r_n = *(const LAS f32x4*)(sR + sn * 64);
                            const float v = vq[u16 >> 2][u16 & 3];
                            const f32x2 vv = {v, v};
                            f32x2 pp = S01 * (f32x2){a_[0], a_[1]}; pp = S23 * (f32x2){a_[2], a_[3]} + pp;
                            f32x2 yy = S01 * (f32x2){rp[0], rp[1]}; yy = S23 * (f32x2){rp[2], rp[3]} + yy;
                            float sa = pp[0] + pp[1], y = yy[0] + yy[1];
                            sa += dpp_f<0xB1>(sa); y += dpp_f<0xB1>(y);
                            sa += dpp_f<0x4E>(sa); y += dpp_f<0x4E>(y);
                            sa += dpp_f<0x141>(sa); y += dpp_f<0x141>(y);
                            sa += dpp_f<0x140>(sa); y += dpp_f<0x140>(y);
                            sY[((s - 1) & 31) * 16 + srow] = y;
                            const f32x2 sv = {sa, sa};
                            S01 = S01 * (f32x2){w_[0], w_[1]} + vv * (f32x2){k_[0], k_[1]};
                            S23 = S23 * (f32x2){w_[2], w_[3]} + vv * (f32x2){k_[2], k_[3]};
                            S01 = sv * (f32x2){b_[0], b_[1]} + S01;
                            S23 = sv * (f32x2){b_[2], b_[3]} + S23;
                            rp = r_;
                            a_ = a_n; w_ = w_n; b_ = b_n; k_ = k_n; r_ = r_n;
                        }
#pragma unroll
                        for (int u = 0; u < 4; ++u) vq[u] = vn[u];
                    }
                    { f32x2 yy = S01 * (f32x2){rp[0], rp[1]}; yy = S23 * (f32x2){rp[2], rp[3]} + yy; sY[31 * 16 + srow] = red16(yy[0] + yy[1]); }
                    __builtin_amdgcn_s_setprio(0);
                }
            } else {
                if (n + 1 < SEQ / 32) {
                    const int cn = n + 1;
                    const int sg = cn * 32 + s_l; const int t = dir ? (SEQ - 1 - sg) : sg;
                    f32x2 qr[4], qk[4]; float qv[8];
                    LAS h16* TWp = (LAS h16*)priv; LAS h16* QAp = TWp + 8 * 72;
                    { unsigned m1u_ = 0xBC00BC00u; asm volatile("" : "+s"(m1u_));
                      typedef unsigned u32x4_ __attribute__((ext_vector_type(4))); const u32x4_ m1v_ = {m1u_, m1u_, m1u_, m1u_}; const h16x8 m1_ = __builtin_bit_cast(h16x8, m1v_);
                      const h16x8 r8 = pr + mu_r8 * (pr * m1_ + qr_), k8 = pk + mu_k8 * (pk * m1_ + qk_), v8 = pv + mu_v8 * (pv * m1_ + qv_);
                      const h16x8 w8 = pw + mu_w8 * (pw * m1_ + qw_), a8 = pa + mu_a8 * (pa * m1_ + qa_);
                      h16x8 tw8;
#pragma unroll
                      for (int pi = 0; pi < 4; ++pi) { qr[pi] = (f32x2){(float)r8[2 * pi], (float)r8[2 * pi + 1]}; qk[pi] = (f32x2){(float)k8[2 * pi], (float)k8[2 * pi + 1]};
                          qv[2 * pi] = (float)v8[2 * pi]; qv[2 * pi + 1] = (float)v8[2 * pi + 1];
                          const f32x2 tx = (f32x2){(float)w8[2 * pi], (float)w8[2 * pi + 1]} * 2.8853900817779268f;
                          const f32x2 dn = (f32x2){__builtin_amdgcn_exp2f(tx[0]), __builtin_amdgcn_exp2f(tx[1])} + 1.f;
                          const f32x2 th = (f32x2){__builtin_amdgcn_rcpf(dn[0]), __builtin_amdgcn_rcpf(dn[1])} * -2.f + 1.f;
                          tw8[2 * pi] = (h16)th[0]; tw8[2 * pi + 1] = (h16)th[1]; }
                      *(LAS h16x8*)(TWp + s_sub * 72 + c8) = tw8; *(LAS h16x8*)(QAp + s_sub * 72 + c8) = a8; }
                    if (cn + 1 < SEQ / 32) SCAN_LOAD(cn + 1);
                    LDS_WAIT();
                    f32x4 accw[4], acca[4];
#pragma unroll
                    for (int ct = 0; ct < 4; ++ct) { accw[ct] = (f32x4){0.f, 0.f, 0.f, 0.f}; acca[ct] = (f32x4){0.f, 0.f, 0.f, 0.f}; }
#pragma unroll
                    for (int ks = 0; ks < 2; ++ks) {
                        const h16x8 atw = *(const LAS h16x8*)(TWp + (lane & 7) * 72 + 32 * ks + 8 * (lane >> 4));
                        const h16x8 aqa = *(const LAS h16x8*)(QAp + (lane & 7) * 72 + 32 * ks + 8 * (lane >> 4));
#pragma unroll
                        for (int ct = 0; ct < 4; ++ct) {
                            const h16x8 bw = *(const LAS h16x8*)(w2T + (16 * ct + (lane & 15)) * 72 + 32 * ks + 8 * (lane >> 4));
                            const h16x8 ba = *(const LAS h16x8*)(a2T + (16 * ct + (lane & 15)) * 72 + 32 * ks + 8 * (lane >> 4));
                            accw[ct] = __builtin_amdgcn_mfma_f32_16x16x32_f16(atw, bw, accw[ct], 0, 0, 0);
                            acca[ct] = __builtin_amdgcn_mfma_f32_16x16x32_f16(aqa, ba, acca[ct], 0, 0, 0);
                        }
                    }
                    LDS_WAIT();
                    { LAS float* Zd = (LAS float*)priv + (lane >> 5) * 512 + (4 * ((lane >> 4) & 1)) * 64 + (lane & 15);
#pragma unroll
                      for (int ct = 0; ct < 4; ++ct)
#pragma unroll
                          for (int r = 0; r < 4; ++r) Zd[r * 64 + 16 * ct] = (lane < 32) ? accw[ct][r] : acca[ct][r]; }
                    LDS_WAIT();
                    const LAS float* Zw = (const LAS float*)priv + s_sub * 64 + c8; const LAS float* Za = Zw + 512;
                    const f32x4 zw0 = *(const LAS f32x4*)Zw, zw1 = *(const LAS f32x4*)(Zw + 4), za0 = *(const LAS f32x4*)Za, za1 = *(const LAS f32x4*)(Za + 4);
                    LDS_WAIT();
                    f32x2 kk[4], av_[4], kp[4], dec[4], kn2 = {0.f, 0.f}, sb2 = {0.f, 0.f};
#pragma unroll
                    for (int pi = 0; pi < 4; ++pi) {
                        const f32x2 zw = (pi < 2 ? (f32x2){zw0[2 * pi], zw0[2 * pi + 1]} : (f32x2){zw1[2 * pi - 4], zw1[2 * pi - 3]}) + w0r[pi];
                        const f32x2 za = (pi < 2 ? (f32x2){za0[2 * pi], za0[2 * pi + 1]} : (f32x2){za1[2 * pi - 4], za1[2 * pi - 3]}) + a0r[pi];
                        const f32x2 tw_ = zw * -1.4426950408889634f, ta_ = za * -1.4426950408889634f;
                        const f32x2 dw = (f32x2){__builtin_amdgcn_exp2f(tw_[0]), __builtin_amdgcn_exp2f(tw_[1])} + 1.f, da = (f32x2){__builtin_amdgcn_exp2f(ta_[0]), __builtin_amdgcn_exp2f(ta_[1])} + 1.f;
                        const f32x2 sw = (f32x2){__builtin_amdgcn_rcpf(dw[0]), __builtin_amdgcn_rcpf(dw[1])} * -0.8750387749225136f;
                        dec[pi] = (f32x2){__builtin_amdgcn_exp2f(sw[0]), __builtin_amdgcn_exp2f(sw[1])};
                        av_[pi] = (f32x2){__builtin_amdgcn_rcpf(da[0]), __builtin_amdgcn_rcpf(da[1])};
                        kk[pi] = qk[pi] * kkr[pi]; kn2 = kk[pi] * kk[pi] + kn2;
                        kp[pi] = qk[pi] * (av_[pi] * kar[pi] + omk[pi]);
                        sb2 = (qr[pi] * kp[pi]) * rkr[pi] + sb2; }
                    const float kn = red8(kn2[0] + kn2[1]), sbn = red8(sb2[0] + sb2[1]);
                    const float ninv = -rsqrtf(fmaxf(kn, 1e-12f));
                    LAS float* dR = OPS + (cn & 1) * SET_F + s_l * 64 + c8;
#pragma unroll
                    for (int hf = 0; hf < 2; ++hf) {
                        const f32x2 na0 = kk[2 * hf] * ninv, na1 = kk[2 * hf + 1] * ninv;
                        const f32x2 nb0 = na0 * av_[2 * hf], nb1 = na1 * av_[2 * hf + 1];
                        *(LAS f32x4*)(dR + 4 * hf) = (f32x4){qr[2 * hf][0], qr[2 * hf][1], qr[2 * hf + 1][0], qr[2 * hf + 1][1]};
                        *(LAS f32x4*)(dR + 2048 + 4 * hf) = (f32x4){dec[2 * hf][0], dec[2 * hf][1], dec[2 * hf + 1][0], dec[2 * hf + 1][1]};
                        *(LAS f32x4*)(dR + 4096 + 4 * hf) = (f32x4){kp[2 * hf][0], kp[2 * hf][1], kp[2 * hf + 1][0], kp[2 * hf + 1][1]};
                        *(LAS f32x4*)(dR + 6144 + 4 * hf) = (f32x4){na0[0], na0[1], na1[0], na1[1]};
                        *(LAS f32x4*)(dR + 8192 + 4 * hf) = (f32x4){-nb0[0], -nb0[1], -nb1[0], -nb1[1]}; }
                    if ((c8 >> 4) == q) { LAS float* dV = OPS + (cn & 1) * SET_F + 10240 + (c8 & 15) * 32 + s_l;
#pragma unroll
                        for (int e = 0; e < 8; ++e) dV[e * 32] = qv[e]; }
                    if (q == 0 && (lane & 7) == 0) SB[(size_t)(b * SEQ + t) * 16 + h] = sbn;
                }
                if (n >= 1) SCAN_YSTORE(n - 1);
            }
            LDS_BAR();
        }
        if (wave >= 4) SCAN_YSTORE(SEQ / 32 - 1);
#undef SCAN_LOAD
#undef SCAN_LOAD_RAW
#undef SCAN_YSTORE
    }
}

__device__ __forceinline__ void phase_post(const Params& p) {
    const int tid = threadIdx.x;
    const h16* Y0 = (const h16*)p.out; const h16* Y1 = (const h16*)((const unsigned char*)p.out + 32 * MiB);
    const h16* PC = (const h16*)(p.ws + WS_PC); h16* ZCD = (h16*)(p.ws + WS_ZCD);
    const float* SB0 = (const float*)(p.ws + WS_SBON); const float* SB1 = SB0 + (size_t)NTOK * 16;
    const float* mu0 = p.in[11] + 2048; const float* mu1 = p.in[11] + 3200 + 2048;
    const float* lg = p.in[19]; const float* lb = p.in[20];
    const int gt = blockIdx.x * 512 + tid, NGT = gridDim.x * 512;
    for (int idx = gt; idx < NTOK * 128; idx += NGT) {
        const int t = idx >> 7, c = (idx & 127) * 8, hh = c >> 6, tp = t & (SEQ - 1);
        const h16x8 y0 = *(const h16x8*)(Y0 + (size_t)t * 1024 + c), y1 = *(const h16x8*)(Y1 + (size_t)t * 1024 + c);
        const h16x8 z8 = {0, 0, 0, 0, 0, 0, 0, 0};
        const h16x8 v0 = *(const h16x8*)(PC + (size_t)t * 3200 + 2048 + c);
        const h16x8 vm = tp > 0 ? *(const h16x8*)(PC + (size_t)(t - 1) * 3200 + 2048 + c) : z8;
        const h16x8 vp = tp < SEQ - 1 ? *(const h16x8*)(PC + (size_t)(t + 1) * 3200 + 2048 + c) : z8;
        const h16x8 zc = *(const h16x8*)(ZCD + (size_t)t * 1536 + c);
        const float s0 = SB0[(size_t)t * 16 + hh], s1 = SB1[(size_t)t * 16 + hh];
        float y[8], s = 0.f;
#pragma unroll
        for (int e = 0; e < 8; ++e) { y[e] = (float)y0[e] + (float)y1[e]; s += y[e]; }
        const float mean = red8(s) * (1.f / 64.f); float q = 0.f;
#pragma unroll
        for (int e = 0; e < 8; ++e) { y[e] -= mean; q += y[e] * y[e]; }
        const float rs = rsqrtf(red8(q) * (1.f / 64.f) + 64e-5f);
        const f32x4 lg0 = *(const f32x4*)(lg + c), lg1 = *(const f32x4*)(lg + c + 4), lb0 = *(const f32x4*)(lb + c), lb1 = *(const f32x4*)(lb + c + 4);
        const f32x4 ma0 = *(const f32x4*)(mu0 + c), ma1 = *(const f32x4*)(mu0 + c + 4), mb0 = *(const f32x4*)(mu1 + c), mb1 = *(const f32x4*)(mu1 + c + 4);
        h16x8 o;
#pragma unroll
        for (int e = 0; e < 8; ++e) { const float vv = (float)v0[e];
            const float m0 = e < 4 ? ma0[e & 3] : ma1[e & 3], m1 = e < 4 ? mb0[e & 3] : mb1[e & 3], gg = e < 4 ? lg0[e & 3] : lg1[e & 3], bb = e < 4 ? lb0[e & 3] : lb1[e & 3];
            const float vd0 = vv + m0 * ((float)vm[e] - vv), vd1 = vv + m1 * ((float)vp[e] - vv);
            const float val = y[e] * rs * gg + bb + s0 * vd0 + s1 * vd1;
            o[e] = (h16)(val * silu_f((float)zc[e])); }
        *(h16x8*)(ZCD + (size_t)t * 1536 + c) = o;
    }
}

__device__ __forceinline__ void phase_final(const Params& p) {
    const int tid = threadIdx.x, lane = tid & 63, wave = tid >> 6;
    const int gw = blockIdx.x * 8 + wave, NGW = gridDim.x * 8;
    const float* g = p.in[23]; const h16* O1 = (const h16*)(p.ws + WS_O1); const h16* O2 = (const h16*)(p.ws + WS_O2);
    for (int r = gw; r < NTOK; r += 2 * NGW) {
        const int rr[2] = {r, (r + NGW < NTOK) ? r + NGW : r};
        f32x4 v[2][4]; h16x4 a[2][4], b[2][4]; float ss[2] = {0.f, 0.f};
#pragma unroll
        for (int u = 0; u < 2; ++u)
#pragma unroll
            for (int j = 0; j < 4; ++j) { const size_t o = (size_t)rr[u] * DM + 4 * lane + 256 * j; v[u][j] = *(const f32x4*)(p.in[0] + o); a[u][j] = *(const h16x4*)(O1 + o); b[u][j] = *(const h16x4*)(O2 + o); }
#pragma unroll
        for (int u = 0; u < 2; ++u)
#pragma unroll
            for (int j = 0; j < 4; ++j) {
#pragma unroll
                for (int e = 0; e < 4; ++e) v[u][j][e] += (float)a[u][j][e] + (float)b[u][j][e];
                ss[u] += v[u][j][0] * v[u][j][0] + v[u][j][1] * v[u][j][1] + v[u][j][2] * v[u][j][2] + v[u][j][3] * v[u][j][3]; }
#pragma unroll
        for (int o = 1; o < 64; o <<= 1) { ss[0] += __shfl_xor(ss[0], o); ss[1] += __shfl_xor(ss[1], o); }
        const float rs[2] = {rsqrtf(ss[0] * (1.f / 1024.f) + 1e-6f), rsqrtf(ss[1] * (1.f / 1024.f) + 1e-6f)};
#pragma unroll
        for (int j = 0; j < 4; ++j) { const f32x4 gg = *(const f32x4*)(g + 4 * lane + 256 * j);
#pragma unroll
            for (int u = 0; u < 2; ++u) { f32x4 o = v[u][j] * rs[u]; o = o * gg; *(f32x4*)(p.out + (size_t)rr[u] * DM + 4 * lane + 256 * j) = o; } }
    }
}

__global__ void __launch_bounds__(512, 2) mega(Params p) {
    extern __shared__ __attribute__((aligned(16))) unsigned char smem[];
    LAS unsigned char* lds = (LAS unsigned char*)smem;
    cg::grid_group grid = cg::this_grid();
    unsigned char* ws = p.ws;
    const int lo = p.ph_lo, hi = p.ph_hi;
#define IN(k) (lo <= (k) && (k) < hi)
    volatile LAS unsigned* bst = (volatile LAS unsigned*)(lds + LDS_MAIN);
    if (threadIdx.x < 4) bst[threadIdx.x] = 0u;
    __syncthreads();
    const XcdBarrier bar = xcd_barrier_post((unsigned*)(ws + WS_BAR), bst);
    if (hi > 1000) grid.sync();
#define SEAM(k) do { if (IN(k) && IN((k) + 1)) { xcd_barrier(bar); if ((REPMASK >> 13) & 1) xcd_barrier(bar); } } while (0)
    if (IN(0)) for (int rep_ = 0; rep_ <= ((REPMASK >> 0) & 1); ++rep_) { phase0(p, lds); } SEAM(0);
    if (IN(1)) for (int rep_ = 0; rep_ <= ((REPMASK >> 1) & 1); ++rep_) { pg8::Gemm g{(const h16*)p.out, (const h16*)(ws + WS_W1T), NTOK, 7168, 1024}; pg8::StaticOrder S; S.init(NTOK, 7168, gridDim.x, blockIdx.x);
                 Epi1 E{(h16*)(ws + WS_XC), (h16*)(ws + WS_G), (h16*)(ws + WS_U), (h16*)(ws + WS_V), (float*)(ws + WS_STATS)}; pg8::gemm_phase<Epi1>(lds, g, S, E); } SEAM(1);
    if (IN(3)) for (int rep_ = 0; rep_ <= ((REPMASK >> 3) & 1); ++rep_) { phase_mix0(p, lds); } SEAM(3);
    if (IN(4)) for (int rep_ = 0; rep_ <= ((REPMASK >> 4) & 1); ++rep_) { pg8::Gemm g{(const h16*)(ws + WS_YCAT), (const h16*)(ws + WS_W2T), NTOK, 1024, 2048}; pg8::StaticOrder S; S.init(NTOK, 1024, gridDim.x, blockIdx.x);
                 Epi2 E{(h16*)(ws + WS_O1)}; pg8::gemm_phase<Epi2>(lds, g, S, E); } SEAM(4);
    if (IN(5)) for (int rep_ = 0; rep_ <= ((REPMASK >> 5) & 1); ++rep_) { phase_norm1(p); } SEAM(5);
    if (IN(6)) for (int rep_ = 0; rep_ <= ((REPMASK >> 6) & 1); ++rep_) { pg8::Gemm g{(const h16*)p.out, (const h16*)(ws + WS_W3T), NTOK, 5376, 1024}; pg8::StaticOrder S; S.init(NTOK, 5376, gridDim.x, blockIdx.x);
                 Epi3 E{(h16*)(ws + WS_PC), (h16*)(ws + WS_ZCD), (h16*)(ws + WS_FD)}; pg8::gemm_phase<Epi3>(lds, g, S, E); } SEAM(6);
    if (IN(7)) for (int rep_ = 0; rep_ <= ((REPMASK >> 7) & 1); ++rep_) { phase_fft(p, lds); }
    if (IN(8)) for (int rep_ = 0; rep_ <= ((REPMASK >> 8) & 1); ++rep_) { phase_scan(p, lds); } SEAM(8);
    if (IN(9)) for (int rep_ = 0; rep_ <= ((REPMASK >> 9) & 1); ++rep_) { phase_fnet_out(p, lds); }
    if (IN(10)) for (int rep_ = 0; rep_ <= ((REPMASK >> 10) & 1); ++rep_) { phase_post(p); } SEAM(10);
    if (IN(11)) for (int rep_ = 0; rep_ <= ((REPMASK >> 11) & 1); ++rep_) { pg8::Gemm g{(const h16*)(ws + WS_ZCD), (const h16*)(ws + WS_W4T), NTOK, 1024, 1536}; pg8::StaticOrder S; S.init(NTOK, 1024, gridDim.x, blockIdx.x);
                  Epi4 E{(h16*)(ws + WS_O2)}; pg8::gemm_phase<Epi4>(lds, g, S, E); } SEAM(11);
    if (IN(12)) for (int rep_ = 0; rep_ <= ((REPMASK >> 12) & 1); ++rep_) { phase_final(p); }
}

extern "C" void kernel_launch(void* const* d_in, const int* in_sizes, int n_in, void* d_out, int out_size, void* d_ws, size_t ws_size, hipStream_t stream) {
    static int grid = 0;
    if (grid == 0) {
        int dev = 0, cus = 0, per_cu = 0;
        hipGetDevice(&dev);
        hipDeviceGetAttribute(&cus, hipDeviceAttributeMultiprocessorCount, dev);
        if (hipFuncSetAttribute((const void*)mega, hipFuncAttributeMaxDynamicSharedMemorySize, LDS_BYTES) != hipSuccess) fprintf(stderr, "kernel_launch: hipFuncSetAttribute failed\n");
        hipOccupancyMaxActiveBlocksPerMultiprocessor(&per_cu, (const void*)mega, 512, LDS_BYTES);
        if (per_cu < 1) { fprintf(stderr, "kernel_launch: occupancy query says %d blocks per CU\n", per_cu); per_cu = 1; }
        (void)hipGetLastError();
        grid = cus;
        if (grid < 64) grid = 64;
    }
    if (hipMemsetAsync((unsigned char*)d_ws + WS_BAR, 0, XCD_BAR_WORDS * 4, stream) != hipSuccess) fprintf(stderr, "kernel_launch: memset of the barrier words failed\n");
    Params p{};
    for (int i = 0; i < 24; ++i) p.in[i] = (const float*)d_in[i];
    p.out = (float*)d_out; p.ws = (unsigned char*)d_ws;
#if N_LAUNCH_MODE == 1
    p.ph_lo = 0; p.ph_hi = NPHASE;
    void* args[] = {&p};
    hipError_t e = hipLaunchCooperativeKernel((const void*)mega, dim3(grid), dim3(512), args, LDS_BYTES, stream);
    if (e != hipSuccess) fprintf(stderr, "kernel_launch: cooperative launch failed: %s (grid %d)\n", hipGetErrorString(e), grid);
#else
    for (int ph = 0; ph < NPHASE; ++ph) { p.ph_lo = ph; p.ph_hi = ph + 1; hipLaunchKernelGGL(mega, dim3(grid), dim3(512), LDS_BYTES, stream, p); }
#endif
}
```

```cpp
#include <hip/hip_runtime.h>
#include <hip/hip_cooperative_groups.h>
#include <cstdio>
#include <cstdint>
namespace cg = cooperative_groups;

#ifndef N_LAUNCH_MODE
#define N_LAUNCH_MODE 1
#endif

#ifndef REPMASK
#define REPMASK 0
#endif
#define LAS __attribute__((address_space(3)))
typedef _Float16 h16;
typedef _Float16 h16x8 __attribute__((ext_vector_type(8)));
typedef _Float16 h16x4 __attribute__((ext_vector_type(4)));
typedef float f32x2 __attribute__((ext_vector_type(2)));
typedef float f32x4 __attribute__((ext_vector_type(4)));
typedef float f32x16 __attribute__((ext_vector_type(16)));

constexpr int NTOK = 16384, DM = 1024, SEQ = 8192;
constexpr int LDS_MAIN = 131072;
constexpr int LDS_BYTES = LDS_MAIN + 16;
constexpr int NPHASE = 13;
constexpr size_t MiB = 1024 * 1024;
constexpr size_t WS_W1T = 0;
constexpr size_t WS_W2T = WS_W1T + (size_t)7168 * 1024 * 2;
constexpr size_t WS_W3T = WS_W2T + (size_t)1024 * 2048 * 2;
constexpr size_t WS_W4T = WS_W3T + (size_t)5376 * 1024 * 2;
constexpr size_t WS_STATS = 32 * MiB;
constexpr size_t WS_WSH = WS_STATS + 131072;
constexpr size_t WS_CWT = WS_WSH + 262144;
constexpr size_t WS_SBON = WS_CWT + 262144;
constexpr size_t WS_BAR = 35 * MiB;
constexpr size_t WS_XC = 36 * MiB, WS_G = 68 * MiB, WS_U = 100 * MiB, WS_V = 132 * MiB, WS_YCAT = 164 * MiB;
constexpr size_t WS_SPR = 0, WS_SPI = 232 * MiB;
constexpr size_t WS_O2 = 68 * MiB;
constexpr size_t WS_O1 = 36 * MiB, WS_PC = 68 * MiB, WS_ZCD = 168 * MiB, WS_FD = 216 * MiB;

namespace pg8 {
constexpr int BM = 256, BK = 64, HALF = 128, HTB = HALF * BK * 2, STAGE_BYTES = 8 * HTB, NXCD = 8, WGM = 8;
__host__ __device__ __forceinline__ int lds_byte(int r, int c) { const int st = (r >> 4) * 2 + (c >> 5), rr = r & 15, cc = c & 31, ob = rr * 64 + cc * 2; return st * 1024 + (ob ^ (((ob >> 9) & 1) << 5)); }
__host__ __device__ __forceinline__ void stage_rc(int b, int& R, int& C) { const int st = b / 1024, sb = b % 1024, swz = sb ^ (((sb >> 9) & 1) << 5); R = (st >> 1) * 16 + swz / 64; C = (st & 1) * 32 + (swz % 64) / 2; }
__host__ __device__ __forceinline__ int perm32(int rho) { const int n = rho >> 4, i = rho & 15; return 8 * (i >> 2) + 4 * n + (i & 3); }
struct Unit { int pm, pn; };
struct Gemm { const h16* A; const h16* Bt; int M, N, K; };
struct StaticOrder {
    int nM, nN, nwg, G, c;
    __host__ __device__ void init(int M, int N, int G_, int c_) { nM = M / BM; nN = N / BM; nwg = nM * nN; G = G_; c = c_; }
    __host__ __device__ bool next(int i, Unit& u) const {
        const long L = (long)i * G + c; if (L >= nwg) return false;
        int wgid = (int)L; { const int q = nwg / NXCD, r = nwg % NXCD, xcd = wgid % NXCD, off = wgid / NXCD; wgid = (xcd < r ? xcd * (q + 1) : r * (q + 1) + (xcd - r) * q) + off; }
        const int nig = WGM * nN, gid = wgid / nig, fm = gid * WGM, gsz = (nM - fm) < WGM ? (nM - fm) : WGM;
        u.pm = fm + ((wgid % nig) % gsz); u.pn = (wgid % nig) / gsz; return true;
    }
};
template <class Epi>
__device__ __forceinline__ void gemm_phase(LAS unsigned char* lds, const Gemm g, const StaticOrder& S, const Epi& E) {
    const int tid = threadIdx.x, wid = __builtin_amdgcn_readfirstlane(tid >> 6), lane = tid & 63, wr = wid >> 2, wc = wid & 3, fr = lane & 15, fq = lane >> 4;
    const int K = g.K, nt = K / BK;
    unsigned voffA[2], voffB[2];
#pragma unroll
    for (int i = 0; i < 2; ++i) { int R, C; stage_rc(tid * 16 + i * 8192, R, C); const int Rb = Epi::PERM ? ((R & ~31) + perm32(R & 31)) : R; voffA[i] = (unsigned)(R * K + C) * 2u; voffB[i] = (unsigned)(Rb * K + C) * 2u; }
    const size_t kstep = (size_t)(BK * 2);
    const size_t hstep = (size_t)HALF * K * 2;
    const size_t tstep = 2 * hstep;
    const unsigned ldsw = (unsigned)wid * 1024u;
    const int aoff = lds_byte(wr * 64 + fr, fq * 8), boff = lds_byte(wc * 32 + fr, fq * 8);
#define PG8_SA(b, h) (((b) * 2 + (h)) * HTB)
#define PG8_SB(b, h) ((4 + (b) * 2 + (h)) * HTB)
#define PG8_STAGE(bufoff, gbase, voff) do { _Pragma("unroll") for (int _i = 0; _i < 2; ++_i) \
        __builtin_amdgcn_global_load_lds((const unsigned*)((const char*)(gbase) + (voff)[_i]), (LAS unsigned*)(lds + (bufoff) + ldsw + _i * 8192), 16, 0, 0); } while (0)
#define PG8_LDA(dst, b, h) do { _Pragma("unroll") for (int m = 0; m < 4; ++m) _Pragma("unroll") for (int k = 0; k < 2; ++k) dst[m][k] = *(const LAS h16x8*)(lds + PG8_SA(b, h) + aoff + m * 2048 + k * 1024); } while (0)
#define PG8_LDB(dst, b, h) do { _Pragma("unroll") for (int n = 0; n < 2; ++n) _Pragma("unroll") for (int k = 0; k < 2; ++k) dst[n][k] = *(const LAS h16x8*)(lds + PG8_SB(b, h) + boff + n * 2048 + k * 1024); } while (0)
#define PG8_MMA(ai, bj, At, Bt) do { __builtin_amdgcn_s_setprio(1); _Pragma("unroll") for (int m = 0; m < 4; ++m) _Pragma("unroll") for (int n = 0; n < 2; ++n) _Pragma("unroll") for (int k = 0; k < 2; ++k) \
        acc[ai][bj][m][n] = __builtin_amdgcn_mfma_f32_16x16x32_f16(Bt[n][k], At[m][k], acc[ai][bj][m][n], 0, 0, 0); __builtin_amdgcn_s_setprio(0); } while (0)
#define PG8_WAIT_V(n) asm volatile("s_waitcnt vmcnt(" #n ")" ::: "memory")
#define PG8_WAIT_L(n) asm volatile("s_waitcnt lgkmcnt(" #n ")" ::: "memory")
#define PG8_BAR __builtin_amdgcn_s_barrier()
#define PG8_SCHED __builtin_amdgcn_sched_barrier(0)
    Unit cur, nxt; int ui = 0;
    if (!S.next(0, cur)) return;
    f32x4 acc[2][2][4][2];
#pragma unroll
    for (int a = 0; a < 2; ++a)
#pragma unroll
        for (int b = 0; b < 2; ++b)
#pragma unroll
            for (int m = 0; m < 4; ++m)
#pragma unroll
                for (int n = 0; n < 2; ++n) acc[a][b][m][n] = (f32x4){0.f, 0.f, 0.f, 0.f};
    h16x8 At[4][2], B0[2][2], B1[2][2];
    const char* cA = (const char*)g.A + (size_t)cur.pm * tstep; const char* cB = (const char*)g.Bt + (size_t)cur.pn * tstep;
    PG8_STAGE(PG8_SB(0, 0), cB, voffB); PG8_STAGE(PG8_SA(0, 0), cA, voffA); PG8_STAGE(PG8_SB(0, 1), cB + hstep, voffB); PG8_STAGE(PG8_SA(0, 1), cA + hstep, voffA);
    if (wr == 1) PG8_BAR;
    PG8_WAIT_V(4); PG8_BAR;
    PG8_STAGE(PG8_SB(1, 0), cB + kstep, voffB); PG8_STAGE(PG8_SA(1, 0), cA + kstep, voffA); PG8_STAGE(PG8_SB(1, 1), cB + hstep + kstep, voffB);
    PG8_WAIT_V(6); PG8_BAR;
    for (;;) {
        const bool has_next = S.next(ui + 1, nxt);
        const char* nA = has_next ? (const char*)g.A + (size_t)nxt.pm * tstep : cA; const char* nB = has_next ? (const char*)g.Bt + (size_t)nxt.pn * tstep : cB;
        for (int t = 0; t < nt; t += 2) {
            const bool last = (t == nt - 2);
            const char* a1 = cA + (size_t)(t + 1) * kstep;
            const char* a2 = last ? nA : cA + (size_t)(t + 2) * kstep; const char* b2 = last ? nB : cB + (size_t)(t + 2) * kstep;
            const char* a3 = a2 + kstep; const char* b3 = b2 + kstep;
            PG8_LDB(B0, 0, 0); PG8_SCHED; PG8_LDA(At, 0, 0); PG8_STAGE(PG8_SA(1, 1), a1 + hstep, voffA);
            PG8_WAIT_L(8); PG8_BAR; PG8_WAIT_L(0); PG8_MMA(0, 0, At, B0); PG8_BAR; PG8_SCHED;
            PG8_LDB(B1, 0, 1); PG8_STAGE(PG8_SB(0, 0), b2, voffB);
            PG8_BAR; PG8_WAIT_L(0); PG8_MMA(0, 1, At, B1); PG8_BAR;
            PG8_LDA(At, 0, 1); PG8_STAGE(PG8_SA(0, 0), a2, voffA);
            PG8_BAR; PG8_WAIT_L(0); PG8_MMA(1, 0, At, B0); PG8_BAR; PG8_SCHED;
            PG8_STAGE(PG8_SB(0, 1), b2 + hstep, voffB);
            PG8_WAIT_V(6); PG8_BAR; PG8_MMA(1, 1, At, B1); PG8_BAR;
            PG8_LDB(B0, 1, 0); PG8_SCHED; PG8_LDA(At, 1, 0); PG8_STAGE(PG8_SA(0, 1), a2 + hstep, voffA);
            PG8_WAIT_L(8); PG8_BAR; PG8_WAIT_L(0); PG8_MMA(0, 0, At, B0); PG8_BAR; PG8_SCHED;
            PG8_LDB(B1, 1, 1); PG8_STAGE(PG8_SB(1, 0), b3, voffB);
            PG8_BAR; PG8_WAIT_L(0); PG8_MMA(0, 1, At, B1); PG8_BAR;
            PG8_LDA(At, 1, 1); PG8_STAGE(PG8_SA(1, 0), a3, voffA);
            PG8_BAR; PG8_WAIT_L(0); PG8_MMA(1, 0, At, B0); PG8_BAR; PG8_SCHED;
            PG8_STAGE(PG8_SB(1, 1), b3 + hstep, voffB);
            PG8_WAIT_V(6); PG8_BAR; PG8_MMA(1, 1, At, B1); PG8_BAR;
        }
        E(acc, cur, wr, wc, fr, fq);
        if (!has_next) break;
#pragma unroll
        for (int a = 0; a < 2; ++a)
#pragma unroll
            for (int b = 0; b < 2; ++b)
#pragma unroll
                for (int m = 0; m < 4; ++m)
#pragma unroll
                    for (int n = 0; n < 2; ++n) acc[a][b][m][n] = (f32x4){0.f, 0.f, 0.f, 0.f};
        cur = nxt; cA = nA; cB = nB; ++ui;
    }
    PG8_WAIT_V(0);
    if (wr == 0) PG8_BAR;
    PG8_BAR;
#undef PG8_SA
#undef PG8_SB
#undef PG8_STAGE
#undef PG8_LDA
#undef PG8_LDB
#undef PG8_MMA
#undef PG8_WAIT_V
#undef PG8_WAIT_L
#undef PG8_BAR
#undef PG8_SCHED
}
}


#define XB_TMO      128
#define XB_XCNT(j)  (256  + 64 * (j))
#define XB_XSUB(j)  (1280 + 64 * (j))
#define XB_XGEN(j)  (2304 + 64 * (j))
#define XB_TOP      3328
#define XB_TOPGEN   3392
#define XCD_BAR_WORDS 3456
#define XB_SPIN_CAP (1u << 18)
__device__ __forceinline__ unsigned xb_ld(unsigned* p)              { return __hip_atomic_load(p, __ATOMIC_RELAXED, __HIP_MEMORY_SCOPE_AGENT); }
__device__ __forceinline__ unsigned xb_add(unsigned* p, unsigned v) { return __hip_atomic_fetch_add(p, v, __ATOMIC_RELAXED, __HIP_MEMORY_SCOPE_AGENT); }
__device__ __forceinline__ unsigned xb_xcc_id() { return (unsigned)__builtin_amdgcn_s_getreg((3 << 11) | 20) & 0xFu; }
#define XB_SPIN(cond, bar) do { unsigned _sp = 0; while (cond) { __builtin_amdgcn_s_sleep(1); \
    if ((++_sp & 255u) == 0u) { if (xb_ld(&(bar)[XB_TMO])) break; if (_sp > XB_SPIN_CAP) { atomicAdd(&(bar)[XB_TMO], 1u); break; } } } } while (0)
struct XcdBarrier { unsigned* bar; unsigned x; volatile LAS unsigned* st; };
__device__ __forceinline__ XcdBarrier xcd_barrier_post(unsigned* bar, volatile LAS unsigned* st) {
    XcdBarrier b; b.bar = bar; b.x = xb_xcc_id(); b.st = st;
    if (threadIdx.x == 0) (void)xb_add(&bar[XB_XCNT(b.x)], 1u);
    return b;
}
__device__ __forceinline__ void xcd_barrier_complete(unsigned* bar, unsigned x, unsigned& nloc, unsigned& nx) {
    const unsigned G = gridDim.x * gridDim.y * gridDim.z;
    unsigned sum, cnt, mine, sp = 0u;
    for (;;) {
        sum = 0u; cnt = 0u; mine = 0u;
#pragma unroll
        for (unsigned j = 0; j < 16; ++j) { const unsigned c = xb_ld(&bar[XB_XCNT(j)]); sum += c; cnt += (c > 0u) ? 1u : 0u; mine = (j == x) ? c : mine; }
        if (sum == G) break;
        __builtin_amdgcn_s_sleep(1);
        if ((++sp & 255u) == 0u) { if (xb_ld(&bar[XB_TMO])) break; if (sp > XB_SPIN_CAP) { atomicAdd(&bar[XB_TMO], 1u); break; } }
    }
    nloc = mine > 0u ? mine : 1u; nx = cnt > 0u ? cnt : 1u;
}
__device__ __forceinline__ void xcd_barrier(const XcdBarrier& b) {
    asm volatile("s_waitcnt vmcnt(0)" ::: "memory");
    __syncthreads();
    if (threadIdx.x == 0) {
        unsigned* bar = b.bar;
        __builtin_amdgcn_s_waitcnt(0);
        unsigned nloc = b.st[0], nx = b.st[1];
        if (nloc == 0u) { xcd_barrier_complete(bar, b.x, nloc, nx); b.st[0] = nloc; b.st[1] = nx; }
        const unsigned old = xb_add(&bar[XB_XSUB(b.x)], 1u);
        const unsigned gen = old / nloc;
        if (old + 1u == (gen + 1u) * nloc) {
            __builtin_amdgcn_fence(__ATOMIC_RELEASE, "agent");
            asm volatile("s_waitcnt vmcnt(0)" ::: "memory");
            const unsigned og = xb_add(&bar[XB_TOP], 1u);
            const unsigned tg = og / nx;
            if (og + 1u == (tg + 1u) * nx) xb_add(&bar[XB_TOPGEN], 1u);
            else XB_SPIN(xb_ld(&bar[XB_TOPGEN]) == tg, bar);
            __builtin_amdgcn_fence(__ATOMIC_ACQUIRE, "agent");
            xb_add(&bar[XB_XGEN(b.x)], 1u);
            asm volatile("s_waitcnt vmcnt(0)" ::: "memory");
        } else {
            XB_SPIN(xb_ld(&bar[XB_XGEN(b.x)]) == gen, bar);
            __builtin_amdgcn_fence(__ATOMIC_ACQUIRE, "agent");
            asm volatile("s_waitcnt vmcnt(0)" ::: "memory");
        }
    }
    __syncthreads();
}

struct Params { const float* in[24]; float* out; unsigned char* ws; int ph_lo, ph_hi; };

__device__ __forceinline__ float silu_f(float x) { return x * __builtin_amdgcn_rcpf(1.f + __expf(-x)); }
__device__ __forceinline__ float sigmoid_f(float x) { return __builtin_amdgcn_rcpf(1.f + __expf(-x)); }
__device__ __forceinline__ float tanh_f(float x) { return 1.f - 2.f * __builtin_amdgcn_rcpf(__expf(2.f * x) + 1.f); }
__device__ __forceinline__ float wave_sum(float v) {
#pragma unroll
    for (int o = 1; o < 64; o <<= 1) v += __shfl_xor(v, o);
    return v;
}
template <int CTRL> __device__ __forceinline__ float dpp_f(float x) { return __int_as_float(__builtin_amdgcn_update_dpp(0, __float_as_int(x), CTRL, 0xf, 0xf, false)); }
__device__ __forceinline__ float red8(float x) {
    x += dpp_f<0xB1>(x); x += dpp_f<0x4E>(x); x += dpp_f<0x141>(x); return x;
}
__device__ __forceinline__ float red16(float x) {
    x += dpp_f<0xB1>(x); x += dpp_f<0x4E>(x); x += dpp_f<0x141>(x); x += dpp_f<0x140>(x); return x;
}

__device__ __forceinline__ int sigma1(int np) {
    const int T = np >> 8, c = np & 255;
    if (T < 16) { const int bj = c >> 7, wc = (c >> 5) & 3, fq = (c >> 3) & 3, n = (c >> 2) & 1, e = c & 3; return 1024 * (2 * bj + n) + 64 * T + 16 * wc + 4 * fq + e; }
    if (T < 24) { return ((c >> 7) ? 6144 : 4096) + 128 * (T - 16) + (c & 127); }
    return 5120 + 256 * (T - 24) + c;
}

template <int MODE>
__device__ __forceinline__ void tr_item(const float* W, int K, int N, h16* WT, LAS float* scr, int item, int nblk, int lane) {
    const int kb = item / nblk, nb = item % nblk, k0 = 64 * kb, n0 = 32 * nb;
    const int np = n0 + (lane & 31);
    const int sc = (MODE == 1) ? sigma1(np) : np;
    const bool valid = (MODE != 2) || (np < 5248);
    float wv_[32];
#pragma unroll
    for (int i = 0; i < 32; ++i) { const int kk = 2 * i + (lane >> 5); wv_[i] = valid ? W[(size_t)(k0 + kk) * N + sc] : 0.f; }
#pragma unroll
    for (int i = 0; i < 32; ++i) { const int kk = 2 * i + (lane >> 5); scr[kk * 33 + (lane & 31)] = wv_[i]; }
    asm volatile("s_waitcnt lgkmcnt(0)" ::: "memory");
    const int c = lane & 7;
#pragma unroll
    for (int j = 0; j < 4; ++j) { const int n = (lane >> 3) + 8 * j; const LAS float* s = scr + (8 * c) * 33 + n;
        h16x8 o;
#pragma unroll
        for (int e = 0; e < 8; ++e) o[e] = (h16)s[e * 33];
        *(h16x8*)(WT + (size_t)(n0 + n) * K + k0 + 8 * c) = o; }
    asm volatile("s_waitcnt lgkmcnt(0)" ::: "memory");
}

__device__ __forceinline__ void rms_rows2_f16(const float* x0, const float* x1, const h16* ad0, const h16* ad1, const float* g, h16* or0, h16* or1, int lane) {
    f32x4 v[2][4]; h16x4 a[2][4]; float ss[2] = {0.f, 0.f};
#pragma unroll
    for (int j = 0; j < 4; ++j) { v[0][j] = *(const f32x4*)(x0 + 4 * lane + 256 * j); v[1][j] = *(const f32x4*)(x1 + 4 * lane + 256 * j);
        if (ad0) { a[0][j] = *(const h16x4*)(ad0 + 4 * lane + 256 * j); a[1][j] = *(const h16x4*)(ad1 + 4 * lane + 256 * j); } }
#pragma unroll
    for (int u = 0; u < 2; ++u)
#pragma unroll
        for (int j = 0; j < 4; ++j) {
            if (ad0) { v[u][j][0] += (float)a[u][j][0]; v[u][j][1] += (float)a[u][j][1]; v[u][j][2] += (float)a[u][j][2]; v[u][j][3] += (float)a[u][j][3]; }
            ss[u] += v[u][j][0] * v[u][j][0] + v[u][j][1] * v[u][j][1] + v[u][j][2] * v[u][j][2] + v[u][j][3] * v[u][j][3]; }
#pragma unroll
    for (int o = 1; o < 64; o <<= 1) { ss[0] += __shfl_xor(ss[0], o); ss[1] += __shfl_xor(ss[1], o); }
    const float rs0 = rsqrtf(ss[0] * (1.f / 1024.f) + 1e-6f), rs1 = rsqrtf(ss[1] * (1.f / 1024.f) + 1e-6f);
#pragma unroll
    for (int j = 0; j < 4; ++j) { const f32x4 gg = *(const f32x4*)(g + 4 * lane + 256 * j); h16x4 o0, o1;
#pragma unroll
        for (int e = 0; e < 4; ++e) { o0[e] = (h16)(v[0][j][e] * rs0 * gg[e]); o1[e] = (h16)(v[1][j][e] * rs1 * gg[e]); }
        *(h16x4*)(or0 + 4 * lane + 256 * j) = o0; *(h16x4*)(or1 + 4 * lane + 256 * j) = o1; }
}

__device__ __forceinline__ void phase0(const Params& p, LAS unsigned char* lds) {
    const int tid = threadIdx.x, lane = tid & 63, wave = tid >> 6;
    const int gw = blockIdx.x * 8 + wave, NGW = gridDim.x * 8;
    LAS float* scr = (LAS float*)(lds + wave * 8448);
    h16* W1T = (h16*)(p.ws + WS_W1T); h16* W2T = (h16*)(p.ws + WS_W2T); h16* W3T = (h16*)(p.ws + WS_W3T); h16* W4T = (h16*)(p.ws + WS_W4T);
    constexpr int I1 = 16 * 224, I2 = 32 * 32, I3 = 16 * 168, I4 = 24 * 32;
    for (int it = gw; it < I1 + I2 + I3 + I4; it += NGW) {
        int r = it;
        if (r < I1) { tr_item<1>(p.in[2], 1024, 7168, W1T, scr, r, 224, lane); continue; } r -= I1;
        if (r < I2) { tr_item<0>(p.in[8], 2048, 1024, W2T, scr, r, 32, lane); continue; } r -= I2;
        if (r < I3) { tr_item<2>(p.in[10], 1024, 5248, W3T, scr, r, 168, lane); continue; } r -= I3;
        tr_item<0>(p.in[22], 1536, 1024, W4T, scr, r, 32, lane);
    }
    h16* H0 = (h16*)p.out;
    for (int r = gw; r < NTOK; r += 2 * NGW) { const int r1 = (r + NGW < NTOK) ? r + NGW : r;
        rms_rows2_f16(p.in[0] + (size_t)r * DM, p.in[0] + (size_t)r1 * DM, nullptr, nullptr, p.in[1], H0 + (size_t)r * DM, H0 + (size_t)r1 * DM, lane); }
    const int gt = blockIdx.x * 512 + tid, NGT = gridDim.x * 512;
    h16* WSH = (h16*)(p.ws + WS_WSH);
    for (int i = gt; i < 8 * 128 * 128; i += NGT) WSH[i] = (h16)p.in[6][i];
    { float* STZ = (float*)(p.ws + WS_STATS); for (int i = gt; i < 2 * NTOK; i += NGT) STZ[i] = 0.f; }
    h16* CWT = (h16*)(p.ws + WS_CWT);
    const float* wf = p.in[21];
    for (int i = gt; i < 4 * 128 * 256; i += NGT) {
        const int k = i & 255, e = (i >> 8) & 127, g = i >> 15, d = k & 127; const bool sn = k >= 128;
        float s = 0.f;
        for (int dp = 0; dp < 128; ++dp) { const float fr = (float)((d * dp) & 127) * (1.f / 128.f);
            const float tw = sn ? __builtin_amdgcn_sinf(fr) : __builtin_amdgcn_cosf(fr);
            s += tw * wf[(g * 128 + dp) * 128 + e]; }
        CWT[i] = (h16)(s * 0.08838834764831845f);
    }
}

struct Epi1 {
    static constexpr bool PERM = true;
    h16 *XC, *G, *U, *V; float* st;
    __device__ __forceinline__ void operator()(const f32x4 (&acc)[2][2][4][2], const pg8::Unit& u, int wr, int wc, int fr, int fq) const {
        const int T = u.pn; const int row0 = u.pm * 256 + wr * 64 + fr;
        if (T < 16) {
            const int ch = 64 * T + 16 * wc + 4 * fq;
#pragma unroll
            for (int ai = 0; ai < 2; ++ai)
#pragma unroll
                for (int m = 0; m < 4; ++m) { const size_t r = (size_t)(row0 + ai * 128 + m * 16);
                    const f32x4 xa = acc[ai][0][m][0], ba = acc[ai][0][m][1], ca = acc[ai][1][m][0], za = acc[ai][1][m][1];
                    h16x4 xc, gg;
#pragma unroll
                    for (int e = 0; e < 4; ++e) { xc[e] = (h16)(ca[e] * xa[e]); gg[e] = (h16)(ba[e] * silu_f(za[e])); }
                    *(h16x4*)(XC + r * 1024 + ch) = xc; *(h16x4*)(G + r * 1024 + ch) = gg; }
        } else if (T < 24) {
            const int ch = 128 * (T - 16) + 32 * wc + 8 * fq;
#pragma unroll
            for (int ai = 0; ai < 2; ++ai)
#pragma unroll
                for (int m = 0; m < 4; ++m) { const size_t r = (size_t)(row0 + ai * 128 + m * 16); h16x8 o;
#pragma unroll
                    for (int n = 0; n < 2; ++n) { const f32x4 ub = acc[ai][0][m][n], zb = acc[ai][1][m][n];
#pragma unroll
                        for (int e = 0; e < 4; ++e) o[4 * n + e] = (h16)(ub[e] * silu_f(zb[e])); }
                    *(h16x8*)(U + r * 1024 + ch) = o; }
        } else {
#pragma unroll
            for (int ai = 0; ai < 2; ++ai)
#pragma unroll
                for (int m = 0; m < 4; ++m) { const size_t r = (size_t)(row0 + ai * 128 + m * 16); float s1 = 0.f, s2 = 0.f;
#pragma unroll
                    for (int bj = 0; bj < 2; ++bj) { const int ch = 256 * (T - 24) + 128 * bj + 32 * wc + 8 * fq; h16x8 o;
#pragma unroll
                        for (int n = 0; n < 2; ++n) { const f32x4 v = acc[ai][bj][m][n];
#pragma unroll
                            for (int e = 0; e < 4; ++e) { o[4 * n + e] = (h16)v[e]; const float f = (float)o[4 * n + e]; s1 += f; s2 += f * f; } }
                        *(h16x8*)(V + r * 1024 + ch) = o; }
                    s1 += __shfl_xor(s1, 16); s2 += __shfl_xor(s2, 16); s1 += __shfl_xor(s1, 32); s2 += __shfl_xor(s2, 32);
                    if (fq == 0) { atomicAdd(st + 2 * r, s1); atomicAdd(st + 2 * r + 1, s2); } }
        }
    }
};
struct Epi2 {
    static constexpr bool PERM = true;
    h16* O1;
    __device__ __forceinline__ void operator()(const f32x4 (&acc)[2][2][4][2], const pg8::Unit& u, int wr, int wc, int fr, int fq) const {
        const int row0 = u.pm * 256 + wr * 64 + fr, col0 = u.pn * 256 + wc * 32 + 8 * fq;
#pragma unroll
        for (int ai = 0; ai < 2; ++ai)
#pragma unroll
            for (int m = 0; m < 4; ++m) { const size_t r = (size_t)(row0 + ai * 128 + m * 16);
#pragma unroll
                for (int bj = 0; bj < 2; ++bj) { const f32x4 v0 = acc[ai][bj][m][0], v1 = acc[ai][bj][m][1]; h16x8 o;
#pragma unroll
                    for (int e = 0; e < 4; ++e) { o[e] = (h16)v0[e]; o[4 + e] = (h16)v1[e]; }
                    *(h16x8*)(O1 + r * 1024 + col0 + bj * 128) = o; } }
    }
};
struct Epi3 {
    static constexpr bool PERM = true;
    h16 *PC, *ZCD, *FD;
    __device__ __forceinline__ void operator()(const f32x4 (&acc)[2][2][4][2], const pg8::Unit& u, int wr, int wc, int fr, int fq) const {
        const int row0 = u.pm * 256 + wr * 64 + fr, col0 = u.pn * 256 + wc * 32 + 8 * fq;
#pragma unroll
        for (int bj = 0; bj < 2; ++bj) { const int c = col0 + bj * 128;
            h16* base; size_t ld;
            if (c < 3200) { base = PC + c; ld = 3200; }
            else if (c < 4224) { base = ZCD + (c - 3200); ld = 1536; }
            else if (c < 4736) {
                const int cg = (c - 4224) >> 2;
#pragma unroll
                for (int ai = 0; ai < 2; ++ai)
#pragma unroll
                    for (int m = 0; m < 4; ++m) { const size_t r = (size_t)(row0 + ai * 128 + m * 16); const f32x4 v0 = acc[ai][bj][m][0], v1 = acc[ai][bj][m][1]; h16x4 o0, o1;
#pragma unroll
                        for (int e = 0; e < 4; ++e) { o0[e] = (h16)v0[e]; o1[e] = (h16)v1[e]; }
                        *(h16x4*)(FD + ((size_t)cg * NTOK + r) * 4) = o0; *(h16x4*)(FD + ((size_t)(cg + 1) * NTOK + r) * 4) = o1; }
                continue; }
            else if (c < 5248) { base = ZCD + 1024 + (c - 4736); ld = 1536; }
            else continue;
#pragma unroll
            for (int ai = 0; ai < 2; ++ai)
#pragma unroll
                for (int m = 0; m < 4; ++m) { const size_t r = (size_t)(row0 + ai * 128 + m * 16); const f32x4 v0 = acc[ai][bj][m][0], v1 = acc[ai][bj][m][1]; h16x8 o;
#pragma unroll
                    for (int e = 0; e < 4; ++e) { o[e] = (h16)v0[e]; o[4 + e] = (h16)v1[e]; }
                    *(h16x8*)(base + r * ld) = o; } }
    }
};
struct Epi4 {
    static constexpr bool PERM = true;
    h16* O2;
    __device__ __forceinline__ void operator()(const f32x4 (&acc)[2][2][4][2], const pg8::Unit& u, int wr, int wc, int fr, int fq) const {
        const int row0 = u.pm * 256 + wr * 64 + fr, col0 = u.pn * 256 + wc * 32 + 8 * fq;
#pragma unroll
        for (int ai = 0; ai < 2; ++ai)
#pragma unroll
            for (int m = 0; m < 4; ++m) { const size_t r = (size_t)(row0 + ai * 128 + m * 16);
#pragma unroll
                for (int bj = 0; bj < 2; ++bj) { const f32x4 v0 = acc[ai][bj][m][0], v1 = acc[ai][bj][m][1]; h16x8 o;
#pragma unroll
                    for (int e = 0; e < 4; ++e) { o[e] = (h16)v0[e]; o[4 + e] = (h16)v1[e]; }
                    *(h16x8*)(O2 + r * 1024 + col0 + bj * 128) = o; } }
    }
};

__device__ __forceinline__ void phase_stats(const Params& p) {
    const int tid = threadIdx.x, lane = tid & 63, wave = tid >> 6;
    const int gw = blockIdx.x * 8 + wave, NGW = gridDim.x * 8;
    const h16* V = (const h16*)(p.ws + WS_V); float* ST = (float*)(p.ws + WS_STATS);
    for (int r = gw; r < NTOK; r += NGW) {
        const h16x8 a = *(const h16x8*)(V + (size_t)r * 1024 + 8 * lane), b = *(const h16x8*)(V + (size_t)r * 1024 + 512 + 8 * lane);
        float s = 0.f;
#pragma unroll
        for (int e = 0; e < 8; ++e) s += (float)a[e] + (float)b[e];
        const float mu = wave_sum(s) * (1.f / 1024.f); float q = 0.f;
#pragma unroll
        for (int e = 0; e < 8; ++e) { const float x = (float)a[e] - mu, y = (float)b[e] - mu; q += x * x + y * y; }
        const float rs = rsqrtf(wave_sum(q) * (1.f / 1024.f) + 1e-5f);
        if (lane == 0) { ST[2 * r] = mu; ST[2 * r + 1] = rs; }
    }
}

__device__ __forceinline__ void phase_mix0(const Params& p, LAS unsigned char* lds) {
    const int tid = threadIdx.x, lane = tid & 63, wave = tid >> 6;
    const h16* XC = (const h16*)(p.ws + WS_XC); const h16* G = (const h16*)(p.ws + WS_G); const h16* U = (const h16*)(p.ws + WS_U); const h16* V = (const h16*)(p.ws + WS_V);
    h16* YC = (h16*)(p.ws + WS_YCAT);
    const float* cw = p.in[3];
    const int gt = blockIdx.x * 512 + tid, NGT = gridDim.x * 512;
    for (int idx0 = gt; idx0 < NTOK * 128; idx0 += 2 * NGT) {
        h16x8 x0[2], xm[2], xp[2], gg[2]; int tt[2], cc[2];
        const h16x8 zero = {0, 0, 0, 0, 0, 0, 0, 0};
#pragma unroll
        for (int u = 0; u < 2; ++u) { const int idx = (idx0 + u * NGT < NTOK * 128) ? idx0 + u * NGT : idx0; const int t = idx >> 7, c8 = (idx & 127) * 8, tp = t & (SEQ - 1); tt[u] = t; cc[u] = c8;
            x0[u] = *(const h16x8*)(XC + (size_t)t * 1024 + c8);
            xm[u] = tp > 0 ? *(const h16x8*)(XC + (size_t)(t - 1) * 1024 + c8) : zero;
            xp[u] = tp < SEQ - 1 ? *(const h16x8*)(XC + (size_t)(t + 1) * 1024 + c8) : zero;
            gg[u] = *(const h16x8*)(G + (size_t)t * 1024 + c8); }
#pragma unroll
        for (int u = 0; u < 2; ++u) { const int c8 = cc[u]; h16x8 o;
#pragma unroll
            for (int e = 0; e < 8; ++e) { const float y = cw[c8 + e] * (float)xm[u][e] + cw[1024 + c8 + e] * (float)x0[u][e] + cw[2048 + c8 + e] * (float)xp[u][e]; o[e] = (h16)(y * (float)gg[u][e]); }
            *(h16x8*)(YC + (size_t)tt[u] * 2048 + c8) = o; }
    }
    const float* ST = (const float*)(p.ws + WS_STATS); const h16* WSH = (const h16*)(p.ws + WS_WSH);
    const float* lng = p.in[4]; const float* lnb = p.in[5]; const float* bs = p.in[7];
    LAS h16* vnT = (LAS h16*)lds;
    for (int it = blockIdx.x; it < 1024; it += gridDim.x) {
        const int g = it & 7, bn = it >> 3, t0 = bn * 128;
        __syncthreads();
#pragma unroll
        for (int q = 0; q < 4; ++q) { const int pc = tid + 512 * q, j = pc >> 4, d8 = (pc & 15) * 8;
            const h16x8 v = *(const h16x8*)(V + (size_t)(t0 + j) * 1024 + g * 128 + d8);
            const float mu = ST[2 * (t0 + j)] * (1.f / 1024.f), rs = rsqrtf(fmaxf(ST[2 * (t0 + j) + 1] * (1.f / 1024.f) - mu * mu, 0.f) + 1e-5f);
#pragma unroll
            for (int e = 0; e < 8; ++e) vnT[(d8 + e) * 136 + ((((j >> 3) ^ (pc & 15)) << 3) | (j & 7))] = (h16)(((float)v[e] - mu) * rs * lng[g * 128 + d8 + e] + lnb[g * 128 + d8 + e]); }
        __syncthreads();
        const int itile = wave >> 1, dt0 = (wave & 1) * 2;
        f32x16 acc0, acc1;
#pragma unroll
        for (int e = 0; e < 16; ++e) { acc0[e] = 0.f; acc1[e] = 0.f; }
        const h16* Arow = WSH + ((size_t)g * 128 + itile * 32 + (lane & 31)) * 128 + 8 * (lane >> 5);
        const int d0_ = dt0 * 32 + (lane & 31), d1_ = d0_ + 32;
        const LAS h16* B0p = vnT + d0_ * 136; const LAS h16* B1p = vnT + d1_ * 136;
#pragma unroll
        for (int ks = 0; ks < 8; ++ks) {
            const h16x8 a = *(const h16x8*)(Arow + 16 * ks);
            const int jg = 2 * ks + (lane >> 5);
            const h16x8 b0 = *(const LAS h16x8*)(B0p + ((jg ^ ((d0_ >> 3) & 15)) << 3)), b1 = *(const LAS h16x8*)(B1p + ((jg ^ ((d1_ >> 3) & 15)) << 3));
            acc0 = __builtin_amdgcn_mfma_f32_32x32x16_f16(a, b0, acc0, 0, 0, 0);
            acc1 = __builtin_amdgcn_mfma_f32_32x32x16_f16(a, b1, acc1, 0, 0, 0);
        }
#pragma unroll
        for (int r = 0; r < 16; ++r) { const int i = itile * 32 + (r & 3) + 8 * (r >> 2) + 4 * (lane >> 5); const size_t t = (size_t)(t0 + i);
            const float bias = bs[g * 128 + i];
            const int d0 = g * 128 + dt0 * 32 + (lane & 31);
            YC[t * 2048 + 1024 + d0] = (h16)((acc0[r] + bias) * (float)U[t * 1024 + d0]);
            YC[t * 2048 + 1024 + d0 + 32] = (h16)((acc1[r] + bias) * (float)U[t * 1024 + d0 + 32]); }
    }
}

__device__ __forceinline__ void phase_norm1(const Params& p) {
    const int tid = threadIdx.x, lane = tid & 63, wave = tid >> 6;
    const int gw = blockIdx.x * 8 + wave, NGW = gridDim.x * 8;
    const h16* O1 = (const h16*)(p.ws + WS_O1); h16* H1 = (h16*)p.out;
    for (int r = gw; r < NTOK; r += 2 * NGW) { const int r1 = (r + NGW < NTOK) ? r + NGW : r;
        rms_rows2_f16(p.in[0] + (size_t)r * DM, p.in[0] + (size_t)r1 * DM, O1 + (size_t)r * DM, O1 + (size_t)r1 * DM, p.in[9], H1 + (size_t)r * DM, H1 + (size_t)r1 * DM, lane); }
}

__device__ __forceinline__ void phase_fft(const Params& p, LAS unsigned char* lds) {
    const int tid = threadIdx.x;
    const h16* FD = (const h16*)(p.ws + WS_FD);
    h16* SPr = (h16*)(p.ws + WS_SPR); h16* SPi = (h16*)(p.ws + WS_SPI);
    LAS f32x2* X0 = (LAS f32x2*)lds; LAS f32x2* X1 = X0 + 8192;
    for (int it = blockIdx.x; it < 256; it += gridDim.x) {
        const int b = it >> 7, c0 = 4 * (it & 127);
        __syncthreads();
        for (int t = tid; t < SEQ; t += 512) { const h16x4 v = *(const h16x4*)(FD + ((size_t)(it & 127) * NTOK + b * SEQ + t) * 4);
            X0[t] = (f32x2){(float)v[0], (float)v[1]}; X1[t] = (f32x2){(float)v[2], (float)v[3]}; }
        __syncthreads();
        for (int s = 0; s < 6; ++s) {
            const int lq = 11 - 2 * s, q = 1 << lq;
            const float rn = 1.f / (float)(4 << lq);
#pragma unroll 2
            for (int j = tid; j < 2048; j += 512) {
                const int pp = j & (q - 1), i0 = ((j >> lq) << (lq + 2)) + pp;
                const float fr = (float)pp * rn;
                const float c1 = __builtin_amdgcn_cosf(fr), s1 = __builtin_amdgcn_sinf(fr), c2 = __builtin_amdgcn_cosf(2.f * fr), s2 = __builtin_amdgcn_sinf(2.f * fr), c3 = __builtin_amdgcn_cosf(3.f * fr), s3 = __builtin_amdgcn_sinf(3.f * fr);
#pragma unroll
                for (int f = 0; f < 2; ++f) { LAS f32x2* X = f ? X1 : X0;
                    const f32x2 a = X[i0], b_ = X[i0 + q], c_ = X[i0 + 2 * q], d_ = X[i0 + 3 * q];
                    const f32x2 t0 = a + c_, t1 = a - c_, t2 = b_ + d_, t3 = b_ - d_;
                    const f32x2 y0 = t0 + t2, y2 = t0 - t2;
                    const f32x2 y1 = {t1[0] + t3[1], t1[1] - t3[0]}, y3 = {t1[0] - t3[1], t1[1] + t3[0]};
                    X[i0] = y0;
                    X[i0 + q] = (f32x2){y1[0] * c1 + y1[1] * s1, y1[1] * c1 - y1[0] * s1};
                    X[i0 + 2 * q] = (f32x2){y2[0] * c2 + y2[1] * s2, y2[1] * c2 - y2[0] * s2};
                    X[i0 + 3 * q] = (f32x2){y3[0] * c3 + y3[1] * s3, y3[1] * c3 - y3[0] * s3}; }
            }
            __syncthreads();
        }
        for (int j = tid; j < 4096; j += 512) {
            { const f32x2 a = X0[2 * j], bb = X0[2 * j + 1]; X0[2 * j] = a + bb; X0[2 * j + 1] = a - bb; }
            { const f32x2 a = X1[2 * j], bb = X1[2 * j + 1]; X1[2 * j] = a + bb; X1[2 * j + 1] = a - bb; }
        }
        __syncthreads();
        const float sc = 0.5f * 0.011048543456039806f;
        for (int k = tid; k < SEQ; k += 512) {
            const unsigned kb = (unsigned)((SEQ - k) & (SEQ - 1));
            const unsigned ya_ = __brev((unsigned)k & 0xFFFu) >> 20, yb_ = __brev(kb & 0xFFFu) >> 20;
            const int ra = (int)(((((ya_ & 0xAAAu) >> 1) | ((ya_ & 0x555u) << 1)) << 1) | ((unsigned)k >> 12));
            const int rb = (int)(((((yb_ & 0xAAAu) >> 1) | ((yb_ & 0x555u) << 1)) << 1) | (kb >> 12));
            const f32x2 za = X0[ra], zb = X0[rb], ya = X1[ra], yb = X1[rb];
            h16x4 orr, oi;
            orr[0] = (h16)((za[0] + zb[0]) * sc); oi[0] = (h16)((za[1] - zb[1]) * sc);
            orr[1] = (h16)((za[1] + zb[1]) * sc); oi[1] = (h16)((zb[0] - za[0]) * sc);
            orr[2] = (h16)((ya[0] + yb[0]) * sc); oi[2] = (h16)((ya[1] - yb[1]) * sc);
            orr[3] = (h16)((ya[1] + yb[1]) * sc); oi[3] = (h16)((yb[0] - ya[0]) * sc);
            *(h16x4*)(SPr + ((size_t)(it & 127) * NTOK + b * SEQ + k) * 4) = orr; *(h16x4*)(SPi + ((size_t)(it & 127) * NTOK + b * SEQ + k) * 4) = oi;
        }
    }
}

__device__ __forceinline__ void phase_fnet_out(const Params& p, LAS unsigned char* lds) {
    const int tid = threadIdx.x, lane = tid & 63, wave = tid >> 6;
    const h16* SPr = (const h16*)(p.ws + WS_SPR); const h16* SPi = (const h16*)(p.ws + WS_SPI);
    const h16* CWT = (const h16*)(p.ws + WS_CWT); h16* ZCD = (h16*)(p.ws + WS_ZCD);
    LAS h16* Lr = (LAS h16*)lds; LAS h16* Li = Lr + 32 * 520;
    const int g = wave >> 1, eh = wave & 1;
    for (int it = blockIdx.x; it < 512; it += gridDim.x) {
        const int t0 = it * 32;
        __syncthreads();
#pragma unroll
        for (int q = 0; q < 8; ++q) { const int idx = tid + 512 * q, arr = idx >> 11, rem = idx & 2047, cg = rem >> 4, tp = rem & 15;
            const h16x8 v = *(const h16x8*)((arr ? SPi : SPr) + ((size_t)cg * NTOK + t0 + 2 * tp) * 4);
            LAS h16* d_ = (arr ? Li : Lr) + (2 * tp) * 520 + 4 * cg;
            *(LAS h16x4*)d_ = (h16x4){v[0], v[1], v[2], v[3]}; *(LAS h16x4*)(d_ + 520) = (h16x4){v[4], v[5], v[6], v[7]}; }
        __syncthreads();
        f32x16 acc0, acc1;
#pragma unroll
        for (int e = 0; e < 16; ++e) { acc0[e] = 0.f; acc1[e] = 0.f; }
        const LAS h16* Ar = Lr + (lane & 31) * 520 + g * 128 + 8 * (lane >> 5); const LAS h16* Ai = Li + (lane & 31) * 520 + g * 128 + 8 * (lane >> 5);
        const h16* B0 = CWT + ((size_t)(g * 128 + (2 * eh) * 32 + (lane & 31))) * 256 + 8 * (lane >> 5); const h16* B1 = B0 + 32 * 256;
#pragma unroll
        for (int ks = 0; ks < 8; ++ks) { const h16x8 a = *(const LAS h16x8*)(Ar + 16 * ks);
            acc0 = __builtin_amdgcn_mfma_f32_32x32x16_f16(a, *(const h16x8*)(B0 + 16 * ks), acc0, 0, 0, 0);
            acc1 = __builtin_amdgcn_mfma_f32_32x32x16_f16(a, *(const h16x8*)(B1 + 16 * ks), acc1, 0, 0, 0); }
#pragma unroll
        for (int ks = 0; ks < 8; ++ks) { const h16x8 a = *(const LAS h16x8*)(Ai + 16 * ks);
            acc0 = __builtin_amdgcn_mfma_f32_32x32x16_f16(a, *(const h16x8*)(B0 + 128 + 16 * ks), acc0, 0, 0, 0);
            acc1 = __builtin_amdgcn_mfma_f32_32x32x16_f16(a, *(const h16x8*)(B1 + 128 + 16 * ks), acc1, 0, 0, 0); }
        h16 z0[16], z1[16];
#pragma unroll
        for (int r = 0; r < 16; ++r) { const size_t t = (size_t)(t0 + (r & 3) + 8 * (r >> 2) + 4 * (lane >> 5));
            const h16* zp = ZCD + t * 1536 + 1024 + g * 128 + (2 * eh) * 32 + (lane & 31); z0[r] = zp[0]; z1[r] = zp[32]; }
#pragma unroll
        for (int r = 0; r < 16; ++r) { const size_t t = (size_t)(t0 + (r & 3) + 8 * (r >> 2) + 4 * (lane >> 5));
            h16* zp = ZCD + t * 1536 + 1024 + g * 128 + (2 * eh) * 32 + (lane & 31);
            zp[0] = (h16)(acc0[r] * silu_f((float)z0[r])); zp[32] = (h16)(acc1[r] * silu_f((float)z1[r])); }
    }
}

#define LDS_BAR() do { asm volatile("s_waitcnt lgkmcnt(0)" ::: "memory"); __builtin_amdgcn_s_barrier(); asm volatile("" ::: "memory"); } while (0)
#define LDS_WAIT() asm volatile("s_waitcnt lgkmcnt(0)" ::: "memory")
__device__ __forceinline__ void phase_scan(const Params& p, LAS unsigned char* lds) {
    const int tid = threadIdx.x, lane = tid & 63, wave = tid >> 6;
    const h16* PC = (const h16*)(p.ws + WS_PC);
    LAS h16* w2T = (LAS h16*)lds;
    LAS h16* a2T = w2T + 64 * 72;
    LAS unsigned char* priv = lds + 18432 + (wave & 3) * 4096;
    constexpr int SET_F = 5 * 2048 + 512;
    LAS float* OPS = (LAS float*)(lds + 18432 + 16384);
    LAS float* sYb = OPS + 2 * SET_F;
    for (int item = blockIdx.x; item < 256; item += gridDim.x) {
        const int xcd = item & 7, slot = item >> 3, gidx = xcd * 8 + (slot >> 2), q = slot & 3;
        const int dir = gidx >> 5, b = (gidx >> 4) & 1, h = gidx & 15;
        h16* Yd = (h16*)((unsigned char*)p.out + (size_t)dir * 32 * MiB);
        float* SB = (float*)(p.ws + WS_SBON) + (size_t)dir * NTOK * 16;
        const float* mu = p.in[11] + dir * 3200; const float* w0 = p.in[12] + dir * 1024 + 64 * h; const float* w2 = p.in[13] + (size_t)dir * 65536 + 64 * h;
        const float* a0 = p.in[14] + dir * 1024 + 64 * h; const float* a2 = p.in[15] + (size_t)dir * 65536 + 64 * h;
        const float* kkw = p.in[16] + 64 * h; const float* kaw = p.in[17] + 64 * h; const float* rkw = p.in[18] + 64 * h;
        __syncthreads();
        for (int i = tid; i < 4096; i += 512) { const int l = i >> 6, c = i & 63; w2T[c * 72 + l] = (h16)w2[l * 1024 + c]; a2T[c * 72 + l] = (h16)a2[l * 1024 + c]; }
        const int pw_ = wave & 3, s_sub = lane >> 3, c8 = (lane & 7) * 8, s_l = 8 * pw_ + s_sub;
        h16x8 mu_r8, mu_k8, mu_v8, mu_w8, mu_a8; f32x2 w0r[4], a0r[4], kkr[4], kar[4], omk[4], rkr[4];
#pragma unroll
        for (int e = 0; e < 8; ++e) { mu_r8[e] = (h16)mu[64 * h + c8 + e]; mu_k8[e] = (h16)mu[1024 + 64 * h + c8 + e]; mu_v8[e] = (h16)mu[2048 + 64 * h + c8 + e]; mu_w8[e] = (h16)mu[3072 + c8 + e]; mu_a8[e] = (h16)mu[3136 + c8 + e];
            w0r[e >> 1][e & 1] = w0[c8 + e]; a0r[e >> 1][e & 1] = a0[c8 + e]; kkr[e >> 1][e & 1] = kkw[c8 + e]; kar[e >> 1][e & 1] = kaw[c8 + e]; omk[e >> 1][e & 1] = 1.f - kaw[c8 + e]; rkr[e >> 1][e & 1] = rkw[c8 + e]; }
        f32x2 S01 = {0.f, 0.f}, S23 = {0.f, 0.f};
        const int srow = 4 * (wave & 3) + (lane >> 4), j0 = 4 * (lane & 15);
        const h16x8 z8 = {0, 0, 0, 0, 0, 0, 0, 0};
        h16x8 pr, pk, pv, pw, pa, qr_, qk_, qv_, qw_, qa_;
        const h16 *pcA, *pcB, *ppA, *ppB;
        { const int t0_ = dir ? (SEQ - 1 - s_l) : s_l; pcA = PC + (size_t)(b * SEQ + t0_) * 3200 + c8 + 64 * h; pcB = pcA + 2048 - 64 * h;
          const long po_ = (s_l > 0) ? (dir ? 3200 : -3200) : 0; ppA = pcA + po_; ppB = pcB + po_; }
        const long cstride_ = dir ? -32 * 3200 : 32 * 3200;
#define SCAN_LOAD_RAW() do { \
            pr = *(const h16x8*)(pcA); pk = *(const h16x8*)(pcA + 1024); pv = *(const h16x8*)(pcB + 64 * h); pw = *(const h16x8*)(pcB + 1024); pa = *(const h16x8*)(pcB + 1088); \
            qr_ = *(const h16x8*)(ppA); qk_ = *(const h16x8*)(ppA + 1024); qv_ = *(const h16x8*)(ppB + 64 * h); qw_ = *(const h16x8*)(ppB + 1024); qa_ = *(const h16x8*)(ppB + 1088); \
            pcA += cstride_; pcB += cstride_; ppA = pcA + (dir ? 3200 : -3200); ppB = pcB + (dir ? 3200 : -3200); } while (0)
#define SCAN_LOAD(chn) SCAN_LOAD_RAW()
#define SCAN_YSTORE(chn) do { const int sg_ = (chn) * 32 + s_l; const int t_ = dir ? (SEQ - 1 - sg_) : sg_; \
            const f32x2 y2_ = *(const LAS f32x2*)(sYb + ((chn) & 1) * 512 + s_l * 16 + 2 * (lane & 7)); \
            typedef _Float16 h16x2_ __attribute__((ext_vector_type(2))); h16x2_ o_; o_[0] = (h16)y2_[0]; o_[1] = (h16)y2_[1]; \
            *(h16x2_*)(Yd + (size_t)(b * SEQ + t_) * 1024 + 64 * h + 16 * q + 2 * (lane & 7)) = o_; } while (0)
        if (wave >= 4) { SCAN_LOAD_RAW(); if (s_l == 0) { qr_ = z8; qk_ = z8; qv_ = z8; qw_ = z8; qa_ = z8; } }
        __syncthreads();
        for (int n = -1; n < SEQ / 32; ++n) {
            if (wave < 4) {
                if (n >= 0) {
                    __builtin_amdgcn_s_setprio(3);
                    const LAS float* sR = OPS + (n & 1) * SET_F + j0; const LAS float* sW = sR + 2048; const LAS float* sK = sW + 2048; const LAS float* sA = sK + 2048; const LAS float* sB = sA + 2048; const LAS float* sV = OPS + (n & 1) * SET_F + 10240;
                    LAS float* sY = sYb + (n & 1) * 512;
                    f32x4 a_ = *(const LAS f32x4*)(sA), w_ = *(const LAS f32x4*)(sW), b_ = *(const LAS f32x4*)(sB);
                    f32x4 k_ = *(const LAS f32x4*)(sK), r_ = *(const LAS f32x4*)(sR);
                    f32x4 vq[4];
#pragma unroll
                    for (int u = 0; u < 4; ++u) vq[u] = *(const LAS f32x4*)(sV + srow * 32 + 4 * u);
                    f32x4 rp = r_;
#pragma unroll
                    for (int hb = 0; hb < 2; ++hb) {
                        f32x4 vn[4];
#pragma unroll
                        for (int u = 0; u < 4; ++u) vn[u] = *(const LAS f32x4*)(sV + srow * 32 + ((16 * (hb + 1)) & 31) + 4 * u);
#pragma unroll
                        for (int u16 = 0; u16 < 16; ++u16) {
                            const int s = 16 * hb + u16;
                            const int sn = (s + 1) & 31;
                            const f32x4 a_n = *(const LAS f32x4*)(sA + sn * 64), w_n = *(const LAS f32x4*)(sW + sn * 64), b_n = *(const LAS f32x4*)(sB + sn * 64);
                            const f32x4 k_n = *(const LAS f32x4*)(sK + sn * 64), r_n = *(const LAS f32x4*)(sR + sn * 64);
                            const float v = vq[u16 >> 2][u16 & 3];
                            const f32x2 vv = {v, v};
                            f32x2 pp = S01 * (f32x2){a_[0], a_[1]}; pp = S23 * (f32x2){a_[2], a_[3]} + pp;
                            f32x2 yy = S01 * (f32x2){rp[0], rp[1]}; yy = S23 * (f32x2){rp[2], rp[3]} + yy;
                            float sa = pp[0] + pp[1], y = yy[0] + yy[1];
                            sa += dpp_f<0xB1>(sa); y += dpp_f<0xB1>(y);
                            sa += dpp_f<0x4E>(sa); y += dpp_f<0x4E>(y);
                            sa += dpp_f<0x141>(sa); y += dpp_f<0x141>(y);
                            sa += dpp_f<0x140>(sa); y += dpp_f<0x140>(y);
                            sY[((s - 1) & 31) * 16 + srow] = y;
                            const f32x2 sv = {sa, sa};
                            S01 = S01 * (f32x2){w_[0], w_[1]} + vv * (f32x2){k_[0], k_[1]};
                            S23 = S23 * (f32x2){w_[2], w_[3]} + vv * (f32x2){k_[2], k_[3]};
                            S01 = sv * (f32x2){b_[0], b_[1]} + S01;
                            S23 = sv * (f32x2){b_[2], b_[3]} + S23;
                            rp = r_;
                            a_ = a_n; w_ = w_n; b_ = b_n; k_ = k_n; r_ = r_n;
                        }
#pragma unroll
                        for (int u = 0; u < 4; ++u) vq[u] = vn[u];
                    }
                    { f32x2 yy = S01 * (f32x2){rp[0], rp[1]}; yy = S23 * (f32x2){rp[2], rp[3]} + yy; sY[31 * 16 + srow] = red16(yy[0] + yy[1]); }
                    __builtin_amdgcn_s_setprio(0);
                }
            } else {
                if (n + 1 < SEQ / 32) {
                    const int cn = n + 1;
                    const int sg = cn * 32 + s_l; const int t = dir ? (SEQ - 1 - sg) : sg;
                    f32x2 qr[4], qk[4]; float qv[8];
                    LAS h16* TWp = (LAS h16*)priv; LAS h16* QAp = TWp + 8 * 72;
                    { unsigned m1u_ = 0xBC00BC00u; asm volatile("" : "+s"(m1u_));
                      typedef unsigned u32x4_ __attribute__((ext_vector_type(4))); const u32x4_ m1v_ = {m1u_, m1u_, m1u_, m1u_}; const h16x8 m1_ = __builtin_bit_cast(h16x8, m1v_);
                      const h16x8 r8 = pr + mu_r8 * (pr * m1_ + qr_), k8 = pk + mu_k8 * (pk * m1_ + qk_), v8 = pv + mu_v8 * (pv * m1_ + qv_);
                      const h16x8 w8 = pw + mu_w8 * (pw * m1_ + qw_), a8 = pa + mu_a8 * (pa * m1_ + qa_);
                      h16x8 tw8;
#pragma unroll
                      for (int pi = 0; pi < 4; ++pi) { qr[pi] = (f32x2){(float)r8[2 * pi], (float)r8[2 * pi + 1]}; qk[pi] = (f32x2){(float)k8[2 * pi], (float)k8[2 * pi + 1]};
                          qv[2 * pi] = (float)v8[2 * pi]; qv[2 * pi + 1] = (float)v8[2 * pi + 1];
                          const f32x2 tx = (f32x2){(float)w8[2 * pi], (float)w8[2 * pi + 1]} * 2.8853900817779268f;
                          const f32x2 dn = (f32x2){__builtin_amdgcn_exp2f(tx[0]), __builtin_amdgcn_exp2f(tx[1])} + 1.f;
                          const f32x2 th = (f32x2){__builtin_amdgcn_rcpf(dn[0]), __builtin_amdgcn_rcpf(dn[1])} * -2.f + 1.f;
                          tw8[2 * pi] = (h16)th[0]; tw8[2 * pi + 1] = (h16)th[1]; }
                      *(LAS h16x8*)(TWp + s_sub * 72 + c8) = tw8; *(LAS h16x8*)(QAp + s_sub * 72 + c8) = a8; }
                    if (cn + 1 < SEQ / 32) SCAN_LOAD(cn + 1);
                    LDS_WAIT();
                    f32x4 accw[4], acca[4];
#pragma unroll
                    for (int ct = 0; ct < 4; ++ct) { accw[ct] = (f32x4){0.f, 0.f, 0.f, 0.f}; acca[ct] = (f32x4){0.f, 0.f, 0.f, 0.f}; }
#pragma unroll
                    for (int ks = 0; ks < 2; ++ks) {
                        const h16x8 atw = *(const LAS h16x8*)(TWp + (lane & 7) * 72 + 32 * ks + 8 * (lane >> 4));
                        const h16x8 aqa = *(const LAS h16x8*)(QAp + (lane & 7) * 72 + 32 * ks + 8 * (lane >> 4));
#pragma unroll
                        for (int ct = 0; ct < 4; ++ct) {
                            const h16x8 bw = *(const LAS h16x8*)(w2T + (16 * ct + (lane & 15)) * 72 + 32 * ks + 8 * (lane >> 4));
                            const h16x8 ba = *(const LAS h16x8*)(a2T + (16 * ct + (lane & 15)) * 72 + 32 * ks + 8 * (lane >> 4));
                            accw[ct] = __builtin_amdgcn_mfma_f32_16x16x32_f16(atw, bw, accw[ct], 0, 0, 0);
                            acca[ct] = __builtin_amdgcn_mfma_f32_16x16x32_f16(aqa, ba, acca[ct], 0, 0, 0);
                        }
                    }
                    LDS_WAIT();
                    { LAS float* Zd = (LAS float*)priv + (lane >> 5) * 512 + (4 * ((lane >> 4) & 1)) * 64 + (lane & 15);
#pragma unroll
                      for (int ct = 0; ct < 4; ++ct)
#pragma unroll
                          for (int r = 0; r < 4; ++r) Zd[r * 64 + 16 * ct] = (lane < 32) ? accw[ct][r] : acca[ct][r]; }
                    LDS_WAIT();
                    const LAS float* Zw = (const LAS float*)priv + s_sub * 64 + c8; const LAS float* Za = Zw + 512;
                    const f32x4 zw0 = *(const LAS f32x4*)Zw, zw1 = *(const LAS f32x4*)(Zw + 4), za0 = *(const LAS f32x4*)Za, za1 = *(const LAS f32x4*)(Za + 4);
                    LDS_WAIT();
                    f32x2 kk[4], av_[4], kp[4], dec[4], kn2 = {0.f, 0.f}, sb2 = {0.f, 0.f};
#pragma unroll
                    for (int pi = 0; pi < 4; ++pi) {
                        const f32x2 zw = (pi < 2 ? (f32x2){zw0[2 * pi], zw0[2 * pi + 1]} : (f32x2){zw1[2 * pi - 4], zw1[2 * pi - 3]}) + w0r[pi];
                        const f32x2 za = (pi < 2 ? (f32x2){za0[2 * pi], za0[2 * pi + 1]} : (f32x2){za1[2 * pi - 4], za1[2 * pi - 3]}) + a0r[pi];
                        const f32x2 tw_ = zw * -1.4426950408889634f, ta_ = za * -1.4426950408889634f;
                        const f32x2 dw = (f32x2){__builtin_amdgcn_exp2f(tw_[0]), __builtin_amdgcn_exp2f(tw_[1])} + 1.f, da = (f32x2){__builtin_amdgcn_exp2f(ta_[0]), __builtin_amdgcn_exp2f(ta_[1])} + 1.f;
                        const f32x2 sw = (f32x2){__builtin_amdgcn_rcpf(dw[0]), __builtin_amdgcn_rcpf(dw[1])} * -0.8750387749225136f;
                        dec[pi] = (f32x2){__builtin_amdgcn_exp2f(sw[0]), __builtin_amdgcn_exp2f(sw[1])};
                        av_[pi] = (f32x2){__builtin_amdgcn_rcpf(da[0]), __builtin_amdgcn_rcpf(da[1])};
                        kk[pi] = qk[pi] * kkr[pi]; kn2 = kk[pi] * kk[pi] + kn2;
                        kp[pi] = qk[pi] * (av_[pi] * kar[pi] + omk[pi]);
                        sb2 = (qr[pi] * kp[pi]) * rkr[pi] + sb2; }
                    const float kn = red8(kn2[0] + kn2[1]), sbn = red8(sb2[0] + sb2[1]);
                    const float ninv = -rsqrtf(fmaxf(kn, 1e-12f));
                    LAS float* dR = OPS + (cn & 1) * SET_F + s_l * 64 + c8;
#pragma unroll
                    for (int hf = 0; hf < 2; ++hf) {
                        const f32x2 na0 = kk[2 * hf] * ninv, na1 = kk[2 * hf + 1] * ninv;
                        const f32x2 nb0 = na0 * av_[2 * hf], nb1 = na1 * av_[2 * hf + 1];
                        *(LAS f32x4*)(dR + 4 * hf) = (f32x4){qr[2 * hf][0], qr[2 * hf][1], qr[2 * hf + 1][0], qr[2 * hf + 1][1]};
                        *(LAS f32x4*)(dR + 2048 + 4 * hf) = (f32x4){dec[2 * hf][0], dec[2 * hf][1], dec[2 * hf + 1][0], dec[2 * hf + 1][1]};
                        *(LAS f32x4*)(dR + 4096 + 4 * hf) = (f32x4){kp[2 * hf][0], kp[2 * hf][1], kp[2 * hf + 1][0], kp[2 * hf + 1][1]};
                        *(LAS f32x4*)(dR + 6144 + 4 * hf) = (f32x4){na0[0], na0[1], na1[0], na1[1]};
                        *(LAS f32x4*)(dR + 8192 + 4 * hf) = (f32x4){-nb0[0], -nb0[1], -nb1[0], -nb1[1]}; }
                    if ((c8 >> 4) == q) { LAS float* dV = OPS + (cn & 1) * SET_F + 10240 + (c8 & 15) * 32 + s_l;
#pragma unroll
                        for (int e = 0; e < 8; ++e) dV[e * 32] = qv[e]; }
                    if (q == 0 && (lane & 7) == 0) SB[(size_t)(b * SEQ + t) * 16 + h] = sbn;
                }
                if (n >= 1) SCAN_YSTORE(n - 1);
            }
            LDS_BAR();
        }
        if (wave >= 4) SCAN_YSTORE(SEQ / 32 - 1);
#undef SCAN_LOAD
#undef SCAN_LOAD_RAW
#undef SCAN_YSTORE
    }
}

__device__ __forceinline__ void phase_post(const Params& p) {
    const int tid = threadIdx.x;
    const h16* Y0 = (const h16*)p.out; const h16* Y1 = (const h16*)((const unsigned char*)p.out + 32 * MiB);
    const h16* PC = (const h16*)(p.ws + WS_PC); h16* ZCD = (h16*)(p.ws + WS_ZCD);
    const float* SB0 = (const float*)(p.ws + WS_SBON); const float* SB1 = SB0 + (size_t)NTOK * 16;
    const float* mu0 = p.in[11] + 2048; const float* mu1 = p.in[11] + 3200 + 2048;
    const float* lg = p.in[19]; const float* lb = p.in[20];
    const int gt = blockIdx.x * 512 + tid, NGT = gridDim.x * 512;
    for (int idx = gt; idx < NTOK * 128; idx += NGT) {
        const int t = idx >> 7, c = (idx & 127) * 8, hh = c >> 6, tp = t & (SEQ - 1);
        const h16x8 y0 = *(const h16x8*)(Y0 + (size_t)t * 1024 + c), y1 = *(const h16x8*)(Y1 + (size_t)t * 1024 + c);
        const h16x8 z8 = {0, 0, 0, 0, 0, 0, 0, 0};
        const h16x8 v0 = *(const h16x8*)(PC + (size_t)t * 3200 + 2048 + c);
        const h16x8 vm = tp > 0 ? *(const h16x8*)(PC + (size_t)(t - 1) * 3200 + 2048 + c) : z8;
        const h16x8 vp = tp < SEQ - 1 ? *(const h16x8*)(PC + (size_t)(t + 1) * 3200 + 2048 + c) : z8;
        const h16x8 zc = *(const h16x8*)(ZCD + (size_t)t * 1536 + c);
        const float s0 = SB0[(size_t)t * 16 + hh], s1 = SB1[(size_t)t * 16 + hh];
        float y[8], s = 0.f;
#pragma unroll
        for (int e = 0; e < 8; ++e) { y[e] = (float)y0[e] + (float)y1[e]; s += y[e]; }
        const float mean = red8(s) * (1.f / 64.f); float q = 0.f;
#pragma unroll
        for (int e = 0; e < 8; ++e) { y[e] -= mean; q += y[e] * y[e]; }
        const float rs = rsqrtf(red8(q) * (1.f / 64.f) + 64e-5f);
        const f32x4 lg0 = *(const f32x4*)(lg + c), lg1 = *(const f32x4*)(lg + c + 4), lb0 = *(const f32x4*)(lb + c), lb1 = *(const f32x4*)(lb + c + 4);
        const f32x4 ma0 = *(const f32x4*)(mu0 + c), ma1 = *(const f32x4*)(mu0 + c + 4), mb0 = *(const f32x4*)(mu1 + c), mb1 = *(const f32x4*)(mu1 + c + 4);
        h16x8 o;
#pragma unroll
        for (int e = 0; e < 8; ++e) { const float vv = (float)v0[e];
            const float m0 = e < 4 ? ma0[e & 3] : ma1[e & 3], m1 = e < 4 ? mb0[e & 3] : mb1[e & 3], gg = e < 4 ? lg0[e & 3] : lg1[e & 3], bb = e < 4 ? lb0[e & 3] : lb1[e & 3];
            const float vd0 = vv + m0 * ((float)vm[e] - vv), vd1 = vv + m1 * ((float)vp[e] - vv);
            const float val = y[e] * rs * gg + bb + s0 * vd0 + s1 * vd1;
            o[e] = (h16)(val * silu_f((float)zc[e])); }
        *(h16x8*)(ZCD + (size_t)t * 1536 + c) = o;
    }
}

__device__ __forceinline__ void phase_final(const Params& p) {
    const int tid = threadIdx.x, lane = tid & 63, wave = tid >> 6;
    const int gw = blockIdx.x * 8 + wave, NGW = gridDim.x * 8;
    const float* g = p.in[23]; const h16* O1 = (const h16*)(p.ws + WS_O1); const h16* O2 = (const h16*)(p.ws + WS_O2);
    for (int r = gw; r < NTOK; r += 2 * NGW) {
        const int rr[2] = {r, (r + NGW < NTOK) ? r + NGW : r};
        f32x4 v[2][4]; h16x4 a[2][4], b[2][4]; float ss[2] = {0.f, 0.f};
#pragma unroll
        for (int u = 0; u < 2; ++u)
#pragma unroll
            for (int j = 0; j < 4; ++j) { const size_t o = (size_t)rr[u] * DM + 4 * lane + 256 * j; v[u][j] = *(const f32x4*)(p.in[0] + o); a[u][j] = *(const h16x4*)(O1 + o); b[u][j] = *(const h16x4*)(O2 + o); }
#pragma unroll
        for (int u = 0; u < 2; ++u)
#pragma unroll
            for (int j = 0; j < 4; ++j) {
#pragma unroll
                for (int e = 0; e < 4; ++e) v[u][j][e] += (float)a[u][j][e] + (float)b[u][j][e];
                ss[u] += v[u][j][0] * v[u][j][0] + v[u][j][1] * v[u][j][1] + v[u][j][2] * v[u][j][2] + v[u][j][3] * v[u][j][3]; }
#pragma unroll
        for (int o = 1; o < 64; o <<= 1) { ss[0] += __shfl_xor(ss[0], o); ss[1] += __shfl_xor(ss[1], o); }
        const float rs[2] = {rsqrtf(ss[0] * (1.f / 1024.f) + 1e-6f), rsqrtf(ss[1] * (1.f / 1024.f) + 1e-6f)};
#pragma unroll
        for (int j = 0; j < 4; ++j) { const f32x4 gg = *(const f32x4*)(g + 4 * lane + 256 * j);
#pragma unroll
            for (int u = 0; u < 2; ++u) { f32x4 o = v[u][j] * rs[u]; o = o * gg; *(f32x4*)(p.out + (size_t)rr[u] * DM + 4 * lane + 256 * j) = o; } }
    }
}

__global__ void __launch_bounds__(512, 2) mega(Params p) {
    extern __shared__ __attribute__((aligned(16))) unsigned char smem[];
    LAS unsigned char* lds = (LAS unsigned char*)smem;
    cg::grid_group grid = cg::this_grid();
    unsigned char* ws = p.ws;
    const int lo = p.ph_lo, hi = p.ph_hi;
#define IN(k) (lo <= (k) && (k) < hi)
    volatile LAS unsigned* bst = (volatile LAS unsigned*)(lds + LDS_MAIN);
    if (threadIdx.x < 4) bst[threadIdx.x] = 0u;
    __syncthreads();
    const XcdBarrier bar = xcd_barrier_post((unsigned*)(ws + WS_BAR), bst);
    if (hi > 1000) grid.sync();
#define SEAM(k) do { if (IN(k) && IN((k) + 1)) { xcd_barrier(bar); if ((REPMASK >> 13) & 1) xcd_barrier(bar); } } while (0)
    if (IN(0)) for (int rep_ = 0; rep_ <= ((REPMASK >> 0) & 1); ++rep_) { phase0(p, lds); } SEAM(0);
    if (IN(1)) for (int rep_ = 0; rep_ <= ((REPMASK >> 1) & 1); ++rep_) { pg8::Gemm g{(const h16*)p.out, (const h16*)(ws + WS_W1T), NTOK, 7168, 1024}; pg8::StaticOrder S; S.init(NTOK, 7168, gridDim.x, blockIdx.x);
                 Epi1 E{(h16*)(ws + WS_XC), (h16*)(ws + WS_G), (h16*)(ws + WS_U), (h16*)(ws + WS_V), (float*)(ws + WS_STATS)}; pg8::gemm_phase<Epi1>(lds, g, S, E); } SEAM(1);
    if (IN(3)) for (int rep_ = 0; rep_ <= ((REPMASK >> 3) & 1); ++rep_) { phase_mix0(p, lds); } SEAM(3);
    if (IN(4)) for (int rep_ = 0; rep_ <= ((REPMASK >> 4) & 1); ++rep_) { pg8::Gemm g{(const h16*)(ws + WS_YCAT), (const h16*)(ws + WS_W2T), NTOK, 1024, 2048}; pg8::StaticOrder S; S.init(NTOK, 1024, gridDim.x, blockIdx.x);
                 Epi2 E{(h16*)(ws + WS_O1)}; pg8::gemm_phase<Epi2>(lds, g, S, E); } SEAM(4);
    if (IN(5)) for (int rep_ = 0; rep_ <= ((REPMASK >> 5) & 1); ++rep_) { phase_norm1(p); } SEAM(5);
    if (IN(6)) for (int rep_ = 0; rep_ <= ((REPMASK >> 6) & 1); ++rep_) { pg8::Gemm g{(const h16*)p.out, (const h16*)(ws + WS_W3T), NTOK, 5376, 1024}; pg8::StaticOrder S; S.init(NTOK, 5376, gridDim.x, blockIdx.x);
                 Epi3 E{(h16*)(ws + WS_PC), (h16*)(ws + WS_ZCD), (h16*)(ws + WS_FD)}; pg8::gemm_phase<Epi3>(lds, g, S, E); } SEAM(6);
    if (IN(7)) for (int rep_ = 0; rep_ <= ((REPMASK >> 7) & 1); ++rep_) { phase_fft(p, lds); }
    if (IN(8)) for (int rep_ = 0; rep_ <= ((REPMASK >> 8) & 1); ++rep_) { phase_scan(p, lds); } SEAM(8);
    if (IN(9)) for (int rep_ = 0; rep_ <= ((REPMASK >> 9) & 1); ++rep_) { phase_fnet_out(p, lds); }
    if (IN(10)) for (int rep_ = 0; rep_ <= ((REPMASK >> 10) & 1); ++rep_) { phase_post(p); } SEAM(10);
    if (IN(11)) for (int rep_ = 0; rep_ <= ((REPMASK >> 11) & 1); ++rep_) { pg8::Gemm g{(const h16*)(ws + WS_ZCD), (const h16*)(ws + WS_W4T), NTOK, 1024, 1536}; pg8::StaticOrder S; S.init(NTOK, 1024, gridDim.x, blockIdx.x);
                  Epi4 E{(h16*)(ws + WS_O2)}; pg8::gemm_phase<Epi4>(lds, g, S, E); } SEAM(11);
    if (IN(12)) for (int rep_ = 0; rep_ <= ((REPMASK >> 12) & 1); ++rep_) { phase_final(p); }
}

extern "C" void kernel_launch(void* const* d_in, const int* in_sizes, int n_in, void* d_out, int out_size, void* d_ws, size_t ws_size, hipStream_t stream) {
    static int grid = 0;
    if (grid == 0) {
        int dev = 0, cus = 0, per_cu = 0;
        hipGetDevice(&dev);
        hipDeviceGetAttribute(&cus, hipDeviceAttributeMultiprocessorCount, dev);
        if (hipFuncSetAttribute((const void*)mega, hipFuncAttributeMaxDynamicSharedMemorySize, LDS_BYTES) != hipSuccess) fprintf(stderr, "kernel_launch: hipFuncSetAttribute failed\n");
        hipOccupancyMaxActiveBlocksPerMultiprocessor(&per_cu, (const void*)mega, 512, LDS_BYTES);
        if (per_cu < 1) { fprintf(stderr, "kernel_launch: occupancy query says %d blocks per CU\n", per_cu); per_cu = 1; }
        (void)hipGetLastError();
        grid = cus;
        if (grid < 64) grid = 64;
    }
    if (hipMemsetAsync((unsigned char*)d_ws + WS_BAR, 0, XCD_BAR_WORDS * 4, stream) != hipSuccess) fprintf(stderr, "kernel_launch: memset of the barrier words failed\n");
    Params p{};
    for (int i = 0; i < 24; ++i) p.in[i] = (const float*)d_in[i];
    p.out = (float*)d_out; p.ws = (unsigned char*)d_ws;
#if N_LAUNCH_MODE == 1
    p.ph_lo = 0; p.ph_hi = NPHASE;
    void* args[] = {&p};
    hipError_t e = hipLaunchCooperativeKernel((const void*)mega, dim3(grid), dim3(512), args, LDS_BYTES, stream);
    if (e != hipSuccess) fprintf(stderr, "kernel_launch: cooperative launch failed: %s (grid %d)\n", hipGetErrorString(e), grid);
#else
    for (int ph = 0; ph < NPHASE; ++ph) { p.ph_lo = ph; p.ph_hi = ph + 1; hipLaunchKernelGGL(mega, dim3(grid), dim3(512), LDS_BYTES, stream, p); }
#endif
}
```

```cpp
#include <hip/hip_runtime.h>
#include <hip/hip_cooperative_groups.h>
#include <cstdio>
#include <cstdint>
namespace cg = cooperative_groups;

#ifndef N_LAUNCH_MODE
#define N_LAUNCH_MODE 1
#endif

#ifndef REPMASK
#define REPMASK 0
#endif
#define LAS __attribute__((address_space(3)))
typedef _Float16 h16;
typedef _Float16 h16x8 __attribute__((ext_vector_type(8)));
typedef _Float16 h16x4 __attribute__((ext_vector_type(4)));
typedef float f32x2 __attribute__((ext_vector_type(2)));
typedef float f32x4 __attribute__((ext_vector_type(4)));
typedef float f32x16 __attribute__((ext_vector_type(16)));

constexpr int NTOK = 16384, DM = 1024, SEQ = 8192;
constexpr int LDS_MAIN = 131072;
constexpr int LDS_BYTES = LDS_MAIN + 16;
constexpr int NPHASE = 13;
constexpr size_t MiB = 1024 * 1024;
constexpr size_t WS_W1T = 0;
constexpr size_t WS_W2T = WS_W1T + (size_t)7168 * 1024 * 2;
constexpr size_t WS_W3T = WS_W2T + (size_t)1024 * 2048 * 2;
constexpr size_t WS_W4T = WS_W3T + (size_t)5376 * 1024 * 2;
constexpr size_t WS_STATS = 32 * MiB;
constexpr size_t WS_WSH = WS_STATS + 131072;
constexpr size_t WS_CWT = WS_WSH + 262144;
constexpr size_t WS_SBON = WS_CWT + 262144;
constexpr size_t WS_BAR = 35 * MiB;
constexpr size_t WS_XC = 36 * MiB, WS_G = 68 * MiB, WS_U = 100 * MiB, WS_V = 132 * MiB, WS_YCAT = 164 * MiB;
constexpr size_t WS_SPR = 0, WS_SPI = 232 * MiB;
constexpr size_t WS_O2 = 68 * MiB;
constexpr size_t WS_O1 = 36 * MiB, WS_PC = 68 * MiB, WS_ZCD = 168 * MiB, WS_FD = 216 * MiB;

namespace pg8 {
constexpr int BM = 256, BK = 64, HALF = 128, HTB = HALF * BK * 2, STAGE_BYTES = 8 * HTB, NXCD = 8, WGM = 8;
__host__ __device__ __forceinline__ int lds_byte(int r, int c) { const int st = (r >> 4) * 2 + (c >> 5), rr = r & 15, cc = c & 31, ob = rr * 64 + cc * 2; return st * 1024 + (ob ^ (((ob >> 9) & 1) << 5)); }
__host__ __device__ __forceinline__ void stage_rc(int b, int& R, int& C) { const int st = b / 1024, sb = b % 1024, swz = sb ^ (((sb >> 9) & 1) << 5); R = (st >> 1) * 16 + swz / 64; C = (st & 1) * 32 + (swz % 64) / 2; }
__host__ __device__ __forceinline__ int perm32(int rho) { const int n = rho >> 4, i = rho & 15; return 8 * (i >> 2) + 4 * n + (i & 3); }
struct Unit { int pm, pn; };
struct Gemm { const h16* A; const h16* Bt; int M, N, K; };
struct StaticOrder {
    int nM, nN, nwg, G, c;
    __host__ __device__ void init(int M, int N, int G_, int c_) { nM = M / BM; nN = N / BM; nwg = nM * nN; G = G_; c = c_; }
    __host__ __device__ bool next(int i, Unit& u) const {
        const long L = (long)i * G + c; if (L >= nwg) return false;
        int wgid = (int)L; { const int q = nwg / NXCD, r = nwg % NXCD, xcd = wgid % NXCD, off = wgid / NXCD; wgid = (xcd < r ? xcd * (q + 1) : r * (q + 1) + (xcd - r) * q) + off; }
        const int nig = WGM * nN, gid = wgid / nig, fm = gid * WGM, gsz = (nM - fm) < WGM ? (nM - fm) : WGM;
        u.pm = fm + ((wgid % nig) % gsz); u.pn = (wgid % nig) / gsz; return true;
    }
};
template <class Epi>
__device__ __forceinline__ void gemm_phase(LAS unsigned char* lds, const Gemm g, const StaticOrder& S, const Epi& E) {
    const int tid = threadIdx.x, wid = __builtin_amdgcn_readfirstlane(tid >> 6), lane = tid & 63, wr = wid >> 2, wc = wid & 3, fr = lane & 15, fq = lane >> 4;
    const int K = g.K, nt = K / BK;
    unsigned voffA[2], voffB[2];
#pragma unroll
    for (int i = 0; i < 2; ++i) { int R, C; stage_rc(tid * 16 + i * 8192, R, C); const int Rb = Epi::PERM ? ((R & ~31) + perm32(R & 31)) : R; voffA[i] = (unsigned)(R * K + C) * 2u; voffB[i] = (unsigned)(Rb * K + C) * 2u; }
    const size_t kstep = (size_t)(BK * 2);
    const size_t hstep = (size_t)HALF * K * 2;
    const size_t tstep = 2 * hstep;
    const unsigned ldsw = (unsigned)wid * 1024u;
    const int aoff = lds_byte(wr * 64 + fr, fq * 8), boff = lds_byte(wc * 32 + fr, fq * 8);
#define PG8_SA(b, h) (((b) * 2 + (h)) * HTB)
#define PG8_SB(b, h) ((4 + (b) * 2 + (h)) * HTB)
#define PG8_STAGE(bufoff, gbase, voff) do { _Pragma("unroll") for (int _i = 0; _i < 2; ++_i) \
        __builtin_amdgcn_global_load_lds((const unsigned*)((const char*)(gbase) + (voff)[_i]), (LAS unsigned*)(lds + (bufoff) + ldsw + _i * 8192), 16, 0, 0); } while (0)
#define PG8_LDA(dst, b, h) do { _Pragma("unroll") for (int m = 0; m < 4; ++m) _Pragma("unroll") for (int k = 0; k < 2; ++k) dst[m][k] = *(const LAS h16x8*)(lds + PG8_SA(b, h) + aoff + m * 2048 + k * 1024); } while (0)
#define PG8_LDB(dst, b, h) do { _Pragma("unroll") for (int n = 0; n < 2; ++n) _Pragma("unroll") for (int k = 0; k < 2; ++k) dst[n][k] = *(const LAS h16x8*)(lds + PG8_SB(b, h) + boff + n * 2048 + k * 1024); } while (0)
#define PG8_MMA(ai, bj, At, Bt) do { __builtin_amdgcn_s_setprio(1); _Pragma("unroll") for (int m = 0; m < 4; ++m) _Pragma("unroll") for (int n = 0; n < 2; ++n) _Pragma("unroll") for (int k = 0; k < 2; ++k) \
        acc[ai][bj][m][n] = __builtin_amdgcn_mfma_f32_16x16x32_f16(Bt[n][k], At[m][k], acc[ai][bj][m][n], 0, 0, 0); __builtin_amdgcn_s_setprio(0); } while (0)
#define PG8_WAIT_V(n) asm volatile("s_waitcnt vmcnt(" #n ")" ::: "memory")
#define PG8_WAIT_L(n) asm volatile("s_waitcnt lgkmcnt(" #n ")" ::: "memory")
#define PG8_BAR __builtin_amdgcn_s_barrier()
#define PG8_SCHED __builtin_amdgcn_sched_barrier(0)
    Unit cur, nxt; int ui = 0;
    if (!S.next(0, cur)) return;
    f32x4 acc[2][2][4][2];
#pragma unroll
    for (int a = 0; a < 2; ++a)
#pragma unroll
        for (int b = 0; b < 2; ++b)
#pragma unroll
            for (int m = 0; m < 4; ++m)
#pragma unroll
                for (int n = 0; n < 2; ++n) acc[a][b][m][n] = (f32x4){0.f, 0.f, 0.f, 0.f};
    h16x8 At[4][2], B0[2][2], B1[2][2];
    const char* cA = (const char*)g.A + (size_t)cur.pm * tstep; const char* cB = (const char*)g.Bt + (size_t)cur.pn * tstep;
    PG8_STAGE(PG8_SB(0, 0), cB, voffB); PG8_STAGE(PG8_SA(0, 0), cA, voffA); PG8_STAGE(PG8_SB(0, 1), cB + hstep, voffB); PG8_STAGE(PG8_SA(0, 1), cA + hstep, voffA);
    if (wr == 1) PG8_BAR;
    PG8_WAIT_V(4); PG8_BAR;
    PG8_STAGE(PG8_SB(1, 0), cB + kstep, voffB); PG8_STAGE(PG8_SA(1, 0), cA + kstep, voffA); PG8_STAGE(PG8_SB(1, 1), cB + hstep + kstep, voffB);
    PG8_WAIT_V(6); PG8_BAR;
    for (;;) {
        const bool has_next = S.next(ui + 1, nxt);
        const char* nA = has_next ? (const char*)g.A + (size_t)nxt.pm * tstep : cA; const char* nB = has_next ? (const char*)g.Bt + (size_t)nxt.pn * tstep : cB;
        for (int t = 0; t < nt; t += 2) {
            const bool last = (t == nt - 2);
            const char* a1 = cA + (size_t)(t + 1) * kstep;
            const char* a2 = last ? nA : cA + (size_t)(t + 2) * kstep; const char* b2 = last ? nB : cB + (size_t)(t + 2) * kstep;
            const char* a3 = a2 + kstep; const char* b3 = b2 + kstep;
            PG8_LDB(B0, 0, 0); PG8_SCHED; PG8_LDA(At, 0, 0); PG8_STAGE(PG8_SA(1, 1), a1 + hstep, voffA);
            PG8_WAIT_L(8); PG8_BAR; PG8_WAIT_L(0); PG8_MMA(0, 0, At, B0); PG8_BAR; PG8_SCHED;
            PG8_LDB(B1, 0, 1); PG8_STAGE(PG8_SB(0, 0), b2, voffB);
            PG8_BAR; PG8_WAIT_L(0); PG8_MMA(0, 1, At, B1); PG8_BAR;
            PG8_LDA(At, 0, 1); PG8_STAGE(PG8_SA(0, 0), a2, voffA);
            PG8_BAR; PG8_WAIT_L(0); PG8_MMA(1, 0, At, B0); PG8_BAR; PG8_SCHED;
            PG8_STAGE(PG8_SB(0, 1), b2 + hstep, voffB);
            PG8_WAIT_V(6); PG8_BAR; PG8_MMA(1, 1, At, B1); PG8_BAR;
            PG8_LDB(B0, 1, 0); PG8_SCHED; PG8_LDA(At, 1, 0); PG8_STAGE(PG8_SA(0, 1), a2 + hstep, voffA);
            PG8_WAIT_L(8); PG8_BAR; PG8_WAIT_L(0); PG8_MMA(0, 0, At, B0); PG8_BAR; PG8_SCHED;
            PG8_LDB(B1, 1, 1); PG8_STAGE(PG8_SB(1, 0), b3, voffB);
            PG8_BAR; PG8_WAIT_L(0); PG8_MMA(0, 1, At, B1); PG8_BAR;
            PG8_LDA(At, 1, 1); PG8_STAGE(PG8_SA(1, 0), a3, voffA);
            PG8_BAR; PG8_WAIT_L(0); PG8_MMA(1, 0, At, B0); PG8_BAR; PG8_SCHED;
            PG8_STAGE(PG8_SB(1, 1), b3 + hstep, voffB);
            PG8_WAIT_V(6); PG8_BAR; PG8_MMA(1, 1, At, B1); PG8_BAR;
        }
        E(acc, cur, wr, wc, fr, fq);
        if (!has_next) break;
#pragma unroll
        for (int a = 0; a < 2; ++a)
#pragma unroll
            for (int b = 0; b < 2; ++b)
#pragma unroll
                for (int m = 0; m < 4; ++m)
#pragma unroll
                    for (int n = 0; n < 2; ++n) acc[a][b][m][n] = (f32x4){0.f, 0.f, 0.f, 0.f};
        cur = nxt; cA = nA; cB = nB; ++ui;
    }
    PG8_WAIT_V(0);
    if (wr == 0) PG8_BAR;
    PG8_BAR;
#undef PG8_SA
#undef PG8_SB
#undef PG8_STAGE
#undef PG8_LDA
#undef PG8_LDB
#undef PG8_MMA
#undef PG8_WAIT_V
#undef PG8_WAIT_L
#undef PG8_BAR
#undef PG8_SCHED
}
}


#define XB_TMO      128
#define XB_XCNT(j)  (256  + 64 * (j))
#define XB_XSUB(j)  (1280 + 64 * (j))
#define XB_XGEN(j)  (2304 + 64 * (j))
#define XB_TOP      3328
#define XB_TOPGEN   3392
#define XCD_BAR_WORDS 3456
#define XB_SPIN_CAP (1u << 18)
__device__ __forceinline__ unsigned xb_ld(unsigned* p)              { return __hip_atomic_load(p, __ATOMIC_RELAXED, __HIP_MEMORY_SCOPE_AGENT); }
__device__ __forceinline__ unsigned xb_add(unsigned* p, unsigned v) { return __hip_atomic_fetch_add(p, v, __ATOMIC_RELAXED, __HIP_MEMORY_SCOPE_AGENT); }
__device__ __forceinline__ unsigned xb_xcc_id() { return (unsigned)__builtin_amdgcn_s_getreg((3 << 11) | 20) & 0xFu; }
#define XB_SPIN(cond, bar) do { unsigned _sp = 0; while (cond) { __builtin_amdgcn_s_sleep(1); \
    if ((++_sp & 255u) == 0u) { if (xb_ld(&(bar)[XB_TMO])) break; if (_sp > XB_SPIN_CAP) { atomicAdd(&(bar)[XB_TMO], 1u); break; } } } } while (0)
struct XcdBarrier { unsigned* bar; unsigned x; volatile LAS unsigned* st; };
__device__ __forceinline__ XcdBarrier xcd_barrier_post(unsigned* bar, volatile LAS unsigned* st) {
    XcdBarrier b; b.bar = bar; b.x = xb_xcc_id(); b.st = st;
    if (threadIdx.x == 0) (void)xb_add(&bar[XB_XCNT(b.x)], 1u);
    return b;
}
__device__ __forceinline__ void xcd_barrier_complete(unsigned* bar, unsigned x, unsigned& nloc, unsigned& nx) {
    const unsigned G = gridDim.x * gridDim.y * gridDim.z;
    unsigned sum, cnt, mine, sp = 0u;
    for (;;) {
        sum = 0u; cnt = 0u; mine = 0u;
#pragma unroll
        for (unsigned j = 0; j < 16; ++j) { const unsigned c = xb_ld(&bar[XB_XCNT(j)]); sum += c; cnt += (c > 0u) ? 1u : 0u; mine = (j == x) ? c : mine; }
        if (sum == G) break;
        __builtin_amdgcn_s_sleep(1);
        if ((++sp & 255u) == 0u) { if (xb_ld(&bar[XB_TMO])) break; if (sp > XB_SPIN_CAP) { atomicAdd(&bar[XB_TMO], 1u); break; } }
    }
    nloc = mine > 0u ? mine : 1u; nx = cnt > 0u ? cnt : 1u;
}
__device__ __forceinline__ void xcd_barrier(const XcdBarrier& b) {
    asm volatile("s_waitcnt vmcnt(0)" ::: "memory");
    __syncthreads();
    if (threadIdx.x == 0) {
        unsigned* bar = b.bar;
        __builtin_amdgcn_s_waitcnt(0);
        unsigned nloc = b.st[0], nx = b.st[1];
        if (nloc == 0u) { xcd_barrier_complete(bar, b.x, nloc, nx); b.st[0] = nloc; b.st[1] = nx; }
        const unsigned old = xb_add(&bar[XB_XSUB(b.x)], 1u);
        const unsigned gen = old / nloc;
        if (old + 1u == (gen + 1u) * nloc) {
            __builtin_amdgcn_fence(__ATOMIC_RELEASE, "agent");
            asm volatile("s_waitcnt vmcnt(0)" ::: "memory");
            const unsigned og = xb_add(&bar[XB_TOP], 1u);
            const unsigned tg = og / nx;
            if (og + 1u == (tg + 1u) * nx) xb_add(&bar[XB_TOPGEN], 1u);
            else XB_SPIN(xb_ld(&bar[XB_TOPGEN]) == tg, bar);
            __builtin_amdgcn_fence(__ATOMIC_ACQUIRE, "agent");
            xb_add(&bar[XB_XGEN(b.x)], 1u);
            asm volatile("s_waitcnt vmcnt(0)" ::: "memory");
        } else {
            XB_SPIN(xb_ld(&bar[XB_XGEN(b.x)]) == gen, bar);
            __builtin_amdgcn_fence(__ATOMIC_ACQUIRE, "agent");
            asm volatile("s_waitcnt vmcnt(0)" ::: "memory");
        }
    }
    __syncthreads();
}

struct Params { const float* in[24]; float* out; unsigned char* ws; int ph_lo, ph_hi; };

__device__ __forceinline__ float silu_f(float x) { return x * __builtin_amdgcn_rcpf(1.f + __expf(-x)); }
__device__ __forceinline__ float sigmoid_f(float x) { return __builtin_amdgcn_rcpf(1.f + __expf(-x)); }
__device__ __forceinline__ float tanh_f(float x) { return 1.f - 2.f * __builtin_amdgcn_rcpf(__expf(2.f * x) + 1.f); }
__device__ __forceinline__ float wave_sum(float v) {
#pragma unroll
    for (int o = 1; o < 64; o <<= 1) v += __shfl_xor(v, o);
    return v;
}
template <int CTRL> __device__ __forceinline__ float dpp_f(float x) { return __int_as_float(__builtin_amdgcn_update_dpp(0, __float_as_int(x), CTRL, 0xf, 0xf, false)); }
__device__ __forceinline__ float red8(float x) {
    x += dpp_f<0xB1>(x); x += dpp_f<0x4E>(x); x += dpp_f<0x141>(x); return x;
}
__device__ __forceinline__ float red16(float x) {
    x += dpp_f<0xB1>(x); x += dpp_f<0x4E>(x); x += dpp_f<0x141>(x); x += dpp_f<0x140>(x); return x;
}

__device__ __forceinline__ int sigma1(int np) {
    const int T = np >> 8, c = np & 255;
    if (T < 16) { const int bj = c >> 7, wc = (c >> 5) & 3, fq = (c >> 3) & 3, n = (c >> 2) & 1, e = c & 3; return 1024 * (2 * bj + n) + 64 * T + 16 * wc + 4 * fq + e; }
    if (T < 24) { return ((c >> 7) ? 6144 : 4096) + 128 * (T - 16) + (c & 127); }
    return 5120 + 256 * (T - 24) + c;
}

template <int MODE>
__device__ __forceinline__ void tr_item(const float* W, int K, int N, h16* WT, LAS float* scr, int item, int nblk, int lane) {
    const int kb = item / nblk, nb = item % nblk, k0 = 64 * kb, n0 = 32 * nb;
    const int np = n0 + (lane & 31);
    const int sc = (MODE == 1) ? sigma1(np) : np;
    const bool valid = (MODE != 2) || (np < 5248);
    float wv_[32];
#pragma unroll
    for (int i = 0; i < 32; ++i) { const int kk = 2 * i + (lane >> 5); wv_[i] = valid ? W[(size_t)(k0 + kk) * N + sc] : 0.f; }
#pragma unroll
    for (int i = 0; i < 32; ++i) { const int kk = 2 * i + (lane >> 5); scr[kk * 33 + (lane & 31)] = wv_[i]; }
    asm volatile("s_waitcnt lgkmcnt(0)" ::: "memory");
    const int c = lane & 7;
#pragma unroll
    for (int j = 0; j < 4; ++j) { const int n = (lane >> 3) + 8 * j; const LAS float* s = scr + (8 * c) * 33 + n;
        h16x8 o;
#pragma unroll
        for (int e = 0; e < 8; ++e) o[e] = (h16)s[e * 33];
        *(h16x8*)(WT + (size_t)(n0 + n) * K + k0 + 8 * c) = o; }
    asm volatile("s_waitcnt lgkmcnt(0)" ::: "memory");
}

__device__ __forceinline__ void rms_rows2_f16(const float* x0, const float* x1, const h16* ad0, const h16* ad1, const float* g, h16* or0, h16* or1, int lane) {
    f32x4 v[2][4]; h16x4 a[2][4]; float ss[2] = {0.f, 0.f};
#pragma unroll
    for (int j = 0; j < 4; ++j) { v[0][j] = *(const f32x4*)(x0 + 4 * lane + 256 * j); v[1][j] = *(const f32x4*)(x1 + 4 * lane + 256 * j);
        if (ad0) { a[0][j] = *(const h16x4*)(ad0 + 4 * lane + 256 * j); a[1][j] = *(const h16x4*)(ad1 + 4 * lane + 256 * j); } }
#pragma unroll
    for (int u = 0; u < 2; ++u)
#pragma unroll
        for (int j = 0; j < 4; ++j) {
            if (ad0) { v[u][j][0] += (float)a[u][j][0]; v[u][j][1] += (float)a[u][j][1]; v[u][j][2] += (float)a[u][j][2]; v[u][j][3] += (float)a[u][j][3]; }
            ss[u] += v[u][j][0] * v[u][j][0] + v[u][j][1] * v[u][j][1] + v[u][j][2] * v[u][j][2] + v[u][j][3] * v[u][j][3]; }
#pragma unroll
    for (int o = 1; o < 64; o <<= 1) { ss[0] += __shfl_xor(ss[0], o); ss[1] += __shfl_xor(ss[1], o); }
    const float rs0 = rsqrtf(ss[0] * (1.f / 1024.f) + 1e-6f), rs1 = rsqrtf(ss[1] * (1.f / 1024.f) + 1e-6f);
#pragma unroll
    for (int j = 0; j < 4; ++j) { const f32x4 gg = *(const f32x4*)(g + 4 * lane + 256 * j); h16x4 o0, o1;
#pragma unroll
        for (int e = 0; e < 4; ++e) { o0[e] = (h16)(v[0][j][e] * rs0 * gg[e]); o1[e] = (h16)(v[1][j][e] * rs1 * gg[e]); }
        *(h16x4*)(or0 + 4 * lane + 256 * j) = o0; *(h16x4*)(or1 + 4 * lane + 256 * j) = o1; }
}

__device__ __forceinline__ void phase0(const Params& p, LAS unsigned char* lds) {
    const int tid = threadIdx.x, lane = tid & 63, wave = tid >> 6;
    const int gw = blockIdx.x * 8 + wave, NGW = gridDim.x * 8;
    LAS float* scr = (LAS float*)(lds + wave * 8448);
    h16* W1T = (h16*)(p.ws + WS_W1T); h16* W2T = (h16*)(p.ws + WS_W2T); h16* W3T = (h16*)(p.ws + WS_W3T); h16* W4T = (h16*)(p.ws + WS_W4T);
    constexpr int I1 = 16 * 224, I2 = 32 * 32, I3 = 16 * 168, I4 = 24 * 32;
    for (int it = gw; it < I1 + I2 + I3 + I4; it += NGW) {
        int r = it;
        if (r < I1) { tr_item<1>(p.in[2], 1024, 7168, W1T, scr, r, 224, lane); continue; } r -= I1;
        if (r < I2) { tr_item<0>(p.in[8], 2048, 1024, W2T, scr, r, 32, lane); continue; } r -= I2;
        if (r < I3) { tr_item<2>(p.in[10], 1024, 5248, W3T, scr, r, 168, lane); continue; } r -= I3;
        tr_item<0>(p.in[22], 1536, 1024, W4T, scr, r, 32, lane);
    }
    h16* H0 = (h16*)p.out;
    for (int r = gw; r < NTOK; r += 2 * NGW) { const int r1 = (r + NGW < NTOK) ? r + NGW : r;
        rms_rows2_f16(p.in[0] + (size_t)r * DM, p.in[0] + (size_t)r1 * DM, nullptr, nullptr, p.in[1], H0 + (size_t)r * DM, H0 + (size_t)r1 * DM, lane); }
    const int gt = blockIdx.x * 512 + tid, NGT = gridDim.x * 512;
    h16* WSH = (h16*)(p.ws + WS_WSH);
    for (int i = gt; i < 8 * 128 * 128; i += NGT) WSH[i] = (h16)p.in[6][i];
    { float* STZ = (float*)(p.ws + WS_STATS); for (int i = gt; i < 2 * NTOK; i += NGT) STZ[i] = 0.f; }
    h16* CWT = (h16*)(p.ws + WS_CWT);
    const float* wf = p.in[21];
    for (int i = gt; i < 4 * 128 * 256; i += NGT) {
        const int k = i & 255, e = (i >> 8) & 127, g = i >> 15, d = k & 127; const bool sn = k >= 128;
        float s = 0.f;
        for (int dp = 0; dp < 128; ++dp) { const float fr = (float)((d * dp) & 127) * (1.f / 128.f);
            const float tw = sn ? __builtin_amdgcn_sinf(fr) : __builtin_amdgcn_cosf(fr);
            s += tw * wf[(g * 128 + dp) * 128 + e]; }
        CWT[i] = (h16)(s * 0.08838834764831845f);
    }
}

struct Epi1 {
    static constexpr bool PERM = true;
    h16 *XC, *G, *U, *V; float* st;
    __device__ __forceinline__ void operator()(const f32x4 (&acc)[2][2][4][2], const pg8::Unit& u, int wr, int wc, int fr, int fq) const {
        const int T = u.pn; const int row0 = u.pm * 256 + wr * 64 + fr;
        if (T < 16) {
            const int ch = 64 * T + 16 * wc + 4 * fq;
#pragma unroll
            for (int ai = 0; ai < 2; ++ai)
#pragma unroll
                for (int m = 0; m < 4; ++m) { const size_t r = (size_t)(row0 + ai * 128 + m * 16);
                    const f32x4 xa = acc[ai][0][m][0], ba = acc[ai][0][m][1], ca = acc[ai][1][m][0], za = acc[ai][1][m][1];
                    h16x4 xc, gg;
#pragma unroll
                    for (int e = 0; e < 4; ++e) { xc[e] = (h16)(ca[e] * xa[e]); gg[e] = (h16)(ba[e] * silu_f(za[e])); }
                    *(h16x4*)(XC + r * 1024 + ch) = xc; *(h16x4*)(G + r * 1024 + ch) = gg; }
        } else if (T < 24) {
            const int ch = 128 * (T - 16) + 32 * wc + 8 * fq;
#pragma unroll
            for (int ai = 0; ai < 2; ++ai)
#pragma unroll
                for (int m = 0; m < 4; ++m) { const size_t r = (size_t)(row0 + ai * 128 + m * 16); h16x8 o;
#pragma unroll
                    for (int n = 0; n < 2; ++n) { const f32x4 ub = acc[ai][0][m][n], zb = acc[ai][1][m][n];
#pragma unroll
                        for (int e = 0; e < 4; ++e) o[4 * n + e] = (h16)(ub[e] * silu_f(zb[e])); }
                    *(h16x8*)(U + r * 1024 + ch) = o; }
        } else {
#pragma unroll
            for (int ai = 0; ai < 2; ++ai)
#pragma unroll
                for (int m = 0; m < 4; ++m) { const size_t r = (size_t)(row0 + ai * 128 + m * 16); float s1 = 0.f, s2 = 0.f;
#pragma unroll
                    for (int bj = 0; bj < 2; ++bj) { const int ch = 256 * (T - 24) + 128 * bj + 32 * wc + 8 * fq; h16x8 o;
#pragma unroll
                        for (int n = 0; n < 2; ++n) { const f32x4 v = acc[ai][bj][m][n];
#pragma unroll
                            for (int e = 0; e < 4; ++e) { o[4 * n + e] = (h16)v[e]; const float f = (float)o[4 * n + e]; s1 += f; s2 += f * f; } }
                        *(h16x8*)(V + r * 1024 + ch) = o; }
                    s1 += __shfl_xor(s1, 16); s2 += __shfl_xor(s2, 16); s1 += __shfl_xor(s1, 32); s2 += __shfl_xor(s2, 32);
                    if (fq == 0) { atomicAdd(st + 2 * r, s1); atomicAdd(st + 2 * r + 1, s2); } }
        }
    }
};
struct Epi2 {
    static constexpr bool PERM = true;
    h16* O1;
    __device__ __forceinline__ void operator()(const f32x4 (&acc)[2][2][4][2], const pg8::Unit& u, int wr, int wc, int fr, int fq) const {
        const int row0 = u.pm * 256 + wr * 64 + fr, col0 = u.pn * 256 + wc * 32 + 8 * fq;
#pragma unroll
        for (int ai = 0; ai < 2; ++ai)
#pragma unroll
            for (int m = 0; m < 4; ++m) { const size_t r = (size_t)(row0 + ai * 128 + m * 16);
#pragma unroll
                for (int bj = 0; bj < 2; ++bj) { const f32x4 v0 = acc[ai][bj][m][0], v1 = acc[ai][bj][m][1]; h16x8 o;
#pragma unroll
                    for (int e = 0; e < 4; ++e) { o[e] = (h16)v0[e]; o[4 + e] = (h16)v1[e]; }
                    *(h16x8*)(O1 + r * 1024 + col0 + bj * 128) = o; } }
    }
};
struct Epi3 {
    static constexpr bool PERM = true;
    h16 *PC, *ZCD, *FD;
    __device__ __forceinline__ void operator()(const f32x4 (&acc)[2][2][4][2], const pg8::Unit& u, int wr, int wc, int fr, int fq) const {
        const int row0 = u.pm * 256 + wr * 64 + fr, col0 = u.pn * 256 + wc * 32 + 8 * fq;
#pragma unroll
        for (int bj = 0; bj < 2; ++bj) { const int c = col0 + bj * 128;
            h16* base; size_t ld;
            if (c < 3200) { base = PC + c; ld = 3200; }
            else if (c < 4224) { base = ZCD + (c - 3200); ld = 1536; }
            else if (c < 4736) {
                const int cg = (c - 4224) >> 2;
#pragma unroll
                for (int ai = 0; ai < 2; ++ai)
#pragma unroll
                    for (int m = 0; m < 4; ++m) { const size_t r = (size_t)(row0 + ai * 128 + m * 16); const f32x4 v0 = acc[ai][bj][m][0], v1 = acc[ai][bj][m][1]; h16x4 o0, o1;
#pragma unroll
                        for (int e = 0; e < 4; ++e) { o0[e] = (h16)v0[e]; o1[e] = (h16)v1[e]; }
                        *(h16x4*)(FD + ((size_t)cg * NTOK + r) * 4) = o0; *(h16x4*)(FD + ((size_t)(cg + 1) * NTOK + r) * 4) = o1; }
                continue; }
            else if (c < 5248) { base = ZCD + 1024 + (c - 4736); ld = 1536; }
            else continue;
#pragma unroll
            for (int ai = 0; ai < 2; ++ai)
#pragma unroll
                for (int m = 0; m < 4; ++m) { const size_t r = (size_t)(row0 + ai * 128 + m * 16); const f32x4 v0 = acc[ai][bj][m][0], v1 = acc[ai][bj][m][1]; h16x8 o;
#pragma unroll
                    for (int e = 0; e < 4; ++e) { o[e] = (h16)v0[e]; o[4 + e] = (h16)v1[e]; }
                    *(h16x8*)(base + r * ld) = o; } }
    }
};
struct Epi4 {
    static constexpr bool PERM = true;
    h16* O2;
    __device__ __forceinline__ void operator()(const f32x4 (&acc)[2][2][4][2], const pg8::Unit& u, int wr, int wc, int fr, int fq) const {
        const int row0 = u.pm * 256 + wr * 64 + fr, col0 = u.pn * 256 + wc * 32 + 8 * fq;
#pragma unroll
        for (int ai = 0; ai < 2; ++ai)
#pragma unroll
            for (int m = 0; m < 4; ++m) { const size_t r = (size_t)(row0 + ai * 128 + m * 16);
#pragma unroll
                for (int bj = 0; bj < 2; ++bj) { const f32x4 v0 = acc[ai][bj][m][0], v1 = acc[ai][bj][m][1]; h16x8 o;
#pragma unroll
                    for (int e = 0; e < 4; ++e) { o[e] = (h16)v0[e]; o[4 + e] = (h16)v1[e]; }
                    *(h16x8*)(O2 + r * 1024 + col0 + bj * 128) = o; } }
    }
};

__device__ __forceinline__ void phase_stats(const Params& p) {
    const int tid = threadIdx.x, lane = tid & 63, wave = tid >> 6;
    const int gw = blockIdx.x * 8 + wave, NGW = gridDim.x * 8;
    const h16* V = (const h16*)(p.ws + WS_V); float* ST = (float*)(p.ws + WS_STATS);
    for (int r = gw; r < NTOK; r += NGW) {
        const h16x8 a = *(const h16x8*)(V + (size_t)r * 1024 + 8 * lane), b = *(const h16x8*)(V + (size_t)r * 1024 + 512 + 8 * lane);
        float s = 0.f;
#pragma unroll
        for (int e = 0; e < 8; ++e) s += (float)a[e] + (float)b[e];
        const float mu = wave_sum(s) * (1.f / 1024.f); float q = 0.f;
#pragma unroll
        for (int e = 0; e < 8; ++e) { const float x = (float)a[e] - mu, y = (float)b[e] - mu; q += x * x + y * y; }
        const float rs = rsqrtf(wave_sum(q) * (1.f / 1024.f) + 1e-5f);
        if (lane == 0) { ST[2 * r] = mu; ST[2 * r + 1] = rs; }
    }
}

__device__ __forceinline__ void phase_mix0(const Params& p, LAS unsigned char* lds) {
    const int tid = threadIdx.x, lane = tid & 63, wave = tid >> 6;
    const h16* XC = (const h16*)(p.ws + WS_XC); const h16* G = (const h16*)(p.ws + WS_G); const h16* U = (const h16*)(p.ws + WS_U); const h16* V = (const h16*)(p.ws + WS_V);
    h16* YC = (h16*)(p.ws + WS_YCAT);
    const float* cw = p.in[3];
    const int gt = blockIdx.x * 512 + tid, NGT = gridDim.x * 512;
    for (int idx = gt; idx < (NTOK / 4) * 128; idx += NGT) {
        const int tb = (idx >> 7) * 4, c8 = (idx & 127) * 8, tp = tb & (SEQ - 1);
        const h16x8 zero = {0, 0, 0, 0, 0, 0, 0, 0};
        h16x8 xr[6], gg[4];
        xr[0] = tp > 0 ? *(const h16x8*)(XC + (size_t)(tb - 1) * 1024 + c8) : zero;
#pragma unroll
        for (int u = 0; u < 4; ++u) { xr[1 + u] = *(const h16x8*)(XC + (size_t)(tb + u) * 1024 + c8); gg[u] = *(const h16x8*)(G + (size_t)(tb + u) * 1024 + c8); }
        xr[5] = tp + 4 < SEQ ? *(const h16x8*)(XC + (size_t)(tb + 4) * 1024 + c8) : zero;
        float w0[8], w1[8], w2[8];
#pragma unroll
        for (int e = 0; e < 8; ++e) { w0[e] = cw[c8 + e]; w1[e] = cw[1024 + c8 + e]; w2[e] = cw[2048 + c8 + e]; }
#pragma unroll
        for (int u = 0; u < 4; ++u) { h16x8 o;
#pragma unroll
            for (int e = 0; e < 8; ++e) { const float y = w0[e] * (float)xr[u][e] + w1[e] * (float)xr[u + 1][e] + w2[e] * (float)xr[u + 2][e]; o[e] = (h16)(y * (float)gg[u][e]); }
            *(h16x8*)(YC + (size_t)(tb + u) * 2048 + c8) = o; }
    }
    const float* ST = (const float*)(p.ws + WS_STATS); const h16* WSH = (const h16*)(p.ws + WS_WSH);
    const float* lng = p.in[4]; const float* lnb = p.in[5]; const float* bs = p.in[7];
    LAS h16* vnT = (LAS h16*)lds;
    for (int it = blockIdx.x; it < 1024; it += gridDim.x) {
        const int g = it & 7, bn = it >> 3, t0 = bn * 128;
        __syncthreads();
#pragma unroll
        for (int q = 0; q < 4; ++q) { const int pc = tid + 512 * q, j = pc >> 4, d8 = (pc & 15) * 8;
            const h16x8 v = *(const h16x8*)(V + (size_t)(t0 + j) * 1024 + g * 128 + d8);
            const float mu = ST[2 * (t0 + j)] * (1.f / 1024.f), rs = rsqrtf(fmaxf(ST[2 * (t0 + j) + 1] * (1.f / 1024.f) - mu * mu, 0.f) + 1e-5f);
#pragma unroll
            for (int e = 0; e < 8; ++e) vnT[(d8 + e) * 136 + ((((j >> 3) ^ (pc & 15)) << 3) | (j & 7))] = (h16)(((float)v[e] - mu) * rs * lng[g * 128 + d8 + e] + lnb[g * 128 + d8 + e]); }
        __syncthreads();
        const int itile = wave >> 1, dt0 = (wave & 1) * 2;
        f32x16 acc0, acc1;
#pragma unroll
        for (int e = 0; e < 16; ++e) { acc0[e] = 0.f; acc1[e] = 0.f; }
        const h16* Arow = WSH + ((size_t)g * 128 + itile * 32 + (lane & 31)) * 128 + 8 * (lane >> 5);
        const int d0_ = dt0 * 32 + (lane & 31), d1_ = d0_ + 32;
        const LAS h16* B0p = vnT + d0_ * 136; const LAS h16* B1p = vnT + d1_ * 136;
#pragma unroll
        for (int ks = 0; ks < 8; ++ks) {
            const h16x8 a = *(const h16x8*)(Arow + 16 * ks);
            const int jg = 2 * ks + (lane >> 5);
            const h16x8 b0 = *(const LAS h16x8*)(B0p + ((jg ^ ((d0_ >> 3) & 15)) << 3)), b1 = *(const LAS h16x8*)(B1p + ((jg ^ ((d1_ >> 3) & 15)) << 3));
            acc0 = __builtin_amdgcn_mfma_f32_32x32x16_f16(a, b0, acc0, 0, 0, 0);
            acc1 = __builtin_amdgcn_mfma_f32_32x32x16_f16(a, b1, acc1, 0, 0, 0);
        }
#pragma unroll
        for (int r = 0; r < 16; ++r) { const int i = itile * 32 + (r & 3) + 8 * (r >> 2) + 4 * (lane >> 5); const size_t t = (size_t)(t0 + i);
            const float bias = bs[g * 128 + i];
            const int d0 = g * 128 + dt0 * 32 + (lane & 31);
            YC[t * 2048 + 1024 + d0] = (h16)((acc0[r] + bias) * (float)U[t * 1024 + d0]);
            YC[t * 2048 + 1024 + d0 + 32] = (h16)((acc1[r] + bias) * (float)U[t * 1024 + d0 + 32]); }
    }
}

__device__ __forceinline__ void phase_norm1(const Params& p) {
    const int tid = threadIdx.x, lane = tid & 63, wave = tid >> 6;
    const int gw = blockIdx.x * 8 + wave, NGW = gridDim.x * 8;
    const h16* O1 = (const h16*)(p.ws + WS_O1); h16* H1 = (h16*)p.out;
    for (int r = gw; r < NTOK; r += 2 * NGW) { const int r1 = (r + NGW < NTOK) ? r + NGW : r;
        rms_rows2_f16(p.in[0] + (size_t)r * DM, p.in[0] + (size_t)r1 * DM, O1 + (size_t)r * DM, O1 + (size_t)r1 * DM, p.in[9], H1 + (size_t)r * DM, H1 + (size_t)r1 * DM, lane); }
}

__device__ __forceinline__ void phase_fft(const Params& p, LAS unsigned char* lds) {
    const int tid = threadIdx.x;
    const h16* FD = (const h16*)(p.ws + WS_FD);
    h16* SPr = (h16*)(p.ws + WS_SPR); h16* SPi = (h16*)(p.ws + WS_SPI);
    LAS f32x2* X0 = (LAS f32x2*)lds; LAS f32x2* X1 = X0 + 8192;
    for (int it = blockIdx.x; it < 256; it += gridDim.x) {
        const int b = it >> 7, c0 = 4 * (it & 127);
        __syncthreads();
        for (int t = tid; t < SEQ; t += 512) { const h16x4 v = *(const h16x4*)(FD + ((size_t)(it & 127) * NTOK + b * SEQ + t) * 4);
            X0[t] = (f32x2){(float)v[0], (float)v[1]}; X1[t] = (f32x2){(float)v[2], (float)v[3]}; }
        __syncthreads();
        for (int s = 0; s < 6; ++s) {
            const int lq = 11 - 2 * s, q = 1 << lq;
            const float rn = 1.f / (float)(4 << lq);
#pragma unroll 2
            for (int j = tid; j < 2048; j += 512) {
                const int pp = j & (q - 1), i0 = ((j >> lq) << (lq + 2)) + pp;
                const float fr = (float)pp * rn;
                const float c1 = __builtin_amdgcn_cosf(fr), s1 = __builtin_amdgcn_sinf(fr), c2 = __builtin_amdgcn_cosf(2.f * fr), s2 = __builtin_amdgcn_sinf(2.f * fr), c3 = __builtin_amdgcn_cosf(3.f * fr), s3 = __builtin_amdgcn_sinf(3.f * fr);
#pragma unroll
                for (int f = 0; f < 2; ++f) { LAS f32x2* X = f ? X1 : X0;
                    const f32x2 a = X[i0], b_ = X[i0 + q], c_ = X[i0 + 2 * q], d_ = X[i0 + 3 * q];
                    const f32x2 t0 = a + c_, t1 = a - c_, t2 = b_ + d_, t3 = b_ - d_;
                    const f32x2 y0 = t0 + t2, y2 = t0 - t2;
                    const f32x2 y1 = {t1[0] + t3[1], t1[1] - t3[0]}, y3 = {t1[0] - t3[1], t1[1] + t3[0]};
                    X[i0] = y0;
                    X[i0 + q] = (f32x2){y1[0] * c1 + y1[1] * s1, y1[1] * c1 - y1[0] * s1};
                    X[i0 + 2 * q] = (f32x2){y2[0] * c2 + y2[1] * s2, y2[1] * c2 - y2[0] * s2};
                    X[i0 + 3 * q] = (f32x2){y3[0] * c3 + y3[1] * s3, y3[1] * c3 - y3[0] * s3}; }
            }
            __syncthreads();
        }
        for (int j = tid; j < 4096; j += 512) {
            { const f32x2 a = X0[2 * j], bb = X0[2 * j + 1]; X0[2 * j] = a + bb; X0[2 * j + 1] = a - bb; }
            { const f32x2 a = X1[2 * j], bb = X1[2 * j + 1]; X1[2 * j] = a + bb; X1[2 * j + 1] = a - bb; }
        }
        __syncthreads();
        const float sc = 0.5f * 0.011048543456039806f;
        for (int k = tid; k < SEQ; k += 512) {
            const unsigned kb = (unsigned)((SEQ - k) & (SEQ - 1));
            const unsigned ya_ = __brev((unsigned)k & 0xFFFu) >> 20, yb_ = __brev(kb & 0xFFFu) >> 20;
            const int ra = (int)(((((ya_ & 0xAAAu) >> 1) | ((ya_ & 0x555u) << 1)) << 1) | ((unsigned)k >> 12));
            const int rb = (int)(((((yb_ & 0xAAAu) >> 1) | ((yb_ & 0x555u) << 1)) << 1) | (kb >> 12));
            const f32x2 za = X0[ra], zb = X0[rb], ya = X1[ra], yb = X1[rb];
            h16x4 orr, oi;
            orr[0] = (h16)((za[0] + zb[0]) * sc); oi[0] = (h16)((za[1] - zb[1]) * sc);
            orr[1] = (h16)((za[1] + zb[1]) * sc); oi[1] = (h16)((zb[0] - za[0]) * sc);
            orr[2] = (h16)((ya[0] + yb[0]) * sc); oi[2] = (h16)((ya[1] - yb[1]) * sc);
            orr[3] = (h16)((ya[1] + yb[1]) * sc); oi[3] = (h16)((yb[0] - ya[0]) * sc);
            *(h16x4*)(SPr + ((size_t)(it & 127) * NTOK + b * SEQ + k) * 4) = orr; *(h16x4*)(SPi + ((size_t)(it & 127) * NTOK + b * SEQ + k) * 4) = oi;
        }
    }
}

__device__ __forceinline__ void phase_fnet_out(const Params& p, LAS unsigned char* lds) {
    const int tid = threadIdx.x, lane = tid & 63, wave = tid >> 6;
    const h16* SPr = (const h16*)(p.ws + WS_SPR); const h16* SPi = (const h16*)(p.ws + WS_SPI);
    const h16* CWT = (const h16*)(p.ws + WS_CWT); h16* ZCD = (h16*)(p.ws + WS_ZCD);
    LAS h16* Lr = (LAS h16*)lds; LAS h16* Li = Lr + 32 * 520;
    const int g = wave >> 1, eh = wave & 1;
    for (int it = blockIdx.x; it < 512; it += gridDim.x) {
        const int t0 = it * 32;
        __syncthreads();
#pragma unroll
        for (int q = 0; q < 8; ++q) { const int idx = tid + 512 * q, arr = idx >> 11, rem = idx & 2047, cg = rem >> 4, tp = rem & 15;
            const h16x8 v = *(const h16x8*)((arr ? SPi : SPr) + ((size_t)cg * NTOK + t0 + 2 * tp) * 4);
            LAS h16* d_ = (arr ? Li : Lr) + (2 * tp) * 520 + 4 * cg;
            *(LAS h16x4*)d_ = (h16x4){v[0], v[1], v[2], v[3]}; *(LAS h16x4*)(d_ + 520) = (h16x4){v[4], v[5], v[6], v[7]}; }
        __syncthreads();
        f32x16 acc0, acc1;
#pragma unroll
        for (int e = 0; e < 16; ++e) { acc0[e] = 0.f; acc1[e] = 0.f; }
        const LAS h16* Ar = Lr + (lane & 31) * 520 + g * 128 + 8 * (lane >> 5); const LAS h16* Ai = Li + (lane & 31) * 520 + g * 128 + 8 * (lane >> 5);
        const h16* B0 = CWT + ((size_t)(g * 128 + (2 * eh) * 32 + (lane & 31))) * 256 + 8 * (lane >> 5); const h16* B1 = B0 + 32 * 256;
#pragma unroll
        for (int ks = 0; ks < 8; ++ks) { const h16x8 a = *(const LAS h16x8*)(Ar + 16 * ks);
            acc0 = __builtin_amdgcn_mfma_f32_32x32x16_f16(a, *(const h16x8*)(B0 + 16 * ks), acc0, 0, 0, 0);
            acc1 = __builtin_amdgcn_mfma_f32_32x32x16_f16(a, *(const h16x8*)(B1 + 16 * ks), acc1, 0, 0, 0); }
#pragma unroll
        for (int ks = 0; ks < 8; ++ks) { const h16x8 a = *(const LAS h16x8*)(Ai + 16 * ks);
            acc0 = __builtin_amdgcn_mfma_f32_32x32x16_f16(a, *(const h16x8*)(B0 + 128 + 16 * ks), acc0, 0, 0, 0);
            acc1 = __builtin_amdgcn_mfma_f32_32x32x16_f16(a, *(const h16x8*)(B1 + 128 + 16 * ks), acc1, 0, 0, 0); }
        h16 z0[16], z1[16];
#pragma unroll
        for (int r = 0; r < 16; ++r) { const size_t t = (size_t)(t0 + (r & 3) + 8 * (r >> 2) + 4 * (lane >> 5));
            const h16* zp = ZCD + t * 1536 + 1024 + g * 128 + (2 * eh) * 32 + (lane & 31); z0[r] = zp[0]; z1[r] = zp[32]; }
#pragma unroll
        for (int r = 0; r < 16; ++r) { const size_t t = (size_t)(t0 + (r & 3) + 8 * (r >> 2) + 4 * (lane >> 5));
            h16* zp = ZCD + t * 1536 + 1024 + g * 128 + (2 * eh) * 32 + (lane & 31);
            zp[0] = (h16)(acc0[r] * silu_f((float)z0[r])); zp[32] = (h16)(acc1[r] * silu_f((float)z1[r])); }
    }
}

#define LDS_BAR() do { asm volatile("s_waitcnt lgkmcnt(0)" ::: "memory"); __builtin_amdgcn_s_barrier(); asm volatile("" ::: "memory"); } while (0)
#define LDS_WAIT() asm volatile("s_waitcnt lgkmcnt(0)" ::: "memory")
__device__ __forceinline__ void phase_scan(const Params& p, LAS unsigned char* lds) {
    const int tid = threadIdx.x, lane = tid & 63, wave = tid >> 6;
    const h16* PC = (const h16*)(p.ws + WS_PC);
    LAS h16* w2T = (LAS h16*)lds;
    LAS h16* a2T = w2T + 64 * 72;
    LAS unsigned char* priv = lds + 18432 + (wave & 3) * 4096;
    constexpr int SET_F = 5 * 2048 + 512;
    LAS float* OPS = (LAS float*)(lds + 18432 + 16384);
    LAS float* sYb = OPS + 2 * SET_F;
    for (int item = blockIdx.x; item < 256; item += gridDim.x) {
        const int xcd = item & 7, slot = item >> 3, gidx = xcd * 8 + (slot >> 2), q = slot & 3;
        const int dir = gidx >> 5, b = (gidx >> 4) & 1, h = gidx & 15;
        h16* Yd = (h16*)((unsigned char*)p.out + (size_t)dir * 32 * MiB);
        float* SB = (float*)(p.ws + WS_SBON) + (size_t)dir * NTOK * 16;
        const float* mu = p.in[11] + dir * 3200; const float* w0 = p.in[12] + dir * 1024 + 64 * h; const float* w2 = p.in[13] + (size_t)dir * 65536 + 64 * h;
        const float* a0 = p.in[14] + dir * 1024 + 64 * h; const float* a2 = p.in[15] + (size_t)dir * 65536 + 64 * h;
        const float* kkw = p.in[16] + 64 * h; const float* kaw = p.in[17] + 64 * h; const float* rkw = p.in[18] + 64 * h;
        __syncthreads();
        for (int i = tid; i < 4096; i += 512) { const int l = i >> 6, c = i & 63; w2T[c * 72 + l] = (h16)w2[l * 1024 + c]; a2T[c * 72 + l] = (h16)a2[l * 1024 + c]; }
        const int pw_ = wave & 3, s_sub = lane >> 3, c8 = (lane & 7) * 8, s_l = 8 * pw_ + s_sub;
        h16x8 mu_r8, mu_k8, mu_v8, mu_w8, mu_a8; f32x2 w0r[4], a0r[4], kkr[4], kar[4], omk[4], rkr[4];
#pragma unroll
        for (int e = 0; e < 8; ++e) { mu_r8[e] = (h16)mu[64 * h + c8 + e]; mu_k8[e] = (h16)mu[1024 + 64 * h + c8 + e]; mu_v8[e] = (h16)mu[2048 + 64 * h + c8 + e]; mu_w8[e] = (h16)mu[3072 + c8 + e]; mu_a8[e] = (h16)mu[3136 + c8 + e];
            w0r[e >> 1][e & 1] = w0[c8 + e]; a0r[e >> 1][e & 1] = a0[c8 + e]; kkr[e >> 1][e & 1] = kkw[c8 + e]; kar[e >> 1][e & 1] = kaw[c8 + e]; omk[e >> 1][e & 1] = 1.f - kaw[c8 + e]; rkr[e >> 1][e & 1] = rkw[c8 + e]; }
        f32x2 S01 = {0.f, 0.f}, S23 = {0.f, 0.f};
        const int srow = 4 * (wave & 3) + (lane >> 4), j0 = 4 * (lane & 15);
        const h16x8 z8 = {0, 0, 0, 0, 0, 0, 0, 0};
        h16x8 pr, pk, pv, pw, pa, qr_, qk_, qv_, qw_, qa_;
        const h16 *pcA, *pcB, *ppA, *ppB;
        { const int t0_ = dir ? (SEQ - 1 - s_l) : s_l; pcA = PC + (size_t)(b * SEQ + t0_) * 3200 + c8 + 64 * h; pcB = pcA + 2048 - 64 * h;
          const long po_ = (s_l > 0) ? (dir ? 3200 : -3200) : 0; ppA = pcA + po_; ppB = pcB + po_; }
        const long cstride_ = dir ? -32 * 3200 : 32 * 3200;
#define SCAN_LOAD_RAW() do { \
            pr = *(const h16x8*)(pcA); pk = *(const h16x8*)(pcA + 1024); pv = *(const h16x8*)(pcB + 64 * h); pw = *(const h16x8*)(pcB + 1024); pa = *(const h16x8*)(pcB + 1088); \
            qr_ = *(const h16x8*)(ppA); qk_ = *(const h16x8*)(ppA + 1024); qv_ = *(const h16x8*)(ppB + 64 * h); qw_ = *(const h16x8*)(ppB + 1024); qa_ = *(const h16x8*)(ppB + 1088); \
            pcA += cstride_; pcB += cstride_; ppA = pcA + (dir ? 3200 : -3200); ppB = pcB + (dir ? 3200 : -3200); } while (0)
#define SCAN_LOAD(chn) SCAN_LOAD_RAW()
#define SCAN_YSTORE(chn) do { const int sg_ = (chn) * 32 + s_l; const int t_ = dir ? (SEQ - 1 - sg_) : sg_; \
            const f32x2 y2_ = *(const LAS f32x2*)(sYb + ((chn) & 1) * 512 + s_l * 16 + 2 * (lane & 7)); \
            typedef _Float16 h16x2_ __attribute__((ext_vector_type(2))); h16x2_ o_; o_[0] = (h16)y2_[0]; o_[1] = (h16)y2_[1]; \
            *(h16x2_*)(Yd + (size_t)(b * SEQ + t_) * 1024 + 64 * h + 16 * q + 2 * (lane & 7)) = o_; } while (0)
        if (wave >= 4) { SCAN_LOAD_RAW(); if (s_l == 0) { qr_ = z8; qk_ = z8; qv_ = z8; qw_ = z8; qa_ = z8; } }
        __syncthreads();
        for (int n = -1; n < SEQ / 32; ++n) {
            if (wave < 4) {
                if (n >= 0) {
                    __builtin_amdgcn_s_setprio(3);
                    const LAS float* sR = OPS + (n & 1) * SET_F + j0; const LAS float* sW = sR + 2048; const LAS float* sK = sW + 2048; const LAS float* sA = sK + 2048; const LAS float* sB = sA + 2048; const LAS float* sV = OPS + (n & 1) * SET_F + 10240;
                    LAS float* sY = sYb + (n & 1) * 512;
                    f32x4 a_ = *(const LAS f32x4*)(sA), w_ = *(const LAS f32x4*)(sW), b_ = *(const LAS f32x4*)(sB);
                    f32x4 k_ = *(const LAS f32x4*)(sK), r_ = *(const LAS f32x4*)(sR);
                    f32x4 vq[4];
#pragma unroll
                    for (int u = 0; u < 4; ++u) vq[u] = *(const LAS f32x4*)(sV + srow * 32 + 4 * u);
                    f32x4 rp = r_;
#pragma unroll
                    for (int hb = 0; hb < 2; ++hb) {
                        f32x4 vn[4];
#pragma unroll
                        for (int u = 0; u < 4; ++u) vn[u] = *(const LAS f32x4*)(sV + srow * 32 + ((16 * (hb + 1)) & 31) + 4 * u);
#pragma unroll
                        for (int u16 = 0; u16 < 16; ++u16) {
                            const int s = 16 * hb + u16;
                            const int sn = (s + 1) & 31;
                            const f32x4 a_n = *(const LAS f32x4*)(sA + sn * 64), w_n = *(const LAS f32x4*)(sW + sn * 64), b_n = *(const LAS f32x4*)(sB + sn * 64);
                            const f32x4 k_n = *(const LAS f32x4*)(sK + sn * 64), r_n = *(const LAS f32x4*)(sR + sn * 64);
                            const float v = vq[u16 >> 2][u16 & 3];
                            const f32x2 vv = {v, v};
                            f32x2 pp = S01 * (f32x2){a_[0], a_[1]}; pp = S23 * (f32x2){a_[2], a_[3]} + pp;
                            f32x2 yy = S01 * (f32x2){rp[0], rp[1]}; yy = S23 * (f32x2){rp[2], rp[3]} + yy;
                            float sa = pp[0] + pp[1], y = yy[0] + yy[1];
                            sa += dpp_f<0xB1>(sa); y += dpp_f<0xB1>(y);
                            sa += dpp_f<0x4E>(sa); y += dpp_f<0x4E>(y);
                            sa += dpp_f<0x141>(sa); y += dpp_f<0x141>(y);
                            sa += dpp_f<0x140>(sa); y += dpp_f<0x140>(y);
                            sY[((s - 1) & 31) * 16 + srow] = y;
                            const f32x2 sv = {sa, sa};
                            S01 = S01 * (f32x2){w_[0], w_[1]} + vv * (f32x2){k_[0], k_[1]};
                            S23 = S23 * (f32x2){w_[2], w_[3]} + vv * (f32x2){k_[2], k_[3]};
                            S01 = sv * (f32x2){b_[0], b_[1]} + S01;
                            S23 = sv * (f32x2){b_[2], b_[3]} + S23;
                            rp = r_;
                            a_ = a_n; w_ = w_n; b_ = b_n; k_ = k_n; r_ = r_n;
                        }
#pragma unroll
                        for (int u = 0; u < 4; ++u) vq[u] = vn[u];
                    }
                    { f32x2 yy = S01 * (f32x2){rp[0], rp[1]}; yy = S23 * (f32x2){rp[2], rp[3]} + yy; sY[31 * 16 + srow] = red16(yy[0] + yy[1]); }
                    __builtin_amdgcn_s_setprio(0);
                }
            } else {
                if (n + 1 < SEQ / 32) {
                    const int cn = n + 1;
                    const int sg = cn * 32 + s_l; const int t = dir ? (SEQ - 1 - sg) : sg;
                    f32x2 qr[4], qk[4]; float qv[8];
                    LAS h16* TWp = (LAS h16*)priv; LAS h16* QAp = TWp + 8 * 72;
                    { unsigned m1u_ = 0xBC00BC00u; asm volatile("" : "+s"(m1u_));
                      typedef unsigned u32x4_ __attribute__((ext_vector_type(4))); const u32x4_ m1v_ = {m1u_, m1u_, m1u_, m1u_}; const h16x8 m1_ = __builtin_bit_cast(h16x8, m1v_);
                      const h16x8 r8 = pr + mu_r8 * (pr * m1_ + qr_), k8 = pk + mu_k8 * (pk * m1_ + qk_), v8 = pv + mu_v8 * (pv * m1_ + qv_);
                      const h16x8 w8 = pw + mu_w8 * (pw * m1_ + qw_), a8 = pa + mu_a8 * (pa * m1_ + qa_);
                      h16x8 tw8;
#pragma unroll
                      for (int pi = 0; pi < 4; ++pi) { qr[pi] = (f32x2){(float)r8[2 * pi], (float)r8[2 * pi + 1]}; qk[pi] = (f32x2){(float)k8[2 * pi], (float)k8[2 * pi + 1]};
                          qv[2 * pi] = (float)v8[2 * pi]; qv[2 * pi + 1] = (float)v8[2 * pi + 1];
                          const f32x2 tx = (f32x2){(float)w8[2 * pi], (float)w8[2 * pi + 1]} * 2.8853900817779268f;
                          const f32x2 dn = (f32x2){__builtin_amdgcn_exp2f(tx[0]), __builtin_amdgcn_exp2f(tx[1])} + 1.f;
                          const f32x2 th = (f32x2){__builtin_amdgcn_rcpf(dn[0]), __builtin_amdgcn_rcpf(dn[1])} * -2.f + 1.f;
                          tw8[2 * pi] = (h16)th[0]; tw8[2 * pi + 1] = (h16)th[1]; }
                      *(LAS h16x8*)(TWp + s_sub * 72 + c8) = tw8; *(LAS h16x8*)(QAp + s_sub * 72 + c8) = a8; }
                    if (cn + 1 < SEQ / 32) SCAN_LOAD(cn + 1);
                    LDS_WAIT();
                    f32x4 accw[4], acca[4];
#pragma unroll
                    for (int ct = 0; ct < 4; ++ct) { accw[ct] = (f32x4){0.f, 0.f, 0.f, 0.f}; acca[ct] = (f32x4){0.f, 0.f, 0.f, 0.f}; }
#pragma unroll
                    for (int ks = 0; ks < 2; ++ks) {
                        const h16x8 atw = *(const LAS h16x8*)(TWp + (lane & 7) * 72 + 32 * ks + 8 * (lane >> 4));
                        const h16x8 aqa = *(const LAS h16x8*)(QAp + (lane & 7) * 72 + 32 * ks + 8 * (lane >> 4));
#pragma unroll
                        for (int ct = 0; ct < 4; ++ct) {
                            const h16x8 bw = *(const LAS h16x8*)(w2T + (16 * ct + (lane & 15)) * 72 + 32 * ks + 8 * (lane >> 4));
                            const h16x8 ba = *(const LAS h16x8*)(a2T + (16 * ct + (lane & 15)) * 72 + 32 * ks + 8 * (lane >> 4));
                            accw[ct] = __builtin_amdgcn_mfma_f32_16x16x32_f16(atw, bw, accw[ct], 0, 0, 0);
                            acca[ct] = __builtin_amdgcn_mfma_f32_16x16x32_f16(aqa, ba, acca[ct], 0, 0, 0);
                        }
                    }
                    LDS_WAIT();
                    { LAS float* Zd = (LAS float*)priv + (lane >> 5) * 512 + (4 * ((lane >> 4) & 1)) * 64 + (lane & 15);
#pragma unroll
                      for (int ct = 0; ct < 4; ++ct)
#pragma unroll
                          for (int r = 0; r < 4; ++r) Zd[r * 64 + 16 * ct] = (lane < 32) ? accw[ct][r] : acca[ct][r]; }
                    LDS_WAIT();
                    const LAS float* Zw = (const LAS float*)priv + s_sub * 64 + c8; const LAS float* Za = Zw + 512;
                    const f32x4 zw0 = *(const LAS f32x4*)Zw, zw1 = *(const LAS f32x4*)(Zw + 4), za0 = *(const LAS f32x4*)Za, za1 = *(const LAS f32x4*)(Za + 4);
                    LDS_WAIT();
                    f32x2 kk[4], av_[4], kp[4], dec[4], kn2 = {0.f, 0.f}, sb2 = {0.f, 0.f};
#pragma unroll
                    for (int pi = 0; pi < 4; ++pi) {
                        const f32x2 zw = (pi < 2 ? (f32x2){zw0[2 * pi], zw0[2 * pi + 1]} : (f32x2){zw1[2 * pi - 4], zw1[2 * pi - 3]}) + w0r[pi];
                        const f32x2 za = (pi < 2 ? (f32x2){za0[2 * pi], za0[2 * pi + 1]} : (f32x2){za1[2 * pi - 4], za1[2 * pi - 3]}) + a0r[pi];
                        const f32x2 tw_ = zw * -1.4426950408889634f, ta_ = za * -1.4426950408889634f;
                        const f32x2 dw = (f32x2){__builtin_amdgcn_exp2f(tw_[0]), __builtin_amdgcn_exp2f(tw_[1])} + 1.f, da = (f32x2){__builtin_amdgcn_exp2f(ta_[0]), __builtin_amdgcn_exp2f(ta_[1])} + 1.f;
                        const f32x2 sw = (f32x2){__builtin_amdgcn_rcpf(dw[0]), __builtin_amdgcn_rcpf(dw[1])} * -0.8750387749225136f;
                        dec[pi] = (f32x2){__builtin_amdgcn_exp2f(sw[0]), __builtin_amdgcn_exp2f(sw[1])};
                        av_[pi] = (f32x2){__builtin_amdgcn_rcpf(da[0]), __builtin_amdgcn_rcpf(da[1])};
                        kk[pi] = qk[pi] * kkr[pi]; kn2 = kk[pi] * kk[pi] + kn2;
                        kp[pi] = qk[pi] * (av_[pi] * kar[pi] + omk[pi]);
                        sb2 = (qr[pi] * kp[pi]) * rkr[pi] + sb2; }
                    const float kn = red8(kn2[0] + kn2[1]), sbn = red8(sb2[0] + sb2[1]);
                    const float ninv = -rsqrtf(fmaxf(kn, 1e-12f));
                    LAS float* dR = OPS + (cn & 1) * SET_F + s_l * 64 + c8;
#pragma unroll
                    for (int hf = 0; hf < 2; ++hf) {
                        const f32x2 na0 = kk[2 * hf] * ninv, na1 = kk[2 * hf + 1] * ninv;
                        const f32x2 nb0 = na0 * av_[2 * hf], nb1 = na1 * av_[2 * hf + 1];
                        *(LAS f32x4*)(dR + 4 * hf) = (f32x4){qr[2 * hf][0], qr[2 * hf][1], qr[2 * hf + 1][0], qr[2 * hf + 1][1]};
                        *(LAS f32x4*)(dR + 2048 + 4 * hf) = (f32x4){dec[2 * hf][0], dec[2 * hf][1], dec[2 * hf + 1][0], dec[2 * hf + 1][1]};
                        *(LAS f32x4*)(dR + 4096 + 4 * hf) = (f32x4){kp[2 * hf][0], kp[2 * hf][1], kp[2 * hf + 1][0], kp[2 * hf + 1][1]};
                        *(LAS f32x4*)(dR + 6144 + 4 * hf) = (f32x4){na0[0], na0[1], na1[0], na1[1]};
                        *(LAS f32x4*)(dR + 8192 + 4 * hf) = (f32x4){-nb0[0], -nb0[1], -nb1[0], -nb1[1]}; }
                    if ((c8 >> 4) == q) { LAS float* dV = OPS + (cn & 1) * SET_F + 10240 + (c8 & 15) * 32 + s_l;
#pragma unroll
                        for (int e = 0; e < 8; ++e) dV[e * 32] = qv[e]; }
                    if (q == 0 && (lane & 7) == 0) SB[(size_t)(b * SEQ + t) * 16 + h] = sbn;
                }
                if (n >= 1) SCAN_YSTORE(n - 1);
            }
            LDS_BAR();
        }
        if (wave >= 4) SCAN_YSTORE(SEQ / 32 - 1);
#undef SCAN_LOAD
#undef SCAN_LOAD_RAW
#undef SCAN_YSTORE
    }
}

__device__ __forceinline__ void phase_post(const Params& p) {
    const int tid = threadIdx.x;
    const h16* Y0 = (const h16*)p.out; const h16* Y1 = (const h16*)((const unsigned char*)p.out + 32 * MiB);
    const h16* PC = (const h16*)(p.ws + WS_PC); h16* ZCD = (h16*)(p.ws + WS_ZCD);
    const float* SB0 = (const float*)(p.ws + WS_SBON); const float* SB1 = SB0 + (size_t)NTOK * 16;
    const float* mu0 = p.in[11] + 2048; const float* mu1 = p.in[11] + 3200 + 2048;
    const float* lg = p.in[19]; const float* lb = p.in[20];
    const int gt = blockIdx.x * 512 + tid, NGT = gridDim.x * 512;
    for (int idx = gt; idx < NTOK * 128; idx += NGT) {
        const int t = idx >> 7, c = (idx & 127) * 8, hh = c >> 6, tp = t & (SEQ - 1);
        const h16x8 y0 = *(const h16x8*)(Y0 + (size_t)t * 1024 + c), y1 = *(const h16x8*)(Y1 + (size_t)t * 1024 + c);
        const h16x8 z8 = {0, 0, 0, 0, 0, 0, 0, 0};
        const h16x8 v0 = *(const h16x8*)(PC + (size_t)t * 3200 + 2048 + c);
        const h16x8 vm = tp > 0 ? *(const h16x8*)(PC + (size_t)(t - 1) * 3200 + 2048 + c) : z8;
        const h16x8 vp = tp < SEQ - 1 ? *(const h16x8*)(PC + (size_t)(t + 1) * 3200 + 2048 + c) : z8;
        const h16x8 zc = *(const h16x8*)(ZCD + (size_t)t * 1536 + c);
        const float s0 = SB0[(size_t)t * 16 + hh], s1 = SB1[(size_t)t * 16 + hh];
        float y[8], s = 0.f;
#pragma unroll
        for (int e = 0; e < 8; ++e) { y[e] = (float)y0[e] + (float)y1[e]; s += y[e]; }
        const float mean = red8(s) * (1.f / 64.f); float q = 0.f;
#pragma unroll
        for (int e = 0; e < 8; ++e) { y[e] -= mean; q += y[e] * y[e]; }
        const float rs = rsqrtf(red8(q) * (1.f / 64.f) + 64e-5f);
        const f32x4 lg0 = *(const f32x4*)(lg + c), lg1 = *(const f32x4*)(lg + c + 4), lb0 = *(const f32x4*)(lb + c), lb1 = *(const f32x4*)(lb + c + 4);
        const f32x4 ma0 = *(const f32x4*)(mu0 + c), ma1 = *(const f32x4*)(mu0 + c + 4), mb0 = *(const f32x4*)(mu1 + c), mb1 = *(const f32x4*)(mu1 + c + 4);
        h16x8 o;
#pragma unroll
        for (int e = 0; e < 8; ++e) { const float vv = (float)v0[e];
            const float m0 = e < 4 ? ma0[e & 3] : ma1[e & 3], m1 = e < 4 ? mb0[e & 3] : mb1[e & 3], gg = e < 4 ? lg0[e & 3] : lg1[e & 3], bb = e < 4 ? lb0[e & 3] : lb1[e & 3];
            const float vd0 = vv + m0 * ((float)vm[e] - vv), vd1 = vv + m1 * ((float)vp[e] - vv);
            const float val = y[e] * rs * gg + bb + s0 * vd0 + s1 * vd1;
            o[e] = (h16)(val * silu_f((float)zc[e])); }
        *(h16x8*)(ZCD + (size_t)t * 1536 + c) = o;
    }
}

__device__ __forceinline__ void phase_final(const Params& p) {
    const int tid = threadIdx.x, lane = tid & 63, wave = tid >> 6;
    const int gw = blockIdx.x * 8 + wave, NGW = gridDim.x * 8;
    const float* g = p.in[23]; const h16* O1 = (const h16*)(p.ws + WS_O1); const h16* O2 = (const h16*)(p.ws + WS_O2);
    for (int r = gw; r < NTOK; r += 2 * NGW) {
        const int rr[2] = {r, (r + NGW < NTOK) ? r + NGW : r};
        f32x4 v[2][4]; h16x4 a[2][4], b[2][4]; float ss[2] = {0.f, 0.f};
#pragma unroll
        for (int u = 0; u < 2; ++u)
#pragma unroll
            for (int j = 0; j < 4; ++j) { const size_t o = (size_t)rr[u] * DM + 4 * lane + 256 * j; v[u][j] = *(const f32x4*)(p.in[0] + o); a[u][j] = *(const h16x4*)(O1 + o); b[u][j] = *(const h16x4*)(O2 + o); }
#pragma unroll
        for (int u = 0; u < 2; ++u)
#pragma unroll
            for (int j = 0; j < 4; ++j) {
#pragma unroll
                for (int e = 0; e < 4; ++e) v[u][j][e] += (float)a[u][j][e] + (float)b[u][j][e];
                ss[u] += v[u][j][0] * v[u][j][0] + v[u][j][1] * v[u][j][1] + v[u][j][2] * v[u][j][2] + v[u][j][3] * v[u][j][3]; }
#pragma unroll
        for (int o = 1; o < 64; o <<= 1) { ss[0] += __shfl_xor(ss[0], o); ss[1] += __shfl_xor(ss[1], o); }
        const float rs[2] = {rsqrtf(ss[0] * (1.f / 1024.f) + 1e-6f), rsqrtf(ss[1] * (1.f / 1024.f) + 1e-6f)};
#pragma unroll
        for (int j = 0; j < 4; ++j) { const f32x4 gg = *(const f32x4*)(g + 4 * lane + 256 * j);
#pragma unroll
            for (int u = 0; u < 2; ++u) { f32x4 o = v[u][j] * rs[u]; o = o * gg; *(f32x4*)(p.out + (size_t)rr[u] * DM + 4 * lane + 256 * j) = o; } }
    }
}

__global__ void __launch_bounds__(512, 2) mega(Params p) {
    extern __shared__ __attribute__((aligned(16))) unsigned char smem[];
    LAS unsigned char* lds = (LAS unsigned char*)smem;
    cg::grid_group grid = cg::this_grid();
    unsigned char* ws = p.ws;
    const int lo = p.ph_lo, hi = p.ph_hi;
#define IN(k) (lo <= (k) && (k) < hi)
    volatile LAS unsigned* bst = (volatile LAS unsigned*)(lds + LDS_MAIN);
    if (threadIdx.x < 4) bst[threadIdx.x] = 0u;
    __syncthreads();
    const XcdBarrier bar = xcd_barrier_post((unsigned*)(ws + WS_BAR), bst);
    if (hi > 1000) grid.sync();
#define SEAM(k) do { if (IN(k) && IN((k) + 1)) { xcd_barrier(bar); if ((REPMASK >> 13) & 1) xcd_barrier(bar); } } while (0)
    if (IN(0)) for (int rep_ = 0; rep_ <= ((REPMASK >> 0) & 1); ++rep_) { phase0(p, lds); } SEAM(0);
    if (IN(1)) for (int rep_ = 0; rep_ <= ((REPMASK >> 1) & 1); ++rep_) { pg8::Gemm g{(const h16*)p.out, (const h16*)(ws + WS_W1T), NTOK, 7168, 1024}; pg8::StaticOrder S; S.init(NTOK, 7168, gridDim.x, blockIdx.x);
                 Epi1 E{(h16*)(ws + WS_XC), (h16*)(ws + WS_G), (h16*)(ws + WS_U), (h16*)(ws + WS_V), (float*)(ws + WS_STATS)}; pg8::gemm_phase<Epi1>(lds, g, S, E); } SEAM(1);
    if (IN(3)) for (int rep_ = 0; rep_ <= ((REPMASK >> 3) & 1); ++rep_) { phase_mix0(p, lds); } SEAM(3);
    if (IN(4)) for (int rep_ = 0; rep_ <= ((REPMASK >> 4) & 1); ++rep_) { pg8::Gemm g{(const h16*)(ws + WS_YCAT), (const h16*)(ws + WS_W2T), NTOK, 1024, 2048}; pg8::StaticOrder S; S.init(NTOK, 1024, gridDim.x, blockIdx.x);
                 Epi2 E{(h16*)(ws + WS_O1)}; pg8::gemm_phase<Epi2>(lds, g, S, E); } SEAM(4);
    if (IN(5)) for (int rep_ = 0; rep_ <= ((REPMASK >> 5) & 1); ++rep_) { phase_norm1(p); } SEAM(5);
    if (IN(6)) for (int rep_ = 0; rep_ <= ((REPMASK >> 6) & 1); ++rep_) { pg8::Gemm g{(const h16*)p.out, (const h16*)(ws + WS_W3T), NTOK, 5376, 1024}; pg8::StaticOrder S; S.init(NTOK, 5376, gridDim.x, blockIdx.x);
                 Epi3 E{(h16*)(ws + WS_PC), (h16*)(ws + WS_ZCD), (h16*)(ws + WS_FD)}; pg8::gemm_phase<Epi3>(lds, g, S, E); } SEAM(6);
    if (IN(7)) for (int rep_ = 0; rep_ <= ((REPMASK >> 7) & 1); ++rep_) { phase_fft(p, lds); }
    if (IN(8)) for (int rep_ = 0; rep_ <= ((REPMASK >> 8) & 1); ++rep_) { phase_scan(p, lds); } SEAM(8);
    if (IN(9)) for (int rep_ = 0; rep_ <= ((REPMASK >> 9) & 1); ++rep_) { phase_fnet_out(p, lds); }
    if (IN(10)) for (int rep_ = 0; rep_ <= ((REPMASK >> 10) & 1); ++rep_) { phase_post(p); } SEAM(10);
    if (IN(11)) for (int rep_ = 0; rep_ <= ((REPMASK >> 11) & 1); ++rep_) { pg8::Gemm g{(const h16*)(ws + WS_ZCD), (const h16*)(ws + WS_W4T), NTOK, 1024, 1536}; pg8::StaticOrder S; S.init(NTOK, 1024, gridDim.x, blockIdx.x);
                  Epi4 E{(h16*)(ws + WS_O2)}; pg8::gemm_phase<Epi4>(lds, g, S, E); } SEAM(11);
    if (IN(12)) for (int rep_ = 0; rep_ <= ((REPMASK >> 12) & 1); ++rep_) { phase_final(p); }
}

extern "C" void kernel_launch(void* const* d_in, const int* in_sizes, int n_in, void* d_out, int out_size, void* d_ws, size_t ws_size, hipStream_t stream) {
    static int grid = 0;
    if (grid == 0) {
        int dev = 0, cus = 0, per_cu = 0;
        hipGetDevice(&dev);
        hipDeviceGetAttribute(&cus, hipDeviceAttributeMultiprocessorCount, dev);
        if (hipFuncSetAttribute((const void*)mega, hipFuncAttributeMaxDynamicSharedMemorySize, LDS_BYTES) != hipSuccess) fprintf(stderr, "kernel_launch: hipFuncSetAttribute failed\n");
        hipOccupancyMaxActiveBlocksPerMultiprocessor(&per_cu, (const void*)mega, 512, LDS_BYTES);
        if (per_cu < 1) { fprintf(stderr, "kernel_launch: occupancy query says %d blocks per CU\n", per_cu); per_cu = 1; }
        (void)hipGetLastError();
        grid = cus;
        if (grid < 64) grid = 64;
    }
    if (hipMemsetAsync((unsigned char*)d_ws + WS_BAR, 0, XCD_BAR_WORDS * 4, stream) != hipSuccess) fprintf(stderr, "kernel_launch: memset of the barrier words failed\n");
    Params p{};
    for (int i = 0; i < 24; ++i) p.in[i] = (const float*)d_in[i];
    p.out = (float*)d_out; p.ws = (unsigned char*)d_ws;
#if N_LAUNCH_MODE == 1
    p.ph_lo = 0; p.ph_hi = NPHASE;
    void* args[] = {&p};
    hipError_t e = hipLaunchCooperativeKernel((const void*)mega, dim3(grid), dim3(512), args, LDS_BYTES, stream);
    if (e != hipSuccess) fprintf(stderr, "kernel_launch: cooperative launch failed: %s (grid %d)\n", hipGetErrorString(e), grid);
#else
    for (int ph = 0; ph < NPHASE; ++ph) { p.ph_lo = ph; p.ph_hi = ph + 1; hipLaunchKernelGGL(mega, dim3(grid), dim3(512), LDS_BYTES, stream, p); }
#endif
}
```
